# Optimizing an MI355X kernel written in HIP

```python
import jax, jax.numpy as jnp
from jax import lax
import numpy as np

D_MODEL = 2048
BATCH = 4
SEQ = 8192
DEPTH = 4

GRID_W = 64
CTX_LEN = 256
HEAD_DIM = 128
ROPE_THETA = 10000.0

RET_HEADS = 4
RET_DIM = RET_HEADS * HEAD_DIM
RET_CHUNK = 128
SWA_HEADS = 6
SWA_KV_HEADS = 2
SWA_GROUP = SWA_HEADS // SWA_KV_HEADS
SWA_WINDOW = 128
SWA_BLOCK = 128
MLA_HEADS = 6
MLA_Q_RANK = 512
MLA_KV_RANK = 256
MLA_NOPE_DIM = 128
MLA_ROPE_DIM = 64
MLA_V_DIM = 128
MLA_Q_BLOCK = 128
MLA_SCALE = (MLA_NOPE_DIM + MLA_ROPE_DIM) ** -0.5

MIX_WIDTH = RET_DIM + SWA_HEADS * HEAD_DIM + MLA_HEADS * MLA_V_DIM
IN_SPLITS = (RET_DIM, RET_DIM, RET_DIM, RET_DIM,
             SWA_HEADS * HEAD_DIM, SWA_KV_HEADS * HEAD_DIM, SWA_KV_HEADS * HEAD_DIM,
             MLA_Q_RANK, MLA_KV_RANK, MLA_ROPE_DIM)
IN_WIDTH = 4 * RET_DIM + (SWA_HEADS + 2 * SWA_KV_HEADS) * HEAD_DIM + MLA_Q_RANK + MLA_KV_RANK + MLA_ROPE_DIM

D_FF = 5632
CONV_W = 3
N_MOD = 6
LN_EPS = 1e-5
RMS_EPS = 1e-6
NEG_INF = -1e30
DEEPNORM_ALPHA = (2 * DEPTH) ** 0.25
DEEPNORM_BETA = (8 * DEPTH) ** -0.25

kernel_name = "hybrid_ret_swa_mla_dit_trunk"


def layer_norm(x, g, b):
    xf = x.astype(jnp.float32)
    mu = jnp.mean(xf, -1, keepdims=True)
    var = jnp.mean(jnp.square(xf - mu), -1, keepdims=True)
    return ((xf - mu) * lax.rsqrt(var + LN_EPS)).astype(x.dtype) * g + b


def rms_norm(x, g=None):
    xf = x.astype(jnp.float32)
    y = (xf * lax.rsqrt(jnp.mean(jnp.square(xf), -1, keepdims=True) + RMS_EPS)).astype(x.dtype)
    return y if g is None else y * g


def heads(t, n):
    return t.reshape(t.shape[:-1] + (n, t.shape[-1] // n))


def axial_rope_tables(n_tokens, dim):
    rows = n_tokens // GRID_W
    r, cc = jnp.meshgrid(jnp.arange(rows, dtype=jnp.float32), jnp.arange(GRID_W, dtype=jnp.float32), indexing="ij")
    r = r.reshape(-1)
    cc = cc.reshape(-1)
    n_freq = dim // 4
    inv = ROPE_THETA ** (-jnp.arange(n_freq, dtype=jnp.float32) / n_freq)
    ang_r = r[:, None] * inv
    ang_c = cc[:, None] * inv
    ang = jnp.concatenate([ang_r, ang_r, ang_c, ang_c], axis=-1)
    return jnp.cos(ang), jnp.sin(ang)


def apply_rope(x, cos, sin):
    nq = x.shape[-1] // 4
    xr = x.reshape(x.shape[:-1] + (2, 2, nq))
    rot = jnp.stack([-xr[..., 1, :], xr[..., 0, :]], axis=-2).reshape(x.shape)
    return x * cos[:, None, :].astype(x.dtype) + rot * sin[:, None, :].astype(x.dtype)


def retention_scan(q, k, v, log_gamma, state0):
    B, L, H, dk = q.shape
    dv = v.shape[-1]
    C = RET_CHUNK
    N = L // C
    dt = q.dtype
    qc = q.reshape(B, N, C, H, dk)
    kc = k.reshape(B, N, C, H, dk)
    vc = v.reshape(B, N, C, H, dv)
    pos = jnp.arange(C, dtype=jnp.float32)
    diff = pos[:, None] - pos[None, :]
    intra = jnp.where(diff >= 0, jnp.exp(log_gamma[:, None, None] * jnp.maximum(diff, 0.0)), 0.0).astype(dt)
    q_decay = jnp.exp(log_gamma[:, None] * (pos + 1.0)).astype(dt)
    k_decay = jnp.exp(log_gamma[:, None] * (C - 1.0 - pos)).astype(dt)
    chunk_decay = jnp.exp(log_gamma * C).astype(dt)[None, :, None, None]
    scores = jnp.einsum("bnihd,bnjhd->bnhij", qc, kc) * intra
    inner = jnp.einsum("bnhij,bnjhe->bnihe", scores, vc)
    kv = jnp.einsum("bnjhd,bnjhe,hj->nbhde", kc, vc, k_decay)

    def step(s, kv_n):
        return chunk_decay * s + kv_n, s

    s_final, s_in = lax.scan(step, state0, kv)
    cross = jnp.einsum("bnihd,nbhde,hi->bnihe", qc, s_in, q_decay)
    return (inner + cross).reshape(B, L, H, dv), s_final


def retention_bidir(q, k, v, lg_f, lg_b, s0_f, s0_b):
    out_f, s_f = retention_scan(q, k, v, lg_f, s0_f)
    out_b, s_b = retention_scan(q[:, ::-1], k[:, ::-1], v[:, ::-1], lg_b, s0_b)
    return out_f + out_b[:, ::-1], s_f, s_b


def softmax_with_sink(s, sink_kg):
    col = jnp.broadcast_to(sink_kg[:, :, None, None], s.shape[:-1] + (1,))
    p = jax.nn.softmax(jnp.concatenate([s, col], axis=-1), axis=-1)
    return p[..., :-1]


def swa_latent(q, k, v, k_ctx, v_ctx, sink_kg):
    B, L, H, d = q.shape
    Cb = SWA_BLOCK
    N = L // Cb
    qb = q.reshape(B, N, Cb, SWA_KV_HEADS, SWA_GROUP, d)

    def band(t):
        tp = jnp.pad(t, ((0, 0), (Cb, Cb), (0, 0), (0, 0))).reshape(B, N + 2, Cb, SWA_KV_HEADS, d)
        return jnp.concatenate([tp[:, :-2], tp[:, 1:-1], tp[:, 2:]], axis=2)

    kw, vw = band(k), band(v)
    scale = d ** -0.5
    s_loc = jnp.einsum("bnqkgd,bnskd->bnkgqs", qb, kw).astype(jnp.float32) * scale
    n_i = jnp.arange(N)[:, None, None]
    q_i = jnp.arange(Cb)[None, :, None]
    s_j = jnp.arange(3 * Cb)[None, None, :]
    key_pos = n_i * Cb + s_j - Cb
    valid = (jnp.abs(key_pos - (n_i * Cb + q_i)) <= SWA_WINDOW) & (key_pos >= 0) & (key_pos < L)
    s_loc = jnp.where(valid[None, :, None, None], s_loc, NEG_INF)
    s_ctx = jnp.einsum("bnqkgd,btkd->bnkgqt", qb, k_ctx).astype(jnp.float32) * scale
    p = softmax_with_sink(jnp.concatenate([s_loc, s_ctx], axis=-1), sink_kg).astype(v.dtype)
    out = (jnp.einsum("bnkgqs,bnskd->bnqkgd", p[..., :3 * Cb], vw)
           + jnp.einsum("bnkgqt,btkd->bnqkgd", p[..., 3 * Cb:], v_ctx))
    return out.reshape(B, L, H * d)


def swa_context(q, k, v, sink_kg):
    B, T, H, d = q.shape
    qg = q.reshape(B, T, SWA_KV_HEADS, SWA_GROUP, d)
    s = jnp.einsum("btkgd,bskd->bkgts", qg, k).astype(jnp.float32) * d ** -0.5
    p = softmax_with_sink(s, sink_kg).astype(v.dtype)
    return jnp.einsum("bkgts,bskd->btkgd", p, v).reshape(B, T, H * d)


def mla_project(cq, ckv, kr, q_norm, w_uq, kv_norm, w_ukv, cos, sin):
    B, L, _ = cq.shape
    q = (rms_norm(cq, q_norm) @ w_uq).reshape(B, L, MLA_HEADS, MLA_NOPE_DIM + MLA_ROPE_DIM)
    q_nope, q_rope = q[..., :MLA_NOPE_DIM], q[..., MLA_NOPE_DIM:]
    kv = (rms_norm(ckv, kv_norm) @ w_ukv).reshape(B, L, MLA_HEADS, MLA_NOPE_DIM + MLA_V_DIM)
    k_nope, v = kv[..., :MLA_NOPE_DIM], kv[..., MLA_NOPE_DIM:]
    k_rope = kr[:, :, None, :]
    if cos is not None:
        q_rope = apply_rope(q_rope, cos, sin)
        k_rope = apply_rope(k_rope, cos, sin)
    return q_nope, q_rope, k_nope, k_rope[:, :, 0], v


def mla_attend(q_nope, q_rope, k_nope, k_rope, v):
    s = (jnp.einsum("bqhd,bshd->bhqs", q_nope, k_nope)
         + jnp.einsum("bqhr,bsr->bhqs", q_rope, k_rope)).astype(jnp.float32) * MLA_SCALE
    p = jax.nn.softmax(s, axis=-1).astype(v.dtype)
    return jnp.einsum("bhqs,bshd->bqhd", p, v)


def mla_latent(qn, qr, kn, kr, v):
    B, L, H, _ = qn.shape
    N = L // MLA_Q_BLOCK

    def blocks(t):
        return jnp.moveaxis(t.reshape((B, N, MLA_Q_BLOCK) + t.shape[2:]), 1, 0)

    out = lax.map(lambda qs: mla_attend(qs[0], qs[1], kn, kr, v), (blocks(qn), blocks(qr)))
    return jnp.moveaxis(out, 0, 1).reshape(B, L, H * MLA_V_DIM)


def conv_ffn(h, w_up, conv_w, conv_b, w_down):
    L = h.shape[1]
    u, g = jnp.split(h @ w_up, 2, axis=-1)
    pad = CONV_W // 2
    gp = jnp.pad(g, ((0, 0), (pad, pad), (0, 0)))
    g = sum(gp[:, j:j + L] * conv_w[j] for j in range(CONV_W)) + conv_b
    return (jax.nn.silu(g) * u) @ w_down


def setup_inputs(seed: int = 0) -> dict:
    key = jax.random.key(seed)
    ks = jax.random.split(key, 24)
    f32 = jnp.float32

    def nrm(k, shape, scale):
        return jax.random.normal(k, shape, f32) * scale

    gam = 1.0 - 2.0 ** (-5.0 - np.arange(RET_HEADS))
    logit = jnp.asarray(np.log(gam / (1.0 - gam)), f32)
    return {
        "x": nrm(ks[0], (BATCH, SEQ, D_MODEL), 1.0),
        "c": nrm(ks[1], (BATCH, D_MODEL), 1.0),
        "ctx": nrm(ks[2], (BATCH, CTX_LEN, D_MODEL), 1.0),
        "c_ctx": nrm(ks[3], (D_MODEL,), 1.0),
        "ada_w": nrm(ks[4], (DEPTH, D_MODEL, N_MOD * D_MODEL), 0.5 * D_MODEL ** -0.5),
        "ada_b": nrm(ks[5], (DEPTH, N_MOD * D_MODEL), 0.02),
        "w_in": nrm(ks[6], (DEPTH, D_MODEL, IN_WIDTH), D_MODEL ** -0.5),
        "ret_decay_fwd": logit + nrm(ks[7], (DEPTH, RET_HEADS), 0.1),
        "ret_decay_bwd": logit + nrm(ks[8], (DEPTH, RET_HEADS), 0.1),
        "swa_sink": nrm(ks[9], (DEPTH, SWA_HEADS), 0.5),
        "mla_q_norm": 1.0 + nrm(ks[10], (DEPTH, MLA_Q_RANK), 0.02),
        "mla_w_uq": nrm(ks[11], (DEPTH, MLA_Q_RANK, MLA_HEADS * (MLA_NOPE_DIM + MLA_ROPE_DIM)), MLA_Q_RANK ** -0.5),
        "mla_kv_norm": 1.0 + nrm(ks[12], (DEPTH, MLA_KV_RANK), 0.02),
        "mla_w_ukv": nrm(ks[13], (DEPTH, MLA_KV_RANK, MLA_HEADS * (MLA_NOPE_DIM + MLA_V_DIM)), MLA_KV_RANK ** -0.5),
        "w_o": nrm(ks[14], (DEPTH, MIX_WIDTH, D_MODEL), DEEPNORM_BETA * MIX_WIDTH ** -0.5),
        "ln1_g": 1.0 + nrm(ks[15], (DEPTH, D_MODEL), 0.02),
        "ln1_b": nrm(ks[16], (DEPTH, D_MODEL), 0.02),
        "ffn_w_up": nrm(ks[17], (DEPTH, D_MODEL, 2 * D_FF), D_MODEL ** -0.5),
        "ffn_conv_w": nrm(ks[18], (DEPTH, CONV_W, D_FF), CONV_W ** -0.5),
        "ffn_conv_b": nrm(ks[19], (DEPTH, D_FF), 0.02),
        "ffn_w_down": nrm(ks[20], (DEPTH, D_FF, D_MODEL), DEEPNORM_BETA * D_FF ** -0.5),
        "ln2_g": 1.0 + nrm(ks[21], (DEPTH, D_MODEL), 0.02),
        "ln2_b": nrm(ks[22], (DEPTH, D_MODEL), 0.02),
    }


def reference(x, c, ctx, c_ctx, ada_w, ada_b, w_in, ret_decay_fwd, ret_decay_bwd, swa_sink,
              mla_q_norm, mla_w_uq, mla_kv_norm, mla_w_ukv, w_o, ln1_g, ln1_b,
              ffn_w_up, ffn_conv_w, ffn_conv_b, ffn_w_down, ln2_g, ln2_b):
    B, L, _ = x.shape
    T = ctx.shape[1]
    cos_h, sin_h = axial_rope_tables(L, HEAD_DIM)
    cos_m, sin_m = axial_rope_tables(L, MLA_ROPE_DIM)
    split_idx = np.cumsum(IN_SPLITS)[:-1].tolist()
    k_scale = HEAD_DIM ** -0.5
    sc = jax.nn.silu(c)
    scc = jax.nn.silu(c_ctx)
    xc = ctx
    for l in range(DEPTH):
        last = l == DEPTH - 1
        mx = [m[:, None, :] for m in jnp.split(sc @ ada_w[l] + ada_b[l], N_MOD, axis=-1)]
        mc = jnp.split(scc @ ada_w[l] + ada_b[l], N_MOD, axis=-1)
        hx = x * (1.0 + mx[1]) + mx[0]
        hc = xc * (1.0 + mc[1]) + mc[0]
        (rq, rk, rv, rg, sq, sk, sv, mcq, mckv, mkr) = jnp.split(hx @ w_in[l], split_idx, axis=-1)
        (rq_c, rk_c, rv_c, rg_c, sq_c, sk_c, sv_c, mcq_c, mckv_c, mkr_c) = jnp.split(hc @ w_in[l], split_idx, axis=-1)

        lg_f = jax.nn.log_sigmoid(ret_decay_fwd[l].astype(jnp.float32))
        lg_b = jax.nn.log_sigmoid(ret_decay_bwd[l].astype(jnp.float32))
        s0 = jnp.zeros((B, RET_HEADS, HEAD_DIM, HEAD_DIM), x.dtype)
        ret_c, st_f, st_b = retention_bidir(heads(rq_c, RET_HEADS), heads(rk_c, RET_HEADS) * k_scale,
                                            heads(rv_c, RET_HEADS), lg_f, lg_b, s0, s0)
        ret_x, _, _ = retention_bidir(apply_rope(heads(rq, RET_HEADS), cos_h, sin_h),
                                      apply_rope(heads(rk, RET_HEADS), cos_h, sin_h) * k_scale,
                                      heads(rv, RET_HEADS), lg_f, lg_b, st_f, st_b)
        y_ret = jax.nn.silu(rg) * rms_norm(ret_x).reshape(B, L, RET_DIM)

        sink_kg = swa_sink[l].astype(jnp.float32).reshape(SWA_KV_HEADS, SWA_GROUP)
        k_sc = heads(sk_c, SWA_KV_HEADS)
        v_sc = heads(sv_c, SWA_KV_HEADS)
        y_swa = swa_latent(apply_rope(heads(sq, SWA_HEADS), cos_h, sin_h),
                           apply_rope(heads(sk, SWA_KV_HEADS), cos_h, sin_h),
                           heads(sv, SWA_KV_HEADS), k_sc, v_sc, sink_kg)

        qn_x, qr_x, kn_x, kr_x, v_x = mla_project(mcq, mckv, mkr, mla_q_norm[l], mla_w_uq[l],
                                                  mla_kv_norm[l], mla_w_ukv[l], cos_m, sin_m)
        qn_c, qr_c, kn_c, kr_c, v_mc = mla_project(mcq_c, mckv_c, mkr_c, mla_q_norm[l], mla_w_uq[l],
                                                   mla_kv_norm[l], mla_w_ukv[l], None, None)
        y_mla = mla_latent(qn_x, qr_x, jnp.concatenate([kn_x, kn_c], axis=1),
                           jnp.concatenate([kr_x, kr_c], axis=1), jnp.concatenate([v_x, v_mc], axis=1))

        mix_x = jnp.concatenate([y_ret, y_swa, y_mla], axis=-1) @ w_o[l]
        x_a = layer_norm(DEEPNORM_ALPHA * x + (1.0 + mx[2]) * mix_x, ln1_g[l], ln1_b[l])
        f_x = conv_ffn(x_a * (1.0 + mx[4]) + mx[3], ffn_w_up[l], ffn_conv_w[l], ffn_conv_b[l], ffn_w_down[l])
        x_new = layer_norm(DEEPNORM_ALPHA * x_a + (1.0 + mx[5]) * f_x, ln2_g[l], ln2_b[l])

        if not last:
            y_ret_c = jax.nn.silu(rg_c) * rms_norm(ret_c).reshape(B, T, RET_DIM)
            y_swa_c = swa_context(heads(sq_c, SWA_HEADS), k_sc, v_sc, sink_kg)
            y_mla_c = mla_attend(qn_c, qr_c, kn_c, kr_c, v_mc).reshape(B, T, MLA_HEADS * MLA_V_DIM)
            mix_c = jnp.concatenate([y_ret_c, y_swa_c, y_mla_c], axis=-1) @ w_o[l]
            xc_a = layer_norm(DEEPNORM_ALPHA * xc + (1.0 + mc[2]) * mix_c, ln1_g[l], ln1_b[l])
            f_c = conv_ffn(xc_a * (1.0 + mc[4]) + mc[3], ffn_w_up[l], ffn_conv_w[l], ffn_conv_b[l], ffn_w_down[l])
            xc = layer_norm(DEEPNORM_ALPHA * xc_a + (1.0 + mc[5]) * f_c, ln2_g[l], ln2_b[l])
        x = x_new
    return x
```

```cpp
#include <hip/hip_runtime.h>
#include <cstdio>
#include <cstdint>

#define LAS __attribute__((address_space(3)))
typedef unsigned short bf16_t;
typedef short bf16x8 __attribute__((ext_vector_type(8)));
typedef short s16x4 __attribute__((ext_vector_type(4)));
typedef float f32x4 __attribute__((ext_vector_type(4)));
typedef float f32x16 __attribute__((ext_vector_type(16)));
typedef unsigned u32x4 __attribute__((ext_vector_type(4)));
typedef unsigned u32x2 __attribute__((ext_vector_type(2)));

#ifndef MK_ONE_LAUNCH
#define MK_ONE_LAUNCH 1
#endif

constexpr int D = 2048, NB = 4, SEQ = 8192, DEPTH = 4, CTXL = 256;
constexpr int NLAT = NB * SEQ, NCTX = NB * CTXL, NROWS = NLAT + NCTX;
constexpr int INW = 4160, INWP = 4352, DFF = 5632, DFF2 = 11264;
constexpr int QUPW = 1152, QUPWP = 1280, KVUPW = 1536;
constexpr int NMOD = 6, MODW = NMOD * D;
constexpr float LN_EPS = 1e-5f, RMS_EPS = 1e-6f;
constexpr float ALPHA = 1.6817928305074292f;
constexpr float KSCALE = 0.08838834764831845f;
constexpr float MLA_QSCALE = 0.07216878364870323f * 1.4426950408889634f;
constexpr float LOG2E = 1.4426950408889634f;

constexpr size_t MiB = 1u << 20;
constexpr size_t WS_CTL = 0, CTL_BYTES = 1 * MiB;
constexpr size_t WS_MOD = 1 * MiB;
constexpr size_t WS_ROPE = 2 * MiB;
constexpr size_t WS_SM = 2 * MiB + 65536;
constexpr int SM_DECF = 0, SM_DECB = 16, SM_SINK = 32, SM_LN1G = 64, SM_LN1B = SM_LN1G + DEPTH * D, SM_LN2G = SM_LN1B + DEPTH * D, SM_LN2B = SM_LN2G + DEPTH * D,
              SM_CONVW = SM_LN2B + DEPTH * D, SM_CONVB = SM_CONVW + DEPTH * 3 * DFF, SM_END = SM_CONVB + DEPTH * DFF;
static_assert(WS_SM + (size_t)SM_END * 4 <= 3 * MiB, "small vectors");
constexpr size_t WS_RS = 3 * MiB;
constexpr size_t WS_W = 5 * MiB;
constexpr size_t W_IN = 0, W_UQ = W_IN + (size_t)INWP * D, W_UKV = W_UQ + (size_t)QUPWP * 512, W_O = W_UKV + (size_t)KVUPW * 256,
                 W_UP = W_O + (size_t)D * D, W_DN = W_UP + (size_t)DFF2 * D, W_LAYER = W_DN + (size_t)D * DFF;
constexpr size_t WS_X = WS_W + W_LAYER * 2 * DEPTH;
constexpr size_t WS_H = WS_X + (size_t)NROWS * D * 4;
constexpr size_t WS_Y = WS_H + (size_t)NROWS * D * 2;
constexpr size_t WS_PROJ = WS_Y + (size_t)NROWS * D * 2;
constexpr size_t WS_QUP = WS_PROJ + (size_t)NROWS * INW * 2;
constexpr size_t WS_KVUP = WS_QUP + (size_t)NROWS * QUPW * 2;
constexpr size_t WS_KVS = WS_KVUP + (size_t)NROWS * KVUPW * 2;
constexpr size_t WS_SIN = WS_KVS + (size_t)NB * 4 * 2 * 33 * 16384 * 4;
constexpr size_t WS_END = WS_SIN + (size_t)NB * 4 * 2 * 33 * 16384 * 2;
constexpr int FCH_LAT = 64 * 256, FCH_ROWS = FCH_LAT + NCTX;
constexpr size_t WS_ACT0 = WS_Y;
constexpr size_t WS_ACT1 = WS_ACT0 + (size_t)FCH_ROWS * DFF * 2;
constexpr int NGRP = FCH_ROWS / 64;
constexpr size_t WS_SB = WS_ACT1 + (size_t)FCH_LAT * DFF * 2;
static_assert(WS_SB + (size_t)2 * NGRP * 3 * DFF * 4 <= WS_QUP, "FFN overlay");
constexpr size_t WS_MIX = WS_QUP;
static_assert(WS_MIX >= WS_QUP && WS_MIX + (size_t)NROWS * D * 2 <= WS_END, "FFN overlay");
static_assert(WS_W % 256 == 0 && W_LAYER % 128 == 0 && WS_X % 256 == 0, "align");

constexpr int LDS_BYTES = 131072 + 512;

#define XB_TMO      128
#define XB_XCNT(j)  (256  + 64 * (j))
#define XB_XSUB(j)  (1280 + 64 * (j))
#define XB_XGEN(j)  (2304 + 64 * (j))
#define XB_TOP      3328
#define XB_TOPGEN   3392
#define XCD_BAR_WORDS 3456
#define XB_SPIN_CAP (1u << 20)

__device__ __forceinline__ unsigned xb_ld(unsigned* p)              { return __hip_atomic_load(p, __ATOMIC_RELAXED, __HIP_MEMORY_SCOPE_AGENT); }
__device__ __forceinline__ unsigned xb_add(unsigned* p, unsigned v) { return __hip_atomic_fetch_add(p, v, __ATOMIC_RELAXED, __HIP_MEMORY_SCOPE_AGENT); }
__device__ __forceinline__ unsigned xb_xcc_id() { return (unsigned)__builtin_amdgcn_s_getreg((3 << 11) | 20) & 0xFu; }
#define XB_SPIN(cond, bar) do { unsigned _sp = 0; while (cond) { __builtin_amdgcn_s_sleep(1); \
    if ((++_sp & 255u) == 0u) { if (xb_ld(&(bar)[XB_TMO])) break; if (_sp > XB_SPIN_CAP) { atomicAdd(&(bar)[XB_TMO], 1u); break; } } } } while (0)

struct XcdBarrier { unsigned* bar; unsigned x; volatile LAS unsigned* st; };

__device__ __forceinline__ XcdBarrier xcd_barrier_post(unsigned* bar, volatile LAS unsigned* st) {
    XcdBarrier b; b.bar = bar; b.x = xb_xcc_id(); b.st = st;
    if (threadIdx.x == 0) (void)xb_add(&bar[XB_XCNT(b.x)], 1u);
    return b;
}
__device__ __forceinline__ void xcd_barrier_complete(unsigned* bar, unsigned x, unsigned& nloc, unsigned& nx) {
    const unsigned G = gridDim.x * gridDim.y * gridDim.z;
    unsigned sum, cnt, mine, sp = 0u;
    for (;;) {
        sum = 0u; cnt = 0u; mine = 0u;
#pragma unroll
        for (unsigned j = 0; j < 16; ++j) { const unsigned c = xb_ld(&bar[XB_XCNT(j)]); sum += c; cnt += (c > 0u) ? 1u : 0u; mine = (j == x) ? c : mine; }
        if (sum == G) break;
        __builtin_amdgcn_s_sleep(1);
        if ((++sp & 255u) == 0u) { if (xb_ld(&bar[XB_TMO])) break; if (sp > XB_SPIN_CAP) { atomicAdd(&bar[XB_TMO], 1u); break; } }
    }
    nloc = mine > 0u ? mine : 1u; nx = cnt > 0u ? cnt : 1u;
}
__device__ __forceinline__ void xcd_barrier(const XcdBarrier& b) {
    asm volatile("s_waitcnt vmcnt(0)" ::: "memory");
    __syncthreads();
    if (threadIdx.x == 0) {
        unsigned* bar = b.bar;
        __builtin_amdgcn_s_waitcnt(0);
        unsigned nloc = b.st[0], nx = b.st[1];
        if (nloc == 0u) { xcd_barrier_complete(bar, b.x, nloc, nx); b.st[0] = nloc; b.st[1] = nx; }
        const unsigned old = xb_add(&bar[XB_XSUB(b.x)], 1u);
        const unsigned gen = old / nloc;
        if (old + 1u == (gen + 1u) * nloc) {
            __builtin_amdgcn_fence(__ATOMIC_RELEASE, "agent");
            asm volatile("s_waitcnt vmcnt(0)" ::: "memory");
            const unsigned og = xb_add(&bar[XB_TOP], 1u);
            const unsigned tg = og / nx;
            if (og + 1u == (tg + 1u) * nx) xb_add(&bar[XB_TOPGEN], 1u);
            else XB_SPIN(xb_ld(&bar[XB_TOPGEN]) == tg, bar);
            __builtin_amdgcn_fence(__ATOMIC_ACQUIRE, "agent");
            xb_add(&bar[XB_XGEN(b.x)], 1u);
            asm volatile("s_waitcnt vmcnt(0)" ::: "memory");
        } else {
            XB_SPIN(xb_ld(&bar[XB_XGEN(b.x)]) == gen, bar);
            __builtin_amdgcn_fence(__ATOMIC_ACQUIRE, "agent");
            asm volatile("s_waitcnt vmcnt(0)" ::: "memory");
        }
    }
    __syncthreads();
}

__device__ __forceinline__ unsigned cvtpk(float lo, float hi) { unsigned r; asm volatile("v_cvt_pk_bf16_f32 %0, %1, %2" : "=v"(r) : "v"(lo), "v"(hi)); return r; }
__device__ __forceinline__ float bf2f(unsigned short b) { return __uint_as_float(((unsigned)b) << 16); }
__device__ __forceinline__ float bflo(unsigned w) { return __uint_as_float(w << 16); }
__device__ __forceinline__ float bfhi(unsigned w) { return __uint_as_float(w & 0xffff0000u); }
__device__ __forceinline__ void st_bf16x4(bf16_t* p, f32x4 v) { u32x2 w; w.x = cvtpk(v[0], v[1]); w.y = cvtpk(v[2], v[3]); *(u32x2*)p = w; }
typedef _Float16 f16x4 __attribute__((ext_vector_type(4)));
__device__ __forceinline__ void st_f16x4(bf16_t* p, f32x4 v) { *(f16x4*)p = __builtin_convertvector(v, f16x4); }
__device__ __forceinline__ f32x4 cvt_f16x4(u32x2 w) { return __builtin_convertvector(__builtin_bit_cast(f16x4, w), f32x4); }
__device__ __forceinline__ float silu_f(float x) { return x * __builtin_amdgcn_rcpf(1.0f + __builtin_amdgcn_exp2f(-1.4426950408889634f * x)); }
__device__ __forceinline__ float wave_sum(float v) {
#pragma unroll
    for (int o = 1; o < 64; o <<= 1) v += __shfl_xor(v, o);
    return v;
}
__device__ __forceinline__ int otid() { int t = threadIdx.x; asm volatile("" : "+v"(t)); return t; }
__device__ __forceinline__ int mod_index(int row) { return row < NLAT ? (row >> 13) : 4; }

namespace pg8 {
constexpr int BM = 256, BK = 64, HALF = 128, HTB = HALF * BK * 2, STAGE_BYTES = 8 * HTB, NXCD = 8, WGM = 8;
__host__ __device__ __forceinline__ int lds_byte(int r, int c) { const int st = (r >> 4) * 2 + (c >> 5), rr = r & 15, cc = c & 31, ob = rr * 64 + cc * 2; return st * 1024 + (ob ^ (((ob >> 9) & 1) << 5)); }
__host__ __device__ __forceinline__ void stage_rc(int b, int& R, int& C) { const int st = b / 1024, sb = b % 1024, swz = sb ^ (((sb >> 9) & 1) << 5); R = (st >> 1) * 16 + swz / 64; C = (st & 1) * 32 + (swz % 64) / 2; }

struct Unit { int pm, pn; };
struct Gemm { const bf16_t* A; const bf16_t* Bt; int lda, K; };

struct TileOrder {
    int nM, nN, nwg, G, c, chunk, skew_n, skew_i;
    __device__ __forceinline__ void init(int nM_, int nN_, int G_, int c_, int chunk_, int skew_n_ = 0, int skew_i_ = 0) { nM = nM_; nN = nN_; nwg = nM * nN; G = G_; c = c_; chunk = chunk_; skew_n = skew_n_; skew_i = skew_i_; }
    __device__ __forceinline__ bool next(int i, Unit& u) const {
        long L;
        if (skew_n == 0 || i < skew_i) L = (long)i * G + c;
        else { if (c < skew_n) return false; L = (long)skew_i * G + (long)(i - skew_i) * (G - skew_n) + (c - skew_n); }
        if (L >= nwg) return false;
        int wgid = (int)L; { const int q = nwg / NXCD, r = nwg % NXCD, xcd = wgid % NXCD, off = wgid / NXCD; wgid = (xcd < r ? xcd * (q + 1) : r * (q + 1) + (xcd - r) * q) + off; }
        const int nig = WGM * nN, gid = wgid / nig, fm = gid * WGM, gsz = (nM - fm) < WGM ? (nM - fm) : WGM;
        int pm = fm + ((wgid % nig) % gsz); u.pn = (wgid % nig) / gsz;
        if (chunk >= 0) pm = (pm < 64) ? 64 * chunk + pm : 128 + (pm - 64);
        u.pm = pm; return true;
    }
    __device__ __forceinline__ void a_ready(const Unit&) const {}
    __device__ __forceinline__ void done(const Unit&) const {}
};

template <class Epi, class Sched>
__device__ __forceinline__ void gemm_phase(LAS unsigned char* lds, const Gemm g, const Sched& S, const Epi& E) {
    const int tid = otid(), wid = __builtin_amdgcn_readfirstlane(tid >> 6), lane = tid & 63, wr = wid >> 2, wc = wid & 3, fr = lane & 15, fq = lane >> 4;
    const int K = g.K, nt = K / BK, lda = g.lda;
    unsigned voffA[2], voffB[2];
#pragma unroll
    for (int i = 0; i < 2; ++i) { int R, C; stage_rc(tid * 16 + i * 8192, R, C);
        voffA[i] = (unsigned)(R * lda + C) * 2u; voffB[i] = (unsigned)(R * K + C) * 2u; }
    const size_t kstep = (size_t)(BK * 2);
    const size_t hstepA = (size_t)HALF * lda * 2, hstepB = (size_t)HALF * K * 2;
    const size_t tstepA = 2 * hstepA, tstepB = 2 * hstepB;
    const unsigned ldsw = (unsigned)wid * 1024u;
    const int aoff = lds_byte(wr * 64 + fr, fq * 8), boff = lds_byte(wc * 32 + fr, fq * 8);
#define PG8_SA(b, h) (((b) * 2 + (h)) * HTB)
#define PG8_SB(b, h) ((4 + (b) * 2 + (h)) * HTB)
#define PG8_STAGE(bufoff, gbase, voff) do { _Pragma("unroll") for (int _i = 0; _i < 2; ++_i) \
        __builtin_amdgcn_global_load_lds((const unsigned*)((const char*)(gbase) + (voff)[_i]), (LAS unsigned*)(lds + (bufoff) + ldsw + _i * 8192), 16, 0, 0); } while (0)
#define PG8_LDA(dst, b, h) do { _Pragma("unroll") for (int m = 0; m < 4; ++m) _Pragma("unroll") for (int k = 0; k < 2; ++k) dst[m][k] = *(const LAS bf16x8*)(lds + PG8_SA(b, h) + aoff + m * 2048 + k * 1024); } while (0)
#define PG8_LDB(dst, b, h) do { _Pragma("unroll") for (int n = 0; n < 2; ++n) _Pragma("unroll") for (int k = 0; k < 2; ++k) dst[n][k] = *(const LAS bf16x8*)(lds + PG8_SB(b, h) + boff + n * 2048 + k * 1024); } while (0)
#define PG8_MMA(ai, bj, At, Bt) do { __builtin_amdgcn_s_setprio(1); _Pragma("unroll") for (int m = 0; m < 4; ++m) _Pragma("unroll") for (int n = 0; n < 2; ++n) _Pragma("unroll") for (int k = 0; k < 2; ++k) \
        acc[ai][bj][m][n] = __builtin_amdgcn_mfma_f32_16x16x32_bf16(Bt[n][k], At[m][k], acc[ai][bj][m][n], 0, 0, 0); __builtin_amdgcn_s_setprio(0); } while (0)
#define PG8_WAIT_V(n) asm volatile("s_waitcnt vmcnt(" #n ")" ::: "memory")
#define PG8_WAIT_L(n) asm volatile("s_waitcnt lgkmcnt(" #n ")" ::: "memory")
#define PG8_BAR __builtin_amdgcn_s_barrier()
#define PG8_SCHED __builtin_amdgcn_sched_barrier(0)
    Unit cur, nxt; int ui = 0;
    if (!S.next(0, cur)) return;
    f32x4 acc[2][2][4][2];
#pragma unroll
    for (int a = 0; a < 2; ++a)
#pragma unroll
        for (int b = 0; b < 2; ++b)
#pragma unroll
            for (int m = 0; m < 4; ++m)
#pragma unroll
                for (int n = 0; n < 2; ++n) acc[a][b][m][n] = (f32x4){0.f, 0.f, 0.f, 0.f};
    bf16x8 At[4][2], B0[2][2], B1[2][2];
    const char* cA = (const char*)g.A + (size_t)cur.pm * tstepA; const char* cB = (const char*)g.Bt + (size_t)cur.pn * tstepB;
    S.a_ready(cur);
    PG8_STAGE(PG8_SB(0, 0), cB, voffB); PG8_STAGE(PG8_SA(0, 0), cA, voffA); PG8_STAGE(PG8_SB(0, 1), cB + hstepB, voffB); PG8_STAGE(PG8_SA(0, 1), cA + hstepA, voffA);
    if (wr == 1) PG8_BAR;
    PG8_WAIT_V(4); PG8_BAR;
    PG8_STAGE(PG8_SB(1, 0), cB + kstep, voffB); PG8_STAGE(PG8_SA(1, 0), cA + kstep, voffA); PG8_STAGE(PG8_SB(1, 1), cB + hstepB + kstep, voffB);
    PG8_WAIT_V(6); PG8_BAR;
    for (;;) {
        const bool has_next = S.next(ui + 1, nxt);
        const char* nA = has_next ? (const char*)g.A + (size_t)nxt.pm * tstepA : cA; const char* nB = has_next ? (const char*)g.Bt + (size_t)nxt.pn * tstepB : cB;
#pragma nounroll
        for (int t = 0; t < nt; t += 2) {
            const bool last = (t == nt - 2);
            const char* a1 = cA + (size_t)(t + 1) * kstep;
            const char* a2 = last ? nA : cA + (size_t)(t + 2) * kstep; const char* b2 = last ? nB : cB + (size_t)(t + 2) * kstep;
            const char* a3 = a2 + kstep; const char* b3 = b2 + kstep;
            if (last && has_next) S.a_ready(nxt);
            PG8_LDB(B0, 0, 0); PG8_SCHED; PG8_LDA(At, 0, 0); PG8_STAGE(PG8_SA(1, 1), a1 + hstepA, voffA);
            PG8_WAIT_L(8); PG8_BAR; PG8_WAIT_L(0); PG8_MMA(0, 0, At, B0); PG8_BAR; PG8_SCHED;
            PG8_LDB(B1, 0, 1); PG8_STAGE(PG8_SB(0, 0), b2, voffB);
            PG8_BAR; PG8_WAIT_L(0); PG8_MMA(0, 1, At, B1); PG8_BAR;
            PG8_LDA(At, 0, 1); PG8_STAGE(PG8_SA(0, 0), a2, voffA);
            PG8_BAR; PG8_WAIT_L(0); PG8_MMA(1, 0, At, B0); PG8_BAR; PG8_SCHED;
            PG8_STAGE(PG8_SB(0, 1), b2 + hstepB, voffB);
            PG8_WAIT_V(6); PG8_BAR; PG8_MMA(1, 1, At, B1); PG8_BAR;
            PG8_LDB(B0, 1, 0); PG8_SCHED; PG8_LDA(At, 1, 0); PG8_STAGE(PG8_SA(0, 1), a2 + hstepA, voffA);
            PG8_WAIT_L(8); PG8_BAR; PG8_WAIT_L(0); PG8_MMA(0, 0, At, B0); PG8_BAR; PG8_SCHED;
            PG8_LDB(B1, 1, 1); PG8_STAGE(PG8_SB(1, 0), b3, voffB);
            PG8_BAR; PG8_WAIT_L(0); PG8_MMA(0, 1, At, B1); PG8_BAR;
            PG8_LDA(At, 1, 1); PG8_STAGE(PG8_SA(1, 0), a3, voffA);
            PG8_BAR; PG8_WAIT_L(0); PG8_MMA(1, 0, At, B0); PG8_BAR; PG8_SCHED;
            PG8_STAGE(PG8_SB(1, 1), b3 + hstepB, voffB);
            PG8_WAIT_V(6); PG8_BAR; PG8_MMA(1, 1, At, B1); PG8_BAR;
        }
        E(acc, cur, wr, wc, fr, fq); S.done(cur);
        if (!has_next) break;
#pragma unroll
        for (int a = 0; a < 2; ++a)
#pragma unroll
            for (int b = 0; b < 2; ++b)
#pragma unroll
                for (int m = 0; m < 4; ++m)
#pragma unroll
                    for (int n = 0; n < 2; ++n) acc[a][b][m][n] = (f32x4){0.f, 0.f, 0.f, 0.f};
        cur = nxt; cA = nA; cB = nB; ++ui;
    }
    PG8_WAIT_V(0);
    if (wr == 0) PG8_BAR;
    PG8_BAR;
#undef PG8_SA
#undef PG8_SB
#undef PG8_STAGE
#undef PG8_LDA
#undef PG8_LDB
#undef PG8_MMA
#undef PG8_WAIT_V
#undef PG8_WAIT_L
#undef PG8_BAR
#undef PG8_SCHED
}


struct EpiProj {
    bf16_t* P; float* RS; const float* thc; const float* ths; const float* tmc; const float* tms;
    __device__ __forceinline__ void operator()(const f32x4 (&acc)[2][2][4][2], const Unit& u, int wr, int wc, int fr, int fq) const {
        asm volatile("" : "+v"(fr), "+v"(fq));
        const int pn = u.pn; const bool lat = u.pm < 128;
        const int row0 = u.pm * BM + wr * 64 + fr;
        if (pn == 16) {
            if (wc < 2) {
#pragma unroll
                for (int ai = 0; ai < 2; ++ai)
#pragma unroll
                    for (int m = 0; m < 4; ++m) {
                        const int row = row0 + ai * HALF + m * 16; const f32x4 v0 = acc[ai][0][m][0], v1 = acc[ai][0][m][1]; f32x4 o0 = v0, o1 = v1;
                        if (lat) { const int pos = row & (SEQ - 1), tp = wc ? (pos & 63) : (pos >> 6);
                            const f32x4 c = *(const f32x4*)(tmc + tp * 16 + 4 * fq), s = *(const f32x4*)(tms + tp * 16 + 4 * fq);
                            o0 = v0 * c - v1 * s; o1 = v1 * c + v0 * s; }
                        bf16_t* rp = P + (size_t)row * INW + 4096 + 32 * wc + 4 * fq;
                        st_bf16x4(rp, o0); st_bf16x4(rp + 16, o1);
                        asm volatile("" ::: "memory");
                    }
            }
            return;
        }
        const bool roped = (pn < 4) || (pn >= 8 && pn < 12);
        if (roped) {
            const float sc = (pn == 2 || pn == 3) ? KSCALE : ((pn >= 8 && pn <= 10) ? KSCALE * LOG2E : 1.0f);
            const int colb = pn * BM + 128 * (wc >> 1) + 64 * (wc & 1) + 8 * fq;
#pragma unroll
            for (int ai = 0; ai < 2; ++ai)
#pragma unroll
                for (int m = 0; m < 4; ++m) {
                    const int row = row0 + ai * HALF + m * 16; const int pos = row & (SEQ - 1), tp = (wc & 1) ? (pos & 63) : (pos >> 6);
                    u32x4 w0, w1;
#pragma unroll
                    for (int n = 0; n < 2; ++n) {
                        f32x4 c = (f32x4){1.f, 1.f, 1.f, 1.f}, s = (f32x4){0.f, 0.f, 0.f, 0.f};
                        if (lat) { c = *(const f32x4*)(thc + tp * 32 + 8 * fq + 4 * n); s = *(const f32x4*)(ths + tp * 32 + 8 * fq + 4 * n); }
                        const f32x4 v0 = acc[ai][0][m][n] * sc, v1 = acc[ai][1][m][n] * sc;
                        const f32x4 o0 = v0 * c - v1 * s, o1 = v1 * c + v0 * s;
                        w0[2 * n] = cvtpk(o0[0], o0[1]); w0[2 * n + 1] = cvtpk(o0[2], o0[3]); w1[2 * n] = cvtpk(o1[0], o1[1]); w1[2 * n + 1] = cvtpk(o1[2], o1[3]);
                    }
                    bf16_t* rp = P + (size_t)row * INW + colb;
                    *(u32x4*)rp = w0; *(u32x4*)(rp + 32) = w1;
                    asm volatile("" ::: "memory");
                }
            return;
        }
#pragma unroll
        for (int ai = 0; ai < 2; ++ai)
#pragma unroll
            for (int m = 0; m < 4; ++m) {
                const int row = row0 + ai * HALF + m * 16; bf16_t* rp = P + (size_t)row * INW + pn * BM + wc * 32 + 8 * fq; float ss = 0.f;
#pragma unroll
                for (int bj = 0; bj < 2; ++bj) { const f32x4 v0 = acc[ai][bj][m][0], v1 = acc[ai][bj][m][1];
                    u32x4 w; w[0] = cvtpk(v0[0], v0[1]); w[1] = cvtpk(v0[2], v0[3]); w[2] = cvtpk(v1[0], v1[1]); w[3] = cvtpk(v1[2], v1[3]);
                    *(u32x4*)(rp + bj * HALF) = w;
                    ss += ((v0[0] * v0[0] + v0[1] * v0[1]) + (v0[2] * v0[2] + v0[3] * v0[3])) + ((v1[0] * v1[0] + v1[1] * v1[1]) + (v1[2] * v1[2] + v1[3] * v1[3])); }
                if (pn >= 13 && pn <= 15) { ss += __shfl_xor(ss, 16); ss += __shfl_xor(ss, 32); if (fq == 0) RS[(size_t)row * 12 + (pn - 13) * 4 + wc] = ss; }
            }
    }
};
struct EpiQup {
    bf16_t* Q; const float* RS; const float* tmc; const float* tms;
    __device__ __forceinline__ void operator()(const f32x4 (&acc)[2][2][4][2], const Unit& u, int wr, int wc, int fr, int fq) const {
        asm volatile("" : "+v"(fr), "+v"(fq));
        const int pn = u.pn; const bool lat = u.pm < 128; const int row0 = u.pm * BM + wr * 64 + fr;
#pragma unroll
        for (int ai = 0; ai < 2; ++ai)
#pragma unroll
            for (int m = 0; m < 4; ++m) {
                const int row = row0 + ai * HALF + m * 16; const f32x4 r0 = *(const f32x4*)(RS + (size_t)row * 12), r1 = *(const f32x4*)(RS + (size_t)row * 12 + 4);
                const float rs = MLA_QSCALE / sqrtf(((r0[0] + r0[1]) + (r0[2] + r0[3]) + (r1[0] + r1[1]) + (r1[2] + r1[3])) * (1.0f / 512.0f) + RMS_EPS);
                const int pos = row & (SEQ - 1), tp = (wc & 1) ? (pos & 63) : (pos >> 6);
                const f32x4 c = *(const f32x4*)(tmc + tp * 16 + 4 * fq), s = *(const f32x4*)(tms + tp * 16 + 4 * fq);
#pragma unroll
                for (int bj = 0; bj < 2; ++bj) {
                    const int colb = pn * BM + bj * HALF + wc * 32; if (colb >= QUPW) continue;
                    const int c64 = 4 * pn + 2 * bj + (wc >> 1);
                    const f32x4 v0 = acc[ai][bj][m][0] * rs, v1 = acc[ai][bj][m][1] * rs; f32x4 o0 = v0, o1 = v1;
                    if (lat && (c64 % 3) == 2) { o0 = v0 * c - v1 * s; o1 = v1 * c + v0 * s; }
                    bf16_t* rp = Q + (size_t)row * QUPW + colb + 4 * fq; st_bf16x4(rp, o0); st_bf16x4(rp + 16, o1);
                }
                asm volatile("" ::: "memory");
            }
    }
};
struct EpiKvup {
    bf16_t* KV; const float* RS;
    __device__ __forceinline__ void operator()(const f32x4 (&acc)[2][2][4][2], const Unit& u, int wr, int wc, int fr, int fq) const {
        asm volatile("" : "+v"(fr), "+v"(fq));
        const int row0 = u.pm * BM + wr * 64 + fr;
#pragma unroll
        for (int ai = 0; ai < 2; ++ai)
#pragma unroll
            for (int m = 0; m < 4; ++m) {
                const int row = row0 + ai * HALF + m * 16; const f32x4 r0 = *(const f32x4*)(RS + (size_t)row * 12 + 8);
                const float rs = 1.0f / sqrtf(((r0[0] + r0[1]) + (r0[2] + r0[3])) * (1.0f / 256.0f) + RMS_EPS);
                bf16_t* rp = KV + (size_t)row * KVUPW + u.pn * BM + wc * 32 + 8 * fq;
#pragma unroll
                for (int bj = 0; bj < 2; ++bj) { const f32x4 v0 = acc[ai][bj][m][0] * rs, v1 = acc[ai][bj][m][1] * rs;
                    u32x4 w; w[0] = cvtpk(v0[0], v0[1]); w[1] = cvtpk(v0[2], v0[3]); w[2] = cvtpk(v1[0], v1[1]); w[3] = cvtpk(v1[2], v1[3]);
                    *(u32x4*)(rp + bj * HALF) = w; }
                asm volatile("" ::: "memory");
            }
    }
};
struct EpiMix {
    bf16_t* MIX; int chunk; int dry;
    __device__ __forceinline__ void operator()(const f32x4 (&acc)[2][2][4][2], const Unit& u, int wr, int wc, int fr, int fq) const {
        asm volatile("" : "+v"(fr), "+v"(fq));
        if (dry) { float s = 0.f;
#pragma unroll
            for (int ai = 0; ai < 2; ++ai)
#pragma unroll
                for (int bj = 0; bj < 2; ++bj)
#pragma unroll
                    for (int m = 0; m < 4; ++m)
#pragma unroll
                        for (int n = 0; n < 2; ++n) s += (acc[ai][bj][m][n][0] + acc[ai][bj][m][n][1]) + (acc[ai][bj][m][n][2] + acc[ai][bj][m][n][3]);
            if (s == 123456.789f) MIX[0] = (bf16_t)1; return; }
        const int pmg = chunk < 0 ? u.pm : (u.pm < 64 ? 64 * chunk + u.pm : 128 + (u.pm - 64));
        const int row0 = pmg * BM + wr * 64 + fr;
#pragma unroll
        for (int ai = 0; ai < 2; ++ai)
#pragma unroll
            for (int m = 0; m < 4; ++m) { bf16_t* rp = MIX + (size_t)(row0 + ai * HALF + m * 16) * D + u.pn * BM + wc * 32 + 8 * fq;
#pragma unroll
                for (int bj = 0; bj < 2; ++bj) { const f32x4 v0 = acc[ai][bj][m][0], v1 = acc[ai][bj][m][1];
                    u32x4 w; w[0] = cvtpk(v0[0], v0[1]); w[1] = cvtpk(v0[2], v0[3]); w[2] = cvtpk(v1[0], v1[1]); w[3] = cvtpk(v1[2], v1[3]);
                    *(u32x4*)(rp + bj * HALF) = w; } }
    }
};
struct EpiUpConv {
    bf16_t* ACTc; float* SB; const float* cw; const float* cb; int chunk;
    static __device__ __forceinline__ float lane_prev(float x) { return __builtin_bit_cast(float, __builtin_amdgcn_update_dpp(0, __builtin_bit_cast(int, x), 0x121, 0xf, 0xf, false)); }
    static __device__ __forceinline__ float lane_next(float x) { return __builtin_bit_cast(float, __builtin_amdgcn_update_dpp(0, __builtin_bit_cast(int, x), 0x12f, 0xf, 0xf, false)); }
    __device__ __forceinline__ void operator()(const f32x4 (&acc)[2][2][4][2], const Unit& u, int wr, int wc, int fr, int fq) const {
        asm volatile("" : "+v"(fr), "+v"(fq));
        const int lpm = u.pm < 128 ? u.pm - 64 * chunk : 64 + (u.pm - 128);
        const int f0 = u.pn * 128 + wc * 32 + 8 * fq;
        f32x4 w0[2], w1[2], w2[2], bb[2];
#pragma unroll
        for (int n = 0; n < 2; ++n) { w0[n] = *(const f32x4*)(cw + f0 + 4 * n); w1[n] = *(const f32x4*)(cw + DFF + f0 + 4 * n); w2[n] = *(const f32x4*)(cw + 2 * DFF + f0 + 4 * n); bb[n] = *(const f32x4*)(cb + f0 + 4 * n); }
#pragma unroll
        for (int ai = 0; ai < 2; ++ai) {
            const int rg = lpm * BM + ai * HALF + wr * 64;
            const int smask = rg < FCH_LAT ? (SEQ - 1) : (CTXL - 1);
            const bool seq_first = (rg & smask) == 0, seq_last = ((rg + 63) & smask) == smask;
#pragma unroll
            for (int m = 0; m < 4; ++m) {
                u32x4 ow;
#pragma unroll
                for (int n = 0; n < 2; ++n) {
                    f32x4 gp, gn;
#pragma unroll
                    for (int e = 0; e < 4; ++e) {
                        const float pa_ = lane_prev(acc[ai][1][m][n][e]), pb_ = m > 0 ? lane_prev(acc[ai][1][m > 0 ? m - 1 : 0][n][e]) : 0.f;
                        const float na_ = lane_next(acc[ai][1][m][n][e]), nb_ = m < 3 ? lane_next(acc[ai][1][m < 3 ? m + 1 : 3][n][e]) : 0.f;
                        gp[e] = fr > 0 ? pa_ : pb_; gn[e] = fr < 15 ? na_ : nb_;
                    }
                    const f32x4 gc = acc[ai][1][m][n], uu = acc[ai][0][m][n];
                    const f32x4 z = w0[n] * gp + w1[n] * gc + w2[n] * gn + bb[n];
                    ow[2 * n] = cvtpk(silu_f(z[0]) * uu[0], silu_f(z[1]) * uu[1]); ow[2 * n + 1] = cvtpk(silu_f(z[2]) * uu[2], silu_f(z[3]) * uu[3]);
                    if (m == 0 && fr == 0) { float* sp = SB + ((size_t)(0 * NGRP + (rg >> 6)) * 3) * DFF + f0 + 4 * n; *(f32x4*)(sp + 2 * DFF) = gc; if (!seq_first) { *(f32x4*)sp = z; *(f32x4*)(sp + DFF) = uu; } }
                    if (m == 3 && fr == 15) { float* sp = SB + ((size_t)(1 * NGRP + (rg >> 6)) * 3) * DFF + f0 + 4 * n; *(f32x4*)(sp + 2 * DFF) = gc; if (!seq_last) { *(f32x4*)sp = z; *(f32x4*)(sp + DFF) = uu; } }
                }
                *(u32x4*)(ACTc + (size_t)(rg + 16 * m + fr) * DFF + f0) = ow;
            }
            asm volatile("" ::: "memory");
        }
    }
};
}

#define SBAR() __builtin_amdgcn_sched_barrier(0)
__device__ __forceinline__ int crow(int r, int hi) { return (r & 3) + 8 * (r >> 2) + 4 * hi; }
template <int DQK> __device__ __forceinline__ int kswz(int row, int cb) {
    return row * (DQK * 2 + 16) + cb;
}
__device__ __forceinline__ int v_st(int k, int c) { const int kk = (k & ~0xC) | ((k & 4) << 1) | ((k & 8) >> 1); return ((kk >> 3) * 4 + (c >> 5)) * 512 + ((kk & 7) * 32 + (c & 31)) * 2; }
__device__ __forceinline__ int v_stn(int k, int c) { return ((k >> 3) * 4 + (c >> 5)) * 512 + ((k & 7) * 32 + (c & 31)) * 2; }
__device__ __forceinline__ int v_rd_base(int lane) { return ((lane & 3) << 3) | (((lane >> 2) & 3) << 6) | (((lane >> 4) & 1) << 5) | (((lane >> 5) & 1) << 8); }
constexpr int v_rd_off(int d0, int ks, int half) { return d0 * 512 + ks * 4096 + half * 2048; }
template <int OFF> __device__ __forceinline__ s16x4 tr_read(int vb) {
    s16x4 r; asm volatile("ds_read_b64_tr_b16 %0, %1 offset:%2" : "=&v"(r) : "v"(vb), "i"(OFF) : "memory"); return r;
}
#define PKLH(L, H) (bf16x8){L[0], L[1], L[2], L[3], H[0], H[1], H[2], H[3]}
template <int D0> __device__ __forceinline__ void pv_one(f32x16& od, int vb, bf16x8 pa0, bf16x8 pa1, bf16x8 pa2, bf16x8 pa3) {
    const s16x4 l0 = tr_read<v_rd_off(D0, 0, 0)>(vb), h0 = tr_read<v_rd_off(D0, 0, 1)>(vb), l1 = tr_read<v_rd_off(D0, 1, 0)>(vb), h1 = tr_read<v_rd_off(D0, 1, 1)>(vb);
    const s16x4 l2 = tr_read<v_rd_off(D0, 2, 0)>(vb), h2 = tr_read<v_rd_off(D0, 2, 1)>(vb), l3 = tr_read<v_rd_off(D0, 3, 0)>(vb), h3 = tr_read<v_rd_off(D0, 3, 1)>(vb);
    asm volatile("s_waitcnt lgkmcnt(0)" ::: "memory"); SBAR();
    od = __builtin_amdgcn_mfma_f32_32x32x16_bf16(pa0, PKLH(l0, h0), od, 0, 0, 0);
    od = __builtin_amdgcn_mfma_f32_32x32x16_bf16(pa1, PKLH(l1, h1), od, 0, 0, 0);
    od = __builtin_amdgcn_mfma_f32_32x32x16_bf16(pa2, PKLH(l2, h2), od, 0, 0, 0);
    od = __builtin_amdgcn_mfma_f32_32x32x16_bf16(pa3, PKLH(l3, h3), od, 0, 0, 0);
}
__device__ __forceinline__ void pv_d0(f32x16* o, int vb, bf16x8 pa0, bf16x8 pa1, bf16x8 pa2, bf16x8 pa3) {
    pv_one<0>(o[0], vb, pa0, pa1, pa2, pa3); pv_one<1>(o[1], vb, pa0, pa1, pa2, pa3); pv_one<2>(o[2], vb, pa0, pa1, pa2, pa3); pv_one<3>(o[3], vb, pa0, pa1, pa2, pa3);
}
template <int DQK> __device__ __forceinline__ void qkt(f32x16& p0, f32x16& p1, const char* Ks, const bf16x8* qr, int r32, int hi, const f32x16 init = f32x16{}) {
    constexpr int NS = DQK / 16;
    p0 = init; p1 = init;
    bf16x8 b0[NS], b1[NS];
#pragma unroll
    for (int d0 = 0; d0 < NS; ++d0) { const int cb = (d0 * 16 + hi * 8) * 2;
        b0[d0] = *reinterpret_cast<const bf16x8*>(Ks + kswz<DQK>(r32, cb));
        b1[d0] = *reinterpret_cast<const bf16x8*>(Ks + kswz<DQK>(32 + r32, cb)); }
#pragma unroll
    for (int d0 = 0; d0 < NS; ++d0) {
        p0 = __builtin_amdgcn_mfma_f32_32x32x16_bf16(b0[d0], qr[d0], p0, 0, 0, 0);
        p1 = __builtin_amdgcn_mfma_f32_32x32x16_bf16(b1[d0], qr[d0], p1, 0, 0, 0); }
#ifndef QKT_AHEAD
#define QKT_AHEAD 2
#endif
    __builtin_amdgcn_sched_group_barrier(0x100, 2 * QKT_AHEAD, 0);
#pragma unroll
    for (int d0 = 0; d0 < NS - QKT_AHEAD; ++d0) { __builtin_amdgcn_sched_group_barrier(0x008, 2, 0); __builtin_amdgcn_sched_group_barrier(0x100, 2, 0); }
    __builtin_amdgcn_sched_group_barrier(0x008, 2 * QKT_AHEAD, 0);
}
#define PK4(P, BASE, OUT) do { const unsigned a0_ = cvtpk(P[BASE + 0], P[BASE + 1]), a1_ = cvtpk(P[BASE + 2], P[BASE + 3]);   \
    const unsigned b0_ = cvtpk(P[BASE + 4], P[BASE + 5]), b1_ = cvtpk(P[BASE + 6], P[BASE + 7]);                              \
    auto r0_ = __builtin_amdgcn_permlane32_swap(a0_, b0_, false, false); auto r1_ = __builtin_amdgcn_permlane32_swap(a1_, b1_, false, false); \
    u32x4 w_ = {r0_[0], r1_[0], r0_[1], r1_[1]}; OUT = *reinterpret_cast<bf16x8*>(&w_); } while (0)

#define PK4N(P, BASE, OUT) do { u32x4 w_ = {cvtpk(P[BASE + 0], P[BASE + 1]), cvtpk(P[BASE + 2], P[BASE + 3]), cvtpk(P[BASE + 4], P[BASE + 5]), cvtpk(P[BASE + 6], P[BASE + 7])}; \
    OUT = *reinterpret_cast<bf16x8*>(&w_); } while (0)

template <int SC1000> struct SmC { };
typedef float f32x2 __attribute__((ext_vector_type(2)));
constexpr float THR = 8.f;

__device__ __forceinline__ void partialSM(f32x16& p0, f32x16& p1, float& m_reg, float& mn, float& alpha, const float C, const float thr_raw) {
    float pmax = p0[0];
#pragma unroll
    for (int r = 1; r < 16; ++r) pmax = fmaxf(pmax, p0[r]);
#pragma unroll
    for (int r = 0; r < 16; ++r) pmax = fmaxf(pmax, p1[r]);
    { auto rr = __builtin_amdgcn_permlane32_swap(__float_as_uint(pmax), __float_as_uint(pmax), false, false);
      pmax = fmaxf(__uint_as_float(rr[0]), __uint_as_float(rr[1])); }
    if (__builtin_expect(__all(pmax - m_reg <= thr_raw), 1)) { mn = m_reg; alpha = 1.f; }
    else { mn = fmaxf(m_reg, pmax); alpha = __builtin_amdgcn_exp2f((m_reg - mn) * C); m_reg = mn; }
    const float mnC = -mn * C;
#pragma unroll
    for (int r = 0; r < 16; ++r) p0[r] = fmaf(p0[r], C, mnC);
#pragma unroll
    for (int r = 0; r < 16; ++r) p1[r] = fmaf(p1[r], C, mnC);
#pragma unroll
    for (int r = 0; r < 16; ++r) p0[r] = __builtin_amdgcn_exp2f(p0[r]);
}
__device__ __forceinline__ void finishSM(f32x16& p0, f32x16& p1, float alpha, float& l_reg, bf16x8& pa0, bf16x8& pa1, bf16x8& pa2, bf16x8& pa3) {
#pragma unroll
    for (int r = 0; r < 16; ++r) p1[r] = __builtin_amdgcn_exp2f(p1[r]);
    float ps = 0;
#pragma unroll
    for (int r = 0; r < 16; ++r) ps += p0[r];
#pragma unroll
    for (int r = 0; r < 16; ++r) ps += p1[r];
    { auto rr = __builtin_amdgcn_permlane32_swap(__float_as_uint(ps), __float_as_uint(ps), false, false);
      ps = __uint_as_float(rr[0]) + __uint_as_float(rr[1]); }
    l_reg = l_reg * alpha + ps;
    PK4N(p0, 0, pa0); PK4N(p0, 8, pa1); PK4N(p1, 0, pa2); PK4N(p1, 8, pa3);
}

constexpr int KVBLK = 64;
struct AttnArgs {
    const bf16_t* Q; int ldq;
    const bf16_t* K; int ldk;
    const bf16_t* KR; int ldkr;
    const bf16_t* V; int ldv;
    bf16_t* O; int ldo;
    int nt;
    int seg0_tiles, seg0_row, seg1_row;
    int qpos0;
    int masked;
    float sink_l2; int has_sink;
    float C;
};
template <int DQK>
__device__ __forceinline__ void attn_body(const AttnArgs& a, char* lds) {
    constexpr int SHM_V = KVBLK * 128 * 2, SHM_K = KVBLK * (DQK * 2 + 16);
    const int tid = otid(), wid = tid >> 6, lane = tid & 63, r32 = lane & 31, hi = lane >> 5;
    char* V_lds = lds; char* K_lds = lds + 2 * SHM_V;
    float* ws = (float*)(lds + 2 * SHM_V + 2 * SHM_K) + wid * 64; float* li_l = ws; float* al_l = ws + 32;
    float m_reg = -1e30f, l_reg = 0; f32x16 o[4] = {}; bf16x8 qr[DQK / 16];
    const float C = a.C, thr_raw = THR * LOG2E / a.C;
    const bf16_t* Qw = a.Q + (long)(wid * 32 + r32) * a.ldq + hi * 8;
#pragma unroll
    for (int d0 = 0; d0 < DQK / 16; ++d0) qr[d0] = *reinterpret_cast<const bf16x8*>(Qw + d0 * 16);
    const int sr = tid >> 4, sc = (tid & 15) * 8, vst0 = v_stn(sr, sc), vst1 = v_stn(32 + sr, sc);
    const int kst0 = kswz<DQK>(sr, sc * 2), kst1 = kswz<DQK>(32 + sr, sc * 2);
    const int sr2 = tid >> 3, sc2 = (tid & 7) * 8, kst2 = (DQK == 192) ? kswz<DQK>(sr2, 256 + sc2 * 2) : 0;
    const int vb0 = (int)(uintptr_t)V_lds + v_rd_base(lane);
    bf16x8 vs0, vs1, ks0, ks1, ks2;
    __syncthreads();
#define TILE_ROW(j) ((j) < a.seg0_tiles ? a.seg0_row + 64 * (j) : ((a.masked && (unsigned)(a.qpos0 - 128 + 64 * ((j) - a.seg0_tiles)) >= (unsigned)SEQ) ? a.seg0_row : a.seg1_row + 64 * ((j) - a.seg0_tiles)))
    int cur_row = TILE_ROW(0);
    const bf16_t* pk0 = a.K + ((long)cur_row + sr) * a.ldk + sc;
    const bf16_t* pkr = a.KR + ((long)cur_row + sr2) * a.ldkr + sc2;
    const long dvk = a.V - a.K, d32 = 32L * a.ldk;
#define SLOAD(j) do { const int nr_ = TILE_ROW(j); const long dr_ = (long)(nr_ - cur_row); cur_row = nr_; pk0 += dr_ * a.ldk; if (DQK == 192) pkr += dr_ * a.ldkr; \
    vs0 = *reinterpret_cast<const bf16x8*>(pk0 + dvk); vs1 = *reinterpret_cast<const bf16x8*>(pk0 + d32 + dvk); \
    ks0 = *reinterpret_cast<const bf16x8*>(pk0); ks1 = *reinterpret_cast<const bf16x8*>(pk0 + d32); \
    if (DQK == 192) ks2 = *reinterpret_cast<const bf16x8*>(pkr); } while (0)
#define SWRITE(b) do { *(bf16x8*)(V_lds + (b) * SHM_V + vst0) = vs0; *(bf16x8*)(V_lds + (b) * SHM_V + vst1) = vs1; \
    *(bf16x8*)(K_lds + (b) * SHM_K + kst0) = ks0; *(bf16x8*)(K_lds + (b) * SHM_K + kst1) = ks1; \
    if (DQK == 192) *(bf16x8*)(K_lds + (b) * SHM_K + kst2) = ks2; } while (0)
#define SWAIT() asm volatile("s_waitcnt vmcnt(0)" ::: "memory")
#define RESC(al) do { if (__any((al) < 1.f)) { if (hi == 0) al_l[r32] = (al); asm volatile("s_waitcnt lgkmcnt(0)" ::: "memory"); \
    _Pragma("unroll") for (int d = 0; d < 4; ++d) _Pragma("unroll") for (int r = 0; r < 16; ++r) o[d][r] *= al_l[crow(r, hi)]; } } while (0)
#define MASK(P0, P1, j) do { if (a.masked && (j) >= a.seg0_tiles) { const int kp0_ = a.qpos0 - 128 + 64 * ((j) - a.seg0_tiles), qp_ = a.qpos0 + wid * 32 + r32; \
    const bool tv_ = (unsigned)kp0_ < (unsigned)SEQ; \
    _Pragma("unroll") for (int r = 0; r < 16; ++r) { const int d0_ = kp0_ + crow(r, hi) - qp_, d1_ = d0_ + 32; \
        P0[r] = (tv_ && d0_ <= 128 && d0_ >= -128) ? P0[r] : -1e30f; P1[r] = (tv_ && d1_ <= 128 && d1_ >= -128) ? P1[r] : -1e30f; } } } while (0)
    f32x16 pA0, pA1; float mnA, alA; bf16x8 pa0, pa1, pa2, pa3; const int NT = a.nt;
    const int wu = __builtin_amdgcn_readfirstlane(wid);
    volatile int* vflag = (volatile int*)(lds + 2 * SHM_V + 2 * SHM_K + 8 * 256);
#define TILE_BODY(CLASSIC) { \
        const int b = j & 1; \
        if (j + 1 < NT) SLOAD(j + 1); \
        bool skip = false;        \
        if (a.masked && j >= a.seg0_tiles) { const int kp0_ = a.qpos0 - 128 + 64 * (j - a.seg0_tiles), q0_ = a.qpos0 + wu * 32; \
            skip = ((unsigned)kp0_ >= (unsigned)SEQ) || (kp0_ + 63 < q0_ - 128) || (kp0_ > q0_ + 31 + 128); } \
        if (!skip) { \
            if (CLASSIC) { \
                SBAR(); qkt<DQK>(pA0, pA1, K_lds + b * SHM_K, qr, r32, hi); MASK(pA0, pA1, j); \
                partialSM(pA0, pA1, m_reg, mnA, alA, C, thr_raw); \
                RESC(alA); \
                finishSM(pA0, pA1, alA, l_reg, pa0, pa1, pa2, pa3); \
            } else { \
                SBAR(); qkt<DQK>(pA0, pA1, K_lds + b * SHM_K, qr, r32, hi, minit); MASK(pA0, pA1, j);        \
                float ps_; \
                _Pragma("unroll") for (int r = 0; r < 16; ++r) pA0[r] = __builtin_amdgcn_exp2f(pA0[r]); \
                _Pragma("unroll") for (int r = 0; r < 16; ++r) pA1[r] = __builtin_amdgcn_exp2f(pA1[r]); \
                { f32x2 s2_ = (f32x2){pA0[0], pA0[1]};                                       \
                  _Pragma("unroll") for (int r = 2; r < 16; r += 2) { const f32x2 t_ = {pA0[r], pA0[r + 1]}; s2_ = s2_ + t_; } \
                  _Pragma("unroll") for (int r = 0; r < 16; r += 2) { const f32x2 t_ = {pA1[r], pA1[r + 1]}; s2_ = s2_ + t_; } \
                  ps_ = s2_[0] + s2_[1]; } \
                { auto rr = __builtin_amdgcn_permlane32_swap(__float_as_uint(ps_), __float_as_uint(ps_), false, false); ps_ = __uint_as_float(rr[0]) + __uint_as_float(rr[1]); } \
                bad |= !__all(ps_ <= 256.0f); \
                l_reg += ps_; \
                PK4N(pA0, 0, pa0); PK4N(pA0, 8, pa1); PK4N(pA1, 0, pa2); PK4N(pA1, 8, pa3); \
            } \
            SBAR(); \
            pv_d0(o, vb0 + b * SHM_V, pa0, pa1, pa2, pa3); \
        } \
        if (j + 1 < NT) { SWAIT(); SWRITE(b ^ 1); } \
        __syncthreads(); }
    if (tid == 0) *vflag = 0;
#pragma nounroll
    for (int pass = 0; pass < 2; ++pass) {
        int bad = 0;
        SLOAD(0); SWAIT(); SWRITE(0); __syncthreads();
        const int jc = pass ? NT : 1;
        f32x16 minit = f32x16{};
#pragma nounroll
        for (int j = 0; j < jc; ++j) TILE_BODY(1)
#pragma unroll
        for (int r = 0; r < 16; ++r) minit[r] = -m_reg * C;
#pragma nounroll
        for (int j = jc; j < NT; ++j) TILE_BODY(0)
        if (pass) break;
        if (bad && lane == 0) *vflag = 1;
        __syncthreads();
        if (*vflag == 0) break;
        __syncthreads();
        m_reg = -1e30f; l_reg = 0.f;
#pragma unroll
        for (int d = 0; d < 4; ++d) o[d] = f32x16{};
    }
#undef TILE_BODY
    if (a.has_sink) l_reg += __builtin_amdgcn_exp2f(a.sink_l2 - m_reg * C);
    if (hi == 0) li_l[r32] = l_reg; asm volatile("s_waitcnt lgkmcnt(0)" ::: "memory");
    float rli[16];
#pragma unroll
    for (int r = 0; r < 16; ++r) rli[r] = __builtin_amdgcn_rcpf(li_l[crow(r, hi)]);
    __syncthreads();
    { unsigned short* stg = (unsigned short*)(lds + wid * 8704);
#pragma unroll
      for (int r = 0; r < 16; ++r) { const int orow = crow(r, hi);
#pragma unroll
          for (int d0 = 0; d0 < 4; ++d0) stg[orow * 136 + d0 * 32 + r32] = (unsigned short)(cvtpk(o[d0][r] * rli[r], 0.f) & 0xffffu); }
      asm volatile("s_waitcnt lgkmcnt(0)" ::: "memory");
      bf16_t* Ow = a.O + (long)(wid * 32) * a.ldo;
#pragma unroll
      for (int i = 0; i < 8; ++i) { const int q = lane + 64 * i, row = q >> 4, c8 = (q & 15) * 8;
          *(u32x4*)(Ow + (long)row * a.ldo + c8) = *(const u32x4*)(stg + row * 136 + c8); } }
#undef TILE_ROW
#undef SLOAD
#undef SWRITE
#undef SWAIT
#undef RESC
#undef MASK
}

__device__ __forceinline__ int ret_row0(int bb, int n) { return n == 32 ? NLAT + bb * CTXL : bb * SEQ + n * 256; }
__device__ __forceinline__ float log2_sigmoid(float x) { return -log1pf(__expf(-x)) * LOG2E; }

__device__ __forceinline__ void ret_kv_unit(const bf16_t* PROJ, float* KVS, int bb, int h, int n, float lgf2, float lgb2, char* lds) {
    const int tid = otid(), wid = tid >> 6, lane = tid & 63, r32 = lane & 31, hi = lane >> 5;
    const int dir = wid >> 2, ablk = wid & 3;
    const int sr = tid >> 4, sc = (tid & 15) * 8, vst0 = v_st(sr, sc), vst1 = v_st(32 + sr, sc);
    const long R0 = ret_row0(bb, n);
    const bf16_t* Kg = PROJ + R0 * INW + 512 + h * 128; const bf16_t* Vg = PROJ + R0 * INW + 1024 + h * 128;
    const int vbK = (int)(uintptr_t)lds + dir * 16384 + v_rd_base(lane) + ablk * 512;
    const int vbV = (int)(uintptr_t)lds + 32768 + v_rd_base(lane);
    f32x16 acc[4] = {};
    u32x4 kq[2]; bf16x8 vq[2];
#pragma unroll
    for (int i = 0; i < 2; ++i) { const int j = sr + 32 * i; kq[i] = *reinterpret_cast<const u32x4*>(Kg + (long)j * INW + sc); vq[i] = *reinterpret_cast<const bf16x8*>(Vg + (long)j * INW + sc); }
    for (int t = 0; t < 4; ++t) {
        __syncthreads();
#pragma unroll
        for (int i = 0; i < 2; ++i) {
            const int j = 64 * t + sr + 32 * i;
            const u32x4 kv = kq[i];
            const bf16x8 vv = vq[i];
            const float kf = __builtin_amdgcn_exp2f(lgf2 * (float)(255 - j)), kb = __builtin_amdgcn_exp2f(lgb2 * (float)j);
            u32x4 wf, wb;
#pragma unroll
            for (int e = 0; e < 4; ++e) { const float lo = bflo(kv[e]), hh = bfhi(kv[e]); wf[e] = cvtpk(lo * kf, hh * kf); wb[e] = cvtpk(lo * kb, hh * kb); }
            const int vo = i ? vst1 : vst0;
            *(u32x4*)(lds + vo) = wf; *(u32x4*)(lds + 16384 + vo) = wb; *(bf16x8*)(lds + 32768 + vo) = vv;
        }
        if (t < 3) {
#pragma unroll
            for (int i = 0; i < 2; ++i) { const int j = 64 * (t + 1) + sr + 32 * i; kq[i] = *reinterpret_cast<const u32x4*>(Kg + (long)j * INW + sc); vq[i] = *reinterpret_cast<const bf16x8*>(Vg + (long)j * INW + sc); }
        }
        __syncthreads();
#define RKV_STEP(KS) do { \
        const s16x4 al_ = tr_read<v_rd_off(0, KS, 0)>(vbK), ah_ = tr_read<v_rd_off(0, KS, 1)>(vbK); \
        const s16x4 l0_ = tr_read<v_rd_off(0, KS, 0)>(vbV), h0_ = tr_read<v_rd_off(0, KS, 1)>(vbV), l1_ = tr_read<v_rd_off(1, KS, 0)>(vbV), h1_ = tr_read<v_rd_off(1, KS, 1)>(vbV); \
        const s16x4 l2_ = tr_read<v_rd_off(2, KS, 0)>(vbV), h2_ = tr_read<v_rd_off(2, KS, 1)>(vbV), l3_ = tr_read<v_rd_off(3, KS, 0)>(vbV), h3_ = tr_read<v_rd_off(3, KS, 1)>(vbV); \
        asm volatile("s_waitcnt lgkmcnt(0)" ::: "memory"); SBAR(); \
        const bf16x8 af_ = PKLH(al_, ah_); \
        acc[0] = __builtin_amdgcn_mfma_f32_32x32x16_bf16(af_, PKLH(l0_, h0_), acc[0], 0, 0, 0); \
        acc[1] = __builtin_amdgcn_mfma_f32_32x32x16_bf16(af_, PKLH(l1_, h1_), acc[1], 0, 0, 0); \
        acc[2] = __builtin_amdgcn_mfma_f32_32x32x16_bf16(af_, PKLH(l2_, h2_), acc[2], 0, 0, 0); \
        acc[3] = __builtin_amdgcn_mfma_f32_32x32x16_bf16(af_, PKLH(l3_, h3_), acc[3], 0, 0, 0); } while (0)
        RKV_STEP(0); RKV_STEP(1); RKV_STEP(2); RKV_STEP(3);
#undef RKV_STEP
    }
    float* outp = KVS + ((((size_t)bb * 4 + h) * 2 + dir) * 33 + n) * 16384;
#pragma unroll
    for (int r = 0; r < 16; ++r) { const int dk = 32 * ablk + crow(r, hi);
#pragma unroll
        for (int d = 0; d < 4; ++d) outp[dk * 128 + 32 * d + r32] = acc[d][r]; }
}

__device__ __forceinline__ void ret_scan(const float* KVS, bf16_t* SIN, const float* dec_f, const float* dec_b, int gtid, int gthreads) {
    for (int it = gtid; it < NB * 4 * 2 * 4096; it += gthreads) {
        const int e4 = it & 4095, dir = (it >> 12) & 1, h = (it >> 13) & 3, bb = it >> 15;
        const float lg2 = log2_sigmoid(dir ? dec_b[h] : dec_f[h]); const float cd = __builtin_amdgcn_exp2f(lg2 * 256.0f);
        const size_t base = ((((size_t)bb * 4 + h) * 2 + dir) * 33) * 16384 + (size_t)e4 * 4;
        f32x4 s = *(const f32x4*)(KVS + base + (size_t)32 * 16384);
        *(u32x2*)(SIN + base + (size_t)32 * 16384) = (u32x2){0u, 0u};
        for (int nb = 0; nb < 4; ++nb) {
            f32x4 kv[8];
#pragma unroll
            for (int q = 0; q < 8; ++q) { const int n = dir ? 31 - (nb * 8 + q) : nb * 8 + q; kv[q] = *(const f32x4*)(KVS + base + (size_t)n * 16384); }
#pragma unroll
            for (int q = 0; q < 8; ++q) { const int n = dir ? 31 - (nb * 8 + q) : nb * 8 + q;
                st_bf16x4(SIN + base + (size_t)n * 16384, s); s = s * cd + kv[q]; }
        }
    }
}

__device__ __forceinline__ void ret_out_unit(const bf16_t* PROJ, const bf16_t* SIN, bf16_t* Y, int bb, int h, int n, float lgf2, float lgb2, char* lds) {
    const int tid = otid(), wid = tid >> 6, lane = tid & 63, r32 = lane & 31, hi = lane >> 5;
    const int sr = tid >> 4, sc = (tid & 15) * 8, vst0 = v_st(sr, sc), vst1 = v_st(32 + sr, sc);
    const int kst0 = kswz<128>(sr, sc * 2), kst1 = kswz<128>(32 + sr, sc * 2);
    const long R0 = ret_row0(bb, n);
    const bf16_t* Qg = PROJ + R0 * INW + h * 128; const bf16_t* Kg = Qg + 512; const bf16_t* Vg = Qg + 1024; const bf16_t* Gg = Qg + 1536;
    char* K_lds = lds; char* V_lds = lds + 17408;
    const int vb0 = (int)(uintptr_t)V_lds + v_rd_base(lane);
    bf16x8 qr[8];
    const bf16_t* Qw = Qg + (long)(wid * 32 + r32) * INW + hi * 8;
#pragma unroll
    for (int d0 = 0; d0 < 8; ++d0) qr[d0] = *reinterpret_cast<const bf16x8*>(Qw + d0 * 16);
    f32x16 o[4] = {};
    const int iq = wid * 32 + r32;
    const bf16_t* S0 = SIN + ((((size_t)bb * 4 + h) * 2) * 33 + n) * 16384;
    bf16x8 kq[2], vq[2];
#pragma unroll
    for (int i = 0; i < 2; ++i) { const int j = sr + 32 * i; kq[i] = *reinterpret_cast<const bf16x8*>(Kg + (long)j * INW + sc); vq[i] = *reinterpret_cast<const bf16x8*>(Vg + (long)j * INW + sc); }
    for (int t = 0; t < 4; ++t) {
        __syncthreads();
#pragma unroll
        for (int i = 0; i < 2; ++i) { *(bf16x8*)(K_lds + (i ? kst1 : kst0)) = kq[i]; *(bf16x8*)(V_lds + (i ? vst1 : vst0)) = vq[i]; }
        if (t < 3) {
#pragma unroll
            for (int i = 0; i < 2; ++i) { const int j = 64 * (t + 1) + sr + 32 * i; kq[i] = *reinterpret_cast<const bf16x8*>(Kg + (long)j * INW + sc); vq[i] = *reinterpret_cast<const bf16x8*>(Vg + (long)j * INW + sc); }
        } else if (n != 32) {
#pragma unroll
            for (int i = 0; i < 2; ++i) vq[i] = *reinterpret_cast<const bf16x8*>(S0 + (sr + 32 * i) * 128 + sc);
        }
        __syncthreads();
        f32x16 p0, p1; qkt<128>(p0, p1, K_lds, qr, r32, hi);
#pragma unroll
        for (int r = 0; r < 16; ++r) {
            const int d0 = iq - (64 * t + crow(r, hi)), d1 = d0 - 32;
            const float m0 = d0 > 0 ? __builtin_amdgcn_exp2f(lgf2 * (float)d0) : (d0 < 0 ? __builtin_amdgcn_exp2f(lgb2 * (float)(-d0)) : 2.0f);
            const float m1 = d1 > 0 ? __builtin_amdgcn_exp2f(lgf2 * (float)d1) : (d1 < 0 ? __builtin_amdgcn_exp2f(lgb2 * (float)(-d1)) : 2.0f);
            p0[r] *= m0; p1[r] *= m1;
        }
        bf16x8 pa0, pa1, pa2, pa3; PK4(p0, 0, pa0); PK4(p0, 8, pa1); PK4(p1, 0, pa2); PK4(p1, 8, pa3);
        pv_d0(o, vb0, pa0, pa1, pa2, pa3);
    }
    if (n != 32) {
#pragma unroll
        for (int s4 = 0; s4 < 4; ++s4) {
            const int dir = s4 >> 1, ts = s4 & 1;
            const float qd = dir ? __builtin_amdgcn_exp2f(lgb2 * (float)(256 - iq)) : __builtin_amdgcn_exp2f(lgf2 * (float)(iq + 1));
            __syncthreads();
#pragma unroll
            for (int i = 0; i < 2; ++i) *(bf16x8*)(V_lds + (i ? vst1 : vst0)) = vq[i];
            if (s4 < 3) { const int d2 = (s4 + 1) >> 1, t2 = (s4 + 1) & 1; const bf16_t* Sn = S0 + (size_t)d2 * 33 * 16384;
#pragma unroll
                for (int i = 0; i < 2; ++i) vq[i] = *reinterpret_cast<const bf16x8*>(Sn + (64 * t2 + sr + 32 * i) * 128 + sc); }
            bf16x8 qs[4];
#pragma unroll
            for (int k = 0; k < 4; ++k) { const u32x4 w = *reinterpret_cast<const u32x4*>(&qr[4 * ts + k]); u32x4 x;
#pragma unroll
                for (int e = 0; e < 4; ++e) x[e] = cvtpk(bflo(w[e]) * qd, bfhi(w[e]) * qd);
                qs[k] = *reinterpret_cast<bf16x8*>(&x); }
            __syncthreads();
            pv_d0(o, vb0, qs[0], qs[1], qs[2], qs[3]);
        }
    }
    __syncthreads();
    { unsigned short* stg = (unsigned short*)(lds + wid * 8704);
#pragma unroll
      for (int r = 0; r < 16; ++r) {
          float ss = (o[0][r] * o[0][r] + o[1][r] * o[1][r]) + (o[2][r] * o[2][r] + o[3][r] * o[3][r]);
          ss += __shfl_xor(ss, 1); ss += __shfl_xor(ss, 2); ss += __shfl_xor(ss, 4); ss += __shfl_xor(ss, 8); ss += __shfl_xor(ss, 16);
          const float rn = 1.0f / sqrtf(ss * (1.0f / 128.0f) + RMS_EPS);
#pragma unroll
          for (int d = 0; d < 4; ++d) stg[crow(r, hi) * 136 + 32 * d + r32] = (unsigned short)(cvtpk(o[d][r] * rn, 0.f) & 0xffffu);
      }
      asm volatile("s_waitcnt lgkmcnt(0)" ::: "memory");
#pragma unroll
      for (int i = 0; i < 8; ++i) { const int q = lane + 64 * i, row = q >> 4, c8 = (q & 15) * 8;
          const u32x4 gw = *(const u32x4*)(Gg + (long)(wid * 32 + row) * INW + c8);
          const u32x4 xw = *(const u32x4*)(stg + row * 136 + c8);
          u32x4 ow;
#pragma unroll
          for (int e = 0; e < 4; ++e) ow[e] = cvtpk(silu_f(bflo(gw[e])) * bflo(xw[e]), silu_f(bfhi(gw[e])) * bfhi(xw[e]));
          *(u32x4*)(Y + (R0 + wid * 32 + row) * D + h * 128 + c8) = ow; } }
}

struct Params {
    const float* in[23];
    float* out; unsigned char* ws;
    int ph_lo, ph_hi, bar_region, pad;
};
enum { I_X = 0, I_C, I_CTX, I_CCTX, I_ADAW, I_ADAB, I_WIN, I_DECF, I_DECB, I_SINK, I_QNORM, I_WUQ, I_KVNORM, I_WUKV, I_WO, I_LN1G, I_LN1B, I_WUP, I_CONVW, I_CONVB, I_WDN, I_LN2G, I_LN2B };

__device__ __forceinline__ int win_src_col(int p) {
    if (p >= INW) return -1;
    if (p >= 4096) return p;
    const int pn = p >> 8;
    if (pn < 4 || (pn >= 8 && pn < 12)) {
        const int bj = (p >> 7) & 1, x = p & 127, wc = x >> 5, nn = (x >> 4) & 1, q = x & 15;
        return (p & ~255) + 128 * (wc >> 1) + 64 * (wc & 1) + 32 * bj + 8 * (q >> 2) + 4 * nn + (q & 3);
    }
    return (p & ~31) + 8 * ((p & 15) >> 2) + 4 * ((p >> 4) & 1) + (p & 3);
}
__device__ __forceinline__ int wup_src_col(int p) {
    const int pn = p >> 8, bj = (p >> 7) & 1, x = p & 127, wc = x >> 5, nn = (x >> 4) & 1, q = x & 15, fq = q >> 2, j = q & 3;
    const int f = 128 * pn + 32 * wc + 8 * fq + 4 * nn + j;
    return bj ? DFF + f : f;
}
__device__ __forceinline__ void cvt_item(const float* W, int K, int N, bf16_t* Bt, int mode, const float* kscale, int item, int nkt, float* scr, int lane) {
    const int pt = item / nkt, kt = item - pt * nkt, p0 = pt * 32, k0 = kt * 64;
    const int p = p0 + (lane & 31);
    const int src = mode == 1 ? win_src_col(p) : (mode == 2 ? wup_src_col(p) : (mode == 3 ? ((p & ~31) + 8 * ((p & 15) >> 2) + 4 * ((p >> 4) & 1) + (p & 3)) : (p < N ? p : -1)));
    const float* wp = W + (size_t)(k0 + (lane >> 5)) * N + (src >= 0 ? src : 0);
    float v[32];
#pragma unroll
    for (int i = 0; i < 32; ++i) v[i] = src >= 0 ? wp[(size_t)(2 * i) * N] : 0.f;
    if (kscale) {
#pragma unroll
        for (int i = 0; i < 32; ++i) v[i] *= kscale[k0 + 2 * i + (lane >> 5)];
    }
#pragma unroll
    for (int i = 0; i < 32; ++i) scr[(2 * i + (lane >> 5)) * 33 + (lane & 31)] = v[i];
    asm volatile("s_waitcnt lgkmcnt(0)" ::: "memory");
    const int c = lane & 7;
#pragma unroll
    for (int j = 0; j < 4; ++j) { const int n = (lane >> 3) + 8 * j; const float* s = scr + (8 * c) * 33 + n;
        u32x4 o; o[0] = cvtpk(s[0 * 33], s[1 * 33]); o[1] = cvtpk(s[2 * 33], s[3 * 33]); o[2] = cvtpk(s[4 * 33], s[5 * 33]); o[3] = cvtpk(s[6 * 33], s[7 * 33]);
        *(u32x4*)(Bt + (size_t)(p0 + n) * K + k0 + 8 * c) = o; }
    asm volatile("s_waitcnt lgkmcnt(0)" ::: "memory");
}

__device__ __forceinline__ void ln_phase(const bf16_t* X, const bf16_t* MIX, float* dstf, bf16_t* dsth, bf16_t* H, const float* g, const float* b,
                                         const float* gate, const float* sc, const float* sh, int nrows, int bid, int G, char* lds) {
    const int tid = otid(), lane = tid & 63, wid = __builtin_amdgcn_readfirstlane(tid >> 6);
    float* L = (float*)lds;
    __syncthreads();
    for (int i = tid; i < D; i += 512) { L[i] = g[i]; L[D + i] = b[i]; }
    const int ngroups = nrows >> 3, grp0 = (int)(((long)bid * ngroups) / G), nsteps = (int)(((long)(bid + 1) * ngroups) / G) - grp0; int s_cur = -1;
#define LN_ROW(k) ((grp0 + (k)) * 8 + wid)
#define LN_LOAD(XA, MA, ROW) do { const bf16_t* xr_ = X + (size_t)(ROW) * D + 4 * lane; const bf16_t* mr_ = MIX + (size_t)(ROW) * D + 4 * lane; \
    _Pragma("unroll") for (int j = 0; j < 8; ++j) { XA[j] = *(const u32x2*)(xr_ + 256 * j); MA[j] = *(const u32x2*)(mr_ + 256 * j); } } while (0)
#define LN_SVEC(k) do { const int s_ = mod_index((grp0 + (k)) * 8); \
    if (s_ != s_cur) { __syncthreads(); \
        { float gv_[4], sv_[4], hv_[4]; \
          _Pragma("unroll") for (int q_ = 0; q_ < 4; ++q_) { const int i = tid + 512 * q_; gv_[q_] = gate[(size_t)s_ * MODW + i]; sv_[q_] = H ? sc[(size_t)s_ * MODW + i] : 0.f; hv_[q_] = H ? sh[(size_t)s_ * MODW + i] : 0.f; } \
          _Pragma("unroll") for (int q_ = 0; q_ < 4; ++q_) { const int i = tid + 512 * q_; L[2 * D + i] = gv_[q_] + 1.0f; L[3 * D + i] = sv_[q_] + 1.0f; L[4 * D + i] = hv_[q_]; } } \
        s_cur = s_; __syncthreads(); } } while (0)
#define LN_COMP(XA, MA, ROW) do { \
    f32x4 v[8]; float sum = 0.f; \
    _Pragma("unroll") for (int j = 0; j < 8; ++j) { const int c = 4 * lane + 256 * j; \
        const f32x4 mv = (f32x4){bflo(MA[j][0]), bfhi(MA[j][0]), bflo(MA[j][1]), bfhi(MA[j][1])}; \
        v[j] = cvt_f16x4(XA[j]) * ALPHA + *(const f32x4*)(L + 2 * D + c) * mv; sum += (v[j][0] + v[j][1]) + (v[j][2] + v[j][3]); } \
    const float mean = wave_sum(sum) * (1.0f / D); float s2 = 0.f; \
    _Pragma("unroll") for (int j = 0; j < 8; ++j) { v[j] = v[j] - mean; s2 += (v[j][0] * v[j][0] + v[j][1] * v[j][1]) + (v[j][2] * v[j][2] + v[j][3] * v[j][3]); } \
    const float rstd = 1.0f / sqrtf(wave_sum(s2) * (1.0f / D) + LN_EPS); \
    _Pragma("unroll") for (int j = 0; j < 8; ++j) { const int c = 4 * lane + 256 * j; \
        const f32x4 y = v[j] * rstd * *(const f32x4*)(L + c) + *(const f32x4*)(L + D + c); \
        if (dstf) *(f32x4*)(dstf + (size_t)(ROW) * D + c) = y; else st_f16x4(dsth + (size_t)(ROW) * D + c, y); \
        if (H) st_bf16x4(H + (size_t)(ROW) * D + c, y * *(const f32x4*)(L + 3 * D + c) + *(const f32x4*)(L + 4 * D + c)); } } while (0)
    u32x2 xa[8], xb[8], ma[8], mb[8];
    if (LN_ROW(0) < nrows) LN_LOAD(xa, ma, LN_ROW(0));
    for (int k = 0; k < nsteps; k += 2) {
        LN_SVEC(k);
        if (k + 1 < nsteps && LN_ROW(k + 1) < nrows) LN_LOAD(xb, mb, LN_ROW(k + 1));
        SBAR();
        if (LN_ROW(k) < nrows) LN_COMP(xa, ma, LN_ROW(k));
        if (k + 1 < nsteps) {
            LN_SVEC(k + 1);
            if (k + 2 < nsteps && LN_ROW(k + 2) < nrows) LN_LOAD(xa, ma, LN_ROW(k + 2));
            SBAR();
            if (LN_ROW(k + 1) < nrows) LN_COMP(xb, mb, LN_ROW(k + 1));
        }
    }
#undef LN_ROW
#undef LN_LOAD
#undef LN_SVEC
#undef LN_COMP
}

__global__ void __launch_bounds__(512, 2) fwd_kernel(Params p) {
    extern __shared__ __attribute__((aligned(16))) unsigned char lds_raw[];
    LAS unsigned char* ldsl = (LAS unsigned char*)lds_raw;
    char* lds = (char*)lds_raw;
    if (threadIdx.x < 4) ((volatile LAS unsigned*)(ldsl + 131072))[threadIdx.x] = 0u;
    __syncthreads();
    XcdBarrier bar; bar.bar = (unsigned*)(p.ws + WS_CTL) + (size_t)p.bar_region * 4096; bar.x = 0; bar.st = (volatile LAS unsigned*)(ldsl + 131072);
    if (p.ph_hi - p.ph_lo > 1) bar = xcd_barrier_post(bar.bar, (volatile LAS unsigned*)(ldsl + 131072));

    int g = 0, lcur = 0;
#ifndef DUPMASK
#define DUPMASK 0
#endif
#define NREP(k) (1 + ((DUPMASK >> (k)) & 1))
#ifndef PHMASK
#define PHMASK 0xffff
#endif
#ifndef SUBMASK
#define SUBMASK 0xffff
#endif
#define SUB(k) ((SUBMASK >> (k)) & 1)
#define PH_BEGIN(k) if (((PHMASK >> (k)) & 1) && g >= p.ph_lo && g < p.ph_hi) { \
    int bid = blockIdx.x, G = gridDim.x; asm volatile("" : "+s"(bid), "+s"(G)); const int NGW = G * 8, gthreads = G * 512; (void)NGW; (void)gthreads; \
    const int tid = otid(), lane = tid & 63, wid = __builtin_amdgcn_readfirstlane(tid >> 6); const int gw = bid * 8 + wid, gtid = bid * 512 + tid; (void)lane; (void)gw; (void)gtid; \
    size_t wsoff_ = 0; asm volatile("" : "+s"(wsoff_)); unsigned char* ws = p.ws + wsoff_; \
    float* MOD = (float*)(ws + WS_MOD); float* ROPE = (float*)(ws + WS_ROPE); float* RS = (float*)(ws + WS_RS); float* SM = (float*)(ws + WS_SM); (void)SM; \
    float* thc = ROPE, *ths = ROPE + 4096, *tmc = ROPE + 8192, *tms = ROPE + 8192 + 2048; \
    bf16_t* WB = (bf16_t*)(ws + WS_W); float* X = (float*)(ws + WS_X); bf16_t* XH = (bf16_t*)(ws + WS_X); (void)XH; bf16_t* H = (bf16_t*)(ws + WS_H); bf16_t* Y = (bf16_t*)(ws + WS_Y); \
    bf16_t* PROJ = (bf16_t*)(ws + WS_PROJ); bf16_t* QUP = (bf16_t*)(ws + WS_QUP); bf16_t* KVUP = (bf16_t*)(ws + WS_KVUP); \
    float* KVS = (float*)(ws + WS_KVS); bf16_t* SIN = (bf16_t*)(ws + WS_SIN); bf16_t* ACT0 = (bf16_t*)(ws + WS_ACT0); bf16_t* ACT1 = (bf16_t*)(ws + WS_ACT1); float* SB = (float*)(ws + WS_SB); bf16_t* MIX = (bf16_t*)(ws + WS_MIX); (void)MIX; \
    const bf16_t* wl = WB + (size_t)lcur * W_LAYER; const float* modl = MOD + (size_t)lcur * 5 * MODW; \
    (void)RS; (void)thc; (void)ths; (void)tmc; (void)tms; (void)X; (void)H; (void)Y; (void)PROJ; (void)QUP; (void)KVUP; (void)KVS; (void)SIN; (void)ACT0; (void)ACT1; (void)SB; (void)wl; (void)modl;
#define PH_END   if (g + 1 < p.ph_hi) xcd_barrier(bar); } ++g;

    PH_BEGIN(0)
    {
        for (int i = gtid; i < SM_END; i += gthreads) {
            float v = 0.f;
            if (i < SM_DECB) v = p.in[I_DECF][i];
            else if (i < SM_SINK) v = p.in[I_DECB][i - SM_DECB];
            else if (i < SM_LN1G) v = (i - SM_SINK) < DEPTH * 6 ? p.in[I_SINK][i - SM_SINK] : 0.f;
            else if (i < SM_LN1B) v = p.in[I_LN1G][i - SM_LN1G];
            else if (i < SM_LN2G) v = p.in[I_LN1B][i - SM_LN1B];
            else if (i < SM_LN2B) v = p.in[I_LN2G][i - SM_LN2G];
            else if (i < SM_CONVW) v = p.in[I_LN2B][i - SM_LN2B];
            else if (i < SM_CONVB) v = p.in[I_CONVW][i - SM_CONVW];
            else v = p.in[I_CONVB][i - SM_CONVB];
            SM[i] = v;
        }
        for (int i = gtid; i < 4096 + 2048; i += gthreads) {
            if (i < 4096) { const int pos = i >> 5, f = i & 31; const float inv = exp2f(-(float)f * (13.287712379549449f / 32.0f)); const float ang = (float)pos * inv; thc[i] = cosf(ang); ths[i] = sinf(ang); }
            else { const int q = i - 4096, pos = q >> 4, f = q & 15; const float inv = exp2f(-(float)f * (13.287712379549449f / 16.0f)); const float ang = (float)pos * inv; tmc[q] = cosf(ang); tms[q] = sinf(ang); }
        }
        {
            float* scs = (float*)lds;
            float* red = (float*)(lds + 5 * 2048 * 4);
            for (int i = tid; i < 5 * 2048; i += 512) { const int s = i >> 11, k = i & 2047; const float cv = s < 4 ? p.in[I_C][s * D + k] : p.in[I_CCTX][k]; scs[i] = silu_f(cv); }
            __syncthreads();
            for (int u = bid; u < DEPTH * (MODW / 64); u += G) {
                const int l = u / (MODW / 64), j = (u % (MODW / 64)) * 64 + lane;
                const float* Wp = p.in[I_ADAW] + (size_t)l * D * MODW + j;
                float a0 = 0.f, a1 = 0.f, a2 = 0.f, a3 = 0.f, a4 = 0.f;
#pragma unroll 16
                for (int kk = 0; kk < 256; ++kk) { const int k = wid * 256 + kk; const float w = Wp[(size_t)k * MODW];
                    a0 += scs[k] * w; a1 += scs[2048 + k] * w; a2 += scs[4096 + k] * w; a3 += scs[6144 + k] * w; a4 += scs[8192 + k] * w; }
                red[(wid * 5 + 0) * 64 + lane] = a0; red[(wid * 5 + 1) * 64 + lane] = a1; red[(wid * 5 + 2) * 64 + lane] = a2; red[(wid * 5 + 3) * 64 + lane] = a3; red[(wid * 5 + 4) * 64 + lane] = a4;
                __syncthreads();
                if (wid < 5) { float sum = 0.f;
#pragma unroll
                    for (int w8 = 0; w8 < 8; ++w8) sum += red[(w8 * 5 + wid) * 64 + lane];
                    MOD[((size_t)l * 5 + wid) * MODW + j] = sum + p.in[I_ADAB][(size_t)l * MODW + j]; }
                __syncthreads();
            }
        }
        {
            __syncthreads();
            float* scr = (float*)(lds + wid * 8448);
            constexpr int T_IN = (INWP / 32) * (D / 64), T_UQ = (QUPWP / 32) * (512 / 64), T_UKV = (KVUPW / 32) * (256 / 64), T_O = (D / 32) * (D / 64), T_UP = (DFF2 / 32) * (D / 64), T_DN = (D / 32) * (DFF / 64);
            constexpr int T_L = T_IN + T_UQ + T_UKV + T_O + T_UP + T_DN;
            for (int u = gw; u < DEPTH * T_L; u += NGW) {
                const int l = u / T_L; int r = u % T_L; bf16_t* wlp = WB + (size_t)l * W_LAYER;
                const float* Wsrc; const float* ksc = nullptr; bf16_t* dst; int Kd, Nd, mode;
                if (r < T_IN) { Wsrc = p.in[I_WIN] + (size_t)l * D * INW; Kd = D; Nd = INW; dst = wlp + W_IN; mode = 1; }
                else if ((r -= T_IN) < T_UQ) { Wsrc = p.in[I_WUQ] + (size_t)l * 512 * QUPW; Kd = 512; Nd = QUPW; dst = wlp + W_UQ; mode = 0; ksc = p.in[I_QNORM] + l * 512; }
                else if ((r -= T_UQ) < T_UKV) { Wsrc = p.in[I_WUKV] + (size_t)l * 256 * KVUPW; Kd = 256; Nd = KVUPW; dst = wlp + W_UKV; mode = 3; ksc = p.in[I_KVNORM] + l * 256; }
                else if ((r -= T_UKV) < T_O) { Wsrc = p.in[I_WO] + (size_t)l * D * D; Kd = D; Nd = D; dst = wlp + W_O; mode = 3; }
                else if ((r -= T_O) < T_UP) { Wsrc = p.in[I_WUP] + (size_t)l * D * DFF2; Kd = D; Nd = DFF2; dst = wlp + W_UP; mode = 2; }
                else { r -= T_UP; Wsrc = p.in[I_WDN] + (size_t)l * DFF * D; Kd = DFF; Nd = D; dst = wlp + W_DN; mode = 3; }
                cvt_item(Wsrc, Kd, Nd, dst, mode, ksc, r, Kd / 64, scr, lane);
            }
        }
    }
    PH_END

    PH_BEGIN(1)
    {
        f32x4 va[8], vb[8];
#define G1_SRC(ROW) ((ROW) < NLAT ? p.in[I_X] + (size_t)(ROW) * D : p.in[I_CTX] + (size_t)((ROW) - NLAT) * D)
#define G1_LOAD(VA, ROW) do { const float* s_ = G1_SRC(ROW) + 4 * lane; _Pragma("unroll") for (int j = 0; j < 8; ++j) VA[j] = *(const f32x4*)(s_ + 256 * j); } while (0)
#define G1_STORE(VA, ROW) do { const float* mp_ = MOD + (size_t)mod_index(ROW) * MODW; \
        _Pragma("unroll") for (int j = 0; j < 8; ++j) { const int c = 4 * lane + 256 * j; \
            st_f16x4(XH + (size_t)(ROW) * D + c, VA[j]); \
            st_bf16x4(H + (size_t)(ROW) * D + c, VA[j] * (*(const f32x4*)(mp_ + D + c) + 1.0f) + *(const f32x4*)(mp_ + c)); } } while (0)
        int row = gw;
        if (row < NROWS) G1_LOAD(va, row);
        for (; row < NROWS; row += 2 * NGW) {
            if (row + NGW < NROWS) G1_LOAD(vb, row + NGW);
            SBAR();
            G1_STORE(va, row);
            if (row + NGW < NROWS) {
                if (row + 2 * NGW < NROWS) G1_LOAD(va, row + 2 * NGW);
                SBAR();
                G1_STORE(vb, row + NGW);
            }
        }
#undef G1_SRC
#undef G1_LOAD
#undef G1_STORE
    }
    PH_END

    for (int l = 0; l < DEPTH; ++l) {
        const bool last = (l == DEPTH - 1);
        const int nMfull = last ? 128 : 132;
        lcur = l;

        PH_BEGIN(2)
        for (int rep_ = 0; rep_ < NREP(0); ++rep_) { pg8::Gemm gm{H, wl + W_IN, D, D}; pg8::TileOrder S; S.init(132, INWP / 256, G, bid, -1);
          pg8::EpiProj E{PROJ, RS, thc, ths, tmc, tms};
          pg8::gemm_phase<pg8::EpiProj, pg8::TileOrder>(ldsl, gm, S, E); }
        PH_END

        PH_BEGIN(3)
        if (SUB(0)) for (int rep_ = 0; rep_ < NREP(1); ++rep_) { pg8::Gemm gm{PROJ + 3328, wl + W_UQ, INW, 512}; pg8::TileOrder S; S.init(132, QUPWP / 256, G, bid, -1);
          pg8::EpiQup E{QUP, RS, tmc, tms};
          pg8::gemm_phase<pg8::EpiQup, pg8::TileOrder>(ldsl, gm, S, E); }
        if (SUB(1)) for (int rep_ = 0; rep_ < NREP(2); ++rep_) { pg8::Gemm gm{PROJ + 3840, wl + W_UKV, INW, 256}; pg8::TileOrder S; S.init(132, KVUPW / 256, G, (G == 256) ? ((bid + 104) & 255) : bid, -1);
          pg8::EpiKvup E{KVUP, RS};
          pg8::gemm_phase<pg8::EpiKvup, pg8::TileOrder>(ldsl, gm, S, E); }
        if (SUB(2)) for (int rep_ = 0; rep_ < NREP(3); ++rep_) for (int u = (G == 256) ? ((bid + 80) & 255) : bid; u < NB * 4 * 33; u += G) {
            const int n = u % 33, h = (u / 33) & 3, bb = u / 132;
            const float lgf2 = log2_sigmoid(SM[SM_DECF + l * 4 + h]), lgb2 = log2_sigmoid(SM[SM_DECB + l * 4 + h]);
            ret_kv_unit(PROJ, KVS, bb, h, n, lgf2, lgb2, lds);
        }
        PH_END

        PH_BEGIN(4)
        if (SUB(3)) for (int rep_ = 0; rep_ < NREP(4); ++rep_) ret_scan(KVS, SIN, SM + SM_DECF + l * 4, SM + SM_DECB + l * 4, gtid, gthreads);
        if (SUB(4)) for (int rep_ = 0; rep_ < NREP(5); ++rep_) {
            const int nun = last ? 768 : 792;
            for (int u = bid; u < nun; u += G) {
                AttnArgs a;
                int bb, h, qrow;
                if (u < 768) { const int rnd = u / G, w_ = u % G; const int bh = (G == 256) ? (rnd * 8 + (w_ & 7)) : (u >> 5); const int qb = (G == 256) ? (w_ >> 3) : (u & 31); h = bh % 6; bb = bh / 6; qrow = bb * SEQ + qb * 256; a.nt = 132; a.seg0_tiles = 128; a.seg0_row = bb * SEQ; a.seg1_row = NLAT + bb * CTXL; }
                else { const int v = u - 768; h = v % 6; bb = v / 6; qrow = NLAT + bb * CTXL; a.nt = 4; a.seg0_tiles = 4; a.seg0_row = NLAT + bb * CTXL; a.seg1_row = a.seg0_row; }
                a.Q = QUP + (size_t)qrow * QUPW + h * 192; a.ldq = QUPW;
                a.K = KVUP + h * 256; a.ldk = KVUPW; a.KR = PROJ + 4096; a.ldkr = INW; a.V = KVUP + h * 256 + 128; a.ldv = KVUPW;
                a.O = Y + (size_t)qrow * D + 1280 + h * 128; a.ldo = D;
                a.qpos0 = 0; a.masked = 0; a.sink_l2 = 0.f; a.has_sink = 0; a.C = 1.0f;
                attn_body<192>(a, lds);
            }
        }
        if (SUB(5)) for (int rep_ = 0; rep_ < NREP(6); ++rep_) {
            const int nun = last ? 768 : 792;
            for (int u = bid; u < nun; u += G) {
                AttnArgs a;
                int bb, h, qrow;
                if (u < 768) { const int rnd = u / G, w_ = u % G; const int bh = (G == 256) ? (rnd * 8 + (w_ & 7)) : (u >> 5); const int qb = (G == 256) ? (w_ >> 3) : (u & 31); h = bh % 6; bb = bh / 6; qrow = bb * SEQ + qb * 256; a.nt = 12; a.seg0_tiles = 4; a.seg0_row = NLAT + bb * CTXL; a.seg1_row = bb * SEQ + qb * 256 - 128; a.qpos0 = qb * 256; a.masked = 1; }
                else { const int v = u - 768; h = v % 6; bb = v / 6; qrow = NLAT + bb * CTXL; a.nt = 4; a.seg0_tiles = 4; a.seg0_row = NLAT + bb * CTXL; a.seg1_row = a.seg0_row; a.qpos0 = 0; a.masked = 0; }
                const int kvh = h / 3;
                a.Q = PROJ + (size_t)qrow * INW + 2048 + h * 128; a.ldq = INW;
                a.K = PROJ + 2816 + kvh * 128; a.ldk = INW; a.KR = a.K; a.ldkr = INW; a.V = PROJ + 3072 + kvh * 128; a.ldv = INW;
                a.O = Y + (size_t)qrow * D + 512 + h * 128; a.ldo = D;
                a.sink_l2 = SM[SM_SINK + l * 6 + h] * LOG2E; a.has_sink = 1; a.C = 1.0f;
                attn_body<128>(a, lds);
            }
        }
        PH_END

        PH_BEGIN(5)
        for (int rep_ = 0; rep_ < NREP(7); ++rep_) for (int u = bid; u < NB * 4 * 33; u += G) {
            const int n = u % 33, h = (u / 33) & 3, bb = u / 132;
            if (last && n == 32) continue;
            const float lgf2 = log2_sigmoid(SM[SM_DECF + l * 4 + h]), lgb2 = log2_sigmoid(SM[SM_DECB + l * 4 + h]);
            ret_out_unit(PROJ, SIN, Y, bb, h, n, lgf2, lgb2, lds);
        }
        PH_END

        PH_BEGIN(6)
        for (int rep_ = 0; rep_ < NREP(10); ++rep_) { pg8::Gemm gm{Y, wl + W_O, D, D}; pg8::TileOrder S; S.init(nMfull, D / 256, G, bid, -1);
          pg8::EpiMix E{MIX, -1, rep_ + 1 < NREP(10)};
          pg8::gemm_phase<pg8::EpiMix, pg8::TileOrder>(ldsl, gm, S, E); }
        PH_END

        PH_BEGIN(7)
        ln_phase(XH, MIX, (float*)nullptr, XH, H, SM + SM_LN1G + l * D, SM + SM_LN1B + l * D, modl + 2 * D, modl + 4 * D, modl + 3 * D, last ? NLAT : NROWS, bid, G, lds);
        PH_END

#define FFN_UP(cc, nMc, skn, ski) for (int rep_ = 0; rep_ < NREP(8); ++rep_) { pg8::Gemm gm{H, wl + W_UP, D, D}; pg8::TileOrder S; S.init(nMc, DFF2 / 256, G, bid, cc, skn, ski); \
              pg8::EpiUpConv E{cc ? ACT1 : ACT0, SB, SM + SM_CONVW + (size_t)l * 3 * DFF, SM + SM_CONVB + (size_t)l * DFF, cc}; pg8::gemm_phase<pg8::EpiUpConv, pg8::TileOrder>(ldsl, gm, S, E); }
#define FFN_DOWN(cc, nMc) for (int rep_ = 0; rep_ < NREP(11); ++rep_) { pg8::Gemm gm{cc ? ACT1 : ACT0, wl + W_DN, DFF, DFF}; pg8::TileOrder S; S.init(nMc, D / 256, G, bid, -1); \
              pg8::EpiMix E{MIX, cc, rep_ + 1 < NREP(11)}; pg8::gemm_phase<pg8::EpiMix, pg8::TileOrder>(ldsl, gm, S, E); }
#define FFN_FIX(ACTc, nrows) { \
                const float* cw = SM + SM_CONVW + (size_t)l * 3 * DFF; \
                const int ngr = (nrows) / 64; \
                for (int it = gtid; it < 2 * ngr * (DFF / 4); it += gthreads) { \
                    const int f = (it % (DFF / 4)) * 4, gk = it / (DFF / 4), kind = gk / ngr, gi = gk % ngr; \
                    const int rg = gi * 64, smask = rg < FCH_LAT ? (SEQ - 1) : (CTXL - 1); \
                    const bool edge = kind ? (((rg + 63) & smask) == smask) : ((rg & smask) == 0); \
                    if (edge) continue; \
                    const float* sp = SB + ((size_t)(kind * NGRP + gi) * 3) * DFF + f; \
                    const float* np_ = SB + ((size_t)((1 - kind) * NGRP + (kind ? gi + 1 : gi - 1)) * 3 + 2) * DFF + f; \
                    const f32x4 z = *(const f32x4*)sp + *(const f32x4*)(cw + (kind ? 2 * DFF : 0) + f) * *(const f32x4*)np_; const f32x4 uu = *(const f32x4*)(sp + DFF); \
                    u32x2 ow; ow[0] = cvtpk(silu_f(z[0]) * uu[0], silu_f(z[1]) * uu[1]); ow[1] = cvtpk(silu_f(z[2]) * uu[2], silu_f(z[3]) * uu[3]); \
                    *(u32x2*)((ACTc) + (size_t)(rg + (kind ? 63 : 0)) * DFF + f) = ow; } }
        {
            const int nM0 = last ? 64 : 68, rows0 = last ? FCH_LAT : FCH_ROWS;
            const int skn = last ? 0 : 32;
            PH_BEGIN(8)
            FFN_UP(0, nM0, 0, 0)
            PH_END
            PH_BEGIN(9)
            FFN_FIX(ACT0, rows0)
            PH_END
            PH_BEGIN(10)
            FFN_DOWN(0, nM0)
            FFN_UP(1, 64, skn, 8)
            PH_END
            PH_BEGIN(11)
            FFN_FIX(ACT1, FCH_LAT)
            PH_END
            PH_BEGIN(12)
            FFN_DOWN(1, 64)
            PH_END
        }
#undef FFN_UP
#undef FFN_DOWN
#undef FFN_FIX

        PH_BEGIN(13)
        { const float* modn = MOD + (size_t)(last ? l : l + 1) * 5 * MODW;
          ln_phase(XH, MIX, last ? p.out : (float*)nullptr, XH, last ? (bf16_t*)nullptr : H, SM + SM_LN2G + l * D, SM + SM_LN2B + l * D, modl + 5 * D, modn + D, modn, last ? NLAT : NROWS, bid, G, lds); }
        PH_END
    }
#undef PH_BEGIN
#undef PH_END
}

constexpr int N_PHASES = 2 + DEPTH * 12;

extern "C" void kernel_launch(void* const* d_in, const int* in_sizes, int n_in, void* d_out, int out_size, void* d_ws, size_t ws_size, hipStream_t stream) {
    static int grid = 0;
    if (grid == 0) {
        if (n_in != 23 || in_sizes[0] != NLAT * D || out_size != NLAT * D || ws_size < WS_END) {
            fprintf(stderr, "kernel_launch: unexpected shapes: n_in %d in0 %d out %d ws %zu (need %zu)\n", n_in, n_in > 0 ? in_sizes[0] : -1, out_size, ws_size, (size_t)WS_END); grid = -1; return; }
        int dev = 0, cus = 0, per_cu = 0;
        if (hipGetDevice(&dev) != hipSuccess || hipDeviceGetAttribute(&cus, hipDeviceAttributeMultiprocessorCount, dev) != hipSuccess) { fprintf(stderr, "kernel_launch: device query failed\n"); grid = -1; return; }
        if (hipFuncSetAttribute((const void*)fwd_kernel, hipFuncAttributeMaxDynamicSharedMemorySize, LDS_BYTES) != hipSuccess) { fprintf(stderr, "kernel_launch: hipFuncSetAttribute failed\n"); grid = -1; return; }
        if (hipOccupancyMaxActiveBlocksPerMultiprocessor(&per_cu, (const void*)fwd_kernel, 512, LDS_BYTES) != hipSuccess || per_cu < 1) {
            fprintf(stderr, "kernel_launch: occupancy query reports %d workgroups per CU\n", per_cu); (void)hipGetLastError(); grid = -1; return; }
        grid = cus;
    }
    if (grid < 0) return;
    if (hipMemsetAsync((char*)d_ws + WS_CTL, 0, CTL_BYTES, stream) != hipSuccess) { fprintf(stderr, "kernel_launch: memset failed\n"); return; }
    Params p{};
    for (int i = 0; i < 23; ++i) p.in[i] = (const float*)d_in[i];
    p.out = (float*)d_out; p.ws = (unsigned char*)d_ws; p.pad = 0;
#if MK_ONE_LAUNCH
    p.ph_lo = 0; p.ph_hi = N_PHASES; p.bar_region = 0;
    hipLaunchKernelGGL(fwd_kernel, dim3(grid), dim3(512), LDS_BYTES, stream, p);
#else
    for (int g = 0; g < N_PHASES; ++g) { p.ph_lo = g; p.ph_hi = g + 1; p.bar_region = 0;
        hipLaunchKernelGGL(fwd_kernel, dim3(grid), dim3(512), LDS_BYTES, stream, p); }
#endif
    const hipError_t le = hipPeekAtLastError();
    if (le != hipSuccess) fprintf(stderr, "kernel_launch: launch failed: %s\n", hipGetErrorName(le));
}
```

```cpp
#include <hip/hip_runtime.h>
#include <cstdio>
#include <cstdint>

#define LAS __attribute__((address_space(3)))
typedef unsigned short bf16_t;
typedef short bf16x8 __attribute__((ext_vector_type(8)));
typedef short s16x4 __attribute__((ext_vector_type(4)));
typedef float f32x4 __attribute__((ext_vector_type(4)));
typedef float f32x16 __attribute__((ext_vector_type(16)));
typedef unsigned u32x4 __attribute__((ext_vector_type(4)));
typedef unsigned u32x2 __attribute__((ext_vector_type(2)));

#ifndef MK_ONE_LAUNCH
#define MK_ONE_LAUNCH 1
#endif

constexpr int D = 2048, NB = 4, SEQ = 8192, DEPTH = 4, CTXL = 256;
constexpr int NLAT = NB * SEQ, NCTX = NB * CTXL, NROWS = NLAT + NCTX;
constexpr int INW = 4160, INWP = 4352, DFF = 5632, DFF2 = 11264;
constexpr int QUPW = 1152, QUPWP = 1280, KVUPW = 1536;
constexpr int NMOD = 6, MODW = NMOD * D;
constexpr float LN_EPS = 1e-5f, RMS_EPS = 1e-6f;
constexpr float ALPHA = 1.6817928305074292f;
constexpr float KSCALE = 0.08838834764831845f;
constexpr float MLA_QSCALE = 0.07216878364870323f * 1.4426950408889634f;
constexpr float LOG2E = 1.4426950408889634f;

constexpr size_t MiB = 1u << 20;
constexpr size_t WS_CTL = 0, CTL_BYTES = 1 * MiB;
constexpr size_t WS_MOD = 1 * MiB;
constexpr size_t WS_ROPE = 2 * MiB;
constexpr size_t WS_SM = 2 * MiB + 65536;
constexpr int SM_DECF = 0, SM_DECB = 16, SM_SINK = 32, SM_LN1G = 64, SM_LN1B = SM_LN1G + DEPTH * D, SM_LN2G = SM_LN1B + DEPTH * D, SM_LN2B = SM_LN2G + DEPTH * D,
              SM_CONVW = SM_LN2B + DEPTH * D, SM_CONVB = SM_CONVW + DEPTH * 3 * DFF, SM_END = SM_CONVB + DEPTH * DFF;
static_assert(WS_SM + (size_t)SM_END * 4 <= 3 * MiB, "small vectors");
constexpr size_t WS_RS = 3 * MiB;
constexpr size_t WS_W = 5 * MiB;
constexpr size_t W_IN = 0, W_UQ = W_IN + (size_t)INWP * D, W_UKV = W_UQ + (size_t)QUPWP * 512, W_O = W_UKV + (size_t)KVUPW * 256,
                 W_UP = W_O + (size_t)D * D, W_DN = W_UP + (size_t)DFF2 * D, W_LAYER = W_DN + (size_t)D * DFF;
constexpr size_t WS_X = WS_W + W_LAYER * 2 * DEPTH;
constexpr size_t WS_H = WS_X + (size_t)NROWS * D * 4;
constexpr size_t WS_Y = WS_H + (size_t)NROWS * D * 2;
constexpr size_t WS_PROJ = WS_Y + (size_t)NROWS * D * 2;
constexpr size_t WS_QUP = WS_PROJ + (size_t)NROWS * INW * 2;
constexpr size_t WS_KVUP = WS_QUP + (size_t)NROWS * QUPW * 2;
constexpr size_t WS_KVS = WS_KVUP + (size_t)NROWS * KVUPW * 2;
constexpr size_t WS_SIN = WS_KVS + (size_t)NB * 4 * 2 * 33 * 16384 * 4;
constexpr size_t WS_END = WS_SIN + (size_t)NB * 4 * 2 * 33 * 16384 * 2;
constexpr int FCH_LAT = 64 * 256, FCH_ROWS = FCH_LAT + NCTX;
constexpr size_t WS_ACT0 = WS_Y;
constexpr size_t WS_ACT1 = WS_ACT0 + (size_t)FCH_ROWS * DFF * 2;
constexpr int NGRP = FCH_ROWS / 64;
constexpr size_t WS_SB = WS_ACT1 + (size_t)FCH_LAT * DFF * 2;
static_assert(WS_SB + (size_t)2 * NGRP * 3 * DFF * 4 <= WS_QUP, "FFN overlay");
constexpr size_t WS_MIX = WS_QUP;
static_assert(WS_MIX >= WS_QUP && WS_MIX + (size_t)NROWS * D * 2 <= WS_END, "FFN overlay");
static_assert(WS_W % 256 == 0 && W_LAYER % 128 == 0 && WS_X % 256 == 0, "align");

constexpr int LDS_BYTES = 131072 + 512;

#define XB_TMO      128
#define XB_XCNT(j)  (256  + 64 * (j))
#define XB_XSUB(j)  (1280 + 64 * (j))
#define XB_XGEN(j)  (2304 + 64 * (j))
#define XB_TOP      3328
#define XB_TOPGEN   3392
#define XCD_BAR_WORDS 3456
#define XB_SPIN_CAP (1u << 20)

__device__ __forceinline__ unsigned xb_ld(unsigned* p)              { return __hip_atomic_load(p, __ATOMIC_RELAXED, __HIP_MEMORY_SCOPE_AGENT); }
__device__ __forceinline__ unsigned xb_add(unsigned* p, unsigned v) { return __hip_atomic_fetch_add(p, v, __ATOMIC_RELAXED, __HIP_MEMORY_SCOPE_AGENT); }
__device__ __forceinline__ unsigned xb_xcc_id() { return (unsigned)__builtin_amdgcn_s_getreg((3 << 11) | 20) & 0xFu; }
#define XB_SPIN(cond, bar) do { unsigned _sp = 0; while (cond) { __builtin_amdgcn_s_sleep(1); \
    if ((++_sp & 255u) == 0u) { if (xb_ld(&(bar)[XB_TMO])) break; if (_sp > XB_SPIN_CAP) { atomicAdd(&(bar)[XB_TMO], 1u); break; } } } } while (0)

struct XcdBarrier { unsigned* bar; unsigned x; volatile LAS unsigned* st; };

__device__ __forceinline__ XcdBarrier xcd_barrier_post(unsigned* bar, volatile LAS unsigned* st) {
    XcdBarrier b; b.bar = bar; b.x = xb_xcc_id(); b.st = st;
    if (threadIdx.x == 0) (void)xb_add(&bar[XB_XCNT(b.x)], 1u);
    return b;
}
__device__ __forceinline__ void xcd_barrier_complete(unsigned* bar, unsigned x, unsigned& nloc, unsigned& nx) {
    const unsigned G = gridDim.x * gridDim.y * gridDim.z;
    unsigned sum, cnt, mine, sp = 0u;
    for (;;) {
        sum = 0u; cnt = 0u; mine = 0u;
#pragma unroll
        for (unsigned j = 0; j < 16; ++j) { const unsigned c = xb_ld(&bar[XB_XCNT(j)]); sum += c; cnt += (c > 0u) ? 1u : 0u; mine = (j == x) ? c : mine; }
        if (sum == G) break;
        __builtin_amdgcn_s_sleep(1);
        if ((++sp & 255u) == 0u) { if (xb_ld(&bar[XB_TMO])) break; if (sp > XB_SPIN_CAP) { atomicAdd(&bar[XB_TMO], 1u); break; } }
    }
    nloc = mine > 0u ? mine : 1u; nx = cnt > 0u ? cnt : 1u;
}
__device__ __forceinline__ void xcd_barrier(const XcdBarrier& b) {
    asm volatile("s_waitcnt vmcnt(0)" ::: "memory");
    __syncthreads();
    if (threadIdx.x == 0) {
        unsigned* bar = b.bar;
        __builtin_amdgcn_s_waitcnt(0);
        unsigned nloc = b.st[0], nx = b.st[1];
        if (nloc == 0u) { xcd_barrier_complete(bar, b.x, nloc, nx); b.st[0] = nloc; b.st[1] = nx; }
        const unsigned old = xb_add(&bar[XB_XSUB(b.x)], 1u);
        const unsigned gen = old / nloc;
        if (old + 1u == (gen + 1u) * nloc) {
            __builtin_amdgcn_fence(__ATOMIC_RELEASE, "agent");
            asm volatile("s_waitcnt vmcnt(0)" ::: "memory");
            const unsigned og = xb_add(&bar[XB_TOP], 1u);
            const unsigned tg = og / nx;
            if (og + 1u == (tg + 1u) * nx) xb_add(&bar[XB_TOPGEN], 1u);
            else XB_SPIN(xb_ld(&bar[XB_TOPGEN]) == tg, bar);
            __builtin_amdgcn_fence(__ATOMIC_ACQUIRE, "agent");
            xb_add(&bar[XB_XGEN(b.x)], 1u);
            asm volatile("s_waitcnt vmcnt(0)" ::: "memory");
        } else {
            XB_SPIN(xb_ld(&bar[XB_XGEN(b.x)]) == gen, bar);
            __builtin_amdgcn_fence(__ATOMIC_ACQUIRE, "agent");
            asm volatile("s_waitcnt vmcnt(0)" ::: "memory");
        }
    }
    __syncthreads();
}

__device__ __forceinline__ unsigned cvtpk(float lo, float hi) { unsigned r; asm volatile("v_cvt_pk_bf16_f32 %0, %1, %2" : "=v"(r) : "v"(lo), "v"(hi)); return r; }
__device__ __forceinline__ float bf2f(unsigned short b) { return __uint_as_float(((unsigned)b) << 16); }
__device__ __forceinline__ float bflo(unsigned w) { return __uint_as_float(w << 16); }
__device__ __forceinline__ float bfhi(unsigned w) { return __uint_as_float(w & 0xffff0000u); }
__device__ __forceinline__ void st_bf16x4(bf16_t* p, f32x4 v) { u32x2 w; w.x = cvtpk(v[0], v[1]); w.y = cvtpk(v[2], v[3]); *(u32x2*)p = w; }
typedef _Float16 f16x4 __attribute__((ext_vector_type(4)));
__device__ __forceinline__ void st_f16x4(bf16_t* p, f32x4 v) { *(f16x4*)p = __builtin_convertvector(v, f16x4); }
__device__ __forceinline__ f32x4 cvt_f16x4(u32x2 w) { return __builtin_convertvector(__builtin_bit_cast(f16x4, w), f32x4); }
__device__ __forceinline__ float silu_f(float x) { return x * __builtin_amdgcn_rcpf(1.0f + __builtin_amdgcn_exp2f(-1.4426950408889634f * x)); }
__device__ __forceinline__ float wave_sum(float v) {
#pragma unroll
    for (int o = 1; o < 64; o <<= 1) v += __shfl_xor(v, o);
    return v;
}
__device__ __forceinline__ int otid() { int t = threadIdx.x; asm volatile("" : "+v"(t)); return t; }
__device__ __forceinline__ int mod_index(int row) { return row < NLAT ? (row >> 13) : 4; }

namespace pg8 {
constexpr int BM = 256, BK = 64, HALF = 128, HTB = HALF * BK * 2, STAGE_BYTES = 8 * HTB, NXCD = 8, WGM = 8;
__host__ __device__ __forceinline__ int lds_byte(int r, int c) { const int st = (r >> 4) * 2 + (c >> 5), rr = r & 15, cc = c & 31, ob = rr * 64 + cc * 2; return st * 1024 + (ob ^ (((ob >> 9) & 1) << 5)); }
__host__ __device__ __forceinline__ void stage_rc(int b, int& R, int& C) { const int st = b / 1024, sb = b % 1024, swz = sb ^ (((sb >> 9) & 1) << 5); R = (st >> 1) * 16 + swz / 64; C = (st & 1) * 32 + (swz % 64) / 2; }

struct Unit { int pm, pn; };
struct Gemm { const bf16_t* A; const bf16_t* Bt; int lda, K; };

struct TileOrder {
    int nM, nN, nwg, G, c, chunk, skew_n, skew_i;
    __device__ __forceinline__ void init(int nM_, int nN_, int G_, int c_, int chunk_, int skew_n_ = 0, int skew_i_ = 0) { nM = nM_; nN = nN_; nwg = nM * nN; G = G_; c = c_; chunk = chunk_; skew_n = skew_n_; skew_i = skew_i_; }
    __device__ __forceinline__ bool next(int i, Unit& u) const {
        long L;
        if (skew_n == 0 || i < skew_i) L = (long)i * G + c;
        else { if (c < skew_n) return false; L = (long)skew_i * G + (long)(i - skew_i) * (G - skew_n) + (c - skew_n); }
        if (L >= nwg) return false;
        int wgid = (int)L; { const int q = nwg / NXCD, r = nwg % NXCD, xcd = wgid % NXCD, off = wgid / NXCD; wgid = (xcd < r ? xcd * (q + 1) : r * (q + 1) + (xcd - r) * q) + off; }
        const int nig = WGM * nN, gid = wgid / nig, fm = gid * WGM, gsz = (nM - fm) < WGM ? (nM - fm) : WGM;
        int pm = fm + ((wgid % nig) % gsz); u.pn = (wgid % nig) / gsz;
        if (chunk >= 0) pm = (pm < 64) ? 64 * chunk + pm : 128 + (pm - 64);
        u.pm = pm; return true;
    }
    __device__ __forceinline__ void a_ready(const Unit&) const {}
    __device__ __forceinline__ void done(const Unit&) const {}
};

template <class Epi, class Sched>
__device__ __forceinline__ void gemm_phase(LAS unsigned char* lds, const Gemm g, const Sched& S, const Epi& E) {
    const int tid = otid(), wid = __builtin_amdgcn_readfirstlane(tid >> 6), lane = tid & 63, wr = wid >> 2, wc = wid & 3, fr = lane & 15, fq = lane >> 4;
    const int K = g.K, nt = K / BK, lda = g.lda;
    unsigned voffA[2], voffB[2];
#pragma unroll
    for (int i = 0; i < 2; ++i) { int R, C; stage_rc(tid * 16 + i * 8192, R, C);
        voffA[i] = (unsigned)(R * lda + C) * 2u; voffB[i] = (unsigned)(R * K + C) * 2u; }
    const size_t kstep = (size_t)(BK * 2);
    const size_t hstepA = (size_t)HALF * lda * 2, hstepB = (size_t)HALF * K * 2;
    const size_t tstepA = 2 * hstepA, tstepB = 2 * hstepB;
    const unsigned ldsw = (unsigned)wid * 1024u;
    const int aoff = lds_byte(wr * 64 + fr, fq * 8), boff = lds_byte(wc * 32 + fr, fq * 8);
#define PG8_SA(b, h) (((b) * 2 + (h)) * HTB)
#define PG8_SB(b, h) ((4 + (b) * 2 + (h)) * HTB)
#define PG8_STAGE(bufoff, gbase, voff) do { _Pragma("unroll") for (int _i = 0; _i < 2; ++_i) \
        __builtin_amdgcn_global_load_lds((const unsigned*)((const char*)(gbase) + (voff)[_i]), (LAS unsigned*)(lds + (bufoff) + ldsw + _i * 8192), 16, 0, 0); } while (0)
#define PG8_LDA(dst, b, h) do { _Pragma("unroll") for (int m = 0; m < 4; ++m) _Pragma("unroll") for (int k = 0; k < 2; ++k) dst[m][k] = *(const LAS bf16x8*)(lds + PG8_SA(b, h) + aoff + m * 2048 + k * 1024); } while (0)
#define PG8_LDB(dst, b, h) do { _Pragma("unroll") for (int n = 0; n < 2; ++n) _Pragma("unroll") for (int k = 0; k < 2; ++k) dst[n][k] = *(const LAS bf16x8*)(lds + PG8_SB(b, h) + boff + n * 2048 + k * 1024); } while (0)
#define PG8_MMA(ai, bj, At, Bt) do { __builtin_amdgcn_s_setprio(1); _Pragma("unroll") for (int m = 0; m < 4; ++m) _Pragma("unroll") for (int n = 0; n < 2; ++n) _Pragma("unroll") for (int k = 0; k < 2; ++k) \
        acc[ai][bj][m][n] = __builtin_amdgcn_mfma_f32_16x16x32_bf16(Bt[n][k], At[m][k], acc[ai][bj][m][n], 0, 0, 0); __builtin_amdgcn_s_setprio(0); } while (0)
#define PG8_WAIT_V(n) asm volatile("s_waitcnt vmcnt(" #n ")" ::: "memory")
#define PG8_WAIT_L(n) asm volatile("s_waitcnt lgkmcnt(" #n ")" ::: "memory")
#define PG8_BAR __builtin_amdgcn_s_barrier()
#define PG8_SCHED __builtin_amdgcn_sched_barrier(0)
    Unit cur, nxt; int ui = 0;
    if (!S.next(0, cur)) return;
    f32x4 acc[2][2][4][2];
#pragma unroll
    for (int a = 0; a < 2; ++a)
#pragma unroll
        for (int b = 0; b < 2; ++b)
#pragma unroll
            for (int m = 0; m < 4; ++m)
#pragma unroll
                for (int n = 0; n < 2; ++n) acc[a][b][m][n] = (f32x4){0.f, 0.f, 0.f, 0.f};
    bf16x8 At[4][2], B0[2][2], B1[2][2];
    const char* cA = (const char*)g.A + (size_t)cur.pm * tstepA; const char* cB = (const char*)g.Bt + (size_t)cur.pn * tstepB;
    S.a_ready(cur);
    PG8_STAGE(PG8_SB(0, 0), cB, voffB); PG8_STAGE(PG8_SA(0, 0), cA, voffA); PG8_STAGE(PG8_SB(0, 1), cB + hstepB, voffB); PG8_STAGE(PG8_SA(0, 1), cA + hstepA, voffA);
    if (wr == 1) PG8_BAR;
    PG8_WAIT_V(4); PG8_BAR;
    PG8_STAGE(PG8_SB(1, 0), cB + kstep, voffB); PG8_STAGE(PG8_SA(1, 0), cA + kstep, voffA); PG8_STAGE(PG8_SB(1, 1), cB + hstepB + kstep, voffB);
    PG8_WAIT_V(6); PG8_BAR;
    for (;;) {
        const bool has_next = S.next(ui + 1, nxt);
        const char* nA = has_next ? (const char*)g.A + (size_t)nxt.pm * tstepA : cA; const char* nB = has_next ? (const char*)g.Bt + (size_t)nxt.pn * tstepB : cB;
#pragma nounroll
        for (int t = 0; t < nt; t += 2) {
            const bool last = (t == nt - 2);
            const char* a1 = cA + (size_t)(t + 1) * kstep;
            const char* a2 = last ? nA : cA + (size_t)(t + 2) * kstep; const char* b2 = last ? nB : cB + (size_t)(t + 2) * kstep;
            const char* a3 = a2 + kstep; const char* b3 = b2 + kstep;
            if (last && has_next) S.a_ready(nxt);
            PG8_LDB(B0, 0, 0); PG8_SCHED; PG8_LDA(At, 0, 0); PG8_STAGE(PG8_SA(1, 1), a1 + hstepA, voffA);
            PG8_WAIT_L(8); PG8_BAR; PG8_WAIT_L(0); PG8_MMA(0, 0, At, B0); PG8_BAR; PG8_SCHED;
            PG8_LDB(B1, 0, 1); PG8_STAGE(PG8_SB(0, 0), b2, voffB);
            PG8_BAR; PG8_WAIT_L(0); PG8_MMA(0, 1, At, B1); PG8_BAR;
            PG8_LDA(At, 0, 1); PG8_STAGE(PG8_SA(0, 0), a2, voffA);
            PG8_BAR; PG8_WAIT_L(0); PG8_MMA(1, 0, At, B0); PG8_BAR; PG8_SCHED;
            PG8_STAGE(PG8_SB(0, 1), b2 + hstepB, voffB);
            PG8_WAIT_V(6); PG8_BAR; PG8_MMA(1, 1, At, B1); PG8_BAR;
            PG8_LDB(B0, 1, 0); PG8_SCHED; PG8_LDA(At, 1, 0); PG8_STAGE(PG8_SA(0, 1), a2 + hstepA, voffA);
            PG8_WAIT_L(8); PG8_BAR; PG8_WAIT_L(0); PG8_MMA(0, 0, At, B0); PG8_BAR; PG8_SCHED;
            PG8_LDB(B1, 1, 1); PG8_STAGE(PG8_SB(1, 0), b3, voffB);
            PG8_BAR; PG8_WAIT_L(0); PG8_MMA(0, 1, At, B1); PG8_BAR;
            PG8_LDA(At, 1, 1); PG8_STAGE(PG8_SA(1, 0), a3, voffA);
            PG8_BAR; PG8_WAIT_L(0); PG8_MMA(1, 0, At, B0); PG8_BAR; PG8_SCHED;
            PG8_STAGE(PG8_SB(1, 1), b3 + hstepB, voffB);
            PG8_WAIT_V(6); PG8_BAR; PG8_MMA(1, 1, At, B1); PG8_BAR;
        }
        E(acc, cur, wr, wc, fr, fq); S.done(cur);
        if (!has_next) break;
#pragma unroll
        for (int a = 0; a < 2; ++a)
#pragma unroll
            for (int b = 0; b < 2; ++b)
#pragma unroll
                for (int m = 0; m < 4; ++m)
#pragma unroll
                    for (int n = 0; n < 2; ++n) acc[a][b][m][n] = (f32x4){0.f, 0.f, 0.f, 0.f};
        cur = nxt; cA = nA; cB = nB; ++ui;
    }
    PG8_WAIT_V(0);
    if (wr == 0) PG8_BAR;
    PG8_BAR;
#undef PG8_SA
#undef PG8_SB
#undef PG8_STAGE
#undef PG8_LDA
#undef PG8_LDB
#undef PG8_MMA
#undef PG8_WAIT_V
#undef PG8_WAIT_L
#undef PG8_BAR
#undef PG8_SCHED
}


struct EpiProj {
    bf16_t* P; float* RS; const float* thc; const float* ths; const float* tmc; const float* tms;
    __device__ __forceinline__ void operator()(const f32x4 (&acc)[2][2][4][2], const Unit& u, int wr, int wc, int fr, int fq) const {
        asm volatile("" : "+v"(fr), "+v"(fq));
        const int pn = u.pn; const bool lat = u.pm < 128;
        const int row0 = u.pm * BM + wr * 64 + fr;
        if (pn == 16) {
            if (wc < 2) {
#pragma unroll
                for (int ai = 0; ai < 2; ++ai)
#pragma unroll
                    for (int m = 0; m < 4; ++m) {
                        const int row = row0 + ai * HALF + m * 16; const f32x4 v0 = acc[ai][0][m][0], v1 = acc[ai][0][m][1]; f32x4 o0 = v0, o1 = v1;
                        if (lat) { const int pos = row & (SEQ - 1), tp = wc ? (pos & 63) : (pos >> 6);
                            const f32x4 c = *(const f32x4*)(tmc + tp * 16 + 4 * fq), s = *(const f32x4*)(tms + tp * 16 + 4 * fq);
                            o0 = v0 * c - v1 * s; o1 = v1 * c + v0 * s; }
                        bf16_t* rp = P + (size_t)row * INW + 4096 + 32 * wc + 4 * fq;
                        st_bf16x4(rp, o0); st_bf16x4(rp + 16, o1);
                        asm volatile("" ::: "memory");
                    }
            }
            return;
        }
        const bool roped = (pn < 4) || (pn >= 8 && pn < 12);
        if (roped) {
            const float sc = (pn == 2 || pn == 3) ? KSCALE : ((pn >= 8 && pn <= 10) ? KSCALE * LOG2E : 1.0f);
            const int colb = pn * BM + 128 * (wc >> 1) + 64 * (wc & 1) + 8 * fq;
#pragma unroll
            for (int ai = 0; ai < 2; ++ai)
#pragma unroll
                for (int m = 0; m < 4; ++m) {
                    const int row = row0 + ai * HALF + m * 16; const int pos = row & (SEQ - 1), tp = (wc & 1) ? (pos & 63) : (pos >> 6);
                    u32x4 w0, w1;
#pragma unroll
                    for (int n = 0; n < 2; ++n) {
                        f32x4 c = (f32x4){1.f, 1.f, 1.f, 1.f}, s = (f32x4){0.f, 0.f, 0.f, 0.f};
                        if (lat) { c = *(const f32x4*)(thc + tp * 32 + 8 * fq + 4 * n); s = *(const f32x4*)(ths + tp * 32 + 8 * fq + 4 * n); }
                        const f32x4 v0 = acc[ai][0][m][n] * sc, v1 = acc[ai][1][m][n] * sc;
                        const f32x4 o0 = v0 * c - v1 * s, o1 = v1 * c + v0 * s;
                        w0[2 * n] = cvtpk(o0[0], o0[1]); w0[2 * n + 1] = cvtpk(o0[2], o0[3]); w1[2 * n] = cvtpk(o1[0], o1[1]); w1[2 * n + 1] = cvtpk(o1[2], o1[3]);
                    }
                    bf16_t* rp = P + (size_t)row * INW + colb;
                    *(u32x4*)rp = w0; *(u32x4*)(rp + 32) = w1;
                    asm volatile("" ::: "memory");
                }
            return;
        }
#pragma unroll
        for (int ai = 0; ai < 2; ++ai)
#pragma unroll
            for (int m = 0; m < 4; ++m) {
                const int row = row0 + ai * HALF + m * 16; bf16_t* rp = P + (size_t)row * INW + pn * BM + wc * 32 + 8 * fq; float ss = 0.f;
#pragma unroll
                for (int bj = 0; bj < 2; ++bj) { const f32x4 v0 = acc[ai][bj][m][0], v1 = acc[ai][bj][m][1];
                    u32x4 w; w[0] = cvtpk(v0[0], v0[1]); w[1] = cvtpk(v0[2], v0[3]); w[2] = cvtpk(v1[0], v1[1]); w[3] = cvtpk(v1[2], v1[3]);
                    *(u32x4*)(rp + bj * HALF) = w;
                    ss += ((v0[0] * v0[0] + v0[1] * v0[1]) + (v0[2] * v0[2] + v0[3] * v0[3])) + ((v1[0] * v1[0] + v1[1] * v1[1]) + (v1[2] * v1[2] + v1[3] * v1[3])); }
                if (pn >= 13 && pn <= 15) { ss += __shfl_xor(ss, 16); ss += __shfl_xor(ss, 32); if (fq == 0) RS[(size_t)row * 12 + (pn - 13) * 4 + wc] = ss; }
            }
    }
};
struct EpiQup {
    bf16_t* Q; const float* RS; const float* tmc; const float* tms;
    __device__ __forceinline__ void operator()(const f32x4 (&acc)[2][2][4][2], const Unit& u, int wr, int wc, int fr, int fq) const {
        asm volatile("" : "+v"(fr), "+v"(fq));
        const int pn = u.pn; const bool lat = u.pm < 128; const int row0 = u.pm * BM + wr * 64 + fr;
#pragma unroll
        for (int ai = 0; ai < 2; ++ai)
#pragma unroll
            for (int m = 0; m < 4; ++m) {
                const int row = row0 + ai * HALF + m * 16; const f32x4 r0 = *(const f32x4*)(RS + (size_t)row * 12), r1 = *(const f32x4*)(RS + (size_t)row * 12 + 4);
                const float rs = MLA_QSCALE / sqrtf(((r0[0] + r0[1]) + (r0[2] + r0[3]) + (r1[0] + r1[1]) + (r1[2] + r1[3])) * (1.0f / 512.0f) + RMS_EPS);
                const int pos = row & (SEQ - 1), tp = (wc & 1) ? (pos & 63) : (pos >> 6);
                const f32x4 c = *(const f32x4*)(tmc + tp * 16 + 4 * fq), s = *(const f32x4*)(tms + tp * 16 + 4 * fq);
#pragma unroll
                for (int bj = 0; bj < 2; ++bj) {
                    const int colb = pn * BM + bj * HALF + wc * 32; if (colb >= QUPW) continue;
                    const int c64 = 4 * pn + 2 * bj + (wc >> 1);
                    const f32x4 v0 = acc[ai][bj][m][0] * rs, v1 = acc[ai][bj][m][1] * rs; f32x4 o0 = v0, o1 = v1;
                    if (lat && (c64 % 3) == 2) { o0 = v0 * c - v1 * s; o1 = v1 * c + v0 * s; }
                    bf16_t* rp = Q + (size_t)row * QUPW + colb + 4 * fq; st_bf16x4(rp, o0); st_bf16x4(rp + 16, o1);
                }
                asm volatile("" ::: "memory");
            }
    }
};
struct EpiKvup {
    bf16_t* KV; const float* RS;
    __device__ __forceinline__ void operator()(const f32x4 (&acc)[2][2][4][2], const Unit& u, int wr, int wc, int fr, int fq) const {
        asm volatile("" : "+v"(fr), "+v"(fq));
        const int row0 = u.pm * BM + wr * 64 + fr;
#pragma unroll
        for (int ai = 0; ai < 2; ++ai)
#pragma unroll
            for (int m = 0; m < 4; ++m) {
                const int row = row0 + ai * HALF + m * 16; const f32x4 r0 = *(const f32x4*)(RS + (size_t)row * 12 + 8);
                const float rs = 1.0f / sqrtf(((r0[0] + r0[1]) + (r0[2] + r0[3])) * (1.0f / 256.0f) + RMS_EPS);
                bf16_t* rp = KV + (size_t)row * KVUPW + u.pn * BM + wc * 32 + 8 * fq;
#pragma unroll
                for (int bj = 0; bj < 2; ++bj) { const f32x4 v0 = acc[ai][bj][m][0] * rs, v1 = acc[ai][bj][m][1] * rs;
                    u32x4 w; w[0] = cvtpk(v0[0], v0[1]); w[1] = cvtpk(v0[2], v0[3]); w[2] = cvtpk(v1[0], v1[1]); w[3] = cvtpk(v1[2], v1[3]);
                    *(u32x4*)(rp + bj * HALF) = w; }
                asm volatile("" ::: "memory");
            }
    }
};
struct EpiMix {
    bf16_t* MIX; int chunk; int dry;
    __device__ __forceinline__ void operator()(const f32x4 (&acc)[2][2][4][2], const Unit& u, int wr, int wc, int fr, int fq) const {
        asm volatile("" : "+v"(fr), "+v"(fq));
        if (dry) { float s = 0.f;
#pragma unroll
            for (int ai = 0; ai < 2; ++ai)
#pragma unroll
                for (int bj = 0; bj < 2; ++bj)
#pragma unroll
                    for (int m = 0; m < 4; ++m)
#pragma unroll
                        for (int n = 0; n < 2; ++n) s += (acc[ai][bj][m][n][0] + acc[ai][bj][m][n][1]) + (acc[ai][bj][m][n][2] + acc[ai][bj][m][n][3]);
            if (s == 123456.789f) MIX[0] = (bf16_t)1; return; }
        const int pmg = chunk < 0 ? u.pm : (u.pm < 64 ? 64 * chunk + u.pm : 128 + (u.pm - 64));
        const int row0 = pmg * BM + wr * 64 + fr;
#pragma unroll
        for (int ai = 0; ai < 2; ++ai)
#pragma unroll
            for (int m = 0; m < 4; ++m) { bf16_t* rp = MIX + (size_t)(row0 + ai * HALF + m * 16) * D + u.pn * BM + wc * 32 + 8 * fq;
#pragma unroll
                for (int bj = 0; bj < 2; ++bj) { const f32x4 v0 = acc[ai][bj][m][0], v1 = acc[ai][bj][m][1];
                    u32x4 w; w[0] = cvtpk(v0[0], v0[1]); w[1] = cvtpk(v0[2], v0[3]); w[2] = cvtpk(v1[0], v1[1]); w[3] = cvtpk(v1[2], v1[3]);
                    *(u32x4*)(rp + bj * HALF) = w; } }
    }
};
struct EpiUpConv {
    bf16_t* ACTc; float* SB; const float* cw; const float* cb; int chunk;
    static __device__ __forceinline__ float lane_prev(float x) { return __builtin_bit_cast(float, __builtin_amdgcn_update_dpp(0, __builtin_bit_cast(int, x), 0x121, 0xf, 0xf, false)); }
    static __device__ __forceinline__ float lane_next(float x) { return __builtin_bit_cast(float, __builtin_amdgcn_update_dpp(0, __builtin_bit_cast(int, x), 0x12f, 0xf, 0xf, false)); }
    __device__ __forceinline__ void operator()(const f32x4 (&acc)[2][2][4][2], const Unit& u, int wr, int wc, int fr, int fq) const {
        asm volatile("" : "+v"(fr), "+v"(fq));
        const int lpm = u.pm < 128 ? u.pm - 64 * chunk : 64 + (u.pm - 128);
        const int f0 = u.pn * 128 + wc * 32 + 8 * fq;
        f32x4 w0[2], w1[2], w2[2], bb[2];
#pragma unroll
        for (int n = 0; n < 2; ++n) { w0[n] = *(const f32x4*)(cw + f0 + 4 * n); w1[n] = *(const f32x4*)(cw + DFF + f0 + 4 * n); w2[n] = *(const f32x4*)(cw + 2 * DFF + f0 + 4 * n); bb[n] = *(const f32x4*)(cb + f0 + 4 * n); }
#pragma unroll
        for (int ai = 0; ai < 2; ++ai) {
            const int rg = lpm * BM + ai * HALF + wr * 64;
            const int smask = rg < FCH_LAT ? (SEQ - 1) : (CTXL - 1);
            const bool seq_first = (rg & smask) == 0, seq_last = ((rg + 63) & smask) == smask;
#pragma unroll
            for (int m = 0; m < 4; ++m) {
                u32x4 ow;
#pragma unroll
                for (int n = 0; n < 2; ++n) {
                    f32x4 gp, gn;
#pragma unroll
                    for (int e = 0; e < 4; ++e) {
                        const float pa_ = lane_prev(acc[ai][1][m][n][e]), pb_ = m > 0 ? lane_prev(acc[ai][1][m > 0 ? m - 1 : 0][n][e]) : 0.f;
                        const float na_ = lane_next(acc[ai][1][m][n][e]), nb_ = m < 3 ? lane_next(acc[ai][1][m < 3 ? m + 1 : 3][n][e]) : 0.f;
                        gp[e] = fr > 0 ? pa_ : pb_; gn[e] = fr < 15 ? na_ : nb_;
                    }
                    const f32x4 gc = acc[ai][1][m][n], uu = acc[ai][0][m][n];
                    f32x4 z; float su[4];
#pragma unroll
                    for (int e = 0; e < 4; ++e) { z[e] = fmaf(w0[n][e], gp[e], fmaf(w1[n][e], gc[e], fmaf(w2[n][e], gn[e], bb[n][e]))); su[e] = silu_f(z[e]) * uu[e]; }
                    ow[2 * n] = cvtpk(su[0], su[1]); ow[2 * n + 1] = cvtpk(su[2], su[3]);
                    if (m == 0 && fr == 0) { float* sp = SB + ((size_t)(0 * NGRP + (rg >> 6)) * 3) * DFF + f0 + 4 * n; *(f32x4*)(sp + 2 * DFF) = gc; if (!seq_first) { *(f32x4*)sp = z; *(f32x4*)(sp + DFF) = uu; } }
                    if (m == 3 && fr == 15) { float* sp = SB + ((size_t)(1 * NGRP + (rg >> 6)) * 3) * DFF + f0 + 4 * n; *(f32x4*)(sp + 2 * DFF) = gc; if (!seq_last) { *(f32x4*)sp = z; *(f32x4*)(sp + DFF) = uu; } }
                }
                *(u32x4*)(ACTc + (size_t)(rg + 16 * m + fr) * DFF + f0) = ow;
            }
            asm volatile("" ::: "memory");
        }
    }
};
}

#define SBAR() __builtin_amdgcn_sched_barrier(0)
__device__ __forceinline__ int crow(int r, int hi) { return (r & 3) + 8 * (r >> 2) + 4 * hi; }
template <int DQK> __device__ __forceinline__ int kswz(int row, int cb) {
    return row * (DQK * 2 + 16) + cb;
}
__device__ __forceinline__ int v_st(int k, int c) { const int kk = (k & ~0xC) | ((k & 4) << 1) | ((k & 8) >> 1); return ((kk >> 3) * 4 + (c >> 5)) * 512 + ((kk & 7) * 32 + (c & 31)) * 2; }
__device__ __forceinline__ int v_stn(int k, int c) { return ((k >> 3) * 4 + (c >> 5)) * 512 + ((k & 7) * 32 + (c & 31)) * 2; }
__device__ __forceinline__ int v_rd_base(int lane) { return ((lane & 3) << 3) | (((lane >> 2) & 3) << 6) | (((lane >> 4) & 1) << 5) | (((lane >> 5) & 1) << 8); }
constexpr int v_rd_off(int d0, int ks, int half) { return d0 * 512 + ks * 4096 + half * 2048; }
template <int OFF> __device__ __forceinline__ s16x4 tr_read(int vb) {
    s16x4 r; asm volatile("ds_read_b64_tr_b16 %0, %1 offset:%2" : "=&v"(r) : "v"(vb), "i"(OFF) : "memory"); return r;
}
#define PKLH(L, H) (bf16x8){L[0], L[1], L[2], L[3], H[0], H[1], H[2], H[3]}
template <int D0> __device__ __forceinline__ void pv_one(f32x16& od, int vb, bf16x8 pa0, bf16x8 pa1, bf16x8 pa2, bf16x8 pa3) {
    const s16x4 l0 = tr_read<v_rd_off(D0, 0, 0)>(vb), h0 = tr_read<v_rd_off(D0, 0, 1)>(vb), l1 = tr_read<v_rd_off(D0, 1, 0)>(vb), h1 = tr_read<v_rd_off(D0, 1, 1)>(vb);
    const s16x4 l2 = tr_read<v_rd_off(D0, 2, 0)>(vb), h2 = tr_read<v_rd_off(D0, 2, 1)>(vb), l3 = tr_read<v_rd_off(D0, 3, 0)>(vb), h3 = tr_read<v_rd_off(D0, 3, 1)>(vb);
    asm volatile("s_waitcnt lgkmcnt(0)" ::: "memory"); SBAR();
    od = __builtin_amdgcn_mfma_f32_32x32x16_bf16(pa0, PKLH(l0, h0), od, 0, 0, 0);
    od = __builtin_amdgcn_mfma_f32_32x32x16_bf16(pa1, PKLH(l1, h1), od, 0, 0, 0);
    od = __builtin_amdgcn_mfma_f32_32x32x16_bf16(pa2, PKLH(l2, h2), od, 0, 0, 0);
    od = __builtin_amdgcn_mfma_f32_32x32x16_bf16(pa3, PKLH(l3, h3), od, 0, 0, 0);
}
__device__ __forceinline__ void pv_d0(f32x16* o, int vb, bf16x8 pa0, bf16x8 pa1, bf16x8 pa2, bf16x8 pa3) {
    pv_one<0>(o[0], vb, pa0, pa1, pa2, pa3); pv_one<1>(o[1], vb, pa0, pa1, pa2, pa3); pv_one<2>(o[2], vb, pa0, pa1, pa2, pa3); pv_one<3>(o[3], vb, pa0, pa1, pa2, pa3);
}
template <int DQK> __device__ __forceinline__ void qkt(f32x16& p0, f32x16& p1, const char* Ks, const bf16x8* qr, int r32, int hi, const f32x16 init = f32x16{}) {
    constexpr int NS = DQK / 16;
    p0 = init; p1 = init;
    bf16x8 b0[NS], b1[NS];
#pragma unroll
    for (int d0 = 0; d0 < NS; ++d0) { const int cb = (d0 * 16 + hi * 8) * 2;
        b0[d0] = *reinterpret_cast<const bf16x8*>(Ks + kswz<DQK>(r32, cb));
        b1[d0] = *reinterpret_cast<const bf16x8*>(Ks + kswz<DQK>(32 + r32, cb)); }
#pragma unroll
    for (int d0 = 0; d0 < NS; ++d0) {
        p0 = __builtin_amdgcn_mfma_f32_32x32x16_bf16(b0[d0], qr[d0], p0, 0, 0, 0);
        p1 = __builtin_amdgcn_mfma_f32_32x32x16_bf16(b1[d0], qr[d0], p1, 0, 0, 0); }
#ifndef QKT_AHEAD
#define QKT_AHEAD 2
#endif
    __builtin_amdgcn_sched_group_barrier(0x100, 2 * QKT_AHEAD, 0);
#pragma unroll
    for (int d0 = 0; d0 < NS - QKT_AHEAD; ++d0) { __builtin_amdgcn_sched_group_barrier(0x008, 2, 0); __builtin_amdgcn_sched_group_barrier(0x100, 2, 0); }
    __builtin_amdgcn_sched_group_barrier(0x008, 2 * QKT_AHEAD, 0);
}
#define PK4(P, BASE, OUT) do { const unsigned a0_ = cvtpk(P[BASE + 0], P[BASE + 1]), a1_ = cvtpk(P[BASE + 2], P[BASE + 3]);   \
    const unsigned b0_ = cvtpk(P[BASE + 4], P[BASE + 5]), b1_ = cvtpk(P[BASE + 6], P[BASE + 7]);                              \
    auto r0_ = __builtin_amdgcn_permlane32_swap(a0_, b0_, false, false); auto r1_ = __builtin_amdgcn_permlane32_swap(a1_, b1_, false, false); \
    u32x4 w_ = {r0_[0], r1_[0], r0_[1], r1_[1]}; OUT = *reinterpret_cast<bf16x8*>(&w_); } while (0)

#define PK4N(P, BASE, OUT) do { u32x4 w_ = {cvtpk(P[BASE + 0], P[BASE + 1]), cvtpk(P[BASE + 2], P[BASE + 3]), cvtpk(P[BASE + 4], P[BASE + 5]), cvtpk(P[BASE + 6], P[BASE + 7])}; \
    OUT = *reinterpret_cast<bf16x8*>(&w_); } while (0)

template <int SC1000> struct SmC { };
constexpr float THR = 8.f;

__device__ __forceinline__ void partialSM(f32x16& p0, f32x16& p1, float& m_reg, float& mn, float& alpha, const float C, const float thr_raw) {
    float pmax = p0[0];
#pragma unroll
    for (int r = 1; r < 16; ++r) pmax = fmaxf(pmax, p0[r]);
#pragma unroll
    for (int r = 0; r < 16; ++r) pmax = fmaxf(pmax, p1[r]);
    { auto rr = __builtin_amdgcn_permlane32_swap(__float_as_uint(pmax), __float_as_uint(pmax), false, false);
      pmax = fmaxf(__uint_as_float(rr[0]), __uint_as_float(rr[1])); }
    if (__builtin_expect(__all(pmax - m_reg <= thr_raw), 1)) { mn = m_reg; alpha = 1.f; }
    else { mn = fmaxf(m_reg, pmax); alpha = __builtin_amdgcn_exp2f((m_reg - mn) * C); m_reg = mn; }
    const float mnC = -mn * C;
#pragma unroll
    for (int r = 0; r < 16; ++r) p0[r] = fmaf(p0[r], C, mnC);
#pragma unroll
    for (int r = 0; r < 16; ++r) p1[r] = fmaf(p1[r], C, mnC);
#pragma unroll
    for (int r = 0; r < 16; ++r) p0[r] = __builtin_amdgcn_exp2f(p0[r]);
}
__device__ __forceinline__ void finishSM(f32x16& p0, f32x16& p1, float alpha, float& l_reg, bf16x8& pa0, bf16x8& pa1, bf16x8& pa2, bf16x8& pa3) {
#pragma unroll
    for (int r = 0; r < 16; ++r) p1[r] = __builtin_amdgcn_exp2f(p1[r]);
    float ps = 0;
#pragma unroll
    for (int r = 0; r < 16; ++r) ps += p0[r];
#pragma unroll
    for (int r = 0; r < 16; ++r) ps += p1[r];
    { auto rr = __builtin_amdgcn_permlane32_swap(__float_as_uint(ps), __float_as_uint(ps), false, false);
      ps = __uint_as_float(rr[0]) + __uint_as_float(rr[1]); }
    l_reg = l_reg * alpha + ps;
    PK4N(p0, 0, pa0); PK4N(p0, 8, pa1); PK4N(p1, 0, pa2); PK4N(p1, 8, pa3);
}

constexpr int KVBLK = 64;
struct AttnArgs {
    const bf16_t* Q; int ldq;
    const bf16_t* K; int ldk;
    const bf16_t* KR; int ldkr;
    const bf16_t* V; int ldv;
    bf16_t* O; int ldo;
    int nt;
    int seg0_tiles, seg0_row, seg1_row;
    int qpos0;
    int masked;
    float sink_l2; int has_sink;
    float C;
};
template <int DQK>
__device__ __forceinline__ void attn_body(const AttnArgs& a, char* lds) {
    constexpr int SHM_V = KVBLK * 128 * 2, SHM_K = KVBLK * (DQK * 2 + 16);
    const int tid = otid(), wid = tid >> 6, lane = tid & 63, r32 = lane & 31, hi = lane >> 5;
    char* V_lds = lds; char* K_lds = lds + 2 * SHM_V;
    float* ws = (float*)(lds + 2 * SHM_V + 2 * SHM_K) + wid * 64; float* li_l = ws; float* al_l = ws + 32;
    float m_reg = -1e30f, l_reg = 0; f32x16 o[4] = {}; bf16x8 qr[DQK / 16];
    const float C = a.C, thr_raw = THR * LOG2E / a.C;
    const bf16_t* Qw = a.Q + (long)(wid * 32 + r32) * a.ldq + hi * 8;
#pragma unroll
    for (int d0 = 0; d0 < DQK / 16; ++d0) qr[d0] = *reinterpret_cast<const bf16x8*>(Qw + d0 * 16);
    const int sr = tid >> 4, sc = (tid & 15) * 8, vst0 = v_stn(sr, sc), vst1 = v_stn(32 + sr, sc);
    const int kst0 = kswz<DQK>(sr, sc * 2), kst1 = kswz<DQK>(32 + sr, sc * 2);
    const int sr2 = tid >> 3, sc2 = (tid & 7) * 8, kst2 = (DQK == 192) ? kswz<DQK>(sr2, 256 + sc2 * 2) : 0;
    const int vb0 = (int)(uintptr_t)V_lds + v_rd_base(lane);
    bf16x8 vs0, vs1, ks0, ks1, ks2;
    __syncthreads();
#define TILE_ROW(j) ((j) < a.seg0_tiles ? a.seg0_row + 64 * (j) : ((a.masked && (unsigned)(a.qpos0 - 128 + 64 * ((j) - a.seg0_tiles)) >= (unsigned)SEQ) ? a.seg0_row : a.seg1_row + 64 * ((j) - a.seg0_tiles)))
    int cur_row = TILE_ROW(0);
    const bf16_t* pk0 = a.K + ((long)cur_row + sr) * a.ldk + sc;
    const bf16_t* pkr = a.KR + ((long)cur_row + sr2) * a.ldkr + sc2;
    const long dvk = a.V - a.K, d32 = 32L * a.ldk;
#define SLOAD(j) do { const int nr_ = TILE_ROW(j); const long dr_ = (long)(nr_ - cur_row); cur_row = nr_; pk0 += dr_ * a.ldk; if (DQK == 192) pkr += dr_ * a.ldkr; \
    vs0 = *reinterpret_cast<const bf16x8*>(pk0 + dvk); vs1 = *reinterpret_cast<const bf16x8*>(pk0 + d32 + dvk); \
    ks0 = *reinterpret_cast<const bf16x8*>(pk0); ks1 = *reinterpret_cast<const bf16x8*>(pk0 + d32); \
    if (DQK == 192) ks2 = *reinterpret_cast<const bf16x8*>(pkr); } while (0)
#define SWRITE(b) do { *(bf16x8*)(V_lds + (b) * SHM_V + vst0) = vs0; *(bf16x8*)(V_lds + (b) * SHM_V + vst1) = vs1; \
    *(bf16x8*)(K_lds + (b) * SHM_K + kst0) = ks0; *(bf16x8*)(K_lds + (b) * SHM_K + kst1) = ks1; \
    if (DQK == 192) *(bf16x8*)(K_lds + (b) * SHM_K + kst2) = ks2; } while (0)
#define SWAIT() asm volatile("s_waitcnt vmcnt(0)" ::: "memory")
#define RESC(al) do { if (__any((al) < 1.f)) { if (hi == 0) al_l[r32] = (al); asm volatile("s_waitcnt lgkmcnt(0)" ::: "memory"); \
    _Pragma("unroll") for (int d = 0; d < 4; ++d) _Pragma("unroll") for (int r = 0; r < 16; ++r) o[d][r] *= al_l[crow(r, hi)]; } } while (0)
#define MASK(P0, P1, j) do { if (a.masked && (j) >= a.seg0_tiles) { const int kp0_ = a.qpos0 - 128 + 64 * ((j) - a.seg0_tiles), qp_ = a.qpos0 + wid * 32 + r32; \
    const bool tv_ = (unsigned)kp0_ < (unsigned)SEQ; \
    _Pragma("unroll") for (int r = 0; r < 16; ++r) { const int d0_ = kp0_ + crow(r, hi) - qp_, d1_ = d0_ + 32; \
        P0[r] = (tv_ && d0_ <= 128 && d0_ >= -128) ? P0[r] : -1e30f; P1[r] = (tv_ && d1_ <= 128 && d1_ >= -128) ? P1[r] : -1e30f; } } } while (0)
    f32x16 pA0, pA1; float mnA, alA; bf16x8 pa0, pa1, pa2, pa3; const int NT = a.nt;
    const int wu = __builtin_amdgcn_readfirstlane(wid);
    volatile int* vflag = (volatile int*)(lds + 2 * SHM_V + 2 * SHM_K + 8 * 256);
#define TILE_BODY(CLASSIC) { \
        const int b = j & 1; \
        if (j + 1 < NT) SLOAD(j + 1); \
        bool skip = false;        \
        if (a.masked && j >= a.seg0_tiles) { const int kp0_ = a.qpos0 - 128 + 64 * (j - a.seg0_tiles), q0_ = a.qpos0 + wu * 32; \
            skip = ((unsigned)kp0_ >= (unsigned)SEQ) || (kp0_ + 63 < q0_ - 128) || (kp0_ > q0_ + 31 + 128); } \
        if (!skip) { \
            if (CLASSIC) { \
                SBAR(); qkt<DQK>(pA0, pA1, K_lds + b * SHM_K, qr, r32, hi); MASK(pA0, pA1, j); \
                partialSM(pA0, pA1, m_reg, mnA, alA, C, thr_raw); \
                RESC(alA); \
                finishSM(pA0, pA1, alA, l_reg, pa0, pa1, pa2, pa3); \
            } else { \
                SBAR(); qkt<DQK>(pA0, pA1, K_lds + b * SHM_K, qr, r32, hi, minit); MASK(pA0, pA1, j);        \
                float ps_ = 0.f; \
                _Pragma("unroll") for (int r = 0; r < 16; ++r) pA0[r] = __builtin_amdgcn_exp2f(pA0[r]); \
                _Pragma("unroll") for (int r = 0; r < 16; ++r) pA1[r] = __builtin_amdgcn_exp2f(pA1[r]); \
                _Pragma("unroll") for (int r = 0; r < 16; ++r) ps_ += pA0[r]; \
                _Pragma("unroll") for (int r = 0; r < 16; ++r) ps_ += pA1[r]; \
                { auto rr = __builtin_amdgcn_permlane32_swap(__float_as_uint(ps_), __float_as_uint(ps_), false, false); ps_ = __uint_as_float(rr[0]) + __uint_as_float(rr[1]); } \
                bad |= !__all(ps_ <= 256.0f); \
                l_reg += ps_; \
                PK4N(pA0, 0, pa0); PK4N(pA0, 8, pa1); PK4N(pA1, 0, pa2); PK4N(pA1, 8, pa3); \
            } \
            SBAR(); \
            pv_d0(o, vb0 + b * SHM_V, pa0, pa1, pa2, pa3); \
        } \
        if (j + 1 < NT) { SWAIT(); SWRITE(b ^ 1); } \
        __syncthreads(); }
    if (tid == 0) *vflag = 0;
#pragma nounroll
    for (int pass = 0; pass < 2; ++pass) {
        int bad = 0;
        SLOAD(0); SWAIT(); SWRITE(0); __syncthreads();
        const int jc = pass ? NT : 1;
        f32x16 minit = f32x16{};
#pragma nounroll
        for (int j = 0; j < jc; ++j) TILE_BODY(1)
#pragma unroll
        for (int r = 0; r < 16; ++r) minit[r] = -m_reg * C;
#pragma nounroll
        for (int j = jc; j < NT; ++j) TILE_BODY(0)
        if (pass) break;
        if (bad && lane == 0) *vflag = 1;
        __syncthreads();
        if (*vflag == 0) break;
        __syncthreads();
        m_reg = -1e30f; l_reg = 0.f;
#pragma unroll
        for (int d = 0; d < 4; ++d) o[d] = f32x16{};
    }
#undef TILE_BODY
    if (a.has_sink) l_reg += __builtin_amdgcn_exp2f(a.sink_l2 - m_reg * C);
    if (hi == 0) li_l[r32] = l_reg; asm volatile("s_waitcnt lgkmcnt(0)" ::: "memory");
    float rli[16];
#pragma unroll
    for (int r = 0; r < 16; ++r) rli[r] = __builtin_amdgcn_rcpf(li_l[crow(r, hi)]);
    __syncthreads();
    { unsigned short* stg = (unsigned short*)(lds + wid * 8704);
#pragma unroll
      for (int r = 0; r < 16; ++r) { const int orow = crow(r, hi);
#pragma unroll
          for (int d0 = 0; d0 < 4; ++d0) stg[orow * 136 + d0 * 32 + r32] = (unsigned short)(cvtpk(o[d0][r] * rli[r], 0.f) & 0xffffu); }
      asm volatile("s_waitcnt lgkmcnt(0)" ::: "memory");
      bf16_t* Ow = a.O + (long)(wid * 32) * a.ldo;
#pragma unroll
      for (int i = 0; i < 8; ++i) { const int q = lane + 64 * i, row = q >> 4, c8 = (q & 15) * 8;
          *(u32x4*)(Ow + (long)row * a.ldo + c8) = *(const u32x4*)(stg + row * 136 + c8); } }
#undef TILE_ROW
#undef SLOAD
#undef SWRITE
#undef SWAIT
#undef RESC
#undef MASK
}

__device__ __forceinline__ int ret_row0(int bb, int n) { return n == 32 ? NLAT + bb * CTXL : bb * SEQ + n * 256; }
__device__ __forceinline__ float log2_sigmoid(float x) { return -log1pf(__expf(-x)) * LOG2E; }

__device__ __forceinline__ void ret_kv_unit(const bf16_t* PROJ, float* KVS, int bb, int h, int n, float lgf2, float lgb2, char* lds) {
    const int tid = otid(), wid = tid >> 6, lane = tid & 63, r32 = lane & 31, hi = lane >> 5;
    const int dir = wid >> 2, ablk = wid & 3;
    const int sr = tid >> 4, sc = (tid & 15) * 8, vst0 = v_st(sr, sc), vst1 = v_st(32 + sr, sc);
    const long R0 = ret_row0(bb, n);
    const bf16_t* Kg = PROJ + R0 * INW + 512 + h * 128; const bf16_t* Vg = PROJ + R0 * INW + 1024 + h * 128;
    const int vbK = (int)(uintptr_t)lds + dir * 16384 + v_rd_base(lane) + ablk * 512;
    const int vbV = (int)(uintptr_t)lds + 32768 + v_rd_base(lane);
    f32x16 acc[4] = {};
    u32x4 kq[2]; bf16x8 vq[2];
#pragma unroll
    for (int i = 0; i < 2; ++i) { const int j = sr + 32 * i; kq[i] = *reinterpret_cast<const u32x4*>(Kg + (long)j * INW + sc); vq[i] = *reinterpret_cast<const bf16x8*>(Vg + (long)j * INW + sc); }
    for (int t = 0; t < 4; ++t) {
        __syncthreads();
#pragma unroll
        for (int i = 0; i < 2; ++i) {
            const int j = 64 * t + sr + 32 * i;
            const u32x4 kv = kq[i];
            const bf16x8 vv = vq[i];
            const float kf = __builtin_amdgcn_exp2f(lgf2 * (float)(255 - j)), kb = __builtin_amdgcn_exp2f(lgb2 * (float)j);
            u32x4 wf, wb;
#pragma unroll
            for (int e = 0; e < 4; ++e) { const float lo = bflo(kv[e]), hh = bfhi(kv[e]); wf[e] = cvtpk(lo * kf, hh * kf); wb[e] = cvtpk(lo * kb, hh * kb); }
            const int vo = i ? vst1 : vst0;
            *(u32x4*)(lds + vo) = wf; *(u32x4*)(lds + 16384 + vo) = wb; *(bf16x8*)(lds + 32768 + vo) = vv;
        }
        if (t < 3) {
#pragma unroll
            for (int i = 0; i < 2; ++i) { const int j = 64 * (t + 1) + sr + 32 * i; kq[i] = *reinterpret_cast<const u32x4*>(Kg + (long)j * INW + sc); vq[i] = *reinterpret_cast<const bf16x8*>(Vg + (long)j * INW + sc); }
        }
        __syncthreads();
#define RKV_STEP(KS) do { \
        const s16x4 al_ = tr_read<v_rd_off(0, KS, 0)>(vbK), ah_ = tr_read<v_rd_off(0, KS, 1)>(vbK); \
        const s16x4 l0_ = tr_read<v_rd_off(0, KS, 0)>(vbV), h0_ = tr_read<v_rd_off(0, KS, 1)>(vbV), l1_ = tr_read<v_rd_off(1, KS, 0)>(vbV), h1_ = tr_read<v_rd_off(1, KS, 1)>(vbV); \
        const s16x4 l2_ = tr_read<v_rd_off(2, KS, 0)>(vbV), h2_ = tr_read<v_rd_off(2, KS, 1)>(vbV), l3_ = tr_read<v_rd_off(3, KS, 0)>(vbV), h3_ = tr_read<v_rd_off(3, KS, 1)>(vbV); \
        asm volatile("s_waitcnt lgkmcnt(0)" ::: "memory"); SBAR(); \
        const bf16x8 af_ = PKLH(al_, ah_); \
        acc[0] = __builtin_amdgcn_mfma_f32_32x32x16_bf16(af_, PKLH(l0_, h0_), acc[0], 0, 0, 0); \
        acc[1] = __builtin_amdgcn_mfma_f32_32x32x16_bf16(af_, PKLH(l1_, h1_), acc[1], 0, 0, 0); \
        acc[2] = __builtin_amdgcn_mfma_f32_32x32x16_bf16(af_, PKLH(l2_, h2_), acc[2], 0, 0, 0); \
        acc[3] = __builtin_amdgcn_mfma_f32_32x32x16_bf16(af_, PKLH(l3_, h3_), acc[3], 0, 0, 0); } while (0)
        RKV_STEP(0); RKV_STEP(1); RKV_STEP(2); RKV_STEP(3);
#undef RKV_STEP
    }
    float* outp = KVS + ((((size_t)bb * 4 + h) * 2 + dir) * 33 + n) * 16384;
#pragma unroll
    for (int r = 0; r < 16; ++r) { const int dk = 32 * ablk + crow(r, hi);
#pragma unroll
        for (int d = 0; d < 4; ++d) outp[dk * 128 + 32 * d + r32] = acc[d][r]; }
}

__device__ __forceinline__ void ret_scan(const float* KVS, bf16_t* SIN, const float* dec_f, const float* dec_b, int gtid, int gthreads) {
    for (int it = gtid; it < NB * 4 * 2 * 4096; it += gthreads) {
        const int e4 = it & 4095, dir = (it >> 12) & 1, h = (it >> 13) & 3, bb = it >> 15;
        const float lg2 = log2_sigmoid(dir ? dec_b[h] : dec_f[h]); const float cd = __builtin_amdgcn_exp2f(lg2 * 256.0f);
        const size_t base = ((((size_t)bb * 4 + h) * 2 + dir) * 33) * 16384 + (size_t)e4 * 4;
        f32x4 s = *(const f32x4*)(KVS + base + (size_t)32 * 16384);
        *(u32x2*)(SIN + base + (size_t)32 * 16384) = (u32x2){0u, 0u};
        for (int nb = 0; nb < 4; ++nb) {
            f32x4 kv[8];
#pragma unroll
            for (int q = 0; q < 8; ++q) { const int n = dir ? 31 - (nb * 8 + q) : nb * 8 + q; kv[q] = *(const f32x4*)(KVS + base + (size_t)n * 16384); }
#pragma unroll
            for (int q = 0; q < 8; ++q) { const int n = dir ? 31 - (nb * 8 + q) : nb * 8 + q;
                st_bf16x4(SIN + base + (size_t)n * 16384, s); s = s * cd + kv[q]; }
        }
    }
}

__device__ __forceinline__ void ret_out_unit(const bf16_t* PROJ, const bf16_t* SIN, bf16_t* Y, int bb, int h, int n, float lgf2, float lgb2, char* lds) {
    const int tid = otid(), wid = tid >> 6, lane = tid & 63, r32 = lane & 31, hi = lane >> 5;
    const int sr = tid >> 4, sc = (tid & 15) * 8, vst0 = v_st(sr, sc), vst1 = v_st(32 + sr, sc);
    const int kst0 = kswz<128>(sr, sc * 2), kst1 = kswz<128>(32 + sr, sc * 2);
    const long R0 = ret_row0(bb, n);
    const bf16_t* Qg = PROJ + R0 * INW + h * 128; const bf16_t* Kg = Qg + 512; const bf16_t* Vg = Qg + 1024; const bf16_t* Gg = Qg + 1536;
    char* K_lds = lds; char* V_lds = lds + 17408;
    const int vb0 = (int)(uintptr_t)V_lds + v_rd_base(lane);
    bf16x8 qr[8];
    const bf16_t* Qw = Qg + (long)(wid * 32 + r32) * INW + hi * 8;
#pragma unroll
    for (int d0 = 0; d0 < 8; ++d0) qr[d0] = *reinterpret_cast<const bf16x8*>(Qw + d0 * 16);
    f32x16 o[4] = {};
    const int iq = wid * 32 + r32;
    const bf16_t* S0 = SIN + ((((size_t)bb * 4 + h) * 2) * 33 + n) * 16384;
    bf16x8 kq[2], vq[2];
#pragma unroll
    for (int i = 0; i < 2; ++i) { const int j = sr + 32 * i; kq[i] = *reinterpret_cast<const bf16x8*>(Kg + (long)j * INW + sc); vq[i] = *reinterpret_cast<const bf16x8*>(Vg + (long)j * INW + sc); }
    for (int t = 0; t < 4; ++t) {
        __syncthreads();
#pragma unroll
        for (int i = 0; i < 2; ++i) { *(bf16x8*)(K_lds + (i ? kst1 : kst0)) = kq[i]; *(bf16x8*)(V_lds + (i ? vst1 : vst0)) = vq[i]; }
        if (t < 3) {
#pragma unroll
            for (int i = 0; i < 2; ++i) { const int j = 64 * (t + 1) + sr + 32 * i; kq[i] = *reinterpret_cast<const bf16x8*>(Kg + (long)j * INW + sc); vq[i] = *reinterpret_cast<const bf16x8*>(Vg + (long)j * INW + sc); }
        } else if (n != 32) {
#pragma unroll
            for (int i = 0; i < 2; ++i) vq[i] = *reinterpret_cast<const bf16x8*>(S0 + (sr + 32 * i) * 128 + sc);
        }
        __syncthreads();
        f32x16 p0, p1; qkt<128>(p0, p1, K_lds, qr, r32, hi);
#pragma unroll
        for (int r = 0; r < 16; ++r) {
            const int d0 = iq - (64 * t + crow(r, hi)), d1 = d0 - 32;
            const float m0 = d0 > 0 ? __builtin_amdgcn_exp2f(lgf2 * (float)d0) : (d0 < 0 ? __builtin_amdgcn_exp2f(lgb2 * (float)(-d0)) : 2.0f);
            const float m1 = d1 > 0 ? __builtin_amdgcn_exp2f(lgf2 * (float)d1) : (d1 < 0 ? __builtin_amdgcn_exp2f(lgb2 * (float)(-d1)) : 2.0f);
            p0[r] *= m0; p1[r] *= m1;
        }
        bf16x8 pa0, pa1, pa2, pa3; PK4(p0, 0, pa0); PK4(p0, 8, pa1); PK4(p1, 0, pa2); PK4(p1, 8, pa3);
        pv_d0(o, vb0, pa0, pa1, pa2, pa3);
    }
    if (n != 32) {
#pragma unroll
        for (int s4 = 0; s4 < 4; ++s4) {
            const int dir = s4 >> 1, ts = s4 & 1;
            const float qd = dir ? __builtin_amdgcn_exp2f(lgb2 * (float)(256 - iq)) : __builtin_amdgcn_exp2f(lgf2 * (float)(iq + 1));
            __syncthreads();
#pragma unroll
            for (int i = 0; i < 2; ++i) *(bf16x8*)(V_lds + (i ? vst1 : vst0)) = vq[i];
            if (s4 < 3) { const int d2 = (s4 + 1) >> 1, t2 = (s4 + 1) & 1; const bf16_t* Sn = S0 + (size_t)d2 * 33 * 16384;
#pragma unroll
                for (int i = 0; i < 2; ++i) vq[i] = *reinterpret_cast<const bf16x8*>(Sn + (64 * t2 + sr + 32 * i) * 128 + sc); }
            bf16x8 qs[4];
#pragma unroll
            for (int k = 0; k < 4; ++k) { const u32x4 w = *reinterpret_cast<const u32x4*>(&qr[4 * ts + k]); u32x4 x;
#pragma unroll
                for (int e = 0; e < 4; ++e) x[e] = cvtpk(bflo(w[e]) * qd, bfhi(w[e]) * qd);
                qs[k] = *reinterpret_cast<bf16x8*>(&x); }
            __syncthreads();
            pv_d0(o, vb0, qs[0], qs[1], qs[2], qs[3]);
        }
    }
    __syncthreads();
    { unsigned short* stg = (unsigned short*)(lds + wid * 8704);
#pragma unroll
      for (int r = 0; r < 16; ++r) {
          float ss = (o[0][r] * o[0][r] + o[1][r] * o[1][r]) + (o[2][r] * o[2][r] + o[3][r] * o[3][r]);
          ss += __shfl_xor(ss, 1); ss += __shfl_xor(ss, 2); ss += __shfl_xor(ss, 4); ss += __shfl_xor(ss, 8); ss += __shfl_xor(ss, 16);
          const float rn = 1.0f / sqrtf(ss * (1.0f / 128.0f) + RMS_EPS);
#pragma unroll
          for (int d = 0; d < 4; ++d) stg[crow(r, hi) * 136 + 32 * d + r32] = (unsigned short)(cvtpk(o[d][r] * rn, 0.f) & 0xffffu);
      }
      asm volatile("s_waitcnt lgkmcnt(0)" ::: "memory");
#pragma unroll
      for (int i = 0; i < 8; ++i) { const int q = lane + 64 * i, row = q >> 4, c8 = (q & 15) * 8;
          const u32x4 gw = *(const u32x4*)(Gg + (long)(wid * 32 + row) * INW + c8);
          const u32x4 xw = *(const u32x4*)(stg + row * 136 + c8);
          u32x4 ow;
#pragma unroll
          for (int e = 0; e < 4; ++e) ow[e] = cvtpk(silu_f(bflo(gw[e])) * bflo(xw[e]), silu_f(bfhi(gw[e])) * bfhi(xw[e]));
          *(u32x4*)(Y + (R0 + wid * 32 + row) * D + h * 128 + c8) = ow; } }
}

struct Params {
    const float* in[23];
    float* out; unsigned char* ws;
    int ph_lo, ph_hi, bar_region, pad;
};
enum { I_X = 0, I_C, I_CTX, I_CCTX, I_ADAW, I_ADAB, I_WIN, I_DECF, I_DECB, I_SINK, I_QNORM, I_WUQ, I_KVNORM, I_WUKV, I_WO, I_LN1G, I_LN1B, I_WUP, I_CONVW, I_CONVB, I_WDN, I_LN2G, I_LN2B };

__device__ __forceinline__ int win_src_col(int p) {
    if (p >= INW) return -1;
    if (p >= 4096) return p;
    const int pn = p >> 8;
    if (pn < 4 || (pn >= 8 && pn < 12)) {
        const int bj = (p >> 7) & 1, x = p & 127, wc = x >> 5, nn = (x >> 4) & 1, q = x & 15;
        return (p & ~255) + 128 * (wc >> 1) + 64 * (wc & 1) + 32 * bj + 8 * (q >> 2) + 4 * nn + (q & 3);
    }
    return (p & ~31) + 8 * ((p & 15) >> 2) + 4 * ((p >> 4) & 1) + (p & 3);
}
__device__ __forceinline__ int wup_src_col(int p) {
    const int pn = p >> 8, bj = (p >> 7) & 1, x = p & 127, wc = x >> 5, nn = (x >> 4) & 1, q = x & 15, fq = q >> 2, j = q & 3;
    const int f = 128 * pn + 32 * wc + 8 * fq + 4 * nn + j;
    return bj ? DFF + f : f;
}
__device__ __forceinline__ void cvt_item(const float* W, int K, int N, bf16_t* Bt, int mode, const float* kscale, int item, int nkt, float* scr, int lane) {
    const int pt = item / nkt, kt = item - pt * nkt, p0 = pt * 32, k0 = kt * 64;
    const int p = p0 + (lane & 31);
    const int src = mode == 1 ? win_src_col(p) : (mode == 2 ? wup_src_col(p) : (mode == 3 ? ((p & ~31) + 8 * ((p & 15) >> 2) + 4 * ((p >> 4) & 1) + (p & 3)) : (p < N ? p : -1)));
    const float* wp = W + (size_t)(k0 + (lane >> 5)) * N + (src >= 0 ? src : 0);
    float v[32];
#pragma unroll
    for (int i = 0; i < 32; ++i) v[i] = src >= 0 ? wp[(size_t)(2 * i) * N] : 0.f;
    if (kscale) {
#pragma unroll
        for (int i = 0; i < 32; ++i) v[i] *= kscale[k0 + 2 * i + (lane >> 5)];
    }
#pragma unroll
    for (int i = 0; i < 32; ++i) scr[(2 * i + (lane >> 5)) * 33 + (lane & 31)] = v[i];
    asm volatile("s_waitcnt lgkmcnt(0)" ::: "memory");
    const int c = lane & 7;
#pragma unroll
    for (int j = 0; j < 4; ++j) { const int n = (lane >> 3) + 8 * j; const float* s = scr + (8 * c) * 33 + n;
        u32x4 o; o[0] = cvtpk(s[0 * 33], s[1 * 33]); o[1] = cvtpk(s[2 * 33], s[3 * 33]); o[2] = cvtpk(s[4 * 33], s[5 * 33]); o[3] = cvtpk(s[6 * 33], s[7 * 33]);
        *(u32x4*)(Bt + (size_t)(p0 + n) * K + k0 + 8 * c) = o; }
    asm volatile("s_waitcnt lgkmcnt(0)" ::: "memory");
}

__device__ __forceinline__ void ln_phase(const bf16_t* X, const bf16_t* MIX, float* dstf, bf16_t* dsth, bf16_t* H, const float* g, const float* b,
                                         const float* gate, const float* sc, const float* sh, int nrows, int bid, int G, char* lds) {
    const int tid = otid(), lane = tid & 63, wid = __builtin_amdgcn_readfirstlane(tid >> 6);
    float* L = (float*)lds;
    __syncthreads();
    for (int i = tid; i < D; i += 512) { L[i] = g[i]; L[D + i] = b[i]; }
    const int ngroups = nrows >> 3, grp0 = (int)(((long)bid * ngroups) / G), nsteps = (int)(((long)(bid + 1) * ngroups) / G) - grp0; int s_cur = -1;
#define LN_ROW(k) ((grp0 + (k)) * 8 + wid)
#define LN_LOAD(XA, MA, ROW) do { const bf16_t* xr_ = X + (size_t)(ROW) * D + 4 * lane; const bf16_t* mr_ = MIX + (size_t)(ROW) * D + 4 * lane; \
    _Pragma("unroll") for (int j = 0; j < 8; ++j) { XA[j] = *(const u32x2*)(xr_ + 256 * j); MA[j] = *(const u32x2*)(mr_ + 256 * j); } } while (0)
#define LN_SVEC(k) do { const int s_ = mod_index((grp0 + (k)) * 8); \
    if (s_ != s_cur) { __syncthreads(); \
        { float gv_[4], sv_[4], hv_[4]; \
          _Pragma("unroll") for (int q_ = 0; q_ < 4; ++q_) { const int i = tid + 512 * q_; gv_[q_] = gate[(size_t)s_ * MODW + i]; sv_[q_] = H ? sc[(size_t)s_ * MODW + i] : 0.f; hv_[q_] = H ? sh[(size_t)s_ * MODW + i] : 0.f; } \
          _Pragma("unroll") for (int q_ = 0; q_ < 4; ++q_) { const int i = tid + 512 * q_; L[2 * D + i] = gv_[q_] + 1.0f; L[3 * D + i] = sv_[q_] + 1.0f; L[4 * D + i] = hv_[q_]; } } \
        s_cur = s_; __syncthreads(); } } while (0)
#define LN_COMP(XA, MA, ROW) do { \
    f32x4 v[8]; float sum = 0.f; \
    _Pragma("unroll") for (int j = 0; j < 8; ++j) { const int c = 4 * lane + 256 * j; \
        const f32x4 mv = (f32x4){bflo(MA[j][0]), bfhi(MA[j][0]), bflo(MA[j][1]), bfhi(MA[j][1])}; \
        v[j] = cvt_f16x4(XA[j]) * ALPHA + *(const f32x4*)(L + 2 * D + c) * mv; sum += (v[j][0] + v[j][1]) + (v[j][2] + v[j][3]); } \
    const float mean = wave_sum(sum) * (1.0f / D); float s2 = 0.f; \
    _Pragma("unroll") for (int j = 0; j < 8; ++j) { v[j] = v[j] - mean; s2 += (v[j][0] * v[j][0] + v[j][1] * v[j][1]) + (v[j][2] * v[j][2] + v[j][3] * v[j][3]); } \
    const float rstd = 1.0f / sqrtf(wave_sum(s2) * (1.0f / D) + LN_EPS); \
    _Pragma("unroll") for (int j = 0; j < 8; ++j) { const int c = 4 * lane + 256 * j; \
        const f32x4 y = v[j] * rstd * *(const f32x4*)(L + c) + *(const f32x4*)(L + D + c); \
        if (dstf) *(f32x4*)(dstf + (size_t)(ROW) * D + c) = y; else st_f16x4(dsth + (size_t)(ROW) * D + c, y); \
        if (H) st_bf16x4(H + (size_t)(ROW) * D + c, y * *(const f32x4*)(L + 3 * D + c) + *(const f32x4*)(L + 4 * D + c)); } } while (0)
    u32x2 xa[8], xb[8], ma[8], mb[8];
    if (LN_ROW(0) < nrows) LN_LOAD(xa, ma, LN_ROW(0));
    for (int k = 0; k < nsteps; k += 2) {
        LN_SVEC(k);
        if (k + 1 < nsteps && LN_ROW(k + 1) < nrows) LN_LOAD(xb, mb, LN_ROW(k + 1));
        SBAR();
        if (LN_ROW(k) < nrows) LN_COMP(xa, ma, LN_ROW(k));
        if (k + 1 < nsteps) {
            LN_SVEC(k + 1);
            if (k + 2 < nsteps && LN_ROW(k + 2) < nrows) LN_LOAD(xa, ma, LN_ROW(k + 2));
            SBAR();
            if (LN_ROW(k + 1) < nrows) LN_COMP(xb, mb, LN_ROW(k + 1));
        }
    }
#undef LN_ROW
#undef LN_LOAD
#undef LN_SVEC
#undef LN_COMP
}

__global__ void __launch_bounds__(512, 2) fwd_kernel(Params p) {
    extern __shared__ __attribute__((aligned(16))) unsigned char lds_raw[];
    LAS unsigned char* ldsl = (LAS unsigned char*)lds_raw;
    char* lds = (char*)lds_raw;
    if (threadIdx.x < 4) ((volatile LAS unsigned*)(ldsl + 131072))[threadIdx.x] = 0u;
    __syncthreads();
    XcdBarrier bar; bar.bar = (unsigned*)(p.ws + WS_CTL) + (size_t)p.bar_region * 4096; bar.x = 0; bar.st = (volatile LAS unsigned*)(ldsl + 131072);
    if (p.ph_hi - p.ph_lo > 1) bar = xcd_barrier_post(bar.bar, (volatile LAS unsigned*)(ldsl + 131072));

    int g = 0, lcur = 0;
#ifndef DUPMASK
#define DUPMASK 0
#endif
#define NREP(k) (1 + ((DUPMASK >> (k)) & 1))
#ifndef PHMASK
#define PHMASK 0xffff
#endif
#ifndef SUBMASK
#define SUBMASK 0xffff
#endif
#define SUB(k) ((SUBMASK >> (k)) & 1)
#define PH_BEGIN(k) if (((PHMASK >> (k)) & 1) && g >= p.ph_lo && g < p.ph_hi) { \
    int bid = blockIdx.x, G = gridDim.x; asm volatile("" : "+s"(bid), "+s"(G)); const int NGW = G * 8, gthreads = G * 512; (void)NGW; (void)gthreads; \
    const int tid = otid(), lane = tid & 63, wid = __builtin_amdgcn_readfirstlane(tid >> 6); const int gw = bid * 8 + wid, gtid = bid * 512 + tid; (void)lane; (void)gw; (void)gtid; \
    size_t wsoff_ = 0; asm volatile("" : "+s"(wsoff_)); unsigned char* ws = p.ws + wsoff_; \
    float* MOD = (float*)(ws + WS_MOD); float* ROPE = (float*)(ws + WS_ROPE); float* RS = (float*)(ws + WS_RS); float* SM = (float*)(ws + WS_SM); (void)SM; \
    float* thc = ROPE, *ths = ROPE + 4096, *tmc = ROPE + 8192, *tms = ROPE + 8192 + 2048; \
    bf16_t* WB = (bf16_t*)(ws + WS_W); float* X = (float*)(ws + WS_X); bf16_t* XH = (bf16_t*)(ws + WS_X); (void)XH; bf16_t* H = (bf16_t*)(ws + WS_H); bf16_t* Y = (bf16_t*)(ws + WS_Y); \
    bf16_t* PROJ = (bf16_t*)(ws + WS_PROJ); bf16_t* QUP = (bf16_t*)(ws + WS_QUP); bf16_t* KVUP = (bf16_t*)(ws + WS_KVUP); \
    float* KVS = (float*)(ws + WS_KVS); bf16_t* SIN = (bf16_t*)(ws + WS_SIN); bf16_t* ACT0 = (bf16_t*)(ws + WS_ACT0); bf16_t* ACT1 = (bf16_t*)(ws + WS_ACT1); float* SB = (float*)(ws + WS_SB); bf16_t* MIX = (bf16_t*)(ws + WS_MIX); (void)MIX; \
    const bf16_t* wl = WB + (size_t)lcur * W_LAYER; const float* modl = MOD + (size_t)lcur * 5 * MODW; \
    (void)RS; (void)thc; (void)ths; (void)tmc; (void)tms; (void)X; (void)H; (void)Y; (void)PROJ; (void)QUP; (void)KVUP; (void)KVS; (void)SIN; (void)ACT0; (void)ACT1; (void)SB; (void)wl; (void)modl;
#define PH_END   if (g + 1 < p.ph_hi) xcd_barrier(bar); } ++g;

    PH_BEGIN(0)
    {
        for (int i = gtid; i < SM_END; i += gthreads) {
            float v = 0.f;
            if (i < SM_DECB) v = p.in[I_DECF][i];
            else if (i < SM_SINK) v = p.in[I_DECB][i - SM_DECB];
            else if (i < SM_LN1G) v = (i - SM_SINK) < DEPTH * 6 ? p.in[I_SINK][i - SM_SINK] : 0.f;
            else if (i < SM_LN1B) v = p.in[I_LN1G][i - SM_LN1G];
            else if (i < SM_LN2G) v = p.in[I_LN1B][i - SM_LN1B];
            else if (i < SM_LN2B) v = p.in[I_LN2G][i - SM_LN2G];
            else if (i < SM_CONVW) v = p.in[I_LN2B][i - SM_LN2B];
            else if (i < SM_CONVB) v = p.in[I_CONVW][i - SM_CONVW];
            else v = p.in[I_CONVB][i - SM_CONVB];
            SM[i] = v;
        }
        for (int i = gtid; i < 4096 + 2048; i += gthreads) {
            if (i < 4096) { const int pos = i >> 5, f = i & 31; const float inv = exp2f(-(float)f * (13.287712379549449f / 32.0f)); const float ang = (float)pos * inv; thc[i] = cosf(ang); ths[i] = sinf(ang); }
            else { const int q = i - 4096, pos = q >> 4, f = q & 15; const float inv = exp2f(-(float)f * (13.287712379549449f / 16.0f)); const float ang = (float)pos * inv; tmc[q] = cosf(ang); tms[q] = sinf(ang); }
        }
        {
            float* scs = (float*)lds;
            float* red = (float*)(lds + 5 * 2048 * 4);
            for (int i = tid; i < 5 * 2048; i += 512) { const int s = i >> 11, k = i & 2047; const float cv = s < 4 ? p.in[I_C][s * D + k] : p.in[I_CCTX][k]; scs[i] = silu_f(cv); }
            __syncthreads();
            for (int u = bid; u < DEPTH * (MODW / 64); u += G) {
                const int l = u / (MODW / 64), j = (u % (MODW / 64)) * 64 + lane;
                const float* Wp = p.in[I_ADAW] + (size_t)l * D * MODW + j;
                float a0 = 0.f, a1 = 0.f, a2 = 0.f, a3 = 0.f, a4 = 0.f;
#pragma unroll 16
                for (int kk = 0; kk < 256; ++kk) { const int k = wid * 256 + kk; const float w = Wp[(size_t)k * MODW];
                    a0 += scs[k] * w; a1 += scs[2048 + k] * w; a2 += scs[4096 + k] * w; a3 += scs[6144 + k] * w; a4 += scs[8192 + k] * w; }
                red[(wid * 5 + 0) * 64 + lane] = a0; red[(wid * 5 + 1) * 64 + lane] = a1; red[(wid * 5 + 2) * 64 + lane] = a2; red[(wid * 5 + 3) * 64 + lane] = a3; red[(wid * 5 + 4) * 64 + lane] = a4;
                __syncthreads();
                if (wid < 5) { float sum = 0.f;
#pragma unroll
                    for (int w8 = 0; w8 < 8; ++w8) sum += red[(w8 * 5 + wid) * 64 + lane];
                    MOD[((size_t)l * 5 + wid) * MODW + j] = sum + p.in[I_ADAB][(size_t)l * MODW + j]; }
                __syncthreads();
            }
        }
        {
            __syncthreads();
            float* scr = (float*)(lds + wid * 8448);
            constexpr int T_IN = (INWP / 32) * (D / 64), T_UQ = (QUPWP / 32) * (512 / 64), T_UKV = (KVUPW / 32) * (256 / 64), T_O = (D / 32) * (D / 64), T_UP = (DFF2 / 32) * (D / 64), T_DN = (D / 32) * (DFF / 64);
            constexpr int T_L = T_IN + T_UQ + T_UKV + T_O + T_UP + T_DN;
            for (int u = gw; u < DEPTH * T_L; u += NGW) {
                const int l = u / T_L; int r = u % T_L; bf16_t* wlp = WB + (size_t)l * W_LAYER;
                const float* Wsrc; const float* ksc = nullptr; bf16_t* dst; int Kd, Nd, mode;
                if (r < T_IN) { Wsrc = p.in[I_WIN] + (size_t)l * D * INW; Kd = D; Nd = INW; dst = wlp + W_IN; mode = 1; }
                else if ((r -= T_IN) < T_UQ) { Wsrc = p.in[I_WUQ] + (size_t)l * 512 * QUPW; Kd = 512; Nd = QUPW; dst = wlp + W_UQ; mode = 0; ksc = p.in[I_QNORM] + l * 512; }
                else if ((r -= T_UQ) < T_UKV) { Wsrc = p.in[I_WUKV] + (size_t)l * 256 * KVUPW; Kd = 256; Nd = KVUPW; dst = wlp + W_UKV; mode = 3; ksc = p.in[I_KVNORM] + l * 256; }
                else if ((r -= T_UKV) < T_O) { Wsrc = p.in[I_WO] + (size_t)l * D * D; Kd = D; Nd = D; dst = wlp + W_O; mode = 3; }
                else if ((r -= T_O) < T_UP) { Wsrc = p.in[I_WUP] + (size_t)l * D * DFF2; Kd = D; Nd = DFF2; dst = wlp + W_UP; mode = 2; }
                else { r -= T_UP; Wsrc = p.in[I_WDN] + (size_t)l * DFF * D; Kd = DFF; Nd = D; dst = wlp + W_DN; mode = 3; }
                cvt_item(Wsrc, Kd, Nd, dst, mode, ksc, r, Kd / 64, scr, lane);
            }
        }
    }
    PH_END

    PH_BEGIN(1)
    {
        f32x4 va[8], vb[8];
#define G1_SRC(ROW) ((ROW) < NLAT ? p.in[I_X] + (size_t)(ROW) * D : p.in[I_CTX] + (size_t)((ROW) - NLAT) * D)
#define G1_LOAD(VA, ROW) do { const float* s_ = G1_SRC(ROW) + 4 * lane; _Pragma("unroll") for (int j = 0; j < 8; ++j) VA[j] = *(const f32x4*)(s_ + 256 * j); } while (0)
#define G1_STORE(VA, ROW) do { const float* mp_ = MOD + (size_t)mod_index(ROW) * MODW; \
        _Pragma("unroll") for (int j = 0; j < 8; ++j) { const int c = 4 * lane + 256 * j; \
            st_f16x4(XH + (size_t)(ROW) * D + c, VA[j]); \
            st_bf16x4(H + (size_t)(ROW) * D + c, VA[j] * (*(const f32x4*)(mp_ + D + c) + 1.0f) + *(const f32x4*)(mp_ + c)); } } while (0)
        int row = gw;
        if (row < NROWS) G1_LOAD(va, row);
        for (; row < NROWS; row += 2 * NGW) {
            if (row + NGW < NROWS) G1_LOAD(vb, row + NGW);
            SBAR();
            G1_STORE(va, row);
            if (row + NGW < NROWS) {
                if (row + 2 * NGW < NROWS) G1_LOAD(va, row + 2 * NGW);
                SBAR();
                G1_STORE(vb, row + NGW);
            }
        }
#undef G1_SRC
#undef G1_LOAD
#undef G1_STORE
    }
    PH_END

    for (int l = 0; l < DEPTH; ++l) {
        const bool last = (l == DEPTH - 1);
        const int nMfull = last ? 128 : 132;
        lcur = l;

        PH_BEGIN(2)
        for (int rep_ = 0; rep_ < NREP(0); ++rep_) { pg8::Gemm gm{H, wl + W_IN, D, D}; pg8::TileOrder S; S.init(132, INWP / 256, G, bid, -1);
          pg8::EpiProj E{PROJ, RS, thc, ths, tmc, tms};
          pg8::gemm_phase<pg8::EpiProj, pg8::TileOrder>(ldsl, gm, S, E); }
        PH_END

        PH_BEGIN(3)
        if (SUB(0)) for (int rep_ = 0; rep_ < NREP(1); ++rep_) { pg8::Gemm gm{PROJ + 3328, wl + W_UQ, INW, 512}; pg8::TileOrder S; S.init(132, QUPWP / 256, G, bid, -1);
          pg8::EpiQup E{QUP, RS, tmc, tms};
          pg8::gemm_phase<pg8::EpiQup, pg8::TileOrder>(ldsl, gm, S, E); }
        if (SUB(1)) for (int rep_ = 0; rep_ < NREP(2); ++rep_) { pg8::Gemm gm{PROJ + 3840, wl + W_UKV, INW, 256}; pg8::TileOrder S; S.init(132, KVUPW / 256, G, (G == 256) ? ((bid + 104) & 255) : bid, -1);
          pg8::EpiKvup E{KVUP, RS};
          pg8::gemm_phase<pg8::EpiKvup, pg8::TileOrder>(ldsl, gm, S, E); }
        if (SUB(2)) for (int rep_ = 0; rep_ < NREP(3); ++rep_) for (int u = (G == 256) ? ((bid + 80) & 255) : bid; u < NB * 4 * 33; u += G) {
            const int n = u % 33, h = (u / 33) & 3, bb = u / 132;
            const float lgf2 = log2_sigmoid(SM[SM_DECF + l * 4 + h]), lgb2 = log2_sigmoid(SM[SM_DECB + l * 4 + h]);
            ret_kv_unit(PROJ, KVS, bb, h, n, lgf2, lgb2, lds);
        }
        PH_END

        PH_BEGIN(4)
        if (SUB(3)) for (int rep_ = 0; rep_ < NREP(4); ++rep_) ret_scan(KVS, SIN, SM + SM_DECF + l * 4, SM + SM_DECB + l * 4, gtid, gthreads);
        if (SUB(4)) for (int rep_ = 0; rep_ < NREP(5); ++rep_) {
            const int nun = last ? 768 : 792;
            for (int u = bid; u < nun; u += G) {
                AttnArgs a;
                int bb, h, qrow;
                if (u < 768) { const int rnd = u / G, w_ = u % G; const int bh = (G == 256) ? (rnd * 8 + (w_ & 7)) : (u >> 5); const int qb = (G == 256) ? (w_ >> 3) : (u & 31); h = bh % 6; bb = bh / 6; qrow = bb * SEQ + qb * 256; a.nt = 132; a.seg0_tiles = 128; a.seg0_row = bb * SEQ; a.seg1_row = NLAT + bb * CTXL; }
                else { const int v = u - 768; h = v % 6; bb = v / 6; qrow = NLAT + bb * CTXL; a.nt = 4; a.seg0_tiles = 4; a.seg0_row = NLAT + bb * CTXL; a.seg1_row = a.seg0_row; }
                a.Q = QUP + (size_t)qrow * QUPW + h * 192; a.ldq = QUPW;
                a.K = KVUP + h * 256; a.ldk = KVUPW; a.KR = PROJ + 4096; a.ldkr = INW; a.V = KVUP + h * 256 + 128; a.ldv = KVUPW;
                a.O = Y + (size_t)qrow * D + 1280 + h * 128; a.ldo = D;
                a.qpos0 = 0; a.masked = 0; a.sink_l2 = 0.f; a.has_sink = 0; a.C = 1.0f;
                attn_body<192>(a, lds);
            }
        }
        if (SUB(5)) for (int rep_ = 0; rep_ < NREP(6); ++rep_) {
            const int nun = last ? 768 : 792;
            for (int u = bid; u < nun; u += G) {
                AttnArgs a;
                int bb, h, qrow;
                if (u < 768) { const int rnd = u / G, w_ = u % G; const int bh = (G == 256) ? (rnd * 8 + (w_ & 7)) : (u >> 5); const int qb = (G == 256) ? (w_ >> 3) : (u & 31); h = bh % 6; bb = bh / 6; qrow = bb * SEQ + qb * 256; a.nt = 12; a.seg0_tiles = 4; a.seg0_row = NLAT + bb * CTXL; a.seg1_row = bb * SEQ + qb * 256 - 128; a.qpos0 = qb * 256; a.masked = 1; }
                else { const int v = u - 768; h = v % 6; bb = v / 6; qrow = NLAT + bb * CTXL; a.nt = 4; a.seg0_tiles = 4; a.seg0_row = NLAT + bb * CTXL; a.seg1_row = a.seg0_row; a.qpos0 = 0; a.masked = 0; }
                const int kvh = h / 3;
                a.Q = PROJ + (size_t)qrow * INW + 2048 + h * 128; a.ldq = INW;
                a.K = PROJ + 2816 + kvh * 128; a.ldk = INW; a.KR = a.K; a.ldkr = INW; a.V = PROJ + 3072 + kvh * 128; a.ldv = INW;
                a.O = Y + (size_t)qrow * D + 512 + h * 128; a.ldo = D;
                a.sink_l2 = SM[SM_SINK + l * 6 + h] * LOG2E; a.has_sink = 1; a.C = 1.0f;
                attn_body<128>(a, lds);
            }
        }
        PH_END

        PH_BEGIN(5)
        for (int rep_ = 0; rep_ < NREP(7); ++rep_) for (int u = bid; u < NB * 4 * 33; u += G) {
            const int n = u % 33, h = (u / 33) & 3, bb = u / 132;
            if (last && n == 32) continue;
            const float lgf2 = log2_sigmoid(SM[SM_DECF + l * 4 + h]), lgb2 = log2_sigmoid(SM[SM_DECB + l * 4 + h]);
            ret_out_unit(PROJ, SIN, Y, bb, h, n, lgf2, lgb2, lds);
        }
        PH_END

        PH_BEGIN(6)
        for (int rep_ = 0; rep_ < NREP(10); ++rep_) { pg8::Gemm gm{Y, wl + W_O, D, D}; pg8::TileOrder S; S.init(nMfull, D / 256, G, bid, -1);
          pg8::EpiMix E{MIX, -1, rep_ + 1 < NREP(10)};
          pg8::gemm_phase<pg8::EpiMix, pg8::TileOrder>(ldsl, gm, S, E); }
        PH_END

        PH_BEGIN(7)
        ln_phase(XH, MIX, (float*)nullptr, XH, H, SM + SM_LN1G + l * D, SM + SM_LN1B + l * D, modl + 2 * D, modl + 4 * D, modl + 3 * D, last ? NLAT : NROWS, bid, G, lds);
        PH_END

#define FFN_UP(cc, nMc, skn, ski) for (int rep_ = 0; rep_ < NREP(8); ++rep_) { pg8::Gemm gm{H, wl + W_UP, D, D}; pg8::TileOrder S; S.init(nMc, DFF2 / 256, G, bid, cc, skn, ski); \
              pg8::EpiUpConv E{cc ? ACT1 : ACT0, SB, SM + SM_CONVW + (size_t)l * 3 * DFF, SM + SM_CONVB + (size_t)l * DFF, cc}; pg8::gemm_phase<pg8::EpiUpConv, pg8::TileOrder>(ldsl, gm, S, E); }
#define FFN_DOWN(cc, nMc) for (int rep_ = 0; rep_ < NREP(11); ++rep_) { pg8::Gemm gm{cc ? ACT1 : ACT0, wl + W_DN, DFF, DFF}; pg8::TileOrder S; S.init(nMc, D / 256, G, bid, -1); \
              pg8::EpiMix E{MIX, cc, rep_ + 1 < NREP(11)}; pg8::gemm_phase<pg8::EpiMix, pg8::TileOrder>(ldsl, gm, S, E); }
#define FFN_FIX(ACTc, nrows) { \
                const float* cw = SM + SM_CONVW + (size_t)l * 3 * DFF; \
                const int ngr = (nrows) / 64; \
                for (int it = gtid; it < 2 * ngr * (DFF / 4); it += gthreads) { \
                    const int f = (it % (DFF / 4)) * 4, gk = it / (DFF / 4), kind = gk / ngr, gi = gk % ngr; \
                    const int rg = gi * 64, smask = rg < FCH_LAT ? (SEQ - 1) : (CTXL - 1); \
                    const bool edge = kind ? (((rg + 63) & smask) == smask) : ((rg & smask) == 0); \
                    if (edge) continue; \
                    const float* sp = SB + ((size_t)(kind * NGRP + gi) * 3) * DFF + f; \
                    const float* np_ = SB + ((size_t)((1 - kind) * NGRP + (kind ? gi + 1 : gi - 1)) * 3 + 2) * DFF + f; \
                    const f32x4 z = *(const f32x4*)sp + *(const f32x4*)(cw + (kind ? 2 * DFF : 0) + f) * *(const f32x4*)np_; const f32x4 uu = *(const f32x4*)(sp + DFF); \
                    u32x2 ow; ow[0] = cvtpk(silu_f(z[0]) * uu[0], silu_f(z[1]) * uu[1]); ow[1] = cvtpk(silu_f(z[2]) * uu[2], silu_f(z[3]) * uu[3]); \
                    *(u32x2*)((ACTc) + (size_t)(rg + (kind ? 63 : 0)) * DFF + f) = ow; } }
        {
            const int nM0 = last ? 64 : 68, rows0 = last ? FCH_LAT : FCH_ROWS;
            const int skn = last ? 0 : 32;
            PH_BEGIN(8)
            FFN_UP(0, nM0, 0, 0)
            PH_END
            PH_BEGIN(9)
            FFN_FIX(ACT0, rows0)
            PH_END
            PH_BEGIN(10)
            FFN_DOWN(0, nM0)
            FFN_UP(1, 64, skn, 8)
            PH_END
            PH_BEGIN(11)
            FFN_FIX(ACT1, FCH_LAT)
            PH_END
            PH_BEGIN(12)
            FFN_DOWN(1, 64)
            PH_END
        }
#undef FFN_UP
#undef FFN_DOWN
#undef FFN_FIX

        PH_BEGIN(13)
        { const float* modn = MOD + (size_t)(last ? l : l + 1) * 5 * MODW;
          ln_phase(XH, MIX, last ? p.out : (float*)nullptr, XH, last ? (bf16_t*)nullptr : H, SM + SM_LN2G + l * D, SM + SM_LN2B + l * D, modl + 5 * D, modn + D, modn, last ? NLAT : NROWS, bid, G, lds); }
        PH_END
    }
#undef PH_BEGIN
#undef PH_END
}

constexpr int N_PHASES = 2 + DEPTH * 12;

extern "C" void kernel_launch(void* const* d_in, const int* in_sizes, int n_in, void* d_out, int out_size, void* d_ws, size_t ws_size, hipStream_t stream) {
    static int grid = 0;
    if (grid == 0) {
        if (n_in != 23 || in_sizes[0] != NLAT * D || out_size != NLAT * D || ws_size < WS_END) {
            fprintf(stderr, "kernel_launch: unexpected shapes: n_in %d in0 %d out %d ws %zu (need %zu)\n", n_in, n_in > 0 ? in_sizes[0] : -1, out_size, ws_size, (size_t)WS_END); grid = -1; return; }
        int dev = 0, cus = 0, per_cu = 0;
        if (hipGetDevice(&dev) != hipSuccess || hipDeviceGetAttribute(&cus, hipDeviceAttributeMultiprocessorCount, dev) != hipSuccess) { fprintf(stderr, "kernel_launch: device query failed\n"); grid = -1; return; }
        if (hipFuncSetAttribute((const void*)fwd_kernel, hipFuncAttributeMaxDynamicSharedMemorySize, LDS_BYTES) != hipSuccess) { fprintf(stderr, "kernel_launch: hipFuncSetAttribute failed\n"); grid = -1; return; }
        if (hipOccupancyMaxActiveBlocksPerMultiprocessor(&per_cu, (const void*)fwd_kernel, 512, LDS_BYTES) != hipSuccess || per_cu < 1) {
            fprintf(stderr, "kernel_launch: occupancy query reports %d workgroups per CU\n", per_cu); (void)hipGetLastError(); grid = -1; return; }
        grid = cus;
    }
    if (grid < 0) return;
    if (hipMemsetAsync((char*)d_ws + WS_CTL, 0, CTL_BYTES, stream) != hipSuccess) { fprintf(stderr, "kernel_launch: memset failed\n"); return; }
    Params p{};
    for (int i = 0; i < 23; ++i) p.in[i] = (const float*)d_in[i];
    p.out = (float*)d_out; p.ws = (unsigned char*)d_ws; p.pad = 0;
#if MK_ONE_LAUNCH
    p.ph_lo = 0; p.ph_hi = N_PHASES; p.bar_region = 0;
    hipLaunchKernelGGL(fwd_kernel, dim3(grid), dim3(512), LDS_BYTES, stream, p);
#else
    for (int g = 0; g < N_PHASES; ++g) { p.ph_lo = g; p.ph_hi = g + 1; p.bar_region = 0;
        hipLaunchKernelGGL(fwd_kernel, dim3(grid), dim3(512), LDS_BYTES, stream, p); }
#endif
    const hipError_t le = hipPeekAtLastError();
    if (le != hipSuccess) fprintf(stderr, "kernel_launch: launch failed: %s\n", hipGetErrorName(le));
}
```

```cpp
#include <hip/hip_runtime.h>
#include <cstdio>
#include <cstdint>

#define LAS __attribute__((address_space(3)))
typedef unsigned short bf16_t;
typedef short bf16x8 __attribute__((ext_vector_type(8)));
typedef short s16x4 __attribute__((ext_vector_type(4)));
typedef float f32x4 __attribute__((ext_vector_type(4)));
typedef float f32x16 __attribute__((ext_vector_type(16)));
typedef unsigned u32x4 __attribute__((ext_vector_type(4)));
typedef unsigned u32x2 __attribute__((ext_vector_type(2)));

#ifndef MK_ONE_LAUNCH
#define MK_ONE_LAUNCH 1
#endif

constexpr int D = 2048, NB = 4, SEQ = 8192, DEPTH = 4, CTXL = 256;
constexpr int NLAT = NB * SEQ, NCTX = NB * CTXL, NROWS = NLAT + NCTX;
constexpr int INW = 4160, INWP = 4352, DFF = 5632, DFF2 = 11264;
constexpr int QUPW = 1152, QUPWP = 1280, KVUPW = 1536;
constexpr int NMOD = 6, MODW = NMOD * D;
constexpr float LN_EPS = 1e-5f, RMS_EPS = 1e-6f;
constexpr float ALPHA = 1.6817928305074292f;
constexpr float KSCALE = 0.08838834764831845f;
constexpr float MLA_QSCALE = 0.07216878364870323f * 1.4426950408889634f;
constexpr float LOG2E = 1.4426950408889634f;

constexpr size_t MiB = 1u << 20;
constexpr size_t WS_CTL = 0, CTL_BYTES = 1 * MiB;
constexpr size_t WS_MOD = 1 * MiB;
constexpr size_t WS_ROPE = 2 * MiB;
constexpr size_t WS_SM = 2 * MiB + 65536;
constexpr int SM_DECF = 0, SM_DECB = 16, SM_SINK = 32, SM_LN1G = 64, SM_LN1B = SM_LN1G + DEPTH * D, SM_LN2G = SM_LN1B + DEPTH * D, SM_LN2B = SM_LN2G + DEPTH * D,
              SM_CONVW = SM_LN2B + DEPTH * D, SM_CONVB = SM_CONVW + DEPTH * 3 * DFF, SM_END = SM_CONVB + DEPTH * DFF;
static_assert(WS_SM + (size_t)SM_END * 4 <= 3 * MiB, "small vectors");
constexpr size_t WS_RS = 3 * MiB;
constexpr size_t WS_W = 5 * MiB;
constexpr size_t W_IN = 0, W_UQ = W_IN + (size_t)INWP * D, W_UKV = W_UQ + (size_t)QUPWP * 512, W_O = W_UKV + (size_t)KVUPW * 256,
                 W_UP = W_O + (size_t)D * D, W_DN = W_UP + (size_t)DFF2 * D, W_LAYER = W_DN + (size_t)D * DFF;
constexpr size_t WS_X = WS_W + W_LAYER * 2 * DEPTH;
constexpr size_t WS_H = WS_X + (size_t)NROWS * D * 4;
constexpr size_t WS_Y = WS_H + (size_t)NROWS * D * 2;
constexpr size_t WS_PROJ = WS_Y + (size_t)NROWS * D * 2;
constexpr size_t WS_QUP = WS_PROJ + (size_t)NROWS * INW * 2;
constexpr size_t WS_KVUP = WS_QUP + (size_t)NROWS * QUPW * 2;
constexpr size_t WS_KVS = WS_KVUP + (size_t)NROWS * KVUPW * 2;
constexpr size_t WS_SIN = WS_KVS + (size_t)NB * 4 * 2 * 33 * 16384 * 4;
constexpr size_t WS_END = WS_SIN + (size_t)NB * 4 * 2 * 33 * 16384 * 2;
constexpr int FCH_LAT = 64 * 256, FCH_ROWS = FCH_LAT + NCTX;
constexpr size_t WS_ACT0 = WS_Y;
constexpr size_t WS_ACT1 = WS_ACT0 + (size_t)FCH_ROWS * DFF * 2;
constexpr int NGRP = FCH_ROWS / 64;
constexpr size_t WS_SB = WS_ACT1 + (size_t)FCH_LAT * DFF * 2;
static_assert(WS_SB + (size_t)2 * NGRP * 3 * DFF * 4 <= WS_QUP, "FFN overlay");
constexpr size_t WS_MIX = WS_QUP;
static_assert(WS_MIX >= WS_QUP && WS_MIX + (size_t)NROWS * D * 2 <= WS_END, "FFN overlay");
static_assert(WS_W % 256 == 0 && W_LAYER % 128 == 0 && WS_X % 256 == 0, "align");

constexpr int LDS_BYTES = 131072 + 512;

#define XB_TMO      128
#define XB_XCNT(j)  (256  + 64 * (j))
#define XB_XSUB(j)  (1280 + 64 * (j))
#define XB_XGEN(j)  (2304 + 64 * (j))
#define XB_TOP      3328
#define XB_TOPGEN   3392
#define XCD_BAR_WORDS 3456
#define XB_SPIN_CAP (1u << 20)

__device__ __forceinline__ unsigned xb_ld(unsigned* p)              { return __hip_atomic_load(p, __ATOMIC_RELAXED, __HIP_MEMORY_SCOPE_AGENT); }
__device__ __forceinline__ unsigned xb_add(unsigned* p, unsigned v) { return __hip_atomic_fetch_add(p, v, __ATOMIC_RELAXED, __HIP_MEMORY_SCOPE_AGENT); }
__device__ __forceinline__ unsigned xb_xcc_id() { return (unsigned)__builtin_amdgcn_s_getreg((3 << 11) | 20) & 0xFu; }
#define XB_SPIN(cond, bar) do { unsigned _sp = 0; while (cond) { __builtin_amdgcn_s_sleep(1); \
    if ((++_sp & 255u) == 0u) { if (xb_ld(&(bar)[XB_TMO])) break; if (_sp > XB_SPIN_CAP) { atomicAdd(&(bar)[XB_TMO], 1u); break; } } } } while (0)

struct XcdBarrier { unsigned* bar; unsigned x; volatile LAS unsigned* st; };

__device__ __forceinline__ XcdBarrier xcd_barrier_post(unsigned* bar, volatile LAS unsigned* st) {
    XcdBarrier b; b.bar = bar; b.x = xb_xcc_id(); b.st = st;
    if (threadIdx.x == 0) (void)xb_add(&bar[XB_XCNT(b.x)], 1u);
    return b;
}
__device__ __forceinline__ void xcd_barrier_complete(unsigned* bar, unsigned x, unsigned& nloc, unsigned& nx) {
    const unsigned G = gridDim.x * gridDim.y * gridDim.z;
    unsigned sum, cnt, mine, sp = 0u;
    for (;;) {
        sum = 0u; cnt = 0u; mine = 0u;
#pragma unroll
        for (unsigned j = 0; j < 16; ++j) { const unsigned c = xb_ld(&bar[XB_XCNT(j)]); sum += c; cnt += (c > 0u) ? 1u : 0u; mine = (j == x) ? c : mine; }
        if (sum == G) break;
        __builtin_amdgcn_s_sleep(1);
        if ((++sp & 255u) == 0u) { if (xb_ld(&bar[XB_TMO])) break; if (sp > XB_SPIN_CAP) { atomicAdd(&bar[XB_TMO], 1u); break; } }
    }
    nloc = mine > 0u ? mine : 1u; nx = cnt > 0u ? cnt : 1u;
}
__device__ __forceinline__ void xcd_barrier(const XcdBarrier& b) {
    asm volatile("s_waitcnt vmcnt(0)" ::: "memory");
    __syncthreads();
    if (threadIdx.x == 0) {
        unsigned* bar = b.bar;
        __builtin_amdgcn_s_waitcnt(0);
        unsigned nloc = b.st[0], nx = b.st[1];
        if (nloc == 0u) { xcd_barrier_complete(bar, b.x, nloc, nx); b.st[0] = nloc; b.st[1] = nx; }
        const unsigned old = xb_add(&bar[XB_XSUB(b.x)], 1u);
        const unsigned gen = old / nloc;
        if (old + 1u == (gen + 1u) * nloc) {
            __builtin_amdgcn_fence(__ATOMIC_RELEASE, "agent");
            asm volatile("s_waitcnt vmcnt(0)" ::: "memory");
            const unsigned og = xb_add(&bar[XB_TOP], 1u);
            const unsigned tg = og / nx;
            if (og + 1u == (tg + 1u) * nx) xb_add(&bar[XB_TOPGEN], 1u);
            else XB_SPIN(xb_ld(&bar[XB_TOPGEN]) == tg, bar);
            __builtin_amdgcn_fence(__ATOMIC_ACQUIRE, "agent");
            xb_add(&bar[XB_XGEN(b.x)], 1u);
            asm volatile("s_waitcnt vmcnt(0)" ::: "memory");
        } else {
            XB_SPIN(xb_ld(&bar[XB_XGEN(b.x)]) == gen, bar);
            __builtin_amdgcn_fence(__ATOMIC_ACQUIRE, "agent");
            asm volatile("s_waitcnt vmcnt(0)" ::: "memory");
        }
    }
    __syncthreads();
}

__device__ __forceinline__ unsigned cvtpk(float lo, float hi) { unsigned r; asm volatile("v_cvt_pk_bf16_f32 %0, %1, %2" : "=v"(r) : "v"(lo), "v"(hi)); return r; }
__device__ __forceinline__ float bf2f(unsigned short b) { return __uint_as_float(((unsigned)b) << 16); }
__device__ __forceinline__ float bflo(unsigned w) { return __uint_as_float(w << 16); }
__device__ __forceinline__ float bfhi(unsigned w) { return __uint_as_float(w & 0xffff0000u); }
__device__ __forceinline__ void st_bf16x4(bf16_t* p, f32x4 v) { u32x2 w; w.x = cvtpk(v[0], v[1]); w.y = cvtpk(v[2], v[3]); *(u32x2*)p = w; }
typedef _Float16 f16x4 __attribute__((ext_vector_type(4)));
__device__ __forceinline__ void st_f16x4(bf16_t* p, f32x4 v) { *(f16x4*)p = __builtin_convertvector(v, f16x4); }
__device__ __forceinline__ f32x4 cvt_f16x4(u32x2 w) { return __builtin_convertvector(__builtin_bit_cast(f16x4, w), f32x4); }
__device__ __forceinline__ float silu_f(float x) { return x * __builtin_amdgcn_rcpf(1.0f + __builtin_amdgcn_exp2f(-1.4426950408889634f * x)); }
__device__ __forceinline__ float wave_sum(float v) {
#pragma unroll
    for (int o = 1; o < 64; o <<= 1) v += __shfl_xor(v, o);
    return v;
}
__device__ __forceinline__ int otid() { int t = threadIdx.x; asm volatile("" : "+v"(t)); return t; }
__device__ __forceinline__ int mod_index(int row) { return row < NLAT ? (row >> 13) : 4; }

namespace pg8 {
constexpr int BM = 256, BK = 64, HALF = 128, HTB = HALF * BK * 2, STAGE_BYTES = 8 * HTB, NXCD = 8, WGM = 8;
__host__ __device__ __forceinline__ int lds_byte(int r, int c) { const int st = (r >> 4) * 2 + (c >> 5), rr = r & 15, cc = c & 31, ob = rr * 64 + cc * 2; return st * 1024 + (ob ^ (((ob >> 9) & 1) << 5)); }
__host__ __device__ __forceinline__ void stage_rc(int b, int& R, int& C) { const int st = b / 1024, sb = b % 1024, swz = sb ^ (((sb >> 9) & 1) << 5); R = (st >> 1) * 16 + swz / 64; C = (st & 1) * 32 + (swz % 64) / 2; }

struct Unit { int pm, pn; };
struct Gemm { const bf16_t* A; const bf16_t* Bt; int lda, K; };

struct TileOrder {
    int nM, nN, nwg, G, c, chunk, skew_n, skew_i;
    __device__ __forceinline__ void init(int nM_, int nN_, int G_, int c_, int chunk_, int skew_n_ = 0, int skew_i_ = 0) { nM = nM_; nN = nN_; nwg = nM * nN; G = G_; c = c_; chunk = chunk_; skew_n = skew_n_; skew_i = skew_i_; }
    __device__ __forceinline__ bool next(int i, Unit& u) const {
        long L;
        if (skew_n == 0 || i < skew_i) L = (long)i * G + c;
        else { if (c < skew_n) return false; L = (long)skew_i * G + (long)(i - skew_i) * (G - skew_n) + (c - skew_n); }
        if (L >= nwg) return false;
        int wgid = (int)L; { const int q = nwg / NXCD, r = nwg % NXCD, xcd = wgid % NXCD, off = wgid / NXCD; wgid = (xcd < r ? xcd * (q + 1) : r * (q + 1) + (xcd - r) * q) + off; }
        const int nig = WGM * nN, gid = wgid / nig, fm = gid * WGM, gsz = (nM - fm) < WGM ? (nM - fm) : WGM;
        int pm = fm + ((wgid % nig) % gsz); u.pn = (wgid % nig) / gsz;
        if (chunk >= 0) pm = (pm < 64) ? 64 * chunk + pm : 128 + (pm - 64);
        u.pm = pm; return true;
    }
    __device__ __forceinline__ void a_ready(const Unit&) const {}
    __device__ __forceinline__ void done(const Unit&) const {}
};

template <class Epi, class Sched>
__device__ __forceinline__ void gemm_phase(LAS unsigned char* lds, const Gemm g, const Sched& S, const Epi& E) {
    const int tid = otid(), wid = __builtin_amdgcn_readfirstlane(tid >> 6), lane = tid & 63, wr = wid >> 2, wc = wid & 3, fr = lane & 15, fq = lane >> 4;
    const int K = g.K, nt = K / BK, lda = g.lda;
    unsigned voffA[2], voffB[2];
#pragma unroll
    for (int i = 0; i < 2; ++i) { int R, C; stage_rc(tid * 16 + i * 8192, R, C);
        voffA[i] = (unsigned)(R * lda + C) * 2u; voffB[i] = (unsigned)(R * K + C) * 2u; }
    const size_t kstep = (size_t)(BK * 2);
    const size_t hstepA = (size_t)HALF * lda * 2, hstepB = (size_t)HALF * K * 2;
    const size_t tstepA = 2 * hstepA, tstepB = 2 * hstepB;
    const unsigned ldsw = (unsigned)wid * 1024u;
    const int aoff = lds_byte(wr * 64 + fr, fq * 8), boff = lds_byte(wc * 32 + fr, fq * 8);
#define PG8_SA(b, h) (((b) * 2 + (h)) * HTB)
#define PG8_SB(b, h) ((4 + (b) * 2 + (h)) * HTB)
#define PG8_STAGE(bufoff, gbase, voff) do { _Pragma("unroll") for (int _i = 0; _i < 2; ++_i) \
        __builtin_amdgcn_global_load_lds((const unsigned*)((const char*)(gbase) + (voff)[_i]), (LAS unsigned*)(lds + (bufoff) + ldsw + _i * 8192), 16, 0, 0); } while (0)
#define PG8_LDA(dst, b, h) do { _Pragma("unroll") for (int m = 0; m < 4; ++m) _Pragma("unroll") for (int k = 0; k < 2; ++k) dst[m][k] = *(const LAS bf16x8*)(lds + PG8_SA(b, h) + aoff + m * 2048 + k * 1024); } while (0)
#define PG8_LDB(dst, b, h) do { _Pragma("unroll") for (int n = 0; n < 2; ++n) _Pragma("unroll") for (int k = 0; k < 2; ++k) dst[n][k] = *(const LAS bf16x8*)(lds + PG8_SB(b, h) + boff + n * 2048 + k * 1024); } while (0)
#define PG8_MMA(ai, bj, At, Bt) do { __builtin_amdgcn_s_setprio(1); _Pragma("unroll") for (int m = 0; m < 4; ++m) _Pragma("unroll") for (int n = 0; n < 2; ++n) _Pragma("unroll") for (int k = 0; k < 2; ++k) \
        acc[ai][bj][m][n] = __builtin_amdgcn_mfma_f32_16x16x32_bf16(Bt[n][k], At[m][k], acc[ai][bj][m][n], 0, 0, 0); __builtin_amdgcn_s_setprio(0); } while (0)
#define PG8_WAIT_V(n) asm volatile("s_waitcnt vmcnt(" #n ")" ::: "memory")
#define PG8_WAIT_L(n) asm volatile("s_waitcnt lgkmcnt(" #n ")" ::: "memory")
#define PG8_BAR __builtin_amdgcn_s_barrier()
#define PG8_SCHED __builtin_amdgcn_sched_barrier(0)
    Unit cur, nxt; int ui = 0;
    if (!S.next(0, cur)) return;
    f32x4 acc[2][2][4][2];
#pragma unroll
    for (int a = 0; a < 2; ++a)
#pragma unroll
        for (int b = 0; b < 2; ++b)
#pragma unroll
            for (int m = 0; m < 4; ++m)
#pragma unroll
                for (int n = 0; n < 2; ++n) acc[a][b][m][n] = (f32x4){0.f, 0.f, 0.f, 0.f};
    bf16x8 At[4][2], B0[2][2], B1[2][2];
    const char* cA = (const char*)g.A + (size_t)cur.pm * tstepA; const char* cB = (const char*)g.Bt + (size_t)cur.pn * tstepB;
    S.a_ready(cur);
    PG8_STAGE(PG8_SB(0, 0), cB, voffB); PG8_STAGE(PG8_SA(0, 0), cA, voffA); PG8_STAGE(PG8_SB(0, 1), cB + hstepB, voffB); PG8_STAGE(PG8_SA(0, 1), cA + hstepA, voffA);
    if (wr == 1) PG8_BAR;
    PG8_WAIT_V(4); PG8_BAR;
    PG8_STAGE(PG8_SB(1, 0), cB + kstep, voffB); PG8_STAGE(PG8_SA(1, 0), cA + kstep, voffA); PG8_STAGE(PG8_SB(1, 1), cB + hstepB + kstep, voffB);
    PG8_WAIT_V(6); PG8_BAR;
    for (;;) {
        const bool has_next = S.next(ui + 1, nxt);
        const char* nA = has_next ? (const char*)g.A + (size_t)nxt.pm * tstepA : cA; const char* nB = has_next ? (const char*)g.Bt + (size_t)nxt.pn * tstepB : cB;
#pragma nounroll
        for (int t = 0; t < nt; t += 2) {
            const bool last = (t == nt - 2);
            const char* a1 = cA + (size_t)(t + 1) * kstep;
            const char* a2 = last ? nA : cA + (size_t)(t + 2) * kstep; const char* b2 = last ? nB : cB + (size_t)(t + 2) * kstep;
            const char* a3 = a2 + kstep; const char* b3 = b2 + kstep;
            if (last && has_next) S.a_ready(nxt);
            PG8_LDB(B0, 0, 0); PG8_SCHED; PG8_LDA(At, 0, 0); PG8_STAGE(PG8_SA(1, 1), a1 + hstepA, voffA);
            PG8_WAIT_L(8); PG8_BAR; PG8_WAIT_L(0); PG8_MMA(0, 0, At, B0); PG8_BAR; PG8_SCHED;
            PG8_LDB(B1, 0, 1); PG8_STAGE(PG8_SB(0, 0), b2, voffB);
            PG8_BAR; PG8_WAIT_L(0); PG8_MMA(0, 1, At, B1); PG8_BAR;
            PG8_LDA(At, 0, 1); PG8_STAGE(PG8_SA(0, 0), a2, voffA);
            PG8_BAR; PG8_WAIT_L(0); PG8_MMA(1, 0, At, B0); PG8_BAR; PG8_SCHED;
            PG8_STAGE(PG8_SB(0, 1), b2 + hstepB, voffB);
            PG8_WAIT_V(6); PG8_BAR; PG8_MMA(1, 1, At, B1); PG8_BAR;
            PG8_LDB(B0, 1, 0); PG8_SCHED; PG8_LDA(At, 1, 0); PG8_STAGE(PG8_SA(0, 1), a2 + hstepA, voffA);
            PG8_WAIT_L(8); PG8_BAR; PG8_WAIT_L(0); PG8_MMA(0, 0, At, B0); PG8_BAR; PG8_SCHED;
            PG8_LDB(B1, 1, 1); PG8_STAGE(PG8_SB(1, 0), b3, voffB);
            PG8_BAR; PG8_WAIT_L(0); PG8_MMA(0, 1, At, B1); PG8_BAR;
            PG8_LDA(At, 1, 1); PG8_STAGE(PG8_SA(1, 0), a3, voffA);
            PG8_BAR; PG8_WAIT_L(0); PG8_MMA(1, 0, At, B0); PG8_BAR; PG8_SCHED;
            PG8_STAGE(PG8_SB(1, 1), b3 + hstepB, voffB);
            PG8_WAIT_V(6); PG8_BAR; PG8_MMA(1, 1, At, B1); PG8_BAR;
        }
        E(acc, cur, wr, wc, fr, fq); S.done(cur);
        if (!has_next) break;
#pragma unroll
        for (int a = 0; a < 2; ++a)
#pragma unroll
            for (int b = 0; b < 2; ++b)
#pragma unroll
                for (int m = 0; m < 4; ++m)
#pragma unroll
                    for (int n = 0; n < 2; ++n) acc[a][b][m][n] = (f32x4){0.f, 0.f, 0.f, 0.f};
        cur = nxt; cA = nA; cB = nB; ++ui;
    }
    PG8_WAIT_V(0);
    if (wr == 0) PG8_BAR;
    PG8_BAR;
#undef PG8_SA
#undef PG8_SB
#undef PG8_STAGE
#undef PG8_LDA
#undef PG8_LDB
#undef PG8_MMA
#undef PG8_WAIT_V
#undef PG8_WAIT_L
#undef PG8_BAR
#undef PG8_SCHED
}


struct EpiProj {
    bf16_t* P; float* RS; const float* thc; const float* ths; const float* tmc; const float* tms;
    __device__ __forceinline__ void operator()(const f32x4 (&acc)[2][2][4][2], const Unit& u, int wr, int wc, int fr, int fq) const {
        asm volatile("" : "+v"(fr), "+v"(fq));
        const int pn = u.pn; const bool lat = u.pm < 128;
        const int row0 = u.pm * BM + wr * 64 + fr;
        if (pn == 16) {
            if (wc < 2) {
#pragma unroll
                for (int ai = 0; ai < 2; ++ai)
#pragma unroll
                    for (int m = 0; m < 4; ++m) {
                        const int row = row0 + ai * HALF + m * 16; const f32x4 v0 = acc[ai][0][m][0], v1 = acc[ai][0][m][1]; f32x4 o0 = v0, o1 = v1;
                        if (lat) { const int pos = row & (SEQ - 1), tp = wc ? (pos & 63) : (pos >> 6);
                            const f32x4 c = *(const f32x4*)(tmc + tp * 16 + 4 * fq), s = *(const f32x4*)(tms + tp * 16 + 4 * fq);
                            o0 = v0 * c - v1 * s; o1 = v1 * c + v0 * s; }
                        bf16_t* rp = P + (size_t)row * INW + 4096 + 32 * wc + 4 * fq;
                        st_bf16x4(rp, o0); st_bf16x4(rp + 16, o1);
                        asm volatile("" ::: "memory");
                    }
            }
            return;
        }
        const bool roped = (pn < 4) || (pn >= 8 && pn < 12);
        if (roped) {
            const float sc = (pn == 2 || pn == 3) ? KSCALE : ((pn >= 8 && pn <= 10) ? KSCALE * LOG2E : 1.0f);
            const int colb = pn * BM + 128 * (wc >> 1) + 64 * (wc & 1) + 8 * fq;
#pragma unroll
            for (int ai = 0; ai < 2; ++ai)
#pragma unroll
                for (int m = 0; m < 4; ++m) {
                    const int row = row0 + ai * HALF + m * 16; const int pos = row & (SEQ - 1), tp = (wc & 1) ? (pos & 63) : (pos >> 6);
                    u32x4 w0, w1;
#pragma unroll
                    for (int n = 0; n < 2; ++n) {
                        f32x4 c = (f32x4){1.f, 1.f, 1.f, 1.f}, s = (f32x4){0.f, 0.f, 0.f, 0.f};
                        if (lat) { c = *(const f32x4*)(thc + tp * 32 + 8 * fq + 4 * n); s = *(const f32x4*)(ths + tp * 32 + 8 * fq + 4 * n); }
                        const f32x4 v0 = acc[ai][0][m][n] * sc, v1 = acc[ai][1][m][n] * sc;
                        const f32x4 o0 = v0 * c - v1 * s, o1 = v1 * c + v0 * s;
                        w0[2 * n] = cvtpk(o0[0], o0[1]); w0[2 * n + 1] = cvtpk(o0[2], o0[3]); w1[2 * n] = cvtpk(o1[0], o1[1]); w1[2 * n + 1] = cvtpk(o1[2], o1[3]);
                    }
                    bf16_t* rp = P + (size_t)row * INW + colb;
                    *(u32x4*)rp = w0; *(u32x4*)(rp + 32) = w1;
                    asm volatile("" ::: "memory");
                }
            return;
        }
#pragma unroll
        for (int ai = 0; ai < 2; ++ai)
#pragma unroll
            for (int m = 0; m < 4; ++m) {
                const int row = row0 + ai * HALF + m * 16; bf16_t* rp = P + (size_t)row * INW + pn * BM + wc * 32 + 8 * fq; float ss = 0.f;
#pragma unroll
                for (int bj = 0; bj < 2; ++bj) { const f32x4 v0 = acc[ai][bj][m][0], v1 = acc[ai][bj][m][1];
                    u32x4 w; w[0] = cvtpk(v0[0], v0[1]); w[1] = cvtpk(v0[2], v0[3]); w[2] = cvtpk(v1[0], v1[1]); w[3] = cvtpk(v1[2], v1[3]);
                    *(u32x4*)(rp + bj * HALF) = w;
                    ss += ((v0[0] * v0[0] + v0[1] * v0[1]) + (v0[2] * v0[2] + v0[3] * v0[3])) + ((v1[0] * v1[0] + v1[1] * v1[1]) + (v1[2] * v1[2] + v1[3] * v1[3])); }
                if (pn >= 13 && pn <= 15) { ss += __shfl_xor(ss, 16); ss += __shfl_xor(ss, 32); if (fq == 0) RS[(size_t)row * 12 + (pn - 13) * 4 + wc] = ss; }
            }
    }
};
struct EpiQup {
    bf16_t* Q; const float* RS; const float* tmc; const float* tms;
    __device__ __forceinline__ void operator()(const f32x4 (&acc)[2][2][4][2], const Unit& u, int wr, int wc, int fr, int fq) const {
        asm volatile("" : "+v"(fr), "+v"(fq));
        const int pn = u.pn; const bool lat = u.pm < 128; const int row0 = u.pm * BM + wr * 64 + fr;
#pragma unroll
        for (int ai = 0; ai < 2; ++ai)
#pragma unroll
            for (int m = 0; m < 4; ++m) {
                const int row = row0 + ai * HALF + m * 16; const f32x4 r0 = *(const f32x4*)(RS + (size_t)row * 12), r1 = *(const f32x4*)(RS + (size_t)row * 12 + 4);
                const float rs = MLA_QSCALE / sqrtf(((r0[0] + r0[1]) + (r0[2] + r0[3]) + (r1[0] + r1[1]) + (r1[2] + r1[3])) * (1.0f / 512.0f) + RMS_EPS);
                const int pos = row & (SEQ - 1), tp = (wc & 1) ? (pos & 63) : (pos >> 6);
                const f32x4 c = *(const f32x4*)(tmc + tp * 16 + 4 * fq), s = *(const f32x4*)(tms + tp * 16 + 4 * fq);
#pragma unroll
                for (int bj = 0; bj < 2; ++bj) {
                    const int colb = pn * BM + bj * HALF + wc * 32; if (colb >= QUPW) continue;
                    const int c64 = 4 * pn + 2 * bj + (wc >> 1);
                    const f32x4 v0 = acc[ai][bj][m][0] * rs, v1 = acc[ai][bj][m][1] * rs; f32x4 o0 = v0, o1 = v1;
                    if (lat && (c64 % 3) == 2) { o0 = v0 * c - v1 * s; o1 = v1 * c + v0 * s; }
                    bf16_t* rp = Q + (size_t)row * QUPW + colb + 4 * fq; st_bf16x4(rp, o0); st_bf16x4(rp + 16, o1);
                }
                asm volatile("" ::: "memory");
            }
    }
};
struct EpiKvup {
    bf16_t* KV; const float* RS;
    __device__ __forceinline__ void operator()(const f32x4 (&acc)[2][2][4][2], const Unit& u, int wr, int wc, int fr, int fq) const {
        asm volatile("" : "+v"(fr), "+v"(fq));
        const int row0 = u.pm * BM + wr * 64 + fr;
#pragma unroll
        for (int ai = 0; ai < 2; ++ai)
#pragma unroll
            for (int m = 0; m < 4; ++m) {
                const int row = row0 + ai * HALF + m * 16; const f32x4 r0 = *(const f32x4*)(RS + (size_t)row * 12 + 8);
                const float rs = 1.0f / sqrtf(((r0[0] + r0[1]) + (r0[2] + r0[3])) * (1.0f / 256.0f) + RMS_EPS);
                bf16_t* rp = KV + (size_t)row * KVUPW + u.pn * BM + wc * 32 + 8 * fq;
#pragma unroll
                for (int bj = 0; bj < 2; ++bj) { const f32x4 v0 = acc[ai][bj][m][0] * rs, v1 = acc[ai][bj][m][1] * rs;
                    u32x4 w; w[0] = cvtpk(v0[0], v0[1]); w[1] = cvtpk(v0[2], v0[3]); w[2] = cvtpk(v1[0], v1[1]); w[3] = cvtpk(v1[2], v1[3]);
                    *(u32x4*)(rp + bj * HALF) = w; }
                asm volatile("" ::: "memory");
            }
    }
};
struct EpiMix {
    bf16_t* MIX; int chunk; int dry;
    __device__ __forceinline__ void operator()(const f32x4 (&acc)[2][2][4][2], const Unit& u, int wr, int wc, int fr, int fq) const {
        asm volatile("" : "+v"(fr), "+v"(fq));
        if (dry) { float s = 0.f;
#pragma unroll
            for (int ai = 0; ai < 2; ++ai)
#pragma unroll
                for (int bj = 0; bj < 2; ++bj)
#pragma unroll
                    for (int m = 0; m < 4; ++m)
#pragma unroll
                        for (int n = 0; n < 2; ++n) s += (acc[ai][bj][m][n][0] + acc[ai][bj][m][n][1]) + (acc[ai][bj][m][n][2] + acc[ai][bj][m][n][3]);
            if (s == 123456.789f) MIX[0] = (bf16_t)1; return; }
        const int pmg = chunk < 0 ? u.pm : (u.pm < 64 ? 64 * chunk + u.pm : 128 + (u.pm - 64));
        const int row0 = pmg * BM + wr * 64 + fr;
#pragma unroll
        for (int ai = 0; ai < 2; ++ai)
#pragma unroll
            for (int m = 0; m < 4; ++m) { bf16_t* rp = MIX + (size_t)(row0 + ai * HALF + m * 16) * D + u.pn * BM + wc * 32 + 8 * fq;
#pragma unroll
                for (int bj = 0; bj < 2; ++bj) { const f32x4 v0 = acc[ai][bj][m][0], v1 = acc[ai][bj][m][1];
                    u32x4 w; w[0] = cvtpk(v0[0], v0[1]); w[1] = cvtpk(v0[2], v0[3]); w[2] = cvtpk(v1[0], v1[1]); w[3] = cvtpk(v1[2], v1[3]);
                    *(u32x4*)(rp + bj * HALF) = w; } }
    }
};
struct EpiUpConv {
    bf16_t* ACTc; float* SB; const float* cw; const float* cb; int chunk;
    static __device__ __forceinline__ float lane_prev(float x) { return __builtin_bit_cast(float, __builtin_amdgcn_update_dpp(0, __builtin_bit_cast(int, x), 0x121, 0xf, 0xf, true)); }
    static __device__ __forceinline__ float lane_next(float x) { return __builtin_bit_cast(float, __builtin_amdgcn_update_dpp(0, __builtin_bit_cast(int, x), 0x12f, 0xf, 0xf, true)); }
    static __device__ __forceinline__ void taps2(const int MM, float& z0, float& z1, float gc0, float gc1, float gp0, float gp1, float gn0, float gn1, float w1a, float w1b, float ba, float bb_,
                                                 float w0ma, float w0mb, float w2ma, float w2mb, float w0ea, float w0eb, float w2ea, float w2eb) {
#define TAP_HEAD "v_fma_f32 %0, %2, %8, %10\n\tv_fma_f32 %1, %3, %9, %11\n\t" \
                 "v_fmac_f32_dpp %0, %2, %12 row_ror:1 row_mask:0xf bank_mask:0xf\n\tv_fmac_f32_dpp %1, %3, %13 row_ror:1 row_mask:0xf bank_mask:0xf\n\t" \
                 "v_fmac_f32_dpp %0, %2, %14 row_ror:15 row_mask:0xf bank_mask:0xf\n\tv_fmac_f32_dpp %1, %3, %15 row_ror:15 row_mask:0xf bank_mask:0xf"
#define TAP_PREV "\n\tv_fmac_f32_dpp %0, %4, %16 row_ror:1 row_mask:0xf bank_mask:0xf\n\tv_fmac_f32_dpp %1, %5, %17 row_ror:1 row_mask:0xf bank_mask:0xf"
#define TAP_NEXT "\n\tv_fmac_f32_dpp %0, %6, %18 row_ror:15 row_mask:0xf bank_mask:0xf\n\tv_fmac_f32_dpp %1, %7, %19 row_ror:15 row_mask:0xf bank_mask:0xf"
#define TAP_OPS : "=&v"(z0), "=&v"(z1) : "v"(gc0), "v"(gc1), "v"(gp0), "v"(gp1), "v"(gn0), "v"(gn1), "v"(w1a), "v"(w1b), "v"(ba), "v"(bb_), "v"(w0ma), "v"(w0mb), "v"(w2ma), "v"(w2mb), "v"(w0ea), "v"(w0eb), "v"(w2ea), "v"(w2eb)
        if (MM == 0) asm(TAP_HEAD TAP_NEXT TAP_OPS);
        else if (MM == 3) asm(TAP_HEAD TAP_PREV TAP_OPS);
        else asm(TAP_HEAD TAP_PREV TAP_NEXT TAP_OPS);
#undef TAP_HEAD
#undef TAP_PREV
#undef TAP_NEXT
#undef TAP_OPS
    }
    __device__ __forceinline__ void operator()(const f32x4 (&acc)[2][2][4][2], const Unit& u, int wr, int wc, int fr, int fq) const {
        asm volatile("" : "+v"(fr), "+v"(fq));
        const int lpm = u.pm < 128 ? u.pm - 64 * chunk : 64 + (u.pm - 128);
        const int f0 = u.pn * 128 + wc * 32 + 8 * fq;
        constexpr float NL2E = -1.4426950408889634f;
        f32x4 w0m[2], w0e[2], w2m[2], w2e[2], w1s[2], bbs[2];
#pragma unroll
        for (int n = 0; n < 2; ++n) {
            const f32x4 a0 = *(const f32x4*)(cw + f0 + 4 * n) * NL2E, a2 = *(const f32x4*)(cw + 2 * DFF + f0 + 4 * n) * NL2E; const f32x4 zero = {0.f, 0.f, 0.f, 0.f};
            w1s[n] = *(const f32x4*)(cw + DFF + f0 + 4 * n) * NL2E; bbs[n] = *(const f32x4*)(cb + f0 + 4 * n) * NL2E;
            w0m[n] = fr > 0 ? a0 : zero; w0e[n] = fr == 0 ? a0 : zero; w2m[n] = fr < 15 ? a2 : zero; w2e[n] = fr == 15 ? a2 : zero;
        }
#pragma unroll
        for (int ai = 0; ai < 2; ++ai) {
            const int rg = lpm * BM + ai * HALF + wr * 64;
            const int smask = rg < FCH_LAT ? (SEQ - 1) : (CTXL - 1);
            const bool seq_first = (rg & smask) == 0, seq_last = ((rg + 63) & smask) == smask;
#pragma unroll
            for (int m = 0; m < 4; ++m) {
                u32x4 ow;
#pragma unroll
                for (int n = 0; n < 2; ++n) {
                    const f32x4 gc = acc[ai][1][m][n], uu = acc[ai][0][m][n];
                    const f32x4 gpf = acc[ai][1][m > 0 ? m - 1 : 0][n], gnf = acc[ai][1][m < 3 ? m + 1 : 3][n];
                    f32x4 zs;
#pragma unroll
                    for (int e = 0; e < 4; e += 2) {
                        float z0, z1;
                        taps2(m, z0, z1, gc[e], gc[e + 1], gpf[e], gpf[e + 1], gnf[e], gnf[e + 1], w1s[n][e], w1s[n][e + 1], bbs[n][e], bbs[n][e + 1],
                                                              w0m[n][e], w0m[n][e + 1], w2m[n][e], w2m[n][e + 1], w0e[n][e], w0e[n][e + 1], w2e[n][e], w2e[n][e + 1]);
                        zs[e] = z0; zs[e + 1] = z1;
                    }
                    f32x4 o;
#pragma unroll
                    for (int e = 0; e < 4; ++e) o[e] = (zs[e] * uu[e]) * __builtin_amdgcn_rcpf(fmaf(__builtin_amdgcn_exp2f(zs[e]), NL2E, NL2E));
                    ow[2 * n] = cvtpk(o[0], o[1]); ow[2 * n + 1] = cvtpk(o[2], o[3]);
                    if (m == 0 && fr == 0) { float* sp = SB + ((size_t)(0 * NGRP + (rg >> 6)) * 3) * DFF + f0 + 4 * n; *(f32x4*)(sp + 2 * DFF) = gc; if (!seq_first) { *(f32x4*)sp = zs * (1.0f / NL2E); *(f32x4*)(sp + DFF) = uu; } }
                    if (m == 3 && fr == 15) { float* sp = SB + ((size_t)(1 * NGRP + (rg >> 6)) * 3) * DFF + f0 + 4 * n; *(f32x4*)(sp + 2 * DFF) = gc; if (!seq_last) { *(f32x4*)sp = zs * (1.0f / NL2E); *(f32x4*)(sp + DFF) = uu; } }
                }
                *(u32x4*)(ACTc + (size_t)(rg + 16 * m + fr) * DFF + f0) = ow;
            }
            asm volatile("" ::: "memory");
        }
    }
};
}

#define SBAR() __builtin_amdgcn_sched_barrier(0)
__device__ __forceinline__ int crow(int r, int hi) { return (r & 3) + 8 * (r >> 2) + 4 * hi; }
template <int DQK> __device__ __forceinline__ int kswz(int row, int cb) {
    return row * (DQK * 2 + 16) + cb;
}
__device__ __forceinline__ int v_st(int k, int c) { const int kk = (k & ~0xC) | ((k & 4) << 1) | ((k & 8) >> 1); return ((kk >> 3) * 4 + (c >> 5)) * 512 + ((kk & 7) * 32 + (c & 31)) * 2; }
__device__ __forceinline__ int v_stn(int k, int c) { return ((k >> 3) * 4 + (c >> 5)) * 512 + ((k & 7) * 32 + (c & 31)) * 2; }
__device__ __forceinline__ int v_rd_base(int lane) { return ((lane & 3) << 3) | (((lane >> 2) & 3) << 6) | (((lane >> 4) & 1) << 5) | (((lane >> 5) & 1) << 8); }
constexpr int v_rd_off(int d0, int ks, int half) { return d0 * 512 + ks * 4096 + half * 2048; }
template <int OFF> __device__ __forceinline__ s16x4 tr_read(int vb) {
    s16x4 r; asm volatile("ds_read_b64_tr_b16 %0, %1 offset:%2" : "=&v"(r) : "v"(vb), "i"(OFF) : "memory"); return r;
}
#define PKLH(L, H) (bf16x8){L[0], L[1], L[2], L[3], H[0], H[1], H[2], H[3]}
template <int D0> __device__ __forceinline__ void pv_one(f32x16& od, int vb, bf16x8 pa0, bf16x8 pa1, bf16x8 pa2, bf16x8 pa3) {
    const s16x4 l0 = tr_read<v_rd_off(D0, 0, 0)>(vb), h0 = tr_read<v_rd_off(D0, 0, 1)>(vb), l1 = tr_read<v_rd_off(D0, 1, 0)>(vb), h1 = tr_read<v_rd_off(D0, 1, 1)>(vb);
    const s16x4 l2 = tr_read<v_rd_off(D0, 2, 0)>(vb), h2 = tr_read<v_rd_off(D0, 2, 1)>(vb), l3 = tr_read<v_rd_off(D0, 3, 0)>(vb), h3 = tr_read<v_rd_off(D0, 3, 1)>(vb);
    asm volatile("s_waitcnt lgkmcnt(0)" ::: "memory"); SBAR();
    od = __builtin_amdgcn_mfma_f32_32x32x16_bf16(pa0, PKLH(l0, h0), od, 0, 0, 0);
    od = __builtin_amdgcn_mfma_f32_32x32x16_bf16(pa1, PKLH(l1, h1), od, 0, 0, 0);
    od = __builtin_amdgcn_mfma_f32_32x32x16_bf16(pa2, PKLH(l2, h2), od, 0, 0, 0);
    od = __builtin_amdgcn_mfma_f32_32x32x16_bf16(pa3, PKLH(l3, h3), od, 0, 0, 0);
}
__device__ __forceinline__ void pv_d0(f32x16* o, int vb, bf16x8 pa0, bf16x8 pa1, bf16x8 pa2, bf16x8 pa3) {
    pv_one<0>(o[0], vb, pa0, pa1, pa2, pa3); pv_one<1>(o[1], vb, pa0, pa1, pa2, pa3); pv_one<2>(o[2], vb, pa0, pa1, pa2, pa3); pv_one<3>(o[3], vb, pa0, pa1, pa2, pa3);
}
template <int DQK> __device__ __forceinline__ void qkt(f32x16& p0, f32x16& p1, const char* Ks, const bf16x8* qr, int r32, int hi, const f32x16 init = f32x16{}) {
    constexpr int NS = DQK / 16;
    p0 = init; p1 = init;
    bf16x8 b0[NS], b1[NS];
#pragma unroll
    for (int d0 = 0; d0 < NS; ++d0) { const int cb = (d0 * 16 + hi * 8) * 2;
        b0[d0] = *reinterpret_cast<const bf16x8*>(Ks + kswz<DQK>(r32, cb));
        b1[d0] = *reinterpret_cast<const bf16x8*>(Ks + kswz<DQK>(32 + r32, cb)); }
#pragma unroll
    for (int d0 = 0; d0 < NS; ++d0) {
        p0 = __builtin_amdgcn_mfma_f32_32x32x16_bf16(b0[d0], qr[d0], p0, 0, 0, 0);
        p1 = __builtin_amdgcn_mfma_f32_32x32x16_bf16(b1[d0], qr[d0], p1, 0, 0, 0); }
#ifndef QKT_AHEAD
#define QKT_AHEAD 2
#endif
    __builtin_amdgcn_sched_group_barrier(0x100, 2 * QKT_AHEAD, 0);
#pragma unroll
    for (int d0 = 0; d0 < NS - QKT_AHEAD; ++d0) { __builtin_amdgcn_sched_group_barrier(0x008, 2, 0); __builtin_amdgcn_sched_group_barrier(0x100, 2, 0); }
    __builtin_amdgcn_sched_group_barrier(0x008, 2 * QKT_AHEAD, 0);
}
#define PK4(P, BASE, OUT) do { const unsigned a0_ = cvtpk(P[BASE + 0], P[BASE + 1]), a1_ = cvtpk(P[BASE + 2], P[BASE + 3]);   \
    const unsigned b0_ = cvtpk(P[BASE + 4], P[BASE + 5]), b1_ = cvtpk(P[BASE + 6], P[BASE + 7]);                              \
    auto r0_ = __builtin_amdgcn_permlane32_swap(a0_, b0_, false, false); auto r1_ = __builtin_amdgcn_permlane32_swap(a1_, b1_, false, false); \
    u32x4 w_ = {r0_[0], r1_[0], r0_[1], r1_[1]}; OUT = *reinterpret_cast<bf16x8*>(&w_); } while (0)

#define PK4N(P, BASE, OUT) do { u32x4 w_ = {cvtpk(P[BASE + 0], P[BASE + 1]), cvtpk(P[BASE + 2], P[BASE + 3]), cvtpk(P[BASE + 4], P[BASE + 5]), cvtpk(P[BASE + 6], P[BASE + 7])}; \
    OUT = *reinterpret_cast<bf16x8*>(&w_); } while (0)

template <int SC1000> struct SmC { };
constexpr float THR = 8.f;

__device__ __forceinline__ void partialSM(f32x16& p0, f32x16& p1, float& m_reg, float& mn, float& alpha, const float C, const float thr_raw) {
    float pmax = p0[0];
#pragma unroll
    for (int r = 1; r < 16; ++r) pmax = fmaxf(pmax, p0[r]);
#pragma unroll
    for (int r = 0; r < 16; ++r) pmax = fmaxf(pmax, p1[r]);
    { auto rr = __builtin_amdgcn_permlane32_swap(__float_as_uint(pmax), __float_as_uint(pmax), false, false);
      pmax = fmaxf(__uint_as_float(rr[0]), __uint_as_float(rr[1])); }
    if (__builtin_expect(__all(pmax - m_reg <= thr_raw), 1)) { mn = m_reg; alpha = 1.f; }
    else { mn = fmaxf(m_reg, pmax); alpha = __builtin_amdgcn_exp2f((m_reg - mn) * C); m_reg = mn; }
    const float mnC = -mn * C;
#pragma unroll
    for (int r = 0; r < 16; ++r) p0[r] = fmaf(p0[r], C, mnC);
#pragma unroll
    for (int r = 0; r < 16; ++r) p1[r] = fmaf(p1[r], C, mnC);
#pragma unroll
    for (int r = 0; r < 16; ++r) p0[r] = __builtin_amdgcn_exp2f(p0[r]);
}
__device__ __forceinline__ void finishSM(f32x16& p0, f32x16& p1, float alpha, float& l_reg, bf16x8& pa0, bf16x8& pa1, bf16x8& pa2, bf16x8& pa3) {
#pragma unroll
    for (int r = 0; r < 16; ++r) p1[r] = __builtin_amdgcn_exp2f(p1[r]);
    float ps = 0;
#pragma unroll
    for (int r = 0; r < 16; ++r) ps += p0[r];
#pragma unroll
    for (int r = 0; r < 16; ++r) ps += p1[r];
    { auto rr = __builtin_amdgcn_permlane32_swap(__float_as_uint(ps), __float_as_uint(ps), false, false);
      ps = __uint_as_float(rr[0]) + __uint_as_float(rr[1]); }
    l_reg = l_reg * alpha + ps;
    PK4N(p0, 0, pa0); PK4N(p0, 8, pa1); PK4N(p1, 0, pa2); PK4N(p1, 8, pa3);
}

constexpr int KVBLK = 64;
struct AttnArgs {
    const bf16_t* Q; int ldq;
    const bf16_t* K; int ldk;
    const bf16_t* KR; int ldkr;
    const bf16_t* V; int ldv;
    bf16_t* O; int ldo;
    int nt;
    int seg0_tiles, seg0_row, seg1_row;
    int qpos0;
    int masked;
    float sink_l2; int has_sink;
    float C;
};
template <int DQK>
__device__ __forceinline__ void attn_body(const AttnArgs& a, char* lds) {
    constexpr int SHM_V = KVBLK * 128 * 2, SHM_K = KVBLK * (DQK * 2 + 16);
    const int tid = otid(), wid = tid >> 6, lane = tid & 63, r32 = lane & 31, hi = lane >> 5;
    char* V_lds = lds; char* K_lds = lds + 2 * SHM_V;
    float* ws = (float*)(lds + 2 * SHM_V + 2 * SHM_K) + wid * 64; float* li_l = ws; float* al_l = ws + 32;
    float m_reg = -1e30f, l_reg = 0; f32x16 o[4] = {}; bf16x8 qr[DQK / 16];
    const float C = a.C, thr_raw = THR * LOG2E / a.C;
    const bf16_t* Qw = a.Q + (long)(wid * 32 + r32) * a.ldq + hi * 8;
#pragma unroll
    for (int d0 = 0; d0 < DQK / 16; ++d0) qr[d0] = *reinterpret_cast<const bf16x8*>(Qw + d0 * 16);
    const int sr = tid >> 4, sc = (tid & 15) * 8, vst0 = v_stn(sr, sc), vst1 = v_stn(32 + sr, sc);
    const int kst0 = kswz<DQK>(sr, sc * 2), kst1 = kswz<DQK>(32 + sr, sc * 2);
    const int sr2 = tid >> 3, sc2 = (tid & 7) * 8, kst2 = (DQK == 192) ? kswz<DQK>(sr2, 256 + sc2 * 2) : 0;
    const int vb0 = (int)(uintptr_t)V_lds + v_rd_base(lane);
    bf16x8 vs0, vs1, ks0, ks1, ks2;
    __syncthreads();
#define TILE_ROW(j) ((j) < a.seg0_tiles ? a.seg0_row + 64 * (j) : ((a.masked && (unsigned)(a.qpos0 - 128 + 64 * ((j) - a.seg0_tiles)) >= (unsigned)SEQ) ? a.seg0_row : a.seg1_row + 64 * ((j) - a.seg0_tiles)))
    int cur_row = TILE_ROW(0);
    const bf16_t* pk0 = a.K + ((long)cur_row + sr) * a.ldk + sc;
    const bf16_t* pkr = a.KR + ((long)cur_row + sr2) * a.ldkr + sc2;
    const long dvk = a.V - a.K, d32 = 32L * a.ldk;
#define SLOAD(j) do { const int nr_ = TILE_ROW(j); const long dr_ = (long)(nr_ - cur_row); cur_row = nr_; pk0 += dr_ * a.ldk; if (DQK == 192) pkr += dr_ * a.ldkr; \
    vs0 = *reinterpret_cast<const bf16x8*>(pk0 + dvk); vs1 = *reinterpret_cast<const bf16x8*>(pk0 + d32 + dvk); \
    ks0 = *reinterpret_cast<const bf16x8*>(pk0); ks1 = *reinterpret_cast<const bf16x8*>(pk0 + d32); \
    if (DQK == 192) ks2 = *reinterpret_cast<const bf16x8*>(pkr); } while (0)
#define SWRITE(b) do { *(bf16x8*)(V_lds + (b) * SHM_V + vst0) = vs0; *(bf16x8*)(V_lds + (b) * SHM_V + vst1) = vs1; \
    *(bf16x8*)(K_lds + (b) * SHM_K + kst0) = ks0; *(bf16x8*)(K_lds + (b) * SHM_K + kst1) = ks1; \
    if (DQK == 192) *(bf16x8*)(K_lds + (b) * SHM_K + kst2) = ks2; } while (0)
#define SWAIT() asm volatile("s_waitcnt vmcnt(0)" ::: "memory")
#define RESC(al) do { if (__any((al) < 1.f)) { if (hi == 0) al_l[r32] = (al); asm volatile("s_waitcnt lgkmcnt(0)" ::: "memory"); \
    _Pragma("unroll") for (int d = 0; d < 4; ++d) _Pragma("unroll") for (int r = 0; r < 16; ++r) o[d][r] *= al_l[crow(r, hi)]; } } while (0)
#define MASK(P0, P1, j) do { if (a.masked && (j) >= a.seg0_tiles) { const int kp0_ = a.qpos0 - 128 + 64 * ((j) - a.seg0_tiles), qp_ = a.qpos0 + wid * 32 + r32; \
    const bool tv_ = (unsigned)kp0_ < (unsigned)SEQ; \
    _Pragma("unroll") for (int r = 0; r < 16; ++r) { const int d0_ = kp0_ + crow(r, hi) - qp_, d1_ = d0_ + 32; \
        P0[r] = (tv_ && d0_ <= 128 && d0_ >= -128) ? P0[r] : -1e30f; P1[r] = (tv_ && d1_ <= 128 && d1_ >= -128) ? P1[r] : -1e30f; } } } while (0)
    f32x16 pA0, pA1; float mnA, alA; bf16x8 pa0, pa1, pa2, pa3; const int NT = a.nt;
    const int wu = __builtin_amdgcn_readfirstlane(wid);
    volatile int* vflag = (volatile int*)(lds + 2 * SHM_V + 2 * SHM_K + 8 * 256);
#define TILE_BODY(CLASSIC, BSEL) { \
        const int b = BSEL; \
        if (j + 1 < NT) SLOAD(j + 1); \
        bool skip = false;        \
        if (a.masked && j >= a.seg0_tiles) { const int kp0_ = a.qpos0 - 128 + 64 * (j - a.seg0_tiles), q0_ = a.qpos0 + wu * 32; \
            skip = ((unsigned)kp0_ >= (unsigned)SEQ) || (kp0_ + 63 < q0_ - 128) || (kp0_ > q0_ + 31 + 128); } \
        if (!skip) { \
            if (CLASSIC) { \
                SBAR(); qkt<DQK>(pA0, pA1, K_lds + b * SHM_K, qr, r32, hi); MASK(pA0, pA1, j); \
                partialSM(pA0, pA1, m_reg, mnA, alA, C, thr_raw); \
                RESC(alA); \
                finishSM(pA0, pA1, alA, l_reg, pa0, pa1, pa2, pa3); \
            } else { \
                SBAR(); qkt<DQK>(pA0, pA1, K_lds + b * SHM_K, qr, r32, hi, minit); MASK(pA0, pA1, j);        \
                float ps_ = 0.f; \
                _Pragma("unroll") for (int r = 0; r < 16; ++r) pA0[r] = __builtin_amdgcn_exp2f(pA0[r]); \
                _Pragma("unroll") for (int r = 0; r < 16; ++r) pA1[r] = __builtin_amdgcn_exp2f(pA1[r]); \
                _Pragma("unroll") for (int r = 0; r < 16; ++r) ps_ += pA0[r]; \
                _Pragma("unroll") for (int r = 0; r < 16; ++r) ps_ += pA1[r]; \
                { auto rr = __builtin_amdgcn_permlane32_swap(__float_as_uint(ps_), __float_as_uint(ps_), false, false); ps_ = __uint_as_float(rr[0]) + __uint_as_float(rr[1]); } \
                badu = __builtin_elementwise_max(badu, __float_as_uint(ps_));        \
                l_reg += ps_; \
                PK4N(pA0, 0, pa0); PK4N(pA0, 8, pa1); PK4N(pA1, 0, pa2); PK4N(pA1, 8, pa3); \
            } \
            SBAR(); \
            if (j + 1 < NT) { SWAIT(); SWRITE(b ^ 1); }        \
            SBAR(); \
            pv_d0(o, vb0 + b * SHM_V, pa0, pa1, pa2, pa3); \
        } else if (j + 1 < NT) { SWAIT(); SWRITE(b ^ 1); } \
        __syncthreads(); }
    if (tid == 0) *vflag = 0;
    if (wu >= 4) __builtin_amdgcn_s_setprio(1);
#pragma nounroll
    for (int pass = 0; pass < 2; ++pass) {
        int bad = 0; unsigned badu = 0u;
        SLOAD(0); SWAIT(); SWRITE(0); __syncthreads();
        const int jc = pass ? NT : 1;
        f32x16 minit = f32x16{};
#pragma nounroll
        for (int j = 0; j < jc; ++j) TILE_BODY(1, (j & 1))
#pragma unroll
        for (int r = 0; r < 16; ++r) minit[r] = -m_reg * C;
        if (!pass) {
            int j = 1;
#pragma nounroll
            for (; j + 1 < NT; j += 2) { TILE_BODY(0, 1) { const int j0_ = j; (void)j0_; } ++j; TILE_BODY(0, 0) --j; }
            if (j < NT) TILE_BODY(0, 1)
        }
        if (pass) break;
        bad = !__all(badu <= __float_as_uint(256.0f));
        if (bad && lane == 0) *vflag = 1;
        __syncthreads();
        if (*vflag == 0) break;
        __syncthreads();
        m_reg = -1e30f; l_reg = 0.f;
#pragma unroll
        for (int d = 0; d < 4; ++d) o[d] = f32x16{};
    }
#undef TILE_BODY
    __builtin_amdgcn_s_setprio(0);
    if (a.has_sink) l_reg += __builtin_amdgcn_exp2f(a.sink_l2 - m_reg * C);
    if (hi == 0) li_l[r32] = l_reg; asm volatile("s_waitcnt lgkmcnt(0)" ::: "memory");
    float rli[16];
#pragma unroll
    for (int r = 0; r < 16; ++r) rli[r] = __builtin_amdgcn_rcpf(li_l[crow(r, hi)]);
    __syncthreads();
    { unsigned short* stg = (unsigned short*)(lds + wid * 8704);
#pragma unroll
      for (int r = 0; r < 16; ++r) { const int orow = crow(r, hi);
#pragma unroll
          for (int d0 = 0; d0 < 4; ++d0) stg[orow * 136 + d0 * 32 + r32] = (unsigned short)(cvtpk(o[d0][r] * rli[r], 0.f) & 0xffffu); }
      asm volatile("s_waitcnt lgkmcnt(0)" ::: "memory");
      bf16_t* Ow = a.O + (long)(wid * 32) * a.ldo;
#pragma unroll
      for (int i = 0; i < 8; ++i) { const int q = lane + 64 * i, row = q >> 4, c8 = (q & 15) * 8;
          *(u32x4*)(Ow + (long)row * a.ldo + c8) = *(const u32x4*)(stg + row * 136 + c8); } }
#undef TILE_ROW
#undef SLOAD
#undef SWRITE
#undef SWAIT
#undef RESC
#undef MASK
}

__device__ __forceinline__ int ret_row0(int bb, int n) { return n == 32 ? NLAT + bb * CTXL : bb * SEQ + n * 256; }
__device__ __forceinline__ float log2_sigmoid(float x) { return -log1pf(__expf(-x)) * LOG2E; }

__device__ __forceinline__ void ret_kv_unit(const bf16_t* PROJ, float* KVS, int bb, int h, int n, float lgf2, float lgb2, char* lds) {
    const int tid = otid(), wid = tid >> 6, lane = tid & 63, r32 = lane & 31, hi = lane >> 5;
    const int dir = wid >> 2, ablk = wid & 3;
    const int sr = tid >> 4, sc = (tid & 15) * 8, vst0 = v_st(sr, sc), vst1 = v_st(32 + sr, sc);
    const long R0 = ret_row0(bb, n);
    const bf16_t* Kg = PROJ + R0 * INW + 512 + h * 128; const bf16_t* Vg = PROJ + R0 * INW + 1024 + h * 128;
    const int vbK = (int)(uintptr_t)lds + dir * 16384 + v_rd_base(lane) + ablk * 512;
    const int vbV = (int)(uintptr_t)lds + 32768 + v_rd_base(lane);
    f32x16 acc[4] = {};
    u32x4 kq[2]; bf16x8 vq[2];
#pragma unroll
    for (int i = 0; i < 2; ++i) { const int j = sr + 32 * i; kq[i] = *reinterpret_cast<const u32x4*>(Kg + (long)j * INW + sc); vq[i] = *reinterpret_cast<const bf16x8*>(Vg + (long)j * INW + sc); }
    for (int t = 0; t < 4; ++t) {
        __syncthreads();
#pragma unroll
        for (int i = 0; i < 2; ++i) {
            const int j = 64 * t + sr + 32 * i;
            const u32x4 kv = kq[i];
            const bf16x8 vv = vq[i];
            const float kf = __builtin_amdgcn_exp2f(lgf2 * (float)(255 - j)), kb = __builtin_amdgcn_exp2f(lgb2 * (float)j);
            u32x4 wf, wb;
#pragma unroll
            for (int e = 0; e < 4; ++e) { const float lo = bflo(kv[e]), hh = bfhi(kv[e]); wf[e] = cvtpk(lo * kf, hh * kf); wb[e] = cvtpk(lo * kb, hh * kb); }
            const int vo = i ? vst1 : vst0;
            *(u32x4*)(lds + vo) = wf; *(u32x4*)(lds + 16384 + vo) = wb; *(bf16x8*)(lds + 32768 + vo) = vv;
        }
        if (t < 3) {
#pragma unroll
            for (int i = 0; i < 2; ++i) { const int j = 64 * (t + 1) + sr + 32 * i; kq[i] = *reinterpret_cast<const u32x4*>(Kg + (long)j * INW + sc); vq[i] = *reinterpret_cast<const bf16x8*>(Vg + (long)j * INW + sc); }
        }
        __syncthreads();
#define RKV_STEP(KS) do { \
        const s16x4 al_ = tr_read<v_rd_off(0, KS, 0)>(vbK), ah_ = tr_read<v_rd_off(0, KS, 1)>(vbK); \
        const s16x4 l0_ = tr_read<v_rd_off(0, KS, 0)>(vbV), h0_ = tr_read<v_rd_off(0, KS, 1)>(vbV), l1_ = tr_read<v_rd_off(1, KS, 0)>(vbV), h1_ = tr_read<v_rd_off(1, KS, 1)>(vbV); \
        const s16x4 l2_ = tr_read<v_rd_off(2, KS, 0)>(vbV), h2_ = tr_read<v_rd_off(2, KS, 1)>(vbV), l3_ = tr_read<v_rd_off(3, KS, 0)>(vbV), h3_ = tr_read<v_rd_off(3, KS, 1)>(vbV); \
        asm volatile("s_waitcnt lgkmcnt(0)" ::: "memory"); SBAR(); \
        const bf16x8 af_ = PKLH(al_, ah_); \
        acc[0] = __builtin_amdgcn_mfma_f32_32x32x16_bf16(af_, PKLH(l0_, h0_), acc[0], 0, 0, 0); \
        acc[1] = __builtin_amdgcn_mfma_f32_32x32x16_bf16(af_, PKLH(l1_, h1_), acc[1], 0, 0, 0); \
        acc[2] = __builtin_amdgcn_mfma_f32_32x32x16_bf16(af_, PKLH(l2_, h2_), acc[2], 0, 0, 0); \
        acc[3] = __builtin_amdgcn_mfma_f32_32x32x16_bf16(af_, PKLH(l3_, h3_), acc[3], 0, 0, 0); } while (0)
        RKV_STEP(0); RKV_STEP(1); RKV_STEP(2); RKV_STEP(3);
#undef RKV_STEP
    }
    float* outp = KVS + ((((size_t)bb * 4 + h) * 2 + dir) * 33 + n) * 16384;
#pragma unroll
    for (int r = 0; r < 16; ++r) { const int dk = 32 * ablk + crow(r, hi);
#pragma unroll
        for (int d = 0; d < 4; ++d) outp[dk * 128 + 32 * d + r32] = acc[d][r]; }
}

__device__ __forceinline__ void ret_scan(const float* KVS, bf16_t* SIN, const float* dec_f, const float* dec_b, int gtid, int gthreads) {
    for (int it = gtid; it < NB * 4 * 2 * 4096; it += gthreads) {
        const int e4 = it & 4095, dir = (it >> 12) & 1, h = (it >> 13) & 3, bb = it >> 15;
        const float lg2 = log2_sigmoid(dir ? dec_b[h] : dec_f[h]); const float cd = __builtin_amdgcn_exp2f(lg2 * 256.0f);
        const size_t base = ((((size_t)bb * 4 + h) * 2 + dir) * 33) * 16384 + (size_t)e4 * 4;
        f32x4 s = *(const f32x4*)(KVS + base + (size_t)32 * 16384);
        *(u32x2*)(SIN + base + (size_t)32 * 16384) = (u32x2){0u, 0u};
        for (int nb = 0; nb < 4; ++nb) {
            f32x4 kv[8];
#pragma unroll
            for (int q = 0; q < 8; ++q) { const int n = dir ? 31 - (nb * 8 + q) : nb * 8 + q; kv[q] = *(const f32x4*)(KVS + base + (size_t)n * 16384); }
#pragma unroll
            for (int q = 0; q < 8; ++q) { const int n = dir ? 31 - (nb * 8 + q) : nb * 8 + q;
                st_bf16x4(SIN + base + (size_t)n * 16384, s); s = s * cd + kv[q]; }
        }
    }
}

__device__ __forceinline__ void ret_out_unit(const bf16_t* PROJ, const bf16_t* SIN, bf16_t* Y, int bb, int h, int n, float lgf2, float lgb2, char* lds) {
    const int tid = otid(), wid = tid >> 6, lane = tid & 63, r32 = lane & 31, hi = lane >> 5;
    const int sr = tid >> 4, sc = (tid & 15) * 8, vst0 = v_st(sr, sc), vst1 = v_st(32 + sr, sc);
    const int kst0 = kswz<128>(sr, sc * 2), kst1 = kswz<128>(32 + sr, sc * 2);
    const long R0 = ret_row0(bb, n);
    const bf16_t* Qg = PROJ + R0 * INW + h * 128; const bf16_t* Kg = Qg + 512; const bf16_t* Vg = Qg + 1024; const bf16_t* Gg = Qg + 1536;
    char* K_lds = lds; char* V_lds = lds + 17408;
    const int vb0 = (int)(uintptr_t)V_lds + v_rd_base(lane);
    bf16x8 qr[8];
    const bf16_t* Qw = Qg + (long)(wid * 32 + r32) * INW + hi * 8;
#pragma unroll
    for (int d0 = 0; d0 < 8; ++d0) qr[d0] = *reinterpret_cast<const bf16x8*>(Qw + d0 * 16);
    f32x16 o[4] = {};
    const int iq = wid * 32 + r32;
    const bf16_t* S0 = SIN + ((((size_t)bb * 4 + h) * 2) * 33 + n) * 16384;
    bf16x8 kq[2], vq[2];
#pragma unroll
    for (int i = 0; i < 2; ++i) { const int j = sr + 32 * i; kq[i] = *reinterpret_cast<const bf16x8*>(Kg + (long)j * INW + sc); vq[i] = *reinterpret_cast<const bf16x8*>(Vg + (long)j * INW + sc); }
    for (int t = 0; t < 4; ++t) {
        __syncthreads();
#pragma unroll
        for (int i = 0; i < 2; ++i) { *(bf16x8*)(K_lds + (i ? kst1 : kst0)) = kq[i]; *(bf16x8*)(V_lds + (i ? vst1 : vst0)) = vq[i]; }
        if (t < 3) {
#pragma unroll
            for (int i = 0; i < 2; ++i) { const int j = 64 * (t + 1) + sr + 32 * i; kq[i] = *reinterpret_cast<const bf16x8*>(Kg + (long)j * INW + sc); vq[i] = *reinterpret_cast<const bf16x8*>(Vg + (long)j * INW + sc); }
        } else if (n != 32) {
#pragma unroll
            for (int i = 0; i < 2; ++i) vq[i] = *reinterpret_cast<const bf16x8*>(S0 + (sr + 32 * i) * 128 + sc);
        }
        __syncthreads();
        f32x16 p0, p1; qkt<128>(p0, p1, K_lds, qr, r32, hi);
#pragma unroll
        for (int r = 0; r < 16; ++r) {
            const int d0 = iq - (64 * t + crow(r, hi)), d1 = d0 - 32;
            const float m0 = d0 > 0 ? __builtin_amdgcn_exp2f(lgf2 * (float)d0) : (d0 < 0 ? __builtin_amdgcn_exp2f(lgb2 * (float)(-d0)) : 2.0f);
            const float m1 = d1 > 0 ? __builtin_amdgcn_exp2f(lgf2 * (float)d1) : (d1 < 0 ? __builtin_amdgcn_exp2f(lgb2 * (float)(-d1)) : 2.0f);
            p0[r] *= m0; p1[r] *= m1;
        }
        bf16x8 pa0, pa1, pa2, pa3; PK4(p0, 0, pa0); PK4(p0, 8, pa1); PK4(p1, 0, pa2); PK4(p1, 8, pa3);
        pv_d0(o, vb0, pa0, pa1, pa2, pa3);
    }
    if (n != 32) {
#pragma unroll
        for (int s4 = 0; s4 < 4; ++s4) {
            const int dir = s4 >> 1, ts = s4 & 1;
            const float qd = dir ? __builtin_amdgcn_exp2f(lgb2 * (float)(256 - iq)) : __builtin_amdgcn_exp2f(lgf2 * (float)(iq + 1));
            __syncthreads();
#pragma unroll
            for (int i = 0; i < 2; ++i) *(bf16x8*)(V_lds + (i ? vst1 : vst0)) = vq[i];
            if (s4 < 3) { const int d2 = (s4 + 1) >> 1, t2 = (s4 + 1) & 1; const bf16_t* Sn = S0 + (size_t)d2 * 33 * 16384;
#pragma unroll
                for (int i = 0; i < 2; ++i) vq[i] = *reinterpret_cast<const bf16x8*>(Sn + (64 * t2 + sr + 32 * i) * 128 + sc); }
            bf16x8 qs[4];
#pragma unroll
            for (int k = 0; k < 4; ++k) { const u32x4 w = *reinterpret_cast<const u32x4*>(&qr[4 * ts + k]); u32x4 x;
#pragma unroll
                for (int e = 0; e < 4; ++e) x[e] = cvtpk(bflo(w[e]) * qd, bfhi(w[e]) * qd);
                qs[k] = *reinterpret_cast<bf16x8*>(&x); }
            __syncthreads();
            pv_d0(o, vb0, qs[0], qs[1], qs[2], qs[3]);
        }
    }
    __syncthreads();
    { unsigned short* stg = (unsigned short*)(lds + wid * 8704);
#pragma unroll
      for (int r = 0; r < 16; ++r) {
          float ss = (o[0][r] * o[0][r] + o[1][r] * o[1][r]) + (o[2][r] * o[2][r] + o[3][r] * o[3][r]);
          ss += __shfl_xor(ss, 1); ss += __shfl_xor(ss, 2); ss += __shfl_xor(ss, 4); ss += __shfl_xor(ss, 8); ss += __shfl_xor(ss, 16);
          const float rn = 1.0f / sqrtf(ss * (1.0f / 128.0f) + RMS_EPS);
#pragma unroll
          for (int d = 0; d < 4; ++d) stg[crow(r, hi) * 136 + 32 * d + r32] = (unsigned short)(cvtpk(o[d][r] * rn, 0.f) & 0xffffu);
      }
      asm volatile("s_waitcnt lgkmcnt(0)" ::: "memory");
#pragma unroll
      for (int i = 0; i < 8; ++i) { const int q = lane + 64 * i, row = q >> 4, c8 = (q & 15) * 8;
          const u32x4 gw = *(const u32x4*)(Gg + (long)(wid * 32 + row) * INW + c8);
          const u32x4 xw = *(const u32x4*)(stg + row * 136 + c8);
          u32x4 ow;
#pragma unroll
          for (int e = 0; e < 4; ++e) ow[e] = cvtpk(silu_f(bflo(gw[e])) * bflo(xw[e]), silu_f(bfhi(gw[e])) * bfhi(xw[e]));
          *(u32x4*)(Y + (R0 + wid * 32 + row) * D + h * 128 + c8) = ow; } }
}

struct Params {
    const float* in[23];
    float* out; unsigned char* ws;
    int ph_lo, ph_hi, bar_region, pad;
};
enum { I_X = 0, I_C, I_CTX, I_CCTX, I_ADAW, I_ADAB, I_WIN, I_DECF, I_DECB, I_SINK, I_QNORM, I_WUQ, I_KVNORM, I_WUKV, I_WO, I_LN1G, I_LN1B, I_WUP, I_CONVW, I_CONVB, I_WDN, I_LN2G, I_LN2B };

__device__ __forceinline__ int win_src_col(int p) {
    if (p >= INW) return -1;
    if (p >= 4096) return p;
    const int pn = p >> 8;
    if (pn < 4 || (pn >= 8 && pn < 12)) {
        const int bj = (p >> 7) & 1, x = p & 127, wc = x >> 5, nn = (x >> 4) & 1, q = x & 15;
        return (p & ~255) + 128 * (wc >> 1) + 64 * (wc & 1) + 32 * bj + 8 * (q >> 2) + 4 * nn + (q & 3);
    }
    return (p & ~31) + 8 * ((p & 15) >> 2) + 4 * ((p >> 4) & 1) + (p & 3);
}
__device__ __forceinline__ int wup_src_col(int p) {
    const int pn = p >> 8, bj = (p >> 7) & 1, x = p & 127, wc = x >> 5, nn = (x >> 4) & 1, q = x & 15, fq = q >> 2, j = q & 3;
    const int f = 128 * pn + 32 * wc + 8 * fq + 4 * nn + j;
    return bj ? DFF + f : f;
}
__device__ __forceinline__ void cvt_item(const float* W, int K, int N, bf16_t* Bt, int mode, const float* kscale, int item, int nkt, float* scr, int lane) {
    const int pt = item / nkt, kt = item - pt * nkt, p0 = pt * 32, k0 = kt * 64;
    const int p = p0 + (lane & 31);
    const int src = mode == 1 ? win_src_col(p) : (mode == 2 ? wup_src_col(p) : (mode == 3 ? ((p & ~31) + 8 * ((p & 15) >> 2) + 4 * ((p >> 4) & 1) + (p & 3)) : (p < N ? p : -1)));
    const float* wp = W + (size_t)(k0 + (lane >> 5)) * N + (src >= 0 ? src : 0);
    float v[32];
#pragma unroll
    for (int i = 0; i < 32; ++i) v[i] = src >= 0 ? wp[(size_t)(2 * i) * N] : 0.f;
    if (kscale) {
#pragma unroll
        for (int i = 0; i < 32; ++i) v[i] *= kscale[k0 + 2 * i + (lane >> 5)];
    }
#pragma unroll
    for (int i = 0; i < 32; ++i) scr[(2 * i + (lane >> 5)) * 33 + (lane & 31)] = v[i];
    asm volatile("s_waitcnt lgkmcnt(0)" ::: "memory");
    const int c = lane & 7;
#pragma unroll
    for (int j = 0; j < 4; ++j) { const int n = (lane >> 3) + 8 * j; const float* s = scr + (8 * c) * 33 + n;
        u32x4 o; o[0] = cvtpk(s[0 * 33], s[1 * 33]); o[1] = cvtpk(s[2 * 33], s[3 * 33]); o[2] = cvtpk(s[4 * 33], s[5 * 33]); o[3] = cvtpk(s[6 * 33], s[7 * 33]);
        *(u32x4*)(Bt + (size_t)(p0 + n) * K + k0 + 8 * c) = o; }
    asm volatile("s_waitcnt lgkmcnt(0)" ::: "memory");
}

__device__ __forceinline__ void ln_phase(const bf16_t* X, const bf16_t* MIX, float* dstf, bf16_t* dsth, bf16_t* H, const float* g, const float* b,
                                         const float* gate, const float* sc, const float* sh, int nrows, int bid, int G, char* lds) {
    const int tid = otid(), lane = tid & 63, wid = __builtin_amdgcn_readfirstlane(tid >> 6);
    float* L = (float*)lds;
    __syncthreads();
    for (int i = tid; i < D; i += 512) { L[i] = g[i]; L[D + i] = b[i]; }
    const int ngroups = nrows >> 3, grp0 = (int)(((long)bid * ngroups) / G), nsteps = (int)(((long)(bid + 1) * ngroups) / G) - grp0; int s_cur = -1;
#define LN_ROW(k) ((grp0 + (k)) * 8 + wid)
#define LN_LOAD(XA, MA, ROW) do { const bf16_t* xr_ = X + (size_t)(ROW) * D + 4 * lane; const bf16_t* mr_ = MIX + (size_t)(ROW) * D + 4 * lane; \
    _Pragma("unroll") for (int j = 0; j < 8; ++j) { XA[j] = *(const u32x2*)(xr_ + 256 * j); MA[j] = *(const u32x2*)(mr_ + 256 * j); } } while (0)
#define LN_SVEC(k) do { const int s_ = mod_index((grp0 + (k)) * 8); \
    if (s_ != s_cur) { __syncthreads(); \
        { float gv_[4], sv_[4], hv_[4]; \
          _Pragma("unroll") for (int q_ = 0; q_ < 4; ++q_) { const int i = tid + 512 * q_; gv_[q_] = gate[(size_t)s_ * MODW + i]; sv_[q_] = H ? sc[(size_t)s_ * MODW + i] : 0.f; hv_[q_] = H ? sh[(size_t)s_ * MODW + i] : 0.f; } \
          _Pragma("unroll") for (int q_ = 0; q_ < 4; ++q_) { const int i = tid + 512 * q_; L[2 * D + i] = gv_[q_] + 1.0f; L[3 * D + i] = sv_[q_] + 1.0f; L[4 * D + i] = hv_[q_]; } } \
        s_cur = s_; __syncthreads(); } } while (0)
#define LN_COMP(XA, MA, ROW) do { \
    f32x4 v[8]; float sum = 0.f; \
    _Pragma("unroll") for (int j = 0; j < 8; ++j) { const int c = 4 * lane + 256 * j; \
        const f32x4 mv = (f32x4){bflo(MA[j][0]), bfhi(MA[j][0]), bflo(MA[j][1]), bfhi(MA[j][1])}; \
        v[j] = cvt_f16x4(XA[j]) * ALPHA + *(const f32x4*)(L + 2 * D + c) * mv; sum += (v[j][0] + v[j][1]) + (v[j][2] + v[j][3]); } \
    const float mean = wave_sum(sum) * (1.0f / D); float s2 = 0.f; \
    _Pragma("unroll") for (int j = 0; j < 8; ++j) { v[j] = v[j] - mean; s2 += (v[j][0] * v[j][0] + v[j][1] * v[j][1]) + (v[j][2] * v[j][2] + v[j][3] * v[j][3]); } \
    const float rstd = 1.0f / sqrtf(wave_sum(s2) * (1.0f / D) + LN_EPS); \
    _Pragma("unroll") for (int j = 0; j < 8; ++j) { const int c = 4 * lane + 256 * j; \
        const f32x4 y = v[j] * rstd * *(const f32x4*)(L + c) + *(const f32x4*)(L + D + c); \
        if (dstf) *(f32x4*)(dstf + (size_t)(ROW) * D + c) = y; else st_f16x4(dsth + (size_t)(ROW) * D + c, y); \
        if (H) st_bf16x4(H + (size_t)(ROW) * D + c, y * *(const f32x4*)(L + 3 * D + c) + *(const f32x4*)(L + 4 * D + c)); } } while (0)
    u32x2 xa[8], xb[8], ma[8], mb[8];
    if (LN_ROW(0) < nrows) LN_LOAD(xa, ma, LN_ROW(0));
    for (int k = 0; k < nsteps; k += 2) {
        LN_SVEC(k);
        if (k + 1 < nsteps && LN_ROW(k + 1) < nrows) LN_LOAD(xb, mb, LN_ROW(k + 1));
        SBAR();
        if (LN_ROW(k) < nrows) LN_COMP(xa, ma, LN_ROW(k));
        if (k + 1 < nsteps) {
            LN_SVEC(k + 1);
            if (k + 2 < nsteps && LN_ROW(k + 2) < nrows) LN_LOAD(xa, ma, LN_ROW(k + 2));
            SBAR();
            if (LN_ROW(k + 1) < nrows) LN_COMP(xb, mb, LN_ROW(k + 1));
        }
    }
#undef LN_ROW
#undef LN_LOAD
#undef LN_SVEC
#undef LN_COMP
}

__global__ void __launch_bounds__(512, 2) fwd_kernel(Params p) {
    extern __shared__ __attribute__((aligned(16))) unsigned char lds_raw[];
    LAS unsigned char* ldsl = (LAS unsigned char*)lds_raw;
    char* lds = (char*)lds_raw;
    if (threadIdx.x < 4) ((volatile LAS unsigned*)(ldsl + 131072))[threadIdx.x] = 0u;
    __syncthreads();
    XcdBarrier bar; bar.bar = (unsigned*)(p.ws + WS_CTL) + (size_t)p.bar_region * 4096; bar.x = 0; bar.st = (volatile LAS unsigned*)(ldsl + 131072);
    if (p.ph_hi - p.ph_lo > 1) bar = xcd_barrier_post(bar.bar, (volatile LAS unsigned*)(ldsl + 131072));

    int g = 0, lcur = 0;
#ifndef DUPMASK
#define DUPMASK 0
#endif
#define NREP(k) (1 + ((DUPMASK >> (k)) & 1))
#ifndef PHMASK
#define PHMASK 0xffff
#endif
#ifndef SUBMASK
#define SUBMASK 0xffff
#endif
#define SUB(k) ((SUBMASK >> (k)) & 1)
#define PH_BEGIN(k) if (((PHMASK >> (k)) & 1) && g >= p.ph_lo && g < p.ph_hi) { \
    int bid = blockIdx.x, G = gridDim.x; asm volatile("" : "+s"(bid), "+s"(G)); const int NGW = G * 8, gthreads = G * 512; (void)NGW; (void)gthreads; \
    const int tid = otid(), lane = tid & 63, wid = __builtin_amdgcn_readfirstlane(tid >> 6); const int gw = bid * 8 + wid, gtid = bid * 512 + tid; (void)lane; (void)gw; (void)gtid; \
    size_t wsoff_ = 0; asm volatile("" : "+s"(wsoff_)); unsigned char* ws = p.ws + wsoff_; \
    float* MOD = (float*)(ws + WS_MOD); float* ROPE = (float*)(ws + WS_ROPE); float* RS = (float*)(ws + WS_RS); float* SM = (float*)(ws + WS_SM); (void)SM; \
    float* thc = ROPE, *ths = ROPE + 4096, *tmc = ROPE + 8192, *tms = ROPE + 8192 + 2048; \
    bf16_t* WB = (bf16_t*)(ws + WS_W); float* X = (float*)(ws + WS_X); bf16_t* XH = (bf16_t*)(ws + WS_X); (void)XH; bf16_t* H = (bf16_t*)(ws + WS_H); bf16_t* Y = (bf16_t*)(ws + WS_Y); \
    bf16_t* PROJ = (bf16_t*)(ws + WS_PROJ); bf16_t* QUP = (bf16_t*)(ws + WS_QUP); bf16_t* KVUP = (bf16_t*)(ws + WS_KVUP); \
    float* KVS = (float*)(ws + WS_KVS); bf16_t* SIN = (bf16_t*)(ws + WS_SIN); bf16_t* ACT0 = (bf16_t*)(ws + WS_ACT0); bf16_t* ACT1 = (bf16_t*)(ws + WS_ACT1); float* SB = (float*)(ws + WS_SB); bf16_t* MIX = (bf16_t*)(ws + WS_MIX); (void)MIX; \
    const bf16_t* wl = WB + (size_t)lcur * W_LAYER; const float* modl = MOD + (size_t)lcur * 5 * MODW; \
    (void)RS; (void)thc; (void)ths; (void)tmc; (void)tms; (void)X; (void)H; (void)Y; (void)PROJ; (void)QUP; (void)KVUP; (void)KVS; (void)SIN; (void)ACT0; (void)ACT1; (void)SB; (void)wl; (void)modl;
#define PH_END   if (g + 1 < p.ph_hi) xcd_barrier(bar); } ++g;

    PH_BEGIN(0)
    {
        for (int i = gtid; i < SM_END; i += gthreads) {
            float v = 0.f;
            if (i < SM_DECB) v = p.in[I_DECF][i];
            else if (i < SM_SINK) v = p.in[I_DECB][i - SM_DECB];
            else if (i < SM_LN1G) v = (i - SM_SINK) < DEPTH * 6 ? p.in[I_SINK][i - SM_SINK] : 0.f;
            else if (i < SM_LN1B) v = p.in[I_LN1G][i - SM_LN1G];
            else if (i < SM_LN2G) v = p.in[I_LN1B][i - SM_LN1B];
            else if (i < SM_LN2B) v = p.in[I_LN2G][i - SM_LN2G];
            else if (i < SM_CONVW) v = p.in[I_LN2B][i - SM_LN2B];
            else if (i < SM_CONVB) v = p.in[I_CONVW][i - SM_CONVW];
            else v = p.in[I_CONVB][i - SM_CONVB];
            SM[i] = v;
        }
        for (int i = gtid; i < 4096 + 2048; i += gthreads) {
            if (i < 4096) { const int pos = i >> 5, f = i & 31; const float inv = exp2f(-(float)f * (13.287712379549449f / 32.0f)); const float ang = (float)pos * inv; thc[i] = cosf(ang); ths[i] = sinf(ang); }
            else { const int q = i - 4096, pos = q >> 4, f = q & 15; const float inv = exp2f(-(float)f * (13.287712379549449f / 16.0f)); const float ang = (float)pos * inv; tmc[q] = cosf(ang); tms[q] = sinf(ang); }
        }
        {
            float* scs = (float*)lds;
            float* red = (float*)(lds + 5 * 2048 * 4);
            for (int i = tid; i < 5 * 2048; i += 512) { const int s = i >> 11, k = i & 2047; const float cv = s < 4 ? p.in[I_C][s * D + k] : p.in[I_CCTX][k]; scs[i] = silu_f(cv); }
            __syncthreads();
            for (int u = bid; u < DEPTH * (MODW / 64); u += G) {
                const int l = u / (MODW / 64), j = (u % (MODW / 64)) * 64 + lane;
                const float* Wp = p.in[I_ADAW] + (size_t)l * D * MODW + j;
                float a0 = 0.f, a1 = 0.f, a2 = 0.f, a3 = 0.f, a4 = 0.f;
#pragma unroll 16
                for (int kk = 0; kk < 256; ++kk) { const int k = wid * 256 + kk; const float w = Wp[(size_t)k * MODW];
                    a0 += scs[k] * w; a1 += scs[2048 + k] * w; a2 += scs[4096 + k] * w; a3 += scs[6144 + k] * w; a4 += scs[8192 + k] * w; }
                red[(wid * 5 + 0) * 64 + lane] = a0; red[(wid * 5 + 1) * 64 + lane] = a1; red[(wid * 5 + 2) * 64 + lane] = a2; red[(wid * 5 + 3) * 64 + lane] = a3; red[(wid * 5 + 4) * 64 + lane] = a4;
                __syncthreads();
                if (wid < 5) { float sum = 0.f;
#pragma unroll
                    for (int w8 = 0; w8 < 8; ++w8) sum += red[(w8 * 5 + wid) * 64 + lane];
                    MOD[((size_t)l * 5 + wid) * MODW + j] = sum + p.in[I_ADAB][(size_t)l * MODW + j]; }
                __syncthreads();
            }
        }
        {
            __syncthreads();
            float* scr = (float*)(lds + wid * 8448);
            constexpr int T_IN = (INWP / 32) * (D / 64), T_UQ = (QUPWP / 32) * (512 / 64), T_UKV = (KVUPW / 32) * (256 / 64), T_O = (D / 32) * (D / 64), T_UP = (DFF2 / 32) * (D / 64), T_DN = (D / 32) * (DFF / 64);
            constexpr int T_L = T_IN + T_UQ + T_UKV + T_O + T_UP + T_DN;
            for (int u = gw; u < DEPTH * T_L; u += NGW) {
                const int l = u / T_L; int r = u % T_L; bf16_t* wlp = WB + (size_t)l * W_LAYER;
                const float* Wsrc; const float* ksc = nullptr; bf16_t* dst; int Kd, Nd, mode;
                if (r < T_IN) { Wsrc = p.in[I_WIN] + (size_t)l * D * INW; Kd = D; Nd = INW; dst = wlp + W_IN; mode = 1; }
                else if ((r -= T_IN) < T_UQ) { Wsrc = p.in[I_WUQ] + (size_t)l * 512 * QUPW; Kd = 512; Nd = QUPW; dst = wlp + W_UQ; mode = 0; ksc = p.in[I_QNORM] + l * 512; }
                else if ((r -= T_UQ) < T_UKV) { Wsrc = p.in[I_WUKV] + (size_t)l * 256 * KVUPW; Kd = 256; Nd = KVUPW; dst = wlp + W_UKV; mode = 3; ksc = p.in[I_KVNORM] + l * 256; }
                else if ((r -= T_UKV) < T_O) { Wsrc = p.in[I_WO] + (size_t)l * D * D; Kd = D; Nd = D; dst = wlp + W_O; mode = 3; }
                else if ((r -= T_O) < T_UP) { Wsrc = p.in[I_WUP] + (size_t)l * D * DFF2; Kd = D; Nd = DFF2; dst = wlp + W_UP; mode = 2; }
                else { r -= T_UP; Wsrc = p.in[I_WDN] + (size_t)l * DFF * D; Kd = DFF; Nd = D; dst = wlp + W_DN; mode = 3; }
                cvt_item(Wsrc, Kd, Nd, dst, mode, ksc, r, Kd / 64, scr, lane);
            }
        }
    }
    PH_END

    PH_BEGIN(1)
    {
        f32x4 va[8], vb[8];
#define G1_SRC(ROW) ((ROW) < NLAT ? p.in[I_X] + (size_t)(ROW) * D : p.in[I_CTX] + (size_t)((ROW) - NLAT) * D)
#define G1_LOAD(VA, ROW) do { const float* s_ = G1_SRC(ROW) + 4 * lane; _Pragma("unroll") for (int j = 0; j < 8; ++j) VA[j] = *(const f32x4*)(s_ + 256 * j); } while (0)
#define G1_STORE(VA, ROW) do { const float* mp_ = MOD + (size_t)mod_index(ROW) * MODW; \
        _Pragma("unroll") for (int j = 0; j < 8; ++j) { const int c = 4 * lane + 256 * j; \
            st_f16x4(XH + (size_t)(ROW) * D + c, VA[j]); \
            st_bf16x4(H + (size_t)(ROW) * D + c, VA[j] * (*(const f32x4*)(mp_ + D + c) + 1.0f) + *(const f32x4*)(mp_ + c)); } } while (0)
        int row = gw;
        if (row < NROWS) G1_LOAD(va, row);
        for (; row < NROWS; row += 2 * NGW) {
            if (row + NGW < NROWS) G1_LOAD(vb, row + NGW);
            SBAR();
            G1_STORE(va, row);
            if (row + NGW < NROWS) {
                if (row + 2 * NGW < NROWS) G1_LOAD(va, row + 2 * NGW);
                SBAR();
                G1_STORE(vb, row + NGW);
            }
        }
#undef G1_SRC
#undef G1_LOAD
#undef G1_STORE
    }
    PH_END

    for (int l = 0; l < DEPTH; ++l) {
        const bool last = (l == DEPTH - 1);
        const int nMfull = last ? 128 : 132;
        lcur = l;

        PH_BEGIN(2)
        for (int rep_ = 0; rep_ < NREP(0); ++rep_) { pg8::Gemm gm{H, wl + W_IN, D, D}; pg8::TileOrder S; S.init(132, INWP / 256, G, bid, -1);
          pg8::EpiProj E{PROJ, RS, thc, ths, tmc, tms};
          pg8::gemm_phase<pg8::EpiProj, pg8::TileOrder>(ldsl, gm, S, E); }
        PH_END

        PH_BEGIN(3)
        if (SUB(0)) for (int rep_ = 0; rep_ < NREP(1); ++rep_) { pg8::Gemm gm{PROJ + 3328, wl + W_UQ, INW, 512}; pg8::TileOrder S; S.init(132, QUPWP / 256, G, bid, -1);
          pg8::EpiQup E{QUP, RS, tmc, tms};
          pg8::gemm_phase<pg8::EpiQup, pg8::TileOrder>(ldsl, gm, S, E); }
        if (SUB(1)) for (int rep_ = 0; rep_ < NREP(2); ++rep_) { pg8::Gemm gm{PROJ + 3840, wl + W_UKV, INW, 256}; pg8::TileOrder S; S.init(132, KVUPW / 256, G, (G == 256) ? ((bid + 104) & 255) : bid, -1);
          pg8::EpiKvup E{KVUP, RS};
          pg8::gemm_phase<pg8::EpiKvup, pg8::TileOrder>(ldsl, gm, S, E); }
        if (SUB(2)) for (int rep_ = 0; rep_ < NREP(3); ++rep_) for (int u = (G == 256) ? ((bid + 80) & 255) : bid; u < NB * 4 * 33; u += G) {
            const int n = u % 33, h = (u / 33) & 3, bb = u / 132;
            const float lgf2 = log2_sigmoid(SM[SM_DECF + l * 4 + h]), lgb2 = log2_sigmoid(SM[SM_DECB + l * 4 + h]);
            ret_kv_unit(PROJ, KVS, bb, h, n, lgf2, lgb2, lds);
        }
        PH_END

        PH_BEGIN(4)
        if (SUB(3)) for (int rep_ = 0; rep_ < NREP(4); ++rep_) ret_scan(KVS, SIN, SM + SM_DECF + l * 4, SM + SM_DECB + l * 4, gtid, gthreads);
        if (SUB(4)) for (int rep_ = 0; rep_ < NREP(5); ++rep_) {
            const int nun = last ? 768 : 792;
            for (int u = bid; u < nun; u += G) {
                AttnArgs a;
                int bb, h, qrow;
                if (u < 768) { const int rnd = u / G, w_ = u % G; const int bh = (G == 256) ? (rnd * 8 + (w_ & 7)) : (u >> 5); const int qb = (G == 256) ? (w_ >> 3) : (u & 31); h = bh % 6; bb = bh / 6; qrow = bb * SEQ + qb * 256; a.nt = 132; a.seg0_tiles = 128; a.seg0_row = bb * SEQ; a.seg1_row = NLAT + bb * CTXL; }
                else { const int v = u - 768; h = v % 6; bb = v / 6; qrow = NLAT + bb * CTXL; a.nt = 4; a.seg0_tiles = 4; a.seg0_row = NLAT + bb * CTXL; a.seg1_row = a.seg0_row; }
                a.Q = QUP + (size_t)qrow * QUPW + h * 192; a.ldq = QUPW;
                a.K = KVUP + h * 256; a.ldk = KVUPW; a.KR = PROJ + 4096; a.ldkr = INW; a.V = KVUP + h * 256 + 128; a.ldv = KVUPW;
                a.O = Y + (size_t)qrow * D + 1280 + h * 128; a.ldo = D;
                a.qpos0 = 0; a.masked = 0; a.sink_l2 = 0.f; a.has_sink = 0; a.C = 1.0f;
                attn_body<192>(a, lds);
            }
        }
        if (SUB(5)) for (int rep_ = 0; rep_ < NREP(6); ++rep_) {
            const int nun = last ? 768 : 792;
            for (int u = bid; u < nun; u += G) {
                AttnArgs a;
                int bb, h, qrow;
                if (u < 768) { const int rnd = u / G, w_ = u % G; const int bh = (G == 256) ? (rnd * 8 + (w_ & 7)) : (u >> 5); const int qb = (G == 256) ? (w_ >> 3) : (u & 31); h = bh % 6; bb = bh / 6; qrow = bb * SEQ + qb * 256; a.nt = 12; a.seg0_tiles = 4; a.seg0_row = NLAT + bb * CTXL; a.seg1_row = bb * SEQ + qb * 256 - 128; a.qpos0 = qb * 256; a.masked = 1; }
                else { const int v = u - 768; h = v % 6; bb = v / 6; qrow = NLAT + bb * CTXL; a.nt = 4; a.seg0_tiles = 4; a.seg0_row = NLAT + bb * CTXL; a.seg1_row = a.seg0_row; a.qpos0 = 0; a.masked = 0; }
                const int kvh = h / 3;
                a.Q = PROJ + (size_t)qrow * INW + 2048 + h * 128; a.ldq = INW;
                a.K = PROJ + 2816 + kvh * 128; a.ldk = INW; a.KR = a.K; a.ldkr = INW; a.V = PROJ + 3072 + kvh * 128; a.ldv = INW;
                a.O = Y + (size_t)qrow * D + 512 + h * 128; a.ldo = D;
                a.sink_l2 = SM[SM_SINK + l * 6 + h] * LOG2E; a.has_sink = 1; a.C = 1.0f;
                attn_body<128>(a, lds);
            }
        }
        PH_END

        PH_BEGIN(5)
        for (int rep_ = 0; rep_ < NREP(7); ++rep_) for (int u = bid; u < NB * 4 * 33; u += G) {
            const int n = u % 33, h = (u / 33) & 3, bb = u / 132;
            if (last && n == 32) continue;
            const float lgf2 = log2_sigmoid(SM[SM_DECF + l * 4 + h]), lgb2 = log2_sigmoid(SM[SM_DECB + l * 4 + h]);
            ret_out_unit(PROJ, SIN, Y, bb, h, n, lgf2, lgb2, lds);
        }
        PH_END

        PH_BEGIN(6)
        for (int rep_ = 0; rep_ < NREP(10); ++rep_) { pg8::Gemm gm{Y, wl + W_O, D, D}; pg8::TileOrder S; S.init(nMfull, D / 256, G, bid, -1);
          pg8::EpiMix E{MIX, -1, rep_ + 1 < NREP(10)};
          pg8::gemm_phase<pg8::EpiMix, pg8::TileOrder>(ldsl, gm, S, E); }
        PH_END

        PH_BEGIN(7)
        ln_phase(XH, MIX, (float*)nullptr, XH, H, SM + SM_LN1G + l * D, SM + SM_LN1B + l * D, modl + 2 * D, modl + 4 * D, modl + 3 * D, last ? NLAT : NROWS, bid, G, lds);
        PH_END

#define FFN_UP(cc, nMc, skn, ski) for (int rep_ = 0; rep_ < NREP(8); ++rep_) { pg8::Gemm gm{H, wl + W_UP, D, D}; pg8::TileOrder S; S.init(nMc, DFF2 / 256, G, bid, cc, skn, ski); \
              pg8::EpiUpConv E{cc ? ACT1 : ACT0, SB, SM + SM_CONVW + (size_t)l * 3 * DFF, SM + SM_CONVB + (size_t)l * DFF, cc}; pg8::gemm_phase<pg8::EpiUpConv, pg8::TileOrder>(ldsl, gm, S, E); }
#define FFN_DOWN(cc, nMc) for (int rep_ = 0; rep_ < NREP(11); ++rep_) { pg8::Gemm gm{cc ? ACT1 : ACT0, wl + W_DN, DFF, DFF}; pg8::TileOrder S; S.init(nMc, D / 256, G, bid, -1); \
              pg8::EpiMix E{MIX, cc, rep_ + 1 < NREP(11)}; pg8::gemm_phase<pg8::EpiMix, pg8::TileOrder>(ldsl, gm, S, E); }
#define FFN_FIX(ACTc, nrows) { \
                const float* cw = SM + SM_CONVW + (size_t)l * 3 * DFF; \
                const int ngr = (nrows) / 64; \
                for (int it = gtid; it < 2 * ngr * (DFF / 4); it += gthreads) { \
                    const int f = (it % (DFF / 4)) * 4, gk = it / (DFF / 4), kind = gk / ngr, gi = gk % ngr; \
                    const int rg = gi * 64, smask = rg < FCH_LAT ? (SEQ - 1) : (CTXL - 1); \
                    const bool edge = kind ? (((rg + 63) & smask) == smask) : ((rg & smask) == 0); \
                    if (edge) continue; \
                    const float* sp = SB + ((size_t)(kind * NGRP + gi) * 3) * DFF + f; \
                    const float* np_ = SB + ((size_t)((1 - kind) * NGRP + (kind ? gi + 1 : gi - 1)) * 3 + 2) * DFF + f; \
                    const f32x4 z = *(const f32x4*)sp + *(const f32x4*)(cw + (kind ? 2 * DFF : 0) + f) * *(const f32x4*)np_; const f32x4 uu = *(const f32x4*)(sp + DFF); \
                    u32x2 ow; ow[0] = cvtpk(silu_f(z[0]) * uu[0], silu_f(z[1]) * uu[1]); ow[1] = cvtpk(silu_f(z[2]) * uu[2], silu_f(z[3]) * uu[3]); \
                    *(u32x2*)((ACTc) + (size_t)(rg + (kind ? 63 : 0)) * DFF + f) = ow; } }
        {
            const int nM0 = last ? 64 : 68, rows0 = last ? FCH_LAT : FCH_ROWS;
            const int skn = last ? 0 : 32;
            PH_BEGIN(8)
            FFN_UP(0, nM0, 0, 0)
            PH_END
            PH_BEGIN(9)
            FFN_FIX(ACT0, rows0)
            PH_END
            PH_BEGIN(10)
            FFN_DOWN(0, nM0)
            FFN_UP(1, 64, skn, 8)
            PH_END
            PH_BEGIN(11)
            FFN_FIX(ACT1, FCH_LAT)
            PH_END
            PH_BEGIN(12)
            FFN_DOWN(1, 64)
            PH_END
        }
#undef FFN_UP
#undef FFN_DOWN
#undef FFN_FIX

        PH_BEGIN(13)
        { const float* modn = MOD + (size_t)(last ? l : l + 1) * 5 * MODW;
          ln_phase(XH, MIX, last ? p.out : (float*)nullptr, XH, last ? (bf16_t*)nullptr : H, SM + SM_LN2G + l * D, SM + SM_LN2B + l * D, modl + 5 * D, modn + D, modn, last ? NLAT : NROWS, bid, G, lds); }
        PH_END
    }
#undef PH_BEGIN
#undef PH_END
}

constexpr int N_PHASES = 2 + DEPTH * 12;

extern "C" void kernel_launch(void* const* d_in, const int* in_sizes, int n_in, void* d_out, int out_size, void* d_ws, size_t ws_size, hipStream_t stream) {
    static int grid = 0;
    if (grid == 0) {
        if (n_in != 23 || in_sizes[0] != NLAT * D || out_size != NLAT * D || ws_size < WS_END) {
            fprintf(stderr, "kernel_launch: unexpected shapes: n_in %d in0 %d out %d ws %zu (need %zu)\n", n_in, n_in > 0 ? in_sizes[0] : -1, out_size, ws_size, (size_t)WS_END); grid = -1; return; }
        int dev = 0, cus = 0, per_cu = 0;
        if (hipGetDevice(&dev) != hipSuccess || hipDeviceGetAttribute(&cus, hipDeviceAttributeMultiprocessorCount, dev) != hipSuccess) { fprintf(stderr, "kernel_launch: device query failed\n"); grid = -1; return; }
        if (hipFuncSetAttribute((const void*)fwd_kernel, hipFuncAttributeMaxDynamicSharedMemorySize, LDS_BYTES) != hipSuccess) { fprintf(stderr, "kernel_launch: hipFuncSetAttribute failed\n"); grid = -1; return; }
        if (hipOccupancyMaxActiveBlocksPerMultiprocessor(&per_cu, (const void*)fwd_kernel, 512, LDS_BYTES) != hipSuccess || per_cu < 1) {
            fprintf(stderr, "kernel_launch: occupancy query reports %d workgroups per CU\n", per_cu); (void)hipGetLastError(); grid = -1; return; }
        grid = cus;
    }
    if (grid < 0) return;
    if (hipMemsetAsync((char*)d_ws + WS_CTL, 0, CTL_BYTES, stream) != hipSuccess) { fprintf(stderr, "kernel_launch: memset failed\n"); return; }
    Params p{};
    for (int i = 0; i < 23; ++i) p.in[i] = (const float*)d_in[i];
    p.out = (float*)d_out; p.ws = (unsigned char*)d_ws; p.pad = 0;
#if MK_ONE_LAUNCH
    p.ph_lo = 0; p.ph_hi = N_PHASES; p.bar_region = 0;
    hipLaunchKernelGGL(fwd_kernel, dim3(grid), dim3(512), LDS_BYTES, stream, p);
#else
    for (int g = 0; g < N_PHASES; ++g) { p.ph_lo = g; p.ph_hi = g + 1; p.bar_region = 0;
        hipLaunchKernelGGL(fwd_kernel, dim3(grid), dim3(512), LDS_BYTES, stream, p); }
#endif
    const hipError_t le = hipPeekAtLastError();
    if (le != hipSuccess) fprintf(stderr, "kernel_launch: launch failed: %s\n", hipGetErrorName(le));
}
```

```cpp
#include <hip/hip_runtime.h>
#include <cstdio>
#include <cstdint>

#define LAS __attribute__((address_space(3)))
typedef unsigned short bf16_t;
typedef short bf16x8 __attribute__((ext_vector_type(8)));
typedef short s16x4 __attribute__((ext_vector_type(4)));
typedef float f32x4 __attribute__((ext_vector_type(4)));
typedef float f32x16 __attribute__((ext_vector_type(16)));
typedef unsigned u32x4 __attribute__((ext_vector_type(4)));
typedef unsigned u32x2 __attribute__((ext_vector_type(2)));

#ifndef MK_ONE_LAUNCH
#define MK_ONE_LAUNCH 1
#endif

constexpr int D = 2048, NB = 4, SEQ = 8192, DEPTH = 4, CTXL = 256;
constexpr int NLAT = NB * SEQ, NCTX = NB * CTXL, NROWS = NLAT + NCTX;
constexpr int INW = 4160, INWP = 4352, DFF = 5632, DFF2 = 11264;
constexpr int QUPW = 1152, QUPWP = 1280, KVUPW = 1536;
constexpr int NMOD = 6, MODW = NMOD * D;
constexpr float LN_EPS = 1e-5f, RMS_EPS = 1e-6f;
constexpr float ALPHA = 1.6817928305074292f;
constexpr float KSCALE = 0.08838834764831845f;
constexpr float MLA_QSCALE = 0.07216878364870323f * 1.4426950408889634f;
constexpr float LOG2E = 1.4426950408889634f;

constexpr size_t MiB = 1u << 20;
constexpr size_t WS_CTL = 0, CTL_BYTES = 1 * MiB;
constexpr size_t WS_MOD = 1 * MiB;
constexpr size_t WS_ROPE = 2 * MiB;
constexpr size_t WS_SM = 2 * MiB + 65536;
constexpr int SM_DECF = 0, SM_DECB = 16, SM_SINK = 32, SM_LN1G = 64, SM_LN1B = SM_LN1G + DEPTH * D, SM_LN2G = SM_LN1B + DEPTH * D, SM_LN2B = SM_LN2G + DEPTH * D,
              SM_CONVW = SM_LN2B + DEPTH * D, SM_CONVB = SM_CONVW + DEPTH * 3 * DFF, SM_END = SM_CONVB + DEPTH * DFF;
static_assert(WS_SM + (size_t)SM_END * 4 <= 3 * MiB, "small vectors");
constexpr size_t WS_RS = 3 * MiB;
constexpr size_t WS_W = 5 * MiB;
constexpr size_t W_IN = 0, W_UQ = W_IN + (size_t)INWP * D, W_UKV = W_UQ + (size_t)QUPWP * 512, W_O = W_UKV + (size_t)KVUPW * 256,
                 W_UP = W_O + (size_t)D * D, W_DN = W_UP + (size_t)DFF2 * D, W_LAYER = W_DN + (size_t)D * DFF;
constexpr size_t WS_X = WS_W + W_LAYER * 2 * DEPTH;
constexpr size_t WS_H = WS_X + (size_t)NROWS * D * 4;
constexpr size_t WS_Y = WS_H + (size_t)NROWS * D * 2;
constexpr size_t WS_PROJ = WS_Y + (size_t)NROWS * D * 2;
constexpr size_t WS_QUP = WS_PROJ + (size_t)NROWS * INW * 2;
constexpr size_t WS_KVUP = WS_QUP + (size_t)NROWS * QUPW * 2;
constexpr size_t WS_KVS = WS_KVUP + (size_t)NROWS * KVUPW * 2;
constexpr size_t WS_SIN = WS_KVS + (size_t)NB * 4 * 2 * 33 * 16384 * 4;
constexpr size_t WS_END = WS_SIN + (size_t)NB * 4 * 2 * 33 * 16384 * 2;
constexpr int FCH_LAT = 64 * 256, FCH_ROWS = FCH_LAT + NCTX;
constexpr size_t WS_ACT0 = WS_Y;
constexpr size_t WS_ACT1 = WS_ACT0 + (size_t)FCH_ROWS * DFF * 2;
constexpr int NGRP = FCH_ROWS / 64;
constexpr size_t WS_SB = WS_ACT1 + (size_t)FCH_LAT * DFF * 2;
static_assert(WS_SB + (size_t)2 * NGRP * 3 * DFF * 4 <= WS_QUP, "FFN overlay");
constexpr size_t WS_MIX = WS_QUP;
static_assert(WS_MIX >= WS_QUP && WS_MIX + (size_t)NROWS * D * 2 <= WS_END, "FFN overlay");
static_assert(WS_W % 256 == 0 && W_LAYER % 128 == 0 && WS_X % 256 == 0, "align");

constexpr int LDS_BYTES = 131072 + 512;

#define XB_TMO      128
#define XB_XCNT(j)  (256  + 64 * (j))
#define XB_XSUB(j)  (1280 + 64 * (j))
#define XB_XGEN(j)  (2304 + 64 * (j))
#define XB_TOP      3328
#define XB_TOPGEN   3392
#define XCD_BAR_WORDS 3456
#define XB_SPIN_CAP (1u << 20)

__device__ __forceinline__ unsigned xb_ld(unsigned* p)              { return __hip_atomic_load(p, __ATOMIC_RELAXED, __HIP_MEMORY_SCOPE_AGENT); }
__device__ __forceinline__ unsigned xb_add(unsigned* p, unsigned v) { return __hip_atomic_fetch_add(p, v, __ATOMIC_RELAXED, __HIP_MEMORY_SCOPE_AGENT); }
__device__ __forceinline__ unsigned xb_xcc_id() { return (unsigned)__builtin_amdgcn_s_getreg((3 << 11) | 20) & 0xFu; }
#define XB_SPIN(cond, bar) do { unsigned _sp = 0; while (cond) { __builtin_amdgcn_s_sleep(1); \
    if ((++_sp & 255u) == 0u) { if (xb_ld(&(bar)[XB_TMO])) break; if (_sp > XB_SPIN_CAP) { atomicAdd(&(bar)[XB_TMO], 1u); break; } } } } while (0)

struct XcdBarrier { unsigned* bar; unsigned x; volatile LAS unsigned* st; };

__device__ __forceinline__ XcdBarrier xcd_barrier_post(unsigned* bar, volatile LAS unsigned* st) {
    XcdBarrier b; b.bar = bar; b.x = xb_xcc_id(); b.st = st;
    if (threadIdx.x == 0) (void)xb_add(&bar[XB_XCNT(b.x)], 1u);
    return b;
}
__device__ __forceinline__ void xcd_barrier_complete(unsigned* bar, unsigned x, unsigned& nloc, unsigned& nx) {
    const unsigned G = gridDim.x * gridDim.y * gridDim.z;
    unsigned sum, cnt, mine, sp = 0u;
    for (;;) {
        sum = 0u; cnt = 0u; mine = 0u;
#pragma unroll
        for (unsigned j = 0; j < 16; ++j) { const unsigned c = xb_ld(&bar[XB_XCNT(j)]); sum += c; cnt += (c > 0u) ? 1u : 0u; mine = (j == x) ? c : mine; }
        if (sum == G) break;
        __builtin_amdgcn_s_sleep(1);
        if ((++sp & 255u) == 0u) { if (xb_ld(&bar[XB_TMO])) break; if (sp > XB_SPIN_CAP) { atomicAdd(&bar[XB_TMO], 1u); break; } }
    }
    nloc = mine > 0u ? mine : 1u; nx = cnt > 0u ? cnt : 1u;
}
__device__ __forceinline__ void xcd_barrier(const XcdBarrier& b) {
    asm volatile("s_waitcnt vmcnt(0)" ::: "memory");
    __syncthreads();
    if (threadIdx.x == 0) {
        unsigned* bar = b.bar;
        __builtin_amdgcn_s_waitcnt(0);
        unsigned nloc = b.st[0], nx = b.st[1];
        if (nloc == 0u) { xcd_barrier_complete(bar, b.x, nloc, nx); b.st[0] = nloc; b.st[1] = nx; }
        const unsigned old = xb_add(&bar[XB_XSUB(b.x)], 1u);
        const unsigned gen = old / nloc;
        if (old + 1u == (gen + 1u) * nloc) {
            __builtin_amdgcn_fence(__ATOMIC_RELEASE, "agent");
            asm volatile("s_waitcnt vmcnt(0)" ::: "memory");
            const unsigned og = xb_add(&bar[XB_TOP], 1u);
            const unsigned tg = og / nx;
            if (og + 1u == (tg + 1u) * nx) xb_add(&bar[XB_TOPGEN], 1u);
            else XB_SPIN(xb_ld(&bar[XB_TOPGEN]) == tg, bar);
            __builtin_amdgcn_fence(__ATOMIC_ACQUIRE, "agent");
            xb_add(&bar[XB_XGEN(b.x)], 1u);
            asm volatile("s_waitcnt vmcnt(0)" ::: "memory");
        } else {
            XB_SPIN(xb_ld(&bar[XB_XGEN(b.x)]) == gen, bar);
            __builtin_amdgcn_fence(__ATOMIC_ACQUIRE, "agent");
            asm volatile("s_waitcnt vmcnt(0)" ::: "memory");
        }
    }
    __syncthreads();
}

__device__ __forceinline__ unsigned cvtpk(float lo, float hi) { unsigned r; asm volatile("v_cvt_pk_bf16_f32 %0, %1, %2" : "=v"(r) : "v"(lo), "v"(hi)); return r; }
__device__ __forceinline__ float bf2f(unsigned short b) { return __uint_as_float(((unsigned)b) << 16); }
__device__ __forceinline__ float bflo(unsigned w) { return __uint_as_float(w << 16); }
__device__ __forceinline__ float bfhi(unsigned w) { return __uint_as_float(w & 0xffff0000u); }
__device__ __forceinline__ void st_bf16x4(bf16_t* p, f32x4 v) { u32x2 w; w.x = cvtpk(v[0], v[1]); w.y = cvtpk(v[2], v[3]); *(u32x2*)p = w; }
typedef _Float16 f16x4 __attribute__((ext_vector_type(4)));
__device__ __forceinline__ void st_f16x4(bf16_t* p, f32x4 v) { *(f16x4*)p = __builtin_convertvector(v, f16x4); }
__device__ __forceinline__ f32x4 cvt_f16x4(u32x2 w) { return __builtin_convertvector(__builtin_bit_cast(f16x4, w), f32x4); }
__device__ __forceinline__ float silu_f(float x) { return x * __builtin_amdgcn_rcpf(1.0f + __builtin_amdgcn_exp2f(-1.4426950408889634f * x)); }
__device__ __forceinline__ float wave_sum(float v) {
#pragma unroll
    for (int o = 1; o < 64; o <<= 1) v += __shfl_xor(v, o);
    return v;
}
__device__ __forceinline__ int otid() { int t = threadIdx.x; asm volatile("" : "+v"(t)); return t; }
__device__ __forceinline__ int mod_index(int row) { return row < NLAT ? (row >> 13) : 4; }

namespace pg8 {
constexpr int BM = 256, BK = 64, HALF = 128, HTB = HALF * BK * 2, STAGE_BYTES = 8 * HTB, NXCD = 8, WGM = 8;
__host__ __device__ __forceinline__ int lds_byte(int r, int c) { const int st = (r >> 4) * 2 + (c >> 5), rr = r & 15, cc = c & 31, ob = rr * 64 + cc * 2; return st * 1024 + (ob ^ (((ob >> 9) & 1) << 5)); }
__host__ __device__ __forceinline__ void stage_rc(int b, int& R, int& C) { const int st = b / 1024, sb = b % 1024, swz = sb ^ (((sb >> 9) & 1) << 5); R = (st >> 1) * 16 + swz / 64; C = (st & 1) * 32 + (swz % 64) / 2; }

struct Unit { int pm, pn; };
struct Gemm { const bf16_t* A; const bf16_t* Bt; int lda, K; };

struct TileOrder {
    int nM, nN, nwg, G, c, chunk, skew_n, skew_i;
    __device__ __forceinline__ void init(int nM_, int nN_, int G_, int c_, int chunk_, int skew_n_ = 0, int skew_i_ = 0) { nM = nM_; nN = nN_; nwg = nM * nN; G = G_; c = c_; chunk = chunk_; skew_n = skew_n_; skew_i = skew_i_; }
    __device__ __forceinline__ bool next(int i, Unit& u) const {
        long L;
        if (skew_n == 0 || i < skew_i) L = (long)i * G + c;
        else { if (c < skew_n) return false; L = (long)skew_i * G + (long)(i - skew_i) * (G - skew_n) + (c - skew_n); }
        if (L >= nwg) return false;
        int wgid = (int)L; { const int q = nwg / NXCD, r = nwg % NXCD, xcd = wgid % NXCD, off = wgid / NXCD; wgid = (xcd < r ? xcd * (q + 1) : r * (q + 1) + (xcd - r) * q) + off; }
        const int nig = WGM * nN, gid = wgid / nig, fm = gid * WGM, gsz = (nM - fm) < WGM ? (nM - fm) : WGM;
        int pm = fm + ((wgid % nig) % gsz); u.pn = (wgid % nig) / gsz;
        if (chunk >= 0) pm = (pm < 64) ? 64 * chunk + pm : 128 + (pm - 64);
        u.pm = pm; return true;
    }
    __device__ __forceinline__ void a_ready(const Unit&) const {}
    __device__ __forceinline__ void done(const Unit&) const {}
};

template <class Epi, class Sched>
__device__ __forceinline__ void gemm_phase(LAS unsigned char* lds, const Gemm g, const Sched& S, const Epi& E) {
    const int tid = otid(), wid = __builtin_amdgcn_readfirstlane(tid >> 6), lane = tid & 63, wr = wid >> 2, wc = wid & 3, fr = lane & 15, fq = lane >> 4;
    const int K = g.K, nt = K / BK, lda = g.lda;
    unsigned voffA[2], voffB[2];
#pragma unroll
    for (int i = 0; i < 2; ++i) { int R, C; stage_rc(tid * 16 + i * 8192, R, C);
        voffA[i] = (unsigned)(R * lda + C) * 2u; voffB[i] = (unsigned)(R * K + C) * 2u; }
    const size_t kstep = (size_t)(BK * 2);
    const size_t hstepA = (size_t)HALF * lda * 2, hstepB = (size_t)HALF * K * 2;
    const size_t tstepA = 2 * hstepA, tstepB = 2 * hstepB;
    const unsigned ldsw = (unsigned)wid * 1024u;
    const int aoff = lds_byte(wr * 64 + fr, fq * 8), boff = lds_byte(wc * 32 + fr, fq * 8);
#define PG8_SA(b, h) (((b) * 2 + (h)) * HTB)
#define PG8_SB(b, h) ((4 + (b) * 2 + (h)) * HTB)
#define PG8_STAGE(bufoff, gbase, voff) do { const char* gb_ = (const char*)(gbase); asm volatile("" : "+s"(gb_));        \
        _Pragma("unroll") for (int _i = 0; _i < 2; ++_i) \
        __builtin_amdgcn_global_load_lds((const unsigned*)(gb_ + (voff)[_i]), (LAS unsigned*)(lds + (bufoff) + ldsw + _i * 8192), 16, 0, 0); } while (0)
#define PG8_LDA(dst, b, h) do { _Pragma("unroll") for (int m = 0; m < 4; ++m) _Pragma("unroll") for (int k = 0; k < 2; ++k) dst[m][k] = *(const LAS bf16x8*)(lds + PG8_SA(b, h) + aoff + m * 2048 + k * 1024); } while (0)
#define PG8_LDB(dst, b, h) do { _Pragma("unroll") for (int n = 0; n < 2; ++n) _Pragma("unroll") for (int k = 0; k < 2; ++k) dst[n][k] = *(const LAS bf16x8*)(lds + PG8_SB(b, h) + boff + n * 2048 + k * 1024); } while (0)
#define PG8_MMA(ai, bj, At, Bt) do { __builtin_amdgcn_s_setprio(1); _Pragma("unroll") for (int m = 0; m < 4; ++m) _Pragma("unroll") for (int n = 0; n < 2; ++n) _Pragma("unroll") for (int k = 0; k < 2; ++k) \
        acc[ai][bj][m][n] = __builtin_amdgcn_mfma_f32_16x16x32_bf16(Bt[n][k], At[m][k], acc[ai][bj][m][n], 0, 0, 0); __builtin_amdgcn_s_setprio(0); } while (0)
#define PG8_WAIT_V(n) asm volatile("s_waitcnt vmcnt(" #n ")" ::: "memory")
#define PG8_WAIT_L(n) asm volatile("s_waitcnt lgkmcnt(" #n ")" ::: "memory")
#define PG8_BAR __builtin_amdgcn_s_barrier()
#define PG8_SCHED __builtin_amdgcn_sched_barrier(0)
    Unit cur, nxt; int ui = 0;
    if (!S.next(0, cur)) return;
    f32x4 acc[2][2][4][2];
#pragma unroll
    for (int a = 0; a < 2; ++a)
#pragma unroll
        for (int b = 0; b < 2; ++b)
#pragma unroll
            for (int m = 0; m < 4; ++m)
#pragma unroll
                for (int n = 0; n < 2; ++n) acc[a][b][m][n] = (f32x4){0.f, 0.f, 0.f, 0.f};
    bf16x8 At[4][2], B0[2][2], B1[2][2];
    const char* cA = (const char*)g.A + (size_t)cur.pm * tstepA; const char* cB = (const char*)g.Bt + (size_t)cur.pn * tstepB;
    S.a_ready(cur);
    PG8_STAGE(PG8_SB(0, 0), cB, voffB); PG8_STAGE(PG8_SA(0, 0), cA, voffA); PG8_STAGE(PG8_SB(0, 1), cB + hstepB, voffB); PG8_STAGE(PG8_SA(0, 1), cA + hstepA, voffA);
    if (wr == 1) PG8_BAR;
    PG8_WAIT_V(4); PG8_BAR;
    PG8_STAGE(PG8_SB(1, 0), cB + kstep, voffB); PG8_STAGE(PG8_SA(1, 0), cA + kstep, voffA); PG8_STAGE(PG8_SB(1, 1), cB + hstepB + kstep, voffB);
    PG8_WAIT_V(6); PG8_BAR;
    for (;;) {
        const bool has_next = S.next(ui + 1, nxt);
        const char* nA = has_next ? (const char*)g.A + (size_t)nxt.pm * tstepA : cA; const char* nB = has_next ? (const char*)g.Bt + (size_t)nxt.pn * tstepB : cB;
#pragma nounroll
        for (int t = 0; t < nt; t += 2) {
            asm volatile("" : "+v"(voffA[0]), "+v"(voffA[1]), "+v"(voffB[0]), "+v"(voffB[1]));
            const bool last = (t == nt - 2);
            const char* a1 = cA + (size_t)(t + 1) * kstep;
            const char* a2 = last ? nA : cA + (size_t)(t + 2) * kstep; const char* b2 = last ? nB : cB + (size_t)(t + 2) * kstep;
            const char* a3 = a2 + kstep; const char* b3 = b2 + kstep;
            if (last && has_next) S.a_ready(nxt);
            PG8_LDB(B0, 0, 0); PG8_SCHED; PG8_LDA(At, 0, 0); PG8_STAGE(PG8_SA(1, 1), a1 + hstepA, voffA);
            PG8_WAIT_L(8); PG8_BAR; PG8_WAIT_L(0); PG8_MMA(0, 0, At, B0); PG8_BAR; PG8_SCHED;
            PG8_LDB(B1, 0, 1); PG8_STAGE(PG8_SB(0, 0), b2, voffB);
            PG8_BAR; PG8_WAIT_L(0); PG8_MMA(0, 1, At, B1); PG8_BAR;
            PG8_LDA(At, 0, 1); PG8_STAGE(PG8_SA(0, 0), a2, voffA);
            PG8_BAR; PG8_WAIT_L(0); PG8_MMA(1, 0, At, B0); PG8_BAR; PG8_SCHED;
            PG8_STAGE(PG8_SB(0, 1), b2 + hstepB, voffB);
            PG8_WAIT_V(6); PG8_BAR; PG8_MMA(1, 1, At, B1); PG8_BAR;
            PG8_LDB(B0, 1, 0); PG8_SCHED; PG8_LDA(At, 1, 0); PG8_STAGE(PG8_SA(0, 1), a2 + hstepA, voffA);
            PG8_WAIT_L(8); PG8_BAR; PG8_WAIT_L(0); PG8_MMA(0, 0, At, B0); PG8_BAR; PG8_SCHED;
            PG8_LDB(B1, 1, 1); PG8_STAGE(PG8_SB(1, 0), b3, voffB);
            PG8_BAR; PG8_WAIT_L(0); PG8_MMA(0, 1, At, B1); PG8_BAR;
            PG8_LDA(At, 1, 1); PG8_STAGE(PG8_SA(1, 0), a3, voffA);
            PG8_BAR; PG8_WAIT_L(0); PG8_MMA(1, 0, At, B0); PG8_BAR; PG8_SCHED;
            PG8_STAGE(PG8_SB(1, 1), b3 + hstepB, voffB);
            PG8_WAIT_V(6); PG8_BAR; PG8_MMA(1, 1, At, B1); PG8_BAR;
        }
        E(acc, cur, wr, wc, fr, fq); S.done(cur);
        if (!has_next) break;
#pragma unroll
        for (int a = 0; a < 2; ++a)
#pragma unroll
            for (int b = 0; b < 2; ++b)
#pragma unroll
                for (int m = 0; m < 4; ++m)
#pragma unroll
                    for (int n = 0; n < 2; ++n) acc[a][b][m][n] = (f32x4){0.f, 0.f, 0.f, 0.f};
        cur = nxt; cA = nA; cB = nB; ++ui;
    }
    PG8_WAIT_V(0);
    if (wr == 0) PG8_BAR;
    PG8_BAR;
#undef PG8_SA
#undef PG8_SB
#undef PG8_STAGE
#undef PG8_LDA
#undef PG8_LDB
#undef PG8_MMA
#undef PG8_WAIT_V
#undef PG8_WAIT_L
#undef PG8_BAR
#undef PG8_SCHED
}


struct EpiProj {
    bf16_t* P; float* RS; const float* thc; const float* ths; const float* tmc; const float* tms;
    __device__ __forceinline__ void operator()(const f32x4 (&acc)[2][2][4][2], const Unit& u, int wr, int wc, int fr, int fq) const {
        asm volatile("" : "+v"(fr), "+v"(fq));
        const int pn = u.pn; const bool lat = u.pm < 128;
        const int row0 = u.pm * BM + wr * 64 + fr;
        if (pn == 16) {
            if (wc < 2) {
#pragma unroll
                for (int ai = 0; ai < 2; ++ai)
#pragma unroll
                    for (int m = 0; m < 4; ++m) {
                        const int row = row0 + ai * HALF + m * 16; const f32x4 v0 = acc[ai][0][m][0], v1 = acc[ai][0][m][1]; f32x4 o0 = v0, o1 = v1;
                        if (lat) { const int pos = row & (SEQ - 1), tp = wc ? (pos & 63) : (pos >> 6);
                            const f32x4 c = *(const f32x4*)(tmc + tp * 16 + 4 * fq), s = *(const f32x4*)(tms + tp * 16 + 4 * fq);
                            o0 = v0 * c - v1 * s; o1 = v1 * c + v0 * s; }
                        bf16_t* rp = P + (size_t)row * INW + 4096 + 32 * wc + 4 * fq;
                        st_bf16x4(rp, o0); st_bf16x4(rp + 16, o1);
                        asm volatile("" ::: "memory");
                    }
            }
            return;
        }
        const bool roped = (pn < 4) || (pn >= 8 && pn < 12);
        if (roped) {
            const float sc = (pn == 2 || pn == 3) ? KSCALE : ((pn >= 8 && pn <= 10) ? KSCALE * LOG2E : 1.0f);
            const int colb = pn * BM + 128 * (wc >> 1) + 64 * (wc & 1) + 8 * fq;
#pragma unroll
            for (int ai = 0; ai < 2; ++ai)
#pragma unroll
                for (int m = 0; m < 4; ++m) {
                    const int row = row0 + ai * HALF + m * 16; const int pos = row & (SEQ - 1), tp = (wc & 1) ? (pos & 63) : (pos >> 6);
                    u32x4 w0, w1;
#pragma unroll
                    for (int n = 0; n < 2; ++n) {
                        f32x4 c = (f32x4){1.f, 1.f, 1.f, 1.f}, s = (f32x4){0.f, 0.f, 0.f, 0.f};
                        if (lat) { c = *(const f32x4*)(thc + tp * 32 + 8 * fq + 4 * n); s = *(const f32x4*)(ths + tp * 32 + 8 * fq + 4 * n); }
                        const f32x4 v0 = acc[ai][0][m][n] * sc, v1 = acc[ai][1][m][n] * sc;
                        const f32x4 o0 = v0 * c - v1 * s, o1 = v1 * c + v0 * s;
                        w0[2 * n] = cvtpk(o0[0], o0[1]); w0[2 * n + 1] = cvtpk(o0[2], o0[3]); w1[2 * n] = cvtpk(o1[0], o1[1]); w1[2 * n + 1] = cvtpk(o1[2], o1[3]);
                    }
                    bf16_t* rp = P + (size_t)row * INW + colb;
                    *(u32x4*)rp = w0; *(u32x4*)(rp + 32) = w1;
                    asm volatile("" ::: "memory");
                }
            return;
        }
#pragma unroll
        for (int ai = 0; ai < 2; ++ai)
#pragma unroll
            for (int m = 0; m < 4; ++m) {
                const int row = row0 + ai * HALF + m * 16; bf16_t* rp = P + (size_t)row * INW + pn * BM + wc * 32 + 8 * fq; float ss = 0.f;
#pragma unroll
                for (int bj = 0; bj < 2; ++bj) { const f32x4 v0 = acc[ai][bj][m][0], v1 = acc[ai][bj][m][1];
                    u32x4 w; w[0] = cvtpk(v0[0], v0[1]); w[1] = cvtpk(v0[2], v0[3]); w[2] = cvtpk(v1[0], v1[1]); w[3] = cvtpk(v1[2], v1[3]);
                    *(u32x4*)(rp + bj * HALF) = w;
                    ss += ((v0[0] * v0[0] + v0[1] * v0[1]) + (v0[2] * v0[2] + v0[3] * v0[3])) + ((v1[0] * v1[0] + v1[1] * v1[1]) + (v1[2] * v1[2] + v1[3] * v1[3])); }
                if (pn >= 13 && pn <= 15) { ss += __shfl_xor(ss, 16); ss += __shfl_xor(ss, 32); if (fq == 0) RS[(size_t)row * 12 + (pn - 13) * 4 + wc] = ss; }
            }
    }
};
struct EpiQup {
    bf16_t* Q; const float* RS; const float* tmc; const float* tms;
    __device__ __forceinline__ void operator()(const f32x4 (&acc)[2][2][4][2], const Unit& u, int wr, int wc, int fr, int fq) const {
        asm volatile("" : "+v"(fr), "+v"(fq));
        const int pn = u.pn; const bool lat = u.pm < 128; const int row0 = u.pm * BM + wr * 64 + fr;
#pragma unroll
        for (int ai = 0; ai < 2; ++ai)
#pragma unroll
            for (int m = 0; m < 4; ++m) {
                const int row = row0 + ai * HALF + m * 16; const f32x4 r0 = *(const f32x4*)(RS + (size_t)row * 12), r1 = *(const f32x4*)(RS + (size_t)row * 12 + 4);
                const float rs = MLA_QSCALE / sqrtf(((r0[0] + r0[1]) + (r0[2] + r0[3]) + (r1[0] + r1[1]) + (r1[2] + r1[3])) * (1.0f / 512.0f) + RMS_EPS);
                const int pos = row & (SEQ - 1), tp = (wc & 1) ? (pos & 63) : (pos >> 6);
                const f32x4 c = *(const f32x4*)(tmc + tp * 16 + 4 * fq), s = *(const f32x4*)(tms + tp * 16 + 4 * fq);
#pragma unroll
                for (int bj = 0; bj < 2; ++bj) {
                    const int colb = pn * BM + bj * HALF + wc * 32; if (colb >= QUPW) continue;
                    const int c64 = 4 * pn + 2 * bj + (wc >> 1);
                    const f32x4 v0 = acc[ai][bj][m][0] * rs, v1 = acc[ai][bj][m][1] * rs; f32x4 o0 = v0, o1 = v1;
                    if (lat && (c64 % 3) == 2) { o0 = v0 * c - v1 * s; o1 = v1 * c + v0 * s; }
                    bf16_t* rp = Q + (size_t)row * QUPW + colb + 4 * fq; st_bf16x4(rp, o0); st_bf16x4(rp + 16, o1);
                }
                asm volatile("" ::: "memory");
            }
    }
};
struct EpiKvup {
    bf16_t* KV; const float* RS;
    __device__ __forceinline__ void operator()(const f32x4 (&acc)[2][2][4][2], const Unit& u, int wr, int wc, int fr, int fq) const {
        asm volatile("" : "+v"(fr), "+v"(fq));
        const int row0 = u.pm * BM + wr * 64 + fr;
#pragma unroll
        for (int ai = 0; ai < 2; ++ai)
#pragma unroll
            for (int m = 0; m < 4; ++m) {
                const int row = row0 + ai * HALF + m * 16; const f32x4 r0 = *(const f32x4*)(RS + (size_t)row * 12 + 8);
                const float rs = 1.0f / sqrtf(((r0[0] + r0[1]) + (r0[2] + r0[3])) * (1.0f / 256.0f) + RMS_EPS);
                bf16_t* rp = KV + (size_t)row * KVUPW + u.pn * BM + wc * 32 + 8 * fq;
#pragma unroll
                for (int bj = 0; bj < 2; ++bj) { const f32x4 v0 = acc[ai][bj][m][0] * rs, v1 = acc[ai][bj][m][1] * rs;
                    u32x4 w; w[0] = cvtpk(v0[0], v0[1]); w[1] = cvtpk(v0[2], v0[3]); w[2] = cvtpk(v1[0], v1[1]); w[3] = cvtpk(v1[2], v1[3]);
                    *(u32x4*)(rp + bj * HALF) = w; }
                asm volatile("" ::: "memory");
            }
    }
};
struct EpiMix {
    bf16_t* MIX; int chunk; int dry;
    __device__ __forceinline__ void operator()(const f32x4 (&acc)[2][2][4][2], const Unit& u, int wr, int wc, int fr, int fq) const {
        asm volatile("" : "+v"(fr), "+v"(fq));
        if (dry) { float s = 0.f;
#pragma unroll
            for (int ai = 0; ai < 2; ++ai)
#pragma unroll
                for (int bj = 0; bj < 2; ++bj)
#pragma unroll
                    for (int m = 0; m < 4; ++m)
#pragma unroll
                        for (int n = 0; n < 2; ++n) s += (acc[ai][bj][m][n][0] + acc[ai][bj][m][n][1]) + (acc[ai][bj][m][n][2] + acc[ai][bj][m][n][3]);
            if (s == 123456.789f) MIX[0] = (bf16_t)1; return; }
        const int pmg = chunk < 0 ? u.pm : (u.pm < 64 ? 64 * chunk + u.pm : 128 + (u.pm - 64));
        const int row0 = pmg * BM + wr * 64 + fr;
#pragma unroll
        for (int ai = 0; ai < 2; ++ai)
#pragma unroll
            for (int m = 0; m < 4; ++m) { bf16_t* rp = MIX + (size_t)(row0 + ai * HALF + m * 16) * D + u.pn * BM + wc * 32 + 8 * fq;
#pragma unroll
                for (int bj = 0; bj < 2; ++bj) { const f32x4 v0 = acc[ai][bj][m][0], v1 = acc[ai][bj][m][1];
                    u32x4 w; w[0] = cvtpk(v0[0], v0[1]); w[1] = cvtpk(v0[2], v0[3]); w[2] = cvtpk(v1[0], v1[1]); w[3] = cvtpk(v1[2], v1[3]);
                    *(u32x4*)(rp + bj * HALF) = w; } }
    }
};
struct EpiUpConv {
    bf16_t* ACTc; float* SB; const float* cw; const float* cb; int chunk;
    static __device__ __forceinline__ float lane_prev(float x) { return __builtin_bit_cast(float, __builtin_amdgcn_update_dpp(0, __builtin_bit_cast(int, x), 0x121, 0xf, 0xf, true)); }
    static __device__ __forceinline__ float lane_next(float x) { return __builtin_bit_cast(float, __builtin_amdgcn_update_dpp(0, __builtin_bit_cast(int, x), 0x12f, 0xf, 0xf, true)); }
    static __device__ __forceinline__ void taps2(const int MM, float& z0, float& z1, float gc0, float gc1, float gp0, float gp1, float gn0, float gn1, float w1a, float w1b, float ba, float bb_,
                                                 float w0ma, float w0mb, float w2ma, float w2mb, float w0ea, float w0eb, float w2ea, float w2eb) {
#define TAP_HEAD "v_fma_f32 %0, %2, %8, %10\n\tv_fma_f32 %1, %3, %9, %11\n\t" \
                 "v_fmac_f32_dpp %0, %2, %12 row_ror:1 row_mask:0xf bank_mask:0xf\n\tv_fmac_f32_dpp %1, %3, %13 row_ror:1 row_mask:0xf bank_mask:0xf\n\t" \
                 "v_fmac_f32_dpp %0, %2, %14 row_ror:15 row_mask:0xf bank_mask:0xf\n\tv_fmac_f32_dpp %1, %3, %15 row_ror:15 row_mask:0xf bank_mask:0xf"
#define TAP_PREV "\n\tv_fmac_f32_dpp %0, %4, %16 row_ror:1 row_mask:0xf bank_mask:0xf\n\tv_fmac_f32_dpp %1, %5, %17 row_ror:1 row_mask:0xf bank_mask:0xf"
#define TAP_NEXT "\n\tv_fmac_f32_dpp %0, %6, %18 row_ror:15 row_mask:0xf bank_mask:0xf\n\tv_fmac_f32_dpp %1, %7, %19 row_ror:15 row_mask:0xf bank_mask:0xf"
#define TAP_OPS : "=&v"(z0), "=&v"(z1) : "v"(gc0), "v"(gc1), "v"(gp0), "v"(gp1), "v"(gn0), "v"(gn1), "v"(w1a), "v"(w1b), "v"(ba), "v"(bb_), "v"(w0ma), "v"(w0mb), "v"(w2ma), "v"(w2mb), "v"(w0ea), "v"(w0eb), "v"(w2ea), "v"(w2eb)
        if (MM == 0) asm(TAP_HEAD TAP_NEXT TAP_OPS);
        else if (MM == 3) asm(TAP_HEAD TAP_PREV TAP_OPS);
        else asm(TAP_HEAD TAP_PREV TAP_NEXT TAP_OPS);
#undef TAP_HEAD
#undef TAP_PREV
#undef TAP_NEXT
#undef TAP_OPS
    }
    __device__ __forceinline__ void operator()(const f32x4 (&acc)[2][2][4][2], const Unit& u, int wr, int wc, int fr, int fq) const {
        asm volatile("" : "+v"(fr), "+v"(fq));
        const int lpm = u.pm < 128 ? u.pm - 64 * chunk : 64 + (u.pm - 128);
        const int f0 = u.pn * 128 + wc * 32 + 8 * fq;
        constexpr float NL2E = -1.4426950408889634f;
        f32x4 w0m[2], w0e[2], w2m[2], w2e[2], w1s[2], bbs[2];
#pragma unroll
        for (int n = 0; n < 2; ++n) {
            const f32x4 a0 = *(const f32x4*)(cw + f0 + 4 * n) * NL2E, a2 = *(const f32x4*)(cw + 2 * DFF + f0 + 4 * n) * NL2E; const f32x4 zero = {0.f, 0.f, 0.f, 0.f};
            w1s[n] = *(const f32x4*)(cw + DFF + f0 + 4 * n) * NL2E; bbs[n] = *(const f32x4*)(cb + f0 + 4 * n) * NL2E;
            w0m[n] = fr > 0 ? a0 : zero; w0e[n] = fr == 0 ? a0 : zero; w2m[n] = fr < 15 ? a2 : zero; w2e[n] = fr == 15 ? a2 : zero;
        }
#pragma unroll
        for (int ai = 0; ai < 2; ++ai) {
            const int rg = lpm * BM + ai * HALF + wr * 64;
            const int smask = rg < FCH_LAT ? (SEQ - 1) : (CTXL - 1);
            const bool seq_first = (rg & smask) == 0, seq_last = ((rg + 63) & smask) == smask;
#pragma unroll
            for (int m = 0; m < 4; ++m) {
                u32x4 ow;
#pragma unroll
                for (int n = 0; n < 2; ++n) {
                    const f32x4 gc = acc[ai][1][m][n], uu = acc[ai][0][m][n];
                    const f32x4 gpf = acc[ai][1][m > 0 ? m - 1 : 0][n], gnf = acc[ai][1][m < 3 ? m + 1 : 3][n];
                    f32x4 zs;
#pragma unroll
                    for (int e = 0; e < 4; e += 2) {
                        float z0, z1;
                        taps2(m, z0, z1, gc[e], gc[e + 1], gpf[e], gpf[e + 1], gnf[e], gnf[e + 1], w1s[n][e], w1s[n][e + 1], bbs[n][e], bbs[n][e + 1],
                                                              w0m[n][e], w0m[n][e + 1], w2m[n][e], w2m[n][e + 1], w0e[n][e], w0e[n][e + 1], w2e[n][e], w2e[n][e + 1]);
                        zs[e] = z0; zs[e + 1] = z1;
                    }
                    f32x4 o;
#pragma unroll
                    for (int e = 0; e < 4; ++e) o[e] = (zs[e] * uu[e]) * __builtin_amdgcn_rcpf(fmaf(__builtin_amdgcn_exp2f(zs[e]), NL2E, NL2E));
                    ow[2 * n] = cvtpk(o[0], o[1]); ow[2 * n + 1] = cvtpk(o[2], o[3]);
                    if (m == 0 && fr == 0) { float* sp = SB + ((size_t)(0 * NGRP + (rg >> 6)) * 3) * DFF + f0 + 4 * n; *(f32x4*)(sp + 2 * DFF) = gc; if (!seq_first) { *(f32x4*)sp = zs * (1.0f / NL2E); *(f32x4*)(sp + DFF) = uu; } }
                    if (m == 3 && fr == 15) { float* sp = SB + ((size_t)(1 * NGRP + (rg >> 6)) * 3) * DFF + f0 + 4 * n; *(f32x4*)(sp + 2 * DFF) = gc; if (!seq_last) { *(f32x4*)sp = zs * (1.0f / NL2E); *(f32x4*)(sp + DFF) = uu; } }
                }
                *(u32x4*)(ACTc + (size_t)(rg + 16 * m + fr) * DFF + f0) = ow;
            }
            asm volatile("" ::: "memory");
        }
    }
};
}

#define SBAR() __builtin_amdgcn_sched_barrier(0)
__device__ __forceinline__ int crow(int r, int hi) { return (r & 3) + 8 * (r >> 2) + 4 * hi; }
template <int DQK> __device__ __forceinline__ int kswz(int row, int cb) {
    return row * (DQK * 2 + 16) + cb;
}
__device__ __forceinline__ int v_st(int k, int c) { const int kk = (k & ~0xC) | ((k & 4) << 1) | ((k & 8) >> 1); return ((kk >> 3) * 4 + (c >> 5)) * 512 + ((kk & 7) * 32 + (c & 31)) * 2; }
__device__ __forceinline__ int v_stn(int k, int c) { return ((k >> 3) * 4 + (c >> 5)) * 512 + ((k & 7) * 32 + (c & 31)) * 2; }
__device__ __forceinline__ int v_rd_base(int lane) { return ((lane & 3) << 3) | (((lane >> 2) & 3) << 6) | (((lane >> 4) & 1) << 5) | (((lane >> 5) & 1) << 8); }
constexpr int v_rd_off(int d0, int ks, int half) { return d0 * 512 + ks * 4096 + half * 2048; }
template <int OFF> __device__ __forceinline__ s16x4 tr_read(int vb) {
    s16x4 r; asm volatile("ds_read_b64_tr_b16 %0, %1 offset:%2" : "=&v"(r) : "v"(vb), "i"(OFF) : "memory"); return r;
}
#define PKLH(L, H) (bf16x8){L[0], L[1], L[2], L[3], H[0], H[1], H[2], H[3]}
template <int D0> __device__ __forceinline__ void pv_one(f32x16& od, int vb, bf16x8 pa0, bf16x8 pa1, bf16x8 pa2, bf16x8 pa3) {
    const s16x4 l0 = tr_read<v_rd_off(D0, 0, 0)>(vb), h0 = tr_read<v_rd_off(D0, 0, 1)>(vb), l1 = tr_read<v_rd_off(D0, 1, 0)>(vb), h1 = tr_read<v_rd_off(D0, 1, 1)>(vb);
    const s16x4 l2 = tr_read<v_rd_off(D0, 2, 0)>(vb), h2 = tr_read<v_rd_off(D0, 2, 1)>(vb), l3 = tr_read<v_rd_off(D0, 3, 0)>(vb), h3 = tr_read<v_rd_off(D0, 3, 1)>(vb);
    asm volatile("s_waitcnt lgkmcnt(0)" ::: "memory"); SBAR();
    od = __builtin_amdgcn_mfma_f32_32x32x16_bf16(pa0, PKLH(l0, h0), od, 0, 0, 0);
    od = __builtin_amdgcn_mfma_f32_32x32x16_bf16(pa1, PKLH(l1, h1), od, 0, 0, 0);
    od = __builtin_amdgcn_mfma_f32_32x32x16_bf16(pa2, PKLH(l2, h2), od, 0, 0, 0);
    od = __builtin_amdgcn_mfma_f32_32x32x16_bf16(pa3, PKLH(l3, h3), od, 0, 0, 0);
}
__device__ __forceinline__ void pv_d0(f32x16* o, int vb, bf16x8 pa0, bf16x8 pa1, bf16x8 pa2, bf16x8 pa3) {
    pv_one<0>(o[0], vb, pa0, pa1, pa2, pa3); pv_one<1>(o[1], vb, pa0, pa1, pa2, pa3); pv_one<2>(o[2], vb, pa0, pa1, pa2, pa3); pv_one<3>(o[3], vb, pa0, pa1, pa2, pa3);
}
template <int DQK> __device__ __forceinline__ void qkt(f32x16& p0, f32x16& p1, const char* Ks, const bf16x8* qr, int r32, int hi, const f32x16 init = f32x16{}) {
    constexpr int NS = DQK / 16;
    p0 = init; p1 = init;
    bf16x8 b0[NS], b1[NS];
#pragma unroll
    for (int d0 = 0; d0 < NS; ++d0) { const int cb = (d0 * 16 + hi * 8) * 2;
        b0[d0] = *reinterpret_cast<const bf16x8*>(Ks + kswz<DQK>(r32, cb));
        b1[d0] = *reinterpret_cast<const bf16x8*>(Ks + kswz<DQK>(32 + r32, cb)); }
#pragma unroll
    for (int d0 = 0; d0 < NS; ++d0) {
        p0 = __builtin_amdgcn_mfma_f32_32x32x16_bf16(b0[d0], qr[d0], p0, 0, 0, 0);
        p1 = __builtin_amdgcn_mfma_f32_32x32x16_bf16(b1[d0], qr[d0], p1, 0, 0, 0); }
#ifndef QKT_AHEAD
#define QKT_AHEAD 3
#endif
    __builtin_amdgcn_sched_group_barrier(0x100, 2 * QKT_AHEAD, 0);
#pragma unroll
    for (int d0 = 0; d0 < NS - QKT_AHEAD; ++d0) { __builtin_amdgcn_sched_group_barrier(0x008, 2, 0); __builtin_amdgcn_sched_group_barrier(0x100, 2, 0); }
    __builtin_amdgcn_sched_group_barrier(0x008, 2 * QKT_AHEAD, 0);
}
#define PK4(P, BASE, OUT) do { const unsigned a0_ = cvtpk(P[BASE + 0], P[BASE + 1]), a1_ = cvtpk(P[BASE + 2], P[BASE + 3]);   \
    const unsigned b0_ = cvtpk(P[BASE + 4], P[BASE + 5]), b1_ = cvtpk(P[BASE + 6], P[BASE + 7]);                              \
    auto r0_ = __builtin_amdgcn_permlane32_swap(a0_, b0_, false, false); auto r1_ = __builtin_amdgcn_permlane32_swap(a1_, b1_, false, false); \
    u32x4 w_ = {r0_[0], r1_[0], r0_[1], r1_[1]}; OUT = *reinterpret_cast<bf16x8*>(&w_); } while (0)

#define PK4N(P, BASE, OUT) do { u32x4 w_ = {cvtpk(P[BASE + 0], P[BASE + 1]), cvtpk(P[BASE + 2], P[BASE + 3]), cvtpk(P[BASE + 4], P[BASE + 5]), cvtpk(P[BASE + 6], P[BASE + 7])}; \
    OUT = *reinterpret_cast<bf16x8*>(&w_); } while (0)

template <int SC1000> struct SmC { };
constexpr float THR = 8.f;

__device__ __forceinline__ void partialSM(f32x16& p0, f32x16& p1, float& m_reg, float& mn, float& alpha, const float C, const float thr_raw) {
    float pmax = p0[0];
#pragma unroll
    for (int r = 1; r < 16; ++r) pmax = fmaxf(pmax, p0[r]);
#pragma unroll
    for (int r = 0; r < 16; ++r) pmax = fmaxf(pmax, p1[r]);
    { auto rr = __builtin_amdgcn_permlane32_swap(__float_as_uint(pmax), __float_as_uint(pmax), false, false);
      pmax = fmaxf(__uint_as_float(rr[0]), __uint_as_float(rr[1])); }
    if (__builtin_expect(__all(pmax - m_reg <= thr_raw), 1)) { mn = m_reg; alpha = 1.f; }
    else { mn = fmaxf(m_reg, pmax); alpha = __builtin_amdgcn_exp2f((m_reg - mn) * C); m_reg = mn; }
    const float mnC = -mn * C;
#pragma unroll
    for (int r = 0; r < 16; ++r) p0[r] = fmaf(p0[r], C, mnC);
#pragma unroll
    for (int r = 0; r < 16; ++r) p1[r] = fmaf(p1[r], C, mnC);
#pragma unroll
    for (int r = 0; r < 16; ++r) p0[r] = __builtin_amdgcn_exp2f(p0[r]);
}
__device__ __forceinline__ void finishSM(f32x16& p0, f32x16& p1, float alpha, float& l_reg, bf16x8& pa0, bf16x8& pa1, bf16x8& pa2, bf16x8& pa3) {
#pragma unroll
    for (int r = 0; r < 16; ++r) p1[r] = __builtin_amdgcn_exp2f(p1[r]);
    float ps = 0;
#pragma unroll
    for (int r = 0; r < 16; ++r) ps += p0[r];
#pragma unroll
    for (int r = 0; r < 16; ++r) ps += p1[r];
    { auto rr = __builtin_amdgcn_permlane32_swap(__float_as_uint(ps), __float_as_uint(ps), false, false);
      ps = __uint_as_float(rr[0]) + __uint_as_float(rr[1]); }
    l_reg = l_reg * alpha + ps;
    PK4N(p0, 0, pa0); PK4N(p0, 8, pa1); PK4N(p1, 0, pa2); PK4N(p1, 8, pa3);
}

constexpr int KVBLK = 64;
struct AttnArgs {
    const bf16_t* Q; int ldq;
    const bf16_t* K; int ldk;
    const bf16_t* KR; int ldkr;
    const bf16_t* V; int ldv;
    bf16_t* O; int ldo;
    int nt;
    int seg0_tiles, seg0_row, seg1_row;
    int qpos0;
    int masked;
    float sink_l2; int has_sink;
    float C;
};
template <int DQK>
__device__ __forceinline__ void attn_body(const AttnArgs& a, char* lds) {
    constexpr int SHM_V = KVBLK * 128 * 2, SHM_K = KVBLK * (DQK * 2 + 16);
    const int tid = otid(), wid = tid >> 6, lane = tid & 63, r32 = lane & 31, hi = lane >> 5;
    char* V_lds = lds; char* K_lds = lds + 2 * SHM_V;
    float* ws = (float*)(lds + 2 * SHM_V + 2 * SHM_K) + wid * 64; float* li_l = ws; float* al_l = ws + 32;
    float m_reg = -1e30f, l_reg = 0; f32x16 o[4] = {}; bf16x8 qr[DQK / 16];
    const float C = a.C, thr_raw = THR * LOG2E / a.C;
    const bf16_t* Qw = a.Q + (long)(wid * 32 + r32) * a.ldq + hi * 8;
#pragma unroll
    for (int d0 = 0; d0 < DQK / 16; ++d0) qr[d0] = *reinterpret_cast<const bf16x8*>(Qw + d0 * 16);
    const int sr = tid >> 4, sc = (tid & 15) * 8, vst0 = v_stn(sr, sc), vst1 = v_stn(32 + sr, sc);
    const int kst0 = kswz<DQK>(sr, sc * 2), kst1 = kswz<DQK>(32 + sr, sc * 2);
    const int sr2 = tid >> 3, sc2 = (tid & 7) * 8, kst2 = (DQK == 192) ? kswz<DQK>(sr2, 256 + sc2 * 2) : 0;
    const int vb0 = (int)(uintptr_t)V_lds + v_rd_base(lane);
    bf16x8 vs0, vs1, ks0, ks1, ks2;
    __syncthreads();
#define TILE_ROW(j) ((j) < a.seg0_tiles ? a.seg0_row + 64 * (j) : ((a.masked && (unsigned)(a.qpos0 - 128 + 64 * ((j) - a.seg0_tiles)) >= (unsigned)SEQ) ? a.seg0_row : a.seg1_row + 64 * ((j) - a.seg0_tiles)))
    int cur_row = TILE_ROW(0);
    const bf16_t* pk0 = a.K + ((long)cur_row + sr) * a.ldk + sc;
    const bf16_t* pkr = a.KR + ((long)cur_row + sr2) * a.ldkr + sc2;
    const long dvk = a.V - a.K, d32 = 32L * a.ldk;
#define SLOAD(j) do { const int nr_ = TILE_ROW(j); const long dr_ = (long)(nr_ - cur_row); cur_row = nr_; pk0 += dr_ * a.ldk; if (DQK == 192) pkr += dr_ * a.ldkr; \
    vs0 = *reinterpret_cast<const bf16x8*>(pk0 + dvk); vs1 = *reinterpret_cast<const bf16x8*>(pk0 + d32 + dvk); \
    ks0 = *reinterpret_cast<const bf16x8*>(pk0); ks1 = *reinterpret_cast<const bf16x8*>(pk0 + d32); \
    if (DQK == 192) ks2 = *reinterpret_cast<const bf16x8*>(pkr); } while (0)
#define SWRITE(b) do { *(bf16x8*)(V_lds + (b) * SHM_V + vst0) = vs0; *(bf16x8*)(V_lds + (b) * SHM_V + vst1) = vs1; \
    *(bf16x8*)(K_lds + (b) * SHM_K + kst0) = ks0; *(bf16x8*)(K_lds + (b) * SHM_K + kst1) = ks1; \
    if (DQK == 192) *(bf16x8*)(K_lds + (b) * SHM_K + kst2) = ks2; } while (0)
#define SWAIT() asm volatile("s_waitcnt vmcnt(0)" ::: "memory")
#define RESC(al) do { if (__any((al) < 1.f)) { if (hi == 0) al_l[r32] = (al); asm volatile("s_waitcnt lgkmcnt(0)" ::: "memory"); \
    _Pragma("unroll") for (int d = 0; d < 4; ++d) _Pragma("unroll") for (int r = 0; r < 16; ++r) o[d][r] *= al_l[crow(r, hi)]; } } while (0)
#define MASK(P0, P1, j) do { if (a.masked && (j) >= a.seg0_tiles) { const int kp0_ = a.qpos0 - 128 + 64 * ((j) - a.seg0_tiles), qp_ = a.qpos0 + wid * 32 + r32; \
    const bool tv_ = (unsigned)kp0_ < (unsigned)SEQ; \
    _Pragma("unroll") for (int r = 0; r < 16; ++r) { const int d0_ = kp0_ + crow(r, hi) - qp_, d1_ = d0_ + 32; \
        P0[r] = (tv_ && d0_ <= 128 && d0_ >= -128) ? P0[r] : -1e30f; P1[r] = (tv_ && d1_ <= 128 && d1_ >= -128) ? P1[r] : -1e30f; } } } while (0)
    f32x16 pA0, pA1; float mnA, alA; bf16x8 pa0, pa1, pa2, pa3; const int NT = a.nt;
    const int wu = __builtin_amdgcn_readfirstlane(wid);
    volatile int* vflag = (volatile int*)(lds + 2 * SHM_V + 2 * SHM_K + 8 * 256);
#define TILE_BODY(CLASSIC) { \
        const int b = j & 1; \
        if (j + 1 < NT) SLOAD(j + 1); \
        bool skip = false;        \
        if (a.masked && j >= a.seg0_tiles) { const int kp0_ = a.qpos0 - 128 + 64 * (j - a.seg0_tiles), q0_ = a.qpos0 + wu * 32; \
            skip = ((unsigned)kp0_ >= (unsigned)SEQ) || (kp0_ + 63 < q0_ - 128) || (kp0_ > q0_ + 31 + 128); } \
        if (!skip) { \
            if (CLASSIC) { \
                SBAR(); qkt<DQK>(pA0, pA1, K_lds + b * SHM_K, qr, r32, hi); MASK(pA0, pA1, j); \
                partialSM(pA0, pA1, m_reg, mnA, alA, C, thr_raw); \
                RESC(alA); \
                finishSM(pA0, pA1, alA, l_reg, pa0, pa1, pa2, pa3); \
            } else { \
                SBAR(); qkt<DQK>(pA0, pA1, K_lds + b * SHM_K, qr, r32, hi, minit); MASK(pA0, pA1, j);        \
                float ps_ = 0.f; \
                _Pragma("unroll") for (int r = 0; r < 16; ++r) pA0[r] = __builtin_amdgcn_exp2f(pA0[r]); \
                _Pragma("unroll") for (int r = 0; r < 16; ++r) pA1[r] = __builtin_amdgcn_exp2f(pA1[r]); \
                _Pragma("unroll") for (int r = 0; r < 16; ++r) ps_ += pA0[r]; \
                _Pragma("unroll") for (int r = 0; r < 16; ++r) ps_ += pA1[r]; \
                { auto rr = __builtin_amdgcn_permlane32_swap(__float_as_uint(ps_), __float_as_uint(ps_), false, false); ps_ = __uint_as_float(rr[0]) + __uint_as_float(rr[1]); } \
                badu = __builtin_elementwise_max(badu, __float_as_uint(ps_));        \
                l_reg += ps_; \
                PK4N(pA0, 0, pa0); PK4N(pA0, 8, pa1); PK4N(pA1, 0, pa2); PK4N(pA1, 8, pa3); \
            } \
            SBAR(); \
            if (j + 1 < NT) { SWAIT(); SWRITE(b ^ 1); }        \
            SBAR(); \
            pv_d0(o, vb0 + b * SHM_V, pa0, pa1, pa2, pa3); \
        } else if (j + 1 < NT) { SWAIT(); SWRITE(b ^ 1); } \
        __syncthreads(); }
    if (tid == 0) *vflag = 0;
    if (wu >= 4) __builtin_amdgcn_s_setprio(1);
#pragma nounroll
    for (int pass = 0; pass < 2; ++pass) {
        int bad = 0; unsigned badu = 0u;
        SLOAD(0); SWAIT(); SWRITE(0); __syncthreads();
        const int jc = pass ? NT : 1;
        f32x16 minit = f32x16{};
#pragma nounroll
        for (int j = 0; j < jc; ++j) TILE_BODY(1)
#pragma unroll
        for (int r = 0; r < 16; ++r) minit[r] = -m_reg * C;
#pragma nounroll
        for (int j = jc; j < NT; ++j) TILE_BODY(0)
        if (pass) break;
        bad = !__all(badu <= __float_as_uint(256.0f));
        if (bad && lane == 0) *vflag = 1;
        __syncthreads();
        if (*vflag == 0) break;
        __syncthreads();
        m_reg = -1e30f; l_reg = 0.f;
#pragma unroll
        for (int d = 0; d < 4; ++d) o[d] = f32x16{};
    }
#undef TILE_BODY
    __builtin_amdgcn_s_setprio(0);
    if (a.has_sink) l_reg += __builtin_amdgcn_exp2f(a.sink_l2 - m_reg * C);
    if (hi == 0) li_l[r32] = l_reg; asm volatile("s_waitcnt lgkmcnt(0)" ::: "memory");
    float rli[16];
#pragma unroll
    for (int r = 0; r < 16; ++r) rli[r] = __builtin_amdgcn_rcpf(li_l[crow(r, hi)]);
    __syncthreads();
    { unsigned short* stg = (unsigned short*)(lds + wid * 8704);
#pragma unroll
      for (int r = 0; r < 16; ++r) { const int orow = crow(r, hi);
#pragma unroll
          for (int d0 = 0; d0 < 4; ++d0) stg[orow * 136 + d0 * 32 + r32] = (unsigned short)(cvtpk(o[d0][r] * rli[r], 0.f) & 0xffffu); }
      asm volatile("s_waitcnt lgkmcnt(0)" ::: "memory");
      bf16_t* Ow = a.O + (long)(wid * 32) * a.ldo;
#pragma unroll
      for (int i = 0; i < 8; ++i) { const int q = lane + 64 * i, row = q >> 4, c8 = (q & 15) * 8;
          *(u32x4*)(Ow + (long)row * a.ldo + c8) = *(const u32x4*)(stg + row * 136 + c8); } }
#undef TILE_ROW
#undef SLOAD
#undef SWRITE
#undef SWAIT
#undef RESC
#undef MASK
}

__device__ __forceinline__ int ret_row0(int bb, int n) { return n == 32 ? NLAT + bb * CTXL : bb * SEQ + n * 256; }
__device__ __forceinline__ float log2_sigmoid(float x) { return -log1pf(__expf(-x)) * LOG2E; }

__device__ __forceinline__ void ret_kv_unit(const bf16_t* PROJ, float* KVS, int bb, int h, int n, float lgf2, float lgb2, char* lds) {
    const int tid = otid(), wid = tid >> 6, lane = tid & 63, r32 = lane & 31, hi = lane >> 5;
    const int dir = wid >> 2, ablk = wid & 3;
    const int sr = tid >> 4, sc = (tid & 15) * 8, vst0 = v_st(sr, sc), vst1 = v_st(32 + sr, sc);
    const long R0 = ret_row0(bb, n);
    const bf16_t* Kg = PROJ + R0 * INW + 512 + h * 128; const bf16_t* Vg = PROJ + R0 * INW + 1024 + h * 128;
    const int vbK = (int)(uintptr_t)lds + dir * 16384 + v_rd_base(lane) + ablk * 512;
    const int vbV = (int)(uintptr_t)lds + 32768 + v_rd_base(lane);
    f32x16 acc[4] = {};
    u32x4 kq[2]; bf16x8 vq[2];
#pragma unroll
    for (int i = 0; i < 2; ++i) { const int j = sr + 32 * i; kq[i] = *reinterpret_cast<const u32x4*>(Kg + (long)j * INW + sc); vq[i] = *reinterpret_cast<const bf16x8*>(Vg + (long)j * INW + sc); }
    for (int t = 0; t < 4; ++t) {
        __syncthreads();
#pragma unroll
        for (int i = 0; i < 2; ++i) {
            const int j = 64 * t + sr + 32 * i;
            const u32x4 kv = kq[i];
            const bf16x8 vv = vq[i];
            const float kf = __builtin_amdgcn_exp2f(lgf2 * (float)(255 - j)), kb = __builtin_amdgcn_exp2f(lgb2 * (float)j);
            u32x4 wf, wb;
#pragma unroll
            for (int e = 0; e < 4; ++e) { const float lo = bflo(kv[e]), hh = bfhi(kv[e]); wf[e] = cvtpk(lo * kf, hh * kf); wb[e] = cvtpk(lo * kb, hh * kb); }
            const int vo = i ? vst1 : vst0;
            *(u32x4*)(lds + vo) = wf; *(u32x4*)(lds + 16384 + vo) = wb; *(bf16x8*)(lds + 32768 + vo) = vv;
        }
        if (t < 3) {
#pragma unroll
            for (int i = 0; i < 2; ++i) { const int j = 64 * (t + 1) + sr + 32 * i; kq[i] = *reinterpret_cast<const u32x4*>(Kg + (long)j * INW + sc); vq[i] = *reinterpret_cast<const bf16x8*>(Vg + (long)j * INW + sc); }
        }
        __syncthreads();
#define RKV_STEP(KS) do { \
        const s16x4 al_ = tr_read<v_rd_off(0, KS, 0)>(vbK), ah_ = tr_read<v_rd_off(0, KS, 1)>(vbK); \
        const s16x4 l0_ = tr_read<v_rd_off(0, KS, 0)>(vbV), h0_ = tr_read<v_rd_off(0, KS, 1)>(vbV), l1_ = tr_read<v_rd_off(1, KS, 0)>(vbV), h1_ = tr_read<v_rd_off(1, KS, 1)>(vbV); \
        const s16x4 l2_ = tr_read<v_rd_off(2, KS, 0)>(vbV), h2_ = tr_read<v_rd_off(2, KS, 1)>(vbV), l3_ = tr_read<v_rd_off(3, KS, 0)>(vbV), h3_ = tr_read<v_rd_off(3, KS, 1)>(vbV); \
        asm volatile("s_waitcnt lgkmcnt(0)" ::: "memory"); SBAR(); \
        const bf16x8 af_ = PKLH(al_, ah_); \
        acc[0] = __builtin_amdgcn_mfma_f32_32x32x16_bf16(af_, PKLH(l0_, h0_), acc[0], 0, 0, 0); \
        acc[1] = __builtin_amdgcn_mfma_f32_32x32x16_bf16(af_, PKLH(l1_, h1_), acc[1], 0, 0, 0); \
        acc[2] = __builtin_amdgcn_mfma_f32_32x32x16_bf16(af_, PKLH(l2_, h2_), acc[2], 0, 0, 0); \
        acc[3] = __builtin_amdgcn_mfma_f32_32x32x16_bf16(af_, PKLH(l3_, h3_), acc[3], 0, 0, 0); } while (0)
        RKV_STEP(0); RKV_STEP(1); RKV_STEP(2); RKV_STEP(3);
#undef RKV_STEP
    }
    float* outp = KVS + ((((size_t)bb * 4 + h) * 2 + dir) * 33 + n) * 16384;
#pragma unroll
    for (int r = 0; r < 16; ++r) { const int dk = 32 * ablk + crow(r, hi);
#pragma unroll
        for (int d = 0; d < 4; ++d) outp[dk * 128 + 32 * d + r32] = acc[d][r]; }
}

__device__ __forceinline__ void ret_scan(const float* KVS, bf16_t* SIN, const float* dec_f, const float* dec_b, int gtid, int gthreads) {
    for (int it = gtid; it < NB * 4 * 2 * 4096; it += gthreads) {
        const int e4 = it & 4095, dir = (it >> 12) & 1, h = (it >> 13) & 3, bb = it >> 15;
        const float lg2 = log2_sigmoid(dir ? dec_b[h] : dec_f[h]); const float cd = __builtin_amdgcn_exp2f(lg2 * 256.0f);
        const size_t base = ((((size_t)bb * 4 + h) * 2 + dir) * 33) * 16384 + (size_t)e4 * 4;
        f32x4 s = *(const f32x4*)(KVS + base + (size_t)32 * 16384);
        *(u32x2*)(SIN + base + (size_t)32 * 16384) = (u32x2){0u, 0u};
        for (int nb = 0; nb < 4; ++nb) {
            f32x4 kv[8];
#pragma unroll
            for (int q = 0; q < 8; ++q) { const int n = dir ? 31 - (nb * 8 + q) : nb * 8 + q; kv[q] = *(const f32x4*)(KVS + base + (size_t)n * 16384); }
#pragma unroll
            for (int q = 0; q < 8; ++q) { const int n = dir ? 31 - (nb * 8 + q) : nb * 8 + q;
                st_bf16x4(SIN + base + (size_t)n * 16384, s); s = s * cd + kv[q]; }
        }
    }
}

__device__ __forceinline__ void ret_out_unit(const bf16_t* PROJ, const bf16_t* SIN, bf16_t* Y, int bb, int h, int n, float lgf2, float lgb2, char* lds) {
    const int tid = otid(), wid = tid >> 6, lane = tid & 63, r32 = lane & 31, hi = lane >> 5;
    const int sr = tid >> 4, sc = (tid & 15) * 8, vst0 = v_st(sr, sc), vst1 = v_st(32 + sr, sc);
    const int kst0 = kswz<128>(sr, sc * 2), kst1 = kswz<128>(32 + sr, sc * 2);
    const long R0 = ret_row0(bb, n);
    const bf16_t* Qg = PROJ + R0 * INW + h * 128; const bf16_t* Kg = Qg + 512; const bf16_t* Vg = Qg + 1024; const bf16_t* Gg = Qg + 1536;
    char* K_lds = lds; char* V_lds = lds + 17408;
    const int vb0 = (int)(uintptr_t)V_lds + v_rd_base(lane);
    bf16x8 qr[8];
    const bf16_t* Qw = Qg + (long)(wid * 32 + r32) * INW + hi * 8;
#pragma unroll
    for (int d0 = 0; d0 < 8; ++d0) qr[d0] = *reinterpret_cast<const bf16x8*>(Qw + d0 * 16);
    f32x16 o[4] = {};
    const int iq = wid * 32 + r32;
    const bf16_t* S0 = SIN + ((((size_t)bb * 4 + h) * 2) * 33 + n) * 16384;
    bf16x8 kq[2], vq[2];
#pragma unroll
    for (int i = 0; i < 2; ++i) { const int j = sr + 32 * i; kq[i] = *reinterpret_cast<const bf16x8*>(Kg + (long)j * INW + sc); vq[i] = *reinterpret_cast<const bf16x8*>(Vg + (long)j * INW + sc); }
    for (int t = 0; t < 4; ++t) {
        __syncthreads();
#pragma unroll
        for (int i = 0; i < 2; ++i) { *(bf16x8*)(K_lds + (i ? kst1 : kst0)) = kq[i]; *(bf16x8*)(V_lds + (i ? vst1 : vst0)) = vq[i]; }
        if (t < 3) {
#pragma unroll
            for (int i = 0; i < 2; ++i) { const int j = 64 * (t + 1) + sr + 32 * i; kq[i] = *reinterpret_cast<const bf16x8*>(Kg + (long)j * INW + sc); vq[i] = *reinterpret_cast<const bf16x8*>(Vg + (long)j * INW + sc); }
        } else if (n != 32) {
#pragma unroll
            for (int i = 0; i < 2; ++i) vq[i] = *reinterpret_cast<const bf16x8*>(S0 + (sr + 32 * i) * 128 + sc);
        }
        __syncthreads();
        f32x16 p0, p1; qkt<128>(p0, p1, K_lds, qr, r32, hi);
#pragma unroll
        for (int r = 0; r < 16; ++r) {
            const int d0 = iq - (64 * t + crow(r, hi)), d1 = d0 - 32;
            const float m0 = d0 > 0 ? __builtin_amdgcn_exp2f(lgf2 * (float)d0) : (d0 < 0 ? __builtin_amdgcn_exp2f(lgb2 * (float)(-d0)) : 2.0f);
            const float m1 = d1 > 0 ? __builtin_amdgcn_exp2f(lgf2 * (float)d1) : (d1 < 0 ? __builtin_amdgcn_exp2f(lgb2 * (float)(-d1)) : 2.0f);
            p0[r] *= m0; p1[r] *= m1;
        }
        bf16x8 pa0, pa1, pa2, pa3; PK4(p0, 0, pa0); PK4(p0, 8, pa1); PK4(p1, 0, pa2); PK4(p1, 8, pa3);
        pv_d0(o, vb0, pa0, pa1, pa2, pa3);
    }
    if (n != 32) {
#pragma unroll
        for (int s4 = 0; s4 < 4; ++s4) {
            const int dir = s4 >> 1, ts = s4 & 1;
            const float qd = dir ? __builtin_amdgcn_exp2f(lgb2 * (float)(256 - iq)) : __builtin_amdgcn_exp2f(lgf2 * (float)(iq + 1));
            __syncthreads();
#pragma unroll
            for (int i = 0; i < 2; ++i) *(bf16x8*)(V_lds + (i ? vst1 : vst0)) = vq[i];
            if (s4 < 3) { const int d2 = (s4 + 1) >> 1, t2 = (s4 + 1) & 1; const bf16_t* Sn = S0 + (size_t)d2 * 33 * 16384;
#pragma unroll
                for (int i = 0; i < 2; ++i) vq[i] = *reinterpret_cast<const bf16x8*>(Sn + (64 * t2 + sr + 32 * i) * 128 + sc); }
            bf16x8 qs[4];
#pragma unroll
            for (int k = 0; k < 4; ++k) { const u32x4 w = *reinterpret_cast<const u32x4*>(&qr[4 * ts + k]); u32x4 x;
#pragma unroll
                for (int e = 0; e < 4; ++e) x[e] = cvtpk(bflo(w[e]) * qd, bfhi(w[e]) * qd);
                qs[k] = *reinterpret_cast<bf16x8*>(&x); }
            __syncthreads();
            pv_d0(o, vb0, qs[0], qs[1], qs[2], qs[3]);
        }
    }
    __syncthreads();
    { unsigned short* stg = (unsigned short*)(lds + wid * 8704);
#pragma unroll
      for (int r = 0; r < 16; ++r) {
          float ss = (o[0][r] * o[0][r] + o[1][r] * o[1][r]) + (o[2][r] * o[2][r] + o[3][r] * o[3][r]);
          ss += __shfl_xor(ss, 1); ss += __shfl_xor(ss, 2); ss += __shfl_xor(ss, 4); ss += __shfl_xor(ss, 8); ss += __shfl_xor(ss, 16);
          const float rn = 1.0f / sqrtf(ss * (1.0f / 128.0f) + RMS_EPS);
#pragma unroll
          for (int d = 0; d < 4; ++d) stg[crow(r, hi) * 136 + 32 * d + r32] = (unsigned short)(cvtpk(o[d][r] * rn, 0.f) & 0xffffu);
      }
      asm volatile("s_waitcnt lgkmcnt(0)" ::: "memory");
#pragma unroll
      for (int i = 0; i < 8; ++i) { const int q = lane + 64 * i, row = q >> 4, c8 = (q & 15) * 8;
          const u32x4 gw = *(const u32x4*)(Gg + (long)(wid * 32 + row) * INW + c8);
          const u32x4 xw = *(const u32x4*)(stg + row * 136 + c8);
          u32x4 ow;
#pragma unroll
          for (int e = 0; e < 4; ++e) ow[e] = cvtpk(silu_f(bflo(gw[e])) * bflo(xw[e]), silu_f(bfhi(gw[e])) * bfhi(xw[e]));
          *(u32x4*)(Y + (R0 + wid * 32 + row) * D + h * 128 + c8) = ow; } }
}

struct Params {
    const float* in[23];
    float* out; unsigned char* ws;
    int ph_lo, ph_hi, bar_region, pad;
};
enum { I_X = 0, I_C, I_CTX, I_CCTX, I_ADAW, I_ADAB, I_WIN, I_DECF, I_DECB, I_SINK, I_QNORM, I_WUQ, I_KVNORM, I_WUKV, I_WO, I_LN1G, I_LN1B, I_WUP, I_CONVW, I_CONVB, I_WDN, I_LN2G, I_LN2B };

__device__ __forceinline__ int win_src_col(int p) {
    if (p >= INW) return -1;
    if (p >= 4096) return p;
    const int pn = p >> 8;
    if (pn < 4 || (pn >= 8 && pn < 12)) {
        const int bj = (p >> 7) & 1, x = p & 127, wc = x >> 5, nn = (x >> 4) & 1, q = x & 15;
        return (p & ~255) + 128 * (wc >> 1) + 64 * (wc & 1) + 32 * bj + 8 * (q >> 2) + 4 * nn + (q & 3);
    }
    return (p & ~31) + 8 * ((p & 15) >> 2) + 4 * ((p >> 4) & 1) + (p & 3);
}
__device__ __forceinline__ int wup_src_col(int p) {
    const int pn = p >> 8, bj = (p >> 7) & 1, x = p & 127, wc = x >> 5, nn = (x >> 4) & 1, q = x & 15, fq = q >> 2, j = q & 3;
    const int f = 128 * pn + 32 * wc + 8 * fq + 4 * nn + j;
    return bj ? DFF + f : f;
}
__device__ __forceinline__ void cvt_item(const float* W, int K, int N, bf16_t* Bt, int mode, const float* kscale, int item, int nkt, float* scr, int lane) {
    const int pt = item / nkt, kt = item - pt * nkt, p0 = pt * 32, k0 = kt * 64;
    const int p = p0 + (lane & 31);
    const int src = mode == 1 ? win_src_col(p) : (mode == 2 ? wup_src_col(p) : (mode == 3 ? ((p & ~31) + 8 * ((p & 15) >> 2) + 4 * ((p >> 4) & 1) + (p & 3)) : (p < N ? p : -1)));
    const float* wp = W + (size_t)(k0 + (lane >> 5)) * N + (src >= 0 ? src : 0);
    float v[32];
#pragma unroll
    for (int i = 0; i < 32; ++i) v[i] = src >= 0 ? wp[(size_t)(2 * i) * N] : 0.f;
    if (kscale) {
#pragma unroll
        for (int i = 0; i < 32; ++i) v[i] *= kscale[k0 + 2 * i + (lane >> 5)];
    }
#pragma unroll
    for (int i = 0; i < 32; ++i) scr[(2 * i + (lane >> 5)) * 33 + (lane & 31)] = v[i];
    asm volatile("s_waitcnt lgkmcnt(0)" ::: "memory");
    const int c = lane & 7;
#pragma unroll
    for (int j = 0; j < 4; ++j) { const int n = (lane >> 3) + 8 * j; const float* s = scr + (8 * c) * 33 + n;
        u32x4 o; o[0] = cvtpk(s[0 * 33], s[1 * 33]); o[1] = cvtpk(s[2 * 33], s[3 * 33]); o[2] = cvtpk(s[4 * 33], s[5 * 33]); o[3] = cvtpk(s[6 * 33], s[7 * 33]);
        *(u32x4*)(Bt + (size_t)(p0 + n) * K + k0 + 8 * c) = o; }
    asm volatile("s_waitcnt lgkmcnt(0)" ::: "memory");
}

__device__ __forceinline__ void ln_phase(const bf16_t* X, const bf16_t* MIX, float* dstf, bf16_t* dsth, bf16_t* H, const float* g, const float* b,
                                         const float* gate, const float* sc, const float* sh, int nrows, int bid, int G, char* lds) {
    const int tid = otid(), lane = tid & 63, wid = __builtin_amdgcn_readfirstlane(tid >> 6);
    float* L = (float*)lds;
    __syncthreads();
    for (int i = tid; i < D; i += 512) { L[i] = g[i]; L[D + i] = b[i]; }
    const int ngroups = nrows >> 3, grp0 = (int)(((long)bid * ngroups) / G), nsteps = (int)(((long)(bid + 1) * ngroups) / G) - grp0; int s_cur = -1;
#define LN_ROW(k) ((grp0 + (k)) * 8 + wid)
#define LN_LOAD(XA, MA, ROW) do { const bf16_t* xr_ = X + (size_t)(ROW) * D + 4 * lane; const bf16_t* mr_ = MIX + (size_t)(ROW) * D + 4 * lane; \
    _Pragma("unroll") for (int j = 0; j < 8; ++j) { XA[j] = *(const u32x2*)(xr_ + 256 * j); MA[j] = *(const u32x2*)(mr_ + 256 * j); } } while (0)
#define LN_SVEC(k) do { const int s_ = mod_index((grp0 + (k)) * 8); \
    if (s_ != s_cur) { __syncthreads(); \
        { float gv_[4], sv_[4], hv_[4]; \
          _Pragma("unroll") for (int q_ = 0; q_ < 4; ++q_) { const int i = tid + 512 * q_; gv_[q_] = gate[(size_t)s_ * MODW + i]; sv_[q_] = H ? sc[(size_t)s_ * MODW + i] : 0.f; hv_[q_] = H ? sh[(size_t)s_ * MODW + i] : 0.f; } \
          _Pragma("unroll") for (int q_ = 0; q_ < 4; ++q_) { const int i = tid + 512 * q_; L[2 * D + i] = gv_[q_] + 1.0f; L[3 * D + i] = sv_[q_] + 1.0f; L[4 * D + i] = hv_[q_]; } } \
        s_cur = s_; __syncthreads(); } } while (0)
#define LN_COMP(XA, MA, ROW) do { \
    f32x4 v[8]; float sum = 0.f; \
    _Pragma("unroll") for (int j = 0; j < 8; ++j) { const int c = 4 * lane + 256 * j; \
        const f32x4 mv = (f32x4){bflo(MA[j][0]), bfhi(MA[j][0]), bflo(MA[j][1]), bfhi(MA[j][1])}; \
        v[j] = cvt_f16x4(XA[j]) * ALPHA + *(const f32x4*)(L + 2 * D + c) * mv; sum += (v[j][0] + v[j][1]) + (v[j][2] + v[j][3]); } \
    const float mean = wave_sum(sum) * (1.0f / D); float s2 = 0.f; \
    _Pragma("unroll") for (int j = 0; j < 8; ++j) { v[j] = v[j] - mean; s2 += (v[j][0] * v[j][0] + v[j][1] * v[j][1]) + (v[j][2] * v[j][2] + v[j][3] * v[j][3]); } \
    const float rstd = 1.0f / sqrtf(wave_sum(s2) * (1.0f / D) + LN_EPS); \
    _Pragma("unroll") for (int j = 0; j < 8; ++j) { const int c = 4 * lane + 256 * j; \
        const f32x4 y = v[j] * rstd * *(const f32x4*)(L + c) + *(const f32x4*)(L + D + c); \
        if (dstf) *(f32x4*)(dstf + (size_t)(ROW) * D + c) = y; else st_f16x4(dsth + (size_t)(ROW) * D + c, y); \
        if (H) st_bf16x4(H + (size_t)(ROW) * D + c, y * *(const f32x4*)(L + 3 * D + c) + *(const f32x4*)(L + 4 * D + c)); } } while (0)
    u32x2 xa[8], xb[8], ma[8], mb[8];
    if (LN_ROW(0) < nrows) LN_LOAD(xa, ma, LN_ROW(0));
    for (int k = 0; k < nsteps; k += 2) {
        LN_SVEC(k);
        if (k + 1 < nsteps && LN_ROW(k + 1) < nrows) LN_LOAD(xb, mb, LN_ROW(k + 1));
        SBAR();
        if (LN_ROW(k) < nrows) LN_COMP(xa, ma, LN_ROW(k));
        if (k + 1 < nsteps) {
            LN_SVEC(k + 1);
            if (k + 2 < nsteps && LN_ROW(k + 2) < nrows) LN_LOAD(xa, ma, LN_ROW(k + 2));
            SBAR();
            if (LN_ROW(k + 1) < nrows) LN_COMP(xb, mb, LN_ROW(k + 1));
        }
    }
#undef LN_ROW
#undef LN_LOAD
#undef LN_SVEC
#undef LN_COMP
}

__global__ void __launch_bounds__(512, 2) fwd_kernel(Params p) {
    extern __shared__ __attribute__((aligned(16))) unsigned char lds_raw[];
    LAS unsigned char* ldsl = (LAS unsigned char*)lds_raw;
    char* lds = (char*)lds_raw;
    if (threadIdx.x < 4) ((volatile LAS unsigned*)(ldsl + 131072))[threadIdx.x] = 0u;
    __syncthreads();
    XcdBarrier bar; bar.bar = (unsigned*)(p.ws + WS_CTL) + (size_t)p.bar_region * 4096; bar.x = 0; bar.st = (volatile LAS unsigned*)(ldsl + 131072);
    if (p.ph_hi - p.ph_lo > 1) bar = xcd_barrier_post(bar.bar, (volatile LAS unsigned*)(ldsl + 131072));

    int g = 0, lcur = 0;
#ifndef DUPMASK
#define DUPMASK 0
#endif
#define NREP(k) (1 + ((DUPMASK >> (k)) & 1))
#ifndef PHMASK
#define PHMASK 0xffff
#endif
#ifndef SUBMASK
#define SUBMASK 0xffff
#endif
#define SUB(k) ((SUBMASK >> (k)) & 1)
#define PH_BEGIN(k) if (((PHMASK >> (k)) & 1) && g >= p.ph_lo && g < p.ph_hi) { \
    int bid = blockIdx.x, G = gridDim.x; asm volatile("" : "+s"(bid), "+s"(G)); const int NGW = G * 8, gthreads = G * 512; (void)NGW; (void)gthreads; \
    const int tid = otid(), lane = tid & 63, wid = __builtin_amdgcn_readfirstlane(tid >> 6); const int gw = bid * 8 + wid, gtid = bid * 512 + tid; (void)lane; (void)gw; (void)gtid; \
    size_t wsoff_ = 0; asm volatile("" : "+s"(wsoff_)); unsigned char* ws = p.ws + wsoff_; \
    float* MOD = (float*)(ws + WS_MOD); float* ROPE = (float*)(ws + WS_ROPE); float* RS = (float*)(ws + WS_RS); float* SM = (float*)(ws + WS_SM); (void)SM; \
    float* thc = ROPE, *ths = ROPE + 4096, *tmc = ROPE + 8192, *tms = ROPE + 8192 + 2048; \
    bf16_t* WB = (bf16_t*)(ws + WS_W); float* X = (float*)(ws + WS_X); bf16_t* XH = (bf16_t*)(ws + WS_X); (void)XH; bf16_t* H = (bf16_t*)(ws + WS_H); bf16_t* Y = (bf16_t*)(ws + WS_Y); \
    bf16_t* PROJ = (bf16_t*)(ws + WS_PROJ); bf16_t* QUP = (bf16_t*)(ws + WS_QUP); bf16_t* KVUP = (bf16_t*)(ws + WS_KVUP); \
    float* KVS = (float*)(ws + WS_KVS); bf16_t* SIN = (bf16_t*)(ws + WS_SIN); bf16_t* ACT0 = (bf16_t*)(ws + WS_ACT0); bf16_t* ACT1 = (bf16_t*)(ws + WS_ACT1); float* SB = (float*)(ws + WS_SB); bf16_t* MIX = (bf16_t*)(ws + WS_MIX); (void)MIX; \
    const bf16_t* wl = WB + (size_t)lcur * W_LAYER; const float* modl = MOD + (size_t)lcur * 5 * MODW; \
    (void)RS; (void)thc; (void)ths; (void)tmc; (void)tms; (void)X; (void)H; (void)Y; (void)PROJ; (void)QUP; (void)KVUP; (void)KVS; (void)SIN; (void)ACT0; (void)ACT1; (void)SB; (void)wl; (void)modl;
#define PH_END   if (g + 1 < p.ph_hi) xcd_barrier(bar); } ++g;

    PH_BEGIN(0)
    {
        for (int i = gtid; i < SM_END; i += gthreads) {
            float v = 0.f;
            if (i < SM_DECB) v = p.in[I_DECF][i];
            else if (i < SM_SINK) v = p.in[I_DECB][i - SM_DECB];
            else if (i < SM_LN1G) v = (i - SM_SINK) < DEPTH * 6 ? p.in[I_SINK][i - SM_SINK] : 0.f;
            else if (i < SM_LN1B) v = p.in[I_LN1G][i - SM_LN1G];
            else if (i < SM_LN2G) v = p.in[I_LN1B][i - SM_LN1B];
            else if (i < SM_LN2B) v = p.in[I_LN2G][i - SM_LN2G];
            else if (i < SM_CONVW) v = p.in[I_LN2B][i - SM_LN2B];
            else if (i < SM_CONVB) v = p.in[I_CONVW][i - SM_CONVW];
            else v = p.in[I_CONVB][i - SM_CONVB];
            SM[i] = v;
        }
        for (int i = gtid; i < 4096 + 2048; i += gthreads) {
            if (i < 4096) { const int pos = i >> 5, f = i & 31; const float inv = exp2f(-(float)f * (13.287712379549449f / 32.0f)); const float ang = (float)pos * inv; thc[i] = cosf(ang); ths[i] = sinf(ang); }
            else { const int q = i - 4096, pos = q >> 4, f = q & 15; const float inv = exp2f(-(float)f * (13.287712379549449f / 16.0f)); const float ang = (float)pos * inv; tmc[q] = cosf(ang); tms[q] = sinf(ang); }
        }
        {
            float* scs = (float*)lds;
            float* red = (float*)(lds + 5 * 2048 * 4);
            for (int i = tid; i < 5 * 2048; i += 512) { const int s = i >> 11, k = i & 2047; const float cv = s < 4 ? p.in[I_C][s * D + k] : p.in[I_CCTX][k]; scs[i] = silu_f(cv); }
            __syncthreads();
            for (int u = bid; u < DEPTH * (MODW / 64); u += G) {
                const int l = u / (MODW / 64), j = (u % (MODW / 64)) * 64 + lane;
                const float* Wp = p.in[I_ADAW] + (size_t)l * D * MODW + j;
                float a0 = 0.f, a1 = 0.f, a2 = 0.f, a3 = 0.f, a4 = 0.f;
#pragma unroll 16
                for (int kk = 0; kk < 256; ++kk) { const int k = wid * 256 + kk; const float w = Wp[(size_t)k * MODW];
                    a0 += scs[k] * w; a1 += scs[2048 + k] * w; a2 += scs[4096 + k] * w; a3 += scs[6144 + k] * w; a4 += scs[8192 + k] * w; }
                red[(wid * 5 + 0) * 64 + lane] = a0; red[(wid * 5 + 1) * 64 + lane] = a1; red[(wid * 5 + 2) * 64 + lane] = a2; red[(wid * 5 + 3) * 64 + lane] = a3; red[(wid * 5 + 4) * 64 + lane] = a4;
                __syncthreads();
                if (wid < 5) { float sum = 0.f;
#pragma unroll
                    for (int w8 = 0; w8 < 8; ++w8) sum += red[(w8 * 5 + wid) * 64 + lane];
                    MOD[((size_t)l * 5 + wid) * MODW + j] = sum + p.in[I_ADAB][(size_t)l * MODW + j]; }
                __syncthreads();
            }
        }
        {
            __syncthreads();
            float* scr = (float*)(lds + wid * 8448);
            constexpr int T_IN = (INWP / 32) * (D / 64), T_UQ = (QUPWP / 32) * (512 / 64), T_UKV = (KVUPW / 32) * (256 / 64), T_O = (D / 32) * (D / 64), T_UP = (DFF2 / 32) * (D / 64), T_DN = (D / 32) * (DFF / 64);
            constexpr int T_L = T_IN + T_UQ + T_UKV + T_O + T_UP + T_DN;
            for (int u = gw; u < DEPTH * T_L; u += NGW) {
                const int l = u / T_L; int r = u % T_L; bf16_t* wlp = WB + (size_t)l * W_LAYER;
                const float* Wsrc; const float* ksc = nullptr; bf16_t* dst; int Kd, Nd, mode;
                if (r < T_IN) { Wsrc = p.in[I_WIN] + (size_t)l * D * INW; Kd = D; Nd = INW; dst = wlp + W_IN; mode = 1; }
                else if ((r -= T_IN) < T_UQ) { Wsrc = p.in[I_WUQ] + (size_t)l * 512 * QUPW; Kd = 512; Nd = QUPW; dst = wlp + W_UQ; mode = 0; ksc = p.in[I_QNORM] + l * 512; }
                else if ((r -= T_UQ) < T_UKV) { Wsrc = p.in[I_WUKV] + (size_t)l * 256 * KVUPW; Kd = 256; Nd = KVUPW; dst = wlp + W_UKV; mode = 3; ksc = p.in[I_KVNORM] + l * 256; }
                else if ((r -= T_UKV) < T_O) { Wsrc = p.in[I_WO] + (size_t)l * D * D; Kd = D; Nd = D; dst = wlp + W_O; mode = 3; }
                else if ((r -= T_O) < T_UP) { Wsrc = p.in[I_WUP] + (size_t)l * D * DFF2; Kd = D; Nd = DFF2; dst = wlp + W_UP; mode = 2; }
                else { r -= T_UP; Wsrc = p.in[I_WDN] + (size_t)l * DFF * D; Kd = DFF; Nd = D; dst = wlp + W_DN; mode = 3; }
                cvt_item(Wsrc, Kd, Nd, dst, mode, ksc, r, Kd / 64, scr, lane);
            }
        }
    }
    PH_END

    PH_BEGIN(1)
    {
        f32x4 va[8], vb[8];
#define G1_SRC(ROW) ((ROW) < NLAT ? p.in[I_X] + (size_t)(ROW) * D : p.in[I_CTX] + (size_t)((ROW) - NLAT) * D)
#define G1_LOAD(VA, ROW) do { const float* s_ = G1_SRC(ROW) + 4 * lane; _Pragma("unroll") for (int j = 0; j < 8; ++j) VA[j] = *(const f32x4*)(s_ + 256 * j); } while (0)
#define G1_STORE(VA, ROW) do { const float* mp_ = MOD + (size_t)mod_index(ROW) * MODW; \
        _Pragma("unroll") for (int j = 0; j < 8; ++j) { const int c = 4 * lane + 256 * j; \
            st_f16x4(XH + (size_t)(ROW) * D + c, VA[j]); \
            st_bf16x4(H + (size_t)(ROW) * D + c, VA[j] * (*(const f32x4*)(mp_ + D + c) + 1.0f) + *(const f32x4*)(mp_ + c)); } } while (0)
        int row = gw;
        if (row < NROWS) G1_LOAD(va, row);
        for (; row < NROWS; row += 2 * NGW) {
            if (row + NGW < NROWS) G1_LOAD(vb, row + NGW);
            SBAR();
            G1_STORE(va, row);
            if (row + NGW < NROWS) {
                if (row + 2 * NGW < NROWS) G1_LOAD(va, row + 2 * NGW);
                SBAR();
                G1_STORE(vb, row + NGW);
            }
        }
#undef G1_SRC
#undef G1_LOAD
#undef G1_STORE
    }
    PH_END

    for (int l = 0; l < DEPTH; ++l) {
        const bool last = (l == DEPTH - 1);
        const int nMfull = last ? 128 : 132;
        lcur = l;

        PH_BEGIN(2)
        for (int rep_ = 0; rep_ < NREP(0); ++rep_) { pg8::Gemm gm{H, wl + W_IN, D, D}; pg8::TileOrder S; S.init(132, INWP / 256, G, bid, -1);
          pg8::EpiProj E{PROJ, RS, thc, ths, tmc, tms};
          pg8::gemm_phase<pg8::EpiProj, pg8::TileOrder>(ldsl, gm, S, E); }
        PH_END

        PH_BEGIN(3)
        if (SUB(0)) for (int rep_ = 0; rep_ < NREP(1); ++rep_) { pg8::Gemm gm{PROJ + 3328, wl + W_UQ, INW, 512}; pg8::TileOrder S; S.init(132, QUPWP / 256, G, bid, -1);
          pg8::EpiQup E{QUP, RS, tmc, tms};
          pg8::gemm_phase<pg8::EpiQup, pg8::TileOrder>(ldsl, gm, S, E); }
        if (SUB(1)) for (int rep_ = 0; rep_ < NREP(2); ++rep_) { pg8::Gemm gm{PROJ + 3840, wl + W_UKV, INW, 256}; pg8::TileOrder S; S.init(132, KVUPW / 256, G, (G == 256) ? ((bid + 104) & 255) : bid, -1);
          pg8::EpiKvup E{KVUP, RS};
          pg8::gemm_phase<pg8::EpiKvup, pg8::TileOrder>(ldsl, gm, S, E); }
        if (SUB(2)) for (int rep_ = 0; rep_ < NREP(3); ++rep_) for (int u = (G == 256) ? ((bid + 80) & 255) : bid; u < NB * 4 * 33; u += G) {
            const int n = u % 33, h = (u / 33) & 3, bb = u / 132;
            const float lgf2 = log2_sigmoid(SM[SM_DECF + l * 4 + h]), lgb2 = log2_sigmoid(SM[SM_DECB + l * 4 + h]);
            ret_kv_unit(PROJ, KVS, bb, h, n, lgf2, lgb2, lds);
        }
        PH_END

        PH_BEGIN(4)
        if (SUB(3)) for (int rep_ = 0; rep_ < NREP(4); ++rep_) ret_scan(KVS, SIN, SM + SM_DECF + l * 4, SM + SM_DECB + l * 4, gtid, gthreads);
        if (SUB(4)) for (int rep_ = 0; rep_ < NREP(5); ++rep_) {
            const int nun = last ? 768 : 792;
            for (int u = bid; u < nun; u += G) {
                AttnArgs a;
                int bb, h, qrow;
                if (u < 768) { const int rnd = u / G, w_ = u % G; const int bh = (G == 256) ? (rnd * 8 + (w_ & 7)) : (u >> 5); const int qb = (G == 256) ? (w_ >> 3) : (u & 31); h = bh % 6; bb = bh / 6; qrow = bb * SEQ + qb * 256; a.nt = 132; a.seg0_tiles = 128; a.seg0_row = bb * SEQ; a.seg1_row = NLAT + bb * CTXL; }
                else { const int v = u - 768; h = v % 6; bb = v / 6; qrow = NLAT + bb * CTXL; a.nt = 4; a.seg0_tiles = 4; a.seg0_row = NLAT + bb * CTXL; a.seg1_row = a.seg0_row; }
                a.Q = QUP + (size_t)qrow * QUPW + h * 192; a.ldq = QUPW;
                a.K = KVUP + h * 256; a.ldk = KVUPW; a.KR = PROJ + 4096; a.ldkr = INW; a.V = KVUP + h * 256 + 128; a.ldv = KVUPW;
                a.O = Y + (size_t)qrow * D + 1280 + h * 128; a.ldo = D;
                a.qpos0 = 0; a.masked = 0; a.sink_l2 = 0.f; a.has_sink = 0; a.C = 1.0f;
                attn_body<192>(a, lds);
            }
        }
        if (SUB(5)) for (int rep_ = 0; rep_ < NREP(6); ++rep_) {
            const int nun = last ? 768 : 792;
            for (int u = bid; u < nun; u += G) {
                AttnArgs a;
                int bb, h, qrow;
                if (u < 768) { const int rnd = u / G, w_ = u % G; const int bh = (G == 256) ? (rnd * 8 + (w_ & 7)) : (u >> 5); const int qb = (G == 256) ? (w_ >> 3) : (u & 31); h = bh % 6; bb = bh / 6; qrow = bb * SEQ + qb * 256; a.nt = 12; a.seg0_tiles = 4; a.seg0_row = NLAT + bb * CTXL; a.seg1_row = bb * SEQ + qb * 256 - 128; a.qpos0 = qb * 256; a.masked = 1; }
                else { const int v = u - 768; h = v % 6; bb = v / 6; qrow = NLAT + bb * CTXL; a.nt = 4; a.seg0_tiles = 4; a.seg0_row = NLAT + bb * CTXL; a.seg1_row = a.seg0_row; a.qpos0 = 0; a.masked = 0; }
                const int kvh = h / 3;
                a.Q = PROJ + (size_t)qrow * INW + 2048 + h * 128; a.ldq = INW;
                a.K = PROJ + 2816 + kvh * 128; a.ldk = INW; a.KR = a.K; a.ldkr = INW; a.V = PROJ + 3072 + kvh * 128; a.ldv = INW;
                a.O = Y + (size_t)qrow * D + 512 + h * 128; a.ldo = D;
                a.sink_l2 = SM[SM_SINK + l * 6 + h] * LOG2E; a.has_sink = 1; a.C = 1.0f;
                attn_body<128>(a, lds);
            }
        }
        PH_END

        PH_BEGIN(5)
        for (int rep_ = 0; rep_ < NREP(7); ++rep_) for (int u = bid; u < NB * 4 * 33; u += G) {
            const int n = u % 33, h = (u / 33) & 3, bb = u / 132;
            if (last && n == 32) continue;
            const float lgf2 = log2_sigmoid(SM[SM_DECF + l * 4 + h]), lgb2 = log2_sigmoid(SM[SM_DECB + l * 4 + h]);
            ret_out_unit(PROJ, SIN, Y, bb, h, n, lgf2, lgb2, lds);
        }
        PH_END

        PH_BEGIN(6)
        for (int rep_ = 0; rep_ < NREP(10); ++rep_) { pg8::Gemm gm{Y, wl + W_O, D, D}; pg8::TileOrder S; S.init(nMfull, D / 256, G, bid, -1);
          pg8::EpiMix E{MIX, -1, rep_ + 1 < NREP(10)};
          pg8::gemm_phase<pg8::EpiMix, pg8::TileOrder>(ldsl, gm, S, E); }
        PH_END

        PH_BEGIN(7)
        ln_phase(XH, MIX, (float*)nullptr, XH, H, SM + SM_LN1G + l * D, SM + SM_LN1B + l * D, modl + 2 * D, modl + 4 * D, modl + 3 * D, last ? NLAT : NROWS, bid, G, lds);
        PH_END

#define FFN_UP(cc, nMc, skn, ski) for (int rep_ = 0; rep_ < NREP(8); ++rep_) { pg8::Gemm gm{H, wl + W_UP, D, D}; pg8::TileOrder S; S.init(nMc, DFF2 / 256, G, bid, cc, skn, ski); \
              pg8::EpiUpConv E{cc ? ACT1 : ACT0, SB, SM + SM_CONVW + (size_t)l * 3 * DFF, SM + SM_CONVB + (size_t)l * DFF, cc}; pg8::gemm_phase<pg8::EpiUpConv, pg8::TileOrder>(ldsl, gm, S, E); }
#define FFN_DOWN(cc, nMc) for (int rep_ = 0; rep_ < NREP(11); ++rep_) { pg8::Gemm gm{cc ? ACT1 : ACT0, wl + W_DN, DFF, DFF}; pg8::TileOrder S; S.init(nMc, D / 256, G, bid, -1); \
              pg8::EpiMix E{MIX, cc, rep_ + 1 < NREP(11)}; pg8::gemm_phase<pg8::EpiMix, pg8::TileOrder>(ldsl, gm, S, E); }
#define FFN_FIX(ACTc, nrows) { \
                const float* cw = SM + SM_CONVW + (size_t)l * 3 * DFF; \
                const int ngr = (nrows) / 64; \
                for (int it = gtid; it < 2 * ngr * (DFF / 4); it += gthreads) { \
                    const int f = (it % (DFF / 4)) * 4, gk = it / (DFF / 4), kind = gk / ngr, gi = gk % ngr; \
                    const int rg = gi * 64, smask = rg < FCH_LAT ? (SEQ - 1) : (CTXL - 1); \
                    const bool edge = kind ? (((rg + 63) & smask) == smask) : ((rg & smask) == 0); \
                    if (edge) continue; \
                    const float* sp = SB + ((size_t)(kind * NGRP + gi) * 3) * DFF + f; \
                    const float* np_ = SB + ((size_t)((1 - kind) * NGRP + (kind ? gi + 1 : gi - 1)) * 3 + 2) * DFF + f; \
                    const f32x4 z = *(const f32x4*)sp + *(const f32x4*)(cw + (kind ? 2 * DFF : 0) + f) * *(const f32x4*)np_; const f32x4 uu = *(const f32x4*)(sp + DFF); \
                    u32x2 ow; ow[0] = cvtpk(silu_f(z[0]) * uu[0], silu_f(z[1]) * uu[1]); ow[1] = cvtpk(silu_f(z[2]) * uu[2], silu_f(z[3]) * uu[3]); \
                    *(u32x2*)((ACTc) + (size_t)(rg + (kind ? 63 : 0)) * DFF + f) = ow; } }
        {
            const int nM0 = last ? 64 : 68, rows0 = last ? FCH_LAT : FCH_ROWS;
            const int skn = last ? 0 : 32;
            PH_BEGIN(8)
            FFN_UP(0, nM0, 0, 0)
            PH_END
            PH_BEGIN(9)
            FFN_FIX(ACT0, rows0)
            PH_END
            PH_BEGIN(10)
            FFN_DOWN(0, nM0)
            FFN_UP(1, 64, skn, 8)
            PH_END
            PH_BEGIN(11)
            FFN_FIX(ACT1, FCH_LAT)
            PH_END
            PH_BEGIN(12)
            FFN_DOWN(1, 64)
            PH_END
        }
#undef FFN_UP
#undef FFN_DOWN
#undef FFN_FIX

        PH_BEGIN(13)
        { const float* modn = MOD + (size_t)(last ? l : l + 1) * 5 * MODW;
          ln_phase(XH, MIX, last ? p.out : (float*)nullptr, XH, last ? (bf16_t*)nullptr : H, SM + SM_LN2G + l * D, SM + SM_LN2B + l * D, modl + 5 * D, modn + D, modn, last ? NLAT : NROWS, bid, G, lds); }
        PH_END
    }
#undef PH_BEGIN
#undef PH_END
}

constexpr int N_PHASES = 2 + DEPTH * 12;

extern "C" void kernel_launch(void* const* d_in, const int* in_sizes, int n_in, void* d_out, int out_size, void* d_ws, size_t ws_size, hipStream_t stream) {
    static int grid = 0;
    if (grid == 0) {
        if (n_in != 23 || in_sizes[0] != NLAT * D || out_size != NLAT * D || ws_size < WS_END) {
            fprintf(stderr, "kernel_launch: unexpected shapes: n_in %d in0 %d out %d ws %zu (need %zu)\n", n_in, n_in > 0 ? in_sizes[0] : -1, out_size, ws_size, (size_t)WS_END); grid = -1; return; }
        int dev = 0, cus = 0, per_cu = 0;
        if (hipGetDevice(&dev) != hipSuccess || hipDeviceGetAttribute(&cus, hipDeviceAttributeMultiprocessorCount, dev) != hipSuccess) { fprintf(stderr, "kernel_launch: device query failed\n"); grid = -1; return; }
        if (hipFuncSetAttribute((const void*)fwd_kernel, hipFuncAttributeMaxDynamicSharedMemorySize, LDS_BYTES) != hipSuccess) { fprintf(stderr, "kernel_launch: hipFuncSetAttribute failed\n"); grid = -1; return; }
        if (hipOccupancyMaxActiveBlocksPerMultiprocessor(&per_cu, (const void*)fwd_kernel, 512, LDS_BYTES) != hipSuccess || per_cu < 1) {
            fprintf(stderr, "kernel_launch: occupancy query reports %d workgroups per CU\n", per_cu); (void)hipGetLastError(); grid = -1; return; }
        grid = cus;
    }
    if (grid < 0) return;
    if (hipMemsetAsync((char*)d_ws + WS_CTL, 0, CTL_BYTES, stream) != hipSuccess) { fprintf(stderr, "kernel_launch: memset failed\n"); return; }
    Params p{};
    for (int i = 0; i < 23; ++i) p.in[i] = (const float*)d_in[i];
    p.out = (float*)d_out; p.ws = (unsigned char*)d_ws; p.pad = 0;
#if MK_ONE_LAUNCH
    p.ph_lo = 0; p.ph_hi = N_PHASES; p.bar_region = 0;
    hipLaunchKernelGGL(fwd_kernel, dim3(grid), dim3(512), LDS_BYTES, stream, p);
#else
    for (int g = 0; g < N_PHASES; ++g) { p.ph_lo = g; p.ph_hi = g + 1; p.bar_region = 0;
        hipLaunchKernelGGL(fwd_kernel, dim3(grid), dim3(512), LDS_BYTES, stream, p); }
#endif
    const hipError_t le = hipPeekAtLastError();
    if (le != hipSuccess) fprintf(stderr, "kernel_launch: launch failed: %s\n", hipGetErrorName(le));
}
```

```cpp
#include <hip/hip_runtime.h>
#include <cstdio>
#include <cstdint>

#define LAS __attribute__((address_space(3)))
typedef unsigned short bf16_t;
typedef short bf16x8 __attribute__((ext_vector_type(8)));
typedef short s16x4 __attribute__((ext_vector_type(4)));
typedef float f32x4 __attribute__((ext_vector_type(4)));
typedef float f32x16 __attribute__((ext_vector_type(16)));
typedef unsigned u32x4 __attribute__((ext_vector_type(4)));
typedef unsigned u32x2 __attribute__((ext_vector_type(2)));

#ifndef MK_ONE_LAUNCH
#define MK_ONE_LAUNCH 1
#endif

constexpr int D = 2048, NB = 4, SEQ = 8192, DEPTH = 4, CTXL = 256;
constexpr int NLAT = NB * SEQ, NCTX = NB * CTXL, NROWS = NLAT + NCTX;
constexpr int INW = 4160, INWP = 4352, DFF = 5632, DFF2 = 11264;
constexpr int QUPW = 1152, QUPWP = 1280, KVUPW = 1536;
constexpr int NMOD = 6, MODW = NMOD * D;
constexpr float LN_EPS = 1e-5f, RMS_EPS = 1e-6f;
constexpr float ALPHA = 1.6817928305074292f;
constexpr float KSCALE = 0.08838834764831845f;
constexpr float MLA_QSCALE = 0.07216878364870323f * 1.4426950408889634f;
constexpr float LOG2E = 1.4426950408889634f;

constexpr size_t MiB = 1u << 20;
constexpr size_t WS_CTL = 0, CTL_BYTES = 1 * MiB;
constexpr size_t WS_MOD = 1 * MiB;
constexpr size_t WS_ROPE = 2 * MiB;
constexpr size_t WS_SM = 2 * MiB + 65536;
constexpr int SM_DECF = 0, SM_DECB = 16, SM_SINK = 32, SM_LN1G = 64, SM_LN1B = SM_LN1G + DEPTH * D, SM_LN2G = SM_LN1B + DEPTH * D, SM_LN2B = SM_LN2G + DEPTH * D,
              SM_CONVW = SM_LN2B + DEPTH * D, SM_CONVB = SM_CONVW + DEPTH * 3 * DFF, SM_END = SM_CONVB + DEPTH * DFF;
static_assert(WS_SM + (size_t)SM_END * 4 <= 3 * MiB, "small vectors");
constexpr size_t WS_RS = 3 * MiB;
constexpr size_t WS_W = 5 * MiB;
constexpr size_t W_IN = 0, W_UQ = W_IN + (size_t)INWP * D, W_UKV = W_UQ + (size_t)QUPWP * 512, W_O = W_UKV + (size_t)KVUPW * 256,
                 W_UP = W_O + (size_t)D * D, W_DN = W_UP + (size_t)DFF2 * D, W_LAYER = W_DN + (size_t)D * DFF;
constexpr size_t WS_X = WS_W + W_LAYER * 2 * DEPTH;
constexpr size_t WS_H = WS_X + (size_t)NROWS * D * 4;
constexpr size_t WS_Y = WS_H + (size_t)NROWS * D * 2;
constexpr size_t WS_PROJ = WS_Y + (size_t)NROWS * D * 2;
constexpr size_t WS_QUP = WS_PROJ + (size_t)NROWS * INW * 2;
constexpr size_t WS_KVUP = WS_QUP + (size_t)NROWS * QUPW * 2;
constexpr size_t WS_KVS = WS_KVUP + (size_t)NROWS * KVUPW * 2;
constexpr size_t WS_SIN = WS_KVS + (size_t)NB * 4 * 2 * 33 * 16384 * 4;
constexpr size_t WS_END = WS_SIN + (size_t)NB * 4 * 2 * 33 * 16384 * 2;
constexpr int FCH_LAT = 64 * 256, FCH_ROWS = FCH_LAT + NCTX;
constexpr size_t WS_ACT0 = WS_Y;
constexpr size_t WS_ACT1 = WS_ACT0 + (size_t)FCH_ROWS * DFF * 2;
constexpr int NGRP = FCH_ROWS / 64;
constexpr size_t WS_SB = WS_ACT1 + (size_t)FCH_LAT * DFF * 2;
static_assert(WS_SB + (size_t)2 * NGRP * 3 * DFF * 4 <= WS_QUP, "FFN overlay");
constexpr size_t WS_MIX = WS_QUP;
static_assert(WS_MIX >= WS_QUP && WS_MIX + (size_t)NROWS * D * 2 <= WS_END, "FFN overlay");
static_assert(WS_W % 256 == 0 && W_LAYER % 128 == 0 && WS_X % 256 == 0, "align");

constexpr int LDS_BYTES = 131072 + 512;

#define XB_TMO      128
#define XB_XCNT(j)  (256  + 64 * (j))
#define XB_XSUB(j)  (1280 + 64 * (j))
#define XB_XGEN(j)  (2304 + 64 * (j))
#define XB_TOP      3328
#define XB_TOPGEN   3392
#define XCD_BAR_WORDS 3456
#define XB_SPIN_CAP (1u << 20)

__device__ __forceinline__ unsigned xb_ld(unsigned* p)              { return __hip_atomic_load(p, __ATOMIC_RELAXED, __HIP_MEMORY_SCOPE_AGENT); }
__device__ __forceinline__ unsigned xb_add(unsigned* p, unsigned v) { return __hip_atomic_fetch_add(p, v, __ATOMIC_RELAXED, __HIP_MEMORY_SCOPE_AGENT); }
__device__ __forceinline__ unsigned xb_xcc_id() { return (unsigned)__builtin_amdgcn_s_getreg((3 << 11) | 20) & 0xFu; }
#define XB_SPIN(cond, bar) do { unsigned _sp = 0; while (cond) { __builtin_amdgcn_s_sleep(1); \
    if ((++_sp & 255u) == 0u) { if (xb_ld(&(bar)[XB_TMO])) break; if (_sp > XB_SPIN_CAP) { atomicAdd(&(bar)[XB_TMO], 1u); break; } } } } while (0)

struct XcdBarrier { unsigned* bar; unsigned x; volatile LAS unsigned* st; };

__device__ __forceinline__ XcdBarrier xcd_barrier_post(unsigned* bar, volatile LAS unsigned* st) {
    XcdBarrier b; b.bar = bar; b.x = xb_xcc_id(); b.st = st;
    if (threadIdx.x == 0) (void)xb_add(&bar[XB_XCNT(b.x)], 1u);
    return b;
}
__device__ __forceinline__ void xcd_barrier_complete(unsigned* bar, unsigned x, unsigned& nloc, unsigned& nx) {
    const unsigned G = gridDim.x * gridDim.y * gridDim.z;
    unsigned sum, cnt, mine, sp = 0u;
    for (;;) {
        sum = 0u; cnt = 0u; mine = 0u;
#pragma unroll
        for (unsigned j = 0; j < 16; ++j) { const unsigned c = xb_ld(&bar[XB_XCNT(j)]); sum += c; cnt += (c > 0u) ? 1u : 0u; mine = (j == x) ? c : mine; }
        if (sum == G) break;
        __builtin_amdgcn_s_sleep(1);
        if ((++sp & 255u) == 0u) { if (xb_ld(&bar[XB_TMO])) break; if (sp > XB_SPIN_CAP) { atomicAdd(&bar[XB_TMO], 1u); break; } }
    }
    nloc = mine > 0u ? mine : 1u; nx = cnt > 0u ? cnt : 1u;
}
__device__ __forceinline__ void xcd_barrier(const XcdBarrier& b) {
    asm volatile("s_waitcnt vmcnt(0)" ::: "memory");
    __syncthreads();
    if (threadIdx.x == 0) {
        unsigned* bar = b.bar;
        __builtin_amdgcn_s_waitcnt(0);
        unsigned nloc = b.st[0], nx = b.st[1];
        if (nloc == 0u) { xcd_barrier_complete(bar, b.x, nloc, nx); b.st[0] = nloc; b.st[1] = nx; }
        const unsigned old = xb_add(&bar[XB_XSUB(b.x)], 1u);
        const unsigned gen = old / nloc;
        if (old + 1u == (gen + 1u) * nloc) {
            __builtin_amdgcn_fence(__ATOMIC_RELEASE, "agent");
            asm volatile("s_waitcnt vmcnt(0)" ::: "memory");
            const unsigned og = xb_add(&bar[XB_TOP], 1u);
            const unsigned tg = og / nx;
            if (og + 1u == (tg + 1u) * nx) xb_add(&bar[XB_TOPGEN], 1u);
            else XB_SPIN(xb_ld(&bar[XB_TOPGEN]) == tg, bar);
            __builtin_amdgcn_fence(__ATOMIC_ACQUIRE, "agent");
            xb_add(&bar[XB_XGEN(b.x)], 1u);
            asm volatile("s_waitcnt vmcnt(0)" ::: "memory");
        } else {
            XB_SPIN(xb_ld(&bar[XB_XGEN(b.x)]) == gen, bar);
            __builtin_amdgcn_fence(__ATOMIC_ACQUIRE, "agent");
            asm volatile("s_waitcnt vmcnt(0)" ::: "memory");
        }
    }
    __syncthreads();
}

__device__ __forceinline__ unsigned cvtpk(float lo, float hi) { unsigned r; asm volatile("v_cvt_pk_bf16_f32 %0, %1, %2" : "=v"(r) : "v"(lo), "v"(hi)); return r; }
__device__ __forceinline__ float bf2f(unsigned short b) { return __uint_as_float(((unsigned)b) << 16); }
__device__ __forceinline__ float bflo(unsigned w) { return __uint_as_float(w << 16); }
__device__ __forceinline__ float bfhi(unsigned w) { return __uint_as_float(w & 0xffff0000u); }
__device__ __forceinline__ void st_bf16x4(bf16_t* p, f32x4 v) { u32x2 w; w.x = cvtpk(v[0], v[1]); w.y = cvtpk(v[2], v[3]); *(u32x2*)p = w; }
typedef _Float16 f16x4 __attribute__((ext_vector_type(4)));
__device__ __forceinline__ void st_f16x4(bf16_t* p, f32x4 v) { *(f16x4*)p = __builtin_convertvector(v, f16x4); }
__device__ __forceinline__ f32x4 cvt_f16x4(u32x2 w) { return __builtin_convertvector(__builtin_bit_cast(f16x4, w), f32x4); }
__device__ __forceinline__ float silu_f(float x) { return x * __builtin_amdgcn_rcpf(1.0f + __builtin_amdgcn_exp2f(-1.4426950408889634f * x)); }
__device__ __forceinline__ float wave_sum(float v) {
#pragma unroll
    for (int o = 1; o < 64; o <<= 1) v += __shfl_xor(v, o);
    return v;
}
__device__ __forceinline__ int otid() { int t = threadIdx.x; asm volatile("" : "+v"(t)); return t; }
__device__ __forceinline__ int mod_index(int row) { return row < NLAT ? (row >> 13) : 4; }

namespace pg8 {
constexpr int BM = 256, BK = 64, HALF = 128, HTB = HALF * BK * 2, STAGE_BYTES = 8 * HTB, NXCD = 8, WGM = 8;
__host__ __device__ __forceinline__ int lds_byte(int r, int c) { const int st = (r >> 4) * 2 + (c >> 5), rr = r & 15, cc = c & 31, ob = rr * 64 + cc * 2; return st * 1024 + (ob ^ (((ob >> 9) & 1) << 5)); }
__host__ __device__ __forceinline__ void stage_rc(int b, int& R, int& C) { const int st = b / 1024, sb = b % 1024, swz = sb ^ (((sb >> 9) & 1) << 5); R = (st >> 1) * 16 + swz / 64; C = (st & 1) * 32 + (swz % 64) / 2; }

struct Unit { int pm, pn; };
struct Gemm { const bf16_t* A; const bf16_t* Bt; int lda, K; };

struct TileOrder {
    int nM, nN, nwg, G, c, chunk, skew_n, skew_i;
    __device__ __forceinline__ void init(int nM_, int nN_, int G_, int c_, int chunk_, int skew_n_ = 0, int skew_i_ = 0) { nM = nM_; nN = nN_; nwg = nM * nN; G = G_; c = c_; chunk = chunk_; skew_n = skew_n_; skew_i = skew_i_; }
    __device__ __forceinline__ bool next(int i, Unit& u) const {
        long L;
        if (skew_n == 0 || i < skew_i) L = (long)i * G + c;
        else { if (c < skew_n) return false; L = (long)skew_i * G + (long)(i - skew_i) * (G - skew_n) + (c - skew_n); }
        if (L >= nwg) return false;
        int wgid = (int)L; { const int q = nwg / NXCD, r = nwg % NXCD, xcd = wgid % NXCD, off = wgid / NXCD; wgid = (xcd < r ? xcd * (q + 1) : r * (q + 1) + (xcd - r) * q) + off; }
        const int nig = WGM * nN, gid = wgid / nig, fm = gid * WGM, gsz = (nM - fm) < WGM ? (nM - fm) : WGM;
        int pm = fm + ((wgid % nig) % gsz); u.pn = (wgid % nig) / gsz;
        if (chunk >= 0) pm = (pm < 64) ? 64 * chunk + pm : 128 + (pm - 64);
        u.pm = pm; return true;
    }
    __device__ __forceinline__ void a_ready(const Unit&) const {}
    __device__ __forceinline__ void done(const Unit&) const {}
};

template <class Epi, class Sched>
__device__ __forceinline__ void gemm_phase(LAS unsigned char* lds, const Gemm g, const Sched& S, const Epi& E) {
    const int tid = otid(), wid = __builtin_amdgcn_readfirstlane(tid >> 6), lane = tid & 63, wr = wid >> 2, wc = wid & 3, fr = lane & 15, fq = lane >> 4;
    const int K = g.K, nt = K / BK, lda = g.lda;
    unsigned voffA[2], voffB[2];
#pragma unroll
    for (int i = 0; i < 2; ++i) { int R, C; stage_rc(tid * 16 + i * 8192, R, C);
        voffA[i] = (unsigned)(R * lda + C) * 2u; voffB[i] = (unsigned)(R * K + C) * 2u; }
    const size_t kstep = (size_t)(BK * 2);
    const size_t hstepA = (size_t)HALF * lda * 2, hstepB = (size_t)HALF * K * 2;
    const size_t tstepA = 2 * hstepA, tstepB = 2 * hstepB;
    const unsigned ldsw = (unsigned)wid * 1024u;
    const int aoff = lds_byte(wr * 64 + fr, fq * 8), boff = lds_byte(wc * 32 + fr, fq * 8);
#define PG8_SA(b, h) (((b) * 2 + (h)) * HTB)
#define PG8_SB(b, h) ((4 + (b) * 2 + (h)) * HTB)
#define PG8_STAGE(bufoff, gbase, voff) do { const char* gb_ = (const char*)(gbase); asm volatile("" : "+s"(gb_));        \
        _Pragma("unroll") for (int _i = 0; _i < 2; ++_i) \
        __builtin_amdgcn_global_load_lds((const unsigned*)(gb_ + (voff)[_i]), (LAS unsigned*)(lds + (bufoff) + ldsw + _i * 8192), 16, 0, 0); } while (0)
#define PG8_LDA(dst, b, h) do { _Pragma("unroll") for (int m = 0; m < 4; ++m) _Pragma("unroll") for (int k = 0; k < 2; ++k) dst[m][k] = *(const LAS bf16x8*)(lds + PG8_SA(b, h) + aoff + m * 2048 + k * 1024); } while (0)
#define PG8_LDB(dst, b, h) do { _Pragma("unroll") for (int n = 0; n < 2; ++n) _Pragma("unroll") for (int k = 0; k < 2; ++k) dst[n][k] = *(const LAS bf16x8*)(lds + PG8_SB(b, h) + boff + n * 2048 + k * 1024); } while (0)
#define PG8_MMA(ai, bj, At, Bt) do { __builtin_amdgcn_s_setprio(1); _Pragma("unroll") for (int m = 0; m < 4; ++m) _Pragma("unroll") for (int n = 0; n < 2; ++n) _Pragma("unroll") for (int k = 0; k < 2; ++k) \
        acc[ai][bj][m][n] = __builtin_amdgcn_mfma_f32_16x16x32_bf16(Bt[n][k], At[m][k], acc[ai][bj][m][n], 0, 0, 0); __builtin_amdgcn_s_setprio(0); } while (0)
#define PG8_WAIT_V(n) asm volatile("s_waitcnt vmcnt(" #n ")" ::: "memory")
#define PG8_WAIT_L(n) asm volatile("s_waitcnt lgkmcnt(" #n ")" ::: "memory")
#define PG8_BAR __builtin_amdgcn_s_barrier()
#define PG8_SCHED __builtin_amdgcn_sched_barrier(0)
    Unit cur, nxt; int ui = 0;
    if (!S.next(0, cur)) return;
    f32x4 acc[2][2][4][2];
#pragma unroll
    for (int a = 0; a < 2; ++a)
#pragma unroll
        for (int b = 0; b < 2; ++b)
#pragma unroll
            for (int m = 0; m < 4; ++m)
#pragma unroll
                for (int n = 0; n < 2; ++n) acc[a][b][m][n] = (f32x4){0.f, 0.f, 0.f, 0.f};
    bf16x8 At[4][2], B0[2][2], B1[2][2];
    const char* cA = (const char*)g.A + (size_t)cur.pm * tstepA; const char* cB = (const char*)g.Bt + (size_t)cur.pn * tstepB;
    S.a_ready(cur);
    PG8_STAGE(PG8_SB(0, 0), cB, voffB); PG8_STAGE(PG8_SA(0, 0), cA, voffA); PG8_STAGE(PG8_SB(0, 1), cB + hstepB, voffB); PG8_STAGE(PG8_SA(0, 1), cA + hstepA, voffA);
    if (wr == 1) PG8_BAR;
    PG8_WAIT_V(4); PG8_BAR;
    PG8_STAGE(PG8_SB(1, 0), cB + kstep, voffB); PG8_STAGE(PG8_SA(1, 0), cA + kstep, voffA); PG8_STAGE(PG8_SB(1, 1), cB + hstepB + kstep, voffB);
    PG8_WAIT_V(6); PG8_BAR;
    for (;;) {
        const bool has_next = S.next(ui + 1, nxt);
        const char* nA = has_next ? (const char*)g.A + (size_t)nxt.pm * tstepA : cA; const char* nB = has_next ? (const char*)g.Bt + (size_t)nxt.pn * tstepB : cB;
#pragma nounroll
        for (int t = 0; t < nt; t += 2) {
            asm volatile("" : "+v"(voffA[0]), "+v"(voffA[1]), "+v"(voffB[0]), "+v"(voffB[1]));
            const bool last = (t == nt - 2);
            const char* a1 = cA + (size_t)(t + 1) * kstep;
            const char* a2 = last ? nA : cA + (size_t)(t + 2) * kstep; const char* b2 = last ? nB : cB + (size_t)(t + 2) * kstep;
            const char* a3 = a2 + kstep; const char* b3 = b2 + kstep;
            if (last && has_next) S.a_ready(nxt);
            PG8_LDB(B0, 0, 0); PG8_SCHED; PG8_LDA(At, 0, 0); PG8_STAGE(PG8_SA(1, 1), a1 + hstepA, voffA);
            PG8_WAIT_L(8); PG8_BAR; PG8_WAIT_L(0); PG8_MMA(0, 0, At, B0); PG8_BAR; PG8_SCHED;
            PG8_LDB(B1, 0, 1); PG8_STAGE(PG8_SB(0, 0), b2, voffB);
            PG8_BAR; PG8_WAIT_L(0); PG8_MMA(0, 1, At, B1); PG8_BAR;
            PG8_LDA(At, 0, 1); PG8_STAGE(PG8_SA(0, 0), a2, voffA);
            PG8_BAR; PG8_WAIT_L(0); PG8_MMA(1, 0, At, B0); PG8_BAR; PG8_SCHED;
            PG8_STAGE(PG8_SB(0, 1), b2 + hstepB, voffB);
            PG8_WAIT_V(6); PG8_BAR; PG8_MMA(1, 1, At, B1); PG8_BAR;
            PG8_LDB(B0, 1, 0); PG8_SCHED; PG8_LDA(At, 1, 0); PG8_STAGE(PG8_SA(0, 1), a2 + hstepA, voffA);
            PG8_WAIT_L(8); PG8_BAR; PG8_WAIT_L(0); PG8_MMA(0, 0, At, B0); PG8_BAR; PG8_SCHED;
            PG8_LDB(B1, 1, 1); PG8_STAGE(PG8_SB(1, 0), b3, voffB);
            PG8_BAR; PG8_WAIT_L(0); PG8_MMA(0, 1, At, B1); PG8_BAR;
            PG8_LDA(At, 1, 1); PG8_STAGE(PG8_SA(1, 0), a3, voffA);
            PG8_BAR; PG8_WAIT_L(0); PG8_MMA(1, 0, At, B0); PG8_BAR; PG8_SCHED;
            PG8_STAGE(PG8_SB(1, 1), b3 + hstepB, voffB);
            PG8_WAIT_V(6); PG8_BAR; PG8_MMA(1, 1, At, B1); PG8_BAR;
        }
        E(acc, cur, wr, wc, fr, fq); S.done(cur);
        if (!has_next) break;
#pragma unroll
        for (int a = 0; a < 2; ++a)
#pragma unroll
            for (int b = 0; b < 2; ++b)
#pragma unroll
                for (int m = 0; m < 4; ++m)
#pragma unroll
                    for (int n = 0; n < 2; ++n) acc[a][b][m][n] = (f32x4){0.f, 0.f, 0.f, 0.f};
        cur = nxt; cA = nA; cB = nB; ++ui;
    }
    PG8_WAIT_V(0);
    if (wr == 0) PG8_BAR;
    PG8_BAR;
#undef PG8_SA
#undef PG8_SB
#undef PG8_STAGE
#undef PG8_LDA
#undef PG8_LDB
#undef PG8_MMA
#undef PG8_WAIT_V
#undef PG8_WAIT_L
#undef PG8_BAR
#undef PG8_SCHED
}


struct EpiProj {
    bf16_t* P; float* RS; const float* thc; const float* ths; const float* tmc; const float* tms;
    __device__ __forceinline__ void operator()(const f32x4 (&acc)[2][2][4][2], const Unit& u, int wr, int wc, int fr, int fq) const {
        asm volatile("" : "+v"(fr), "+v"(fq));
        const int pn = u.pn; const bool lat = u.pm < 128;
        const int row0 = u.pm * BM + wr * 64 + fr;
        if (pn == 16) {
            if (wc < 2) {
#pragma unroll
                for (int ai = 0; ai < 2; ++ai)
#pragma unroll
                    for (int m = 0; m < 4; ++m) {
                        const int row = row0 + ai * HALF + m * 16; const f32x4 v0 = acc[ai][0][m][0], v1 = acc[ai][0][m][1]; f32x4 o0 = v0, o1 = v1;
                        if (lat) { const int pos = row & (SEQ - 1), tp = wc ? (pos & 63) : (pos >> 6);
                            const f32x4 c = *(const f32x4*)(tmc + tp * 16 + 4 * fq), s = *(const f32x4*)(tms + tp * 16 + 4 * fq);
                            o0 = v0 * c - v1 * s; o1 = v1 * c + v0 * s; }
                        bf16_t* rp = P + (size_t)row * INW + 4096 + 32 * wc + 4 * fq;
                        st_bf16x4(rp, o0); st_bf16x4(rp + 16, o1);
                        asm volatile("" ::: "memory");
                    }
            }
            return;
        }
        const bool roped = (pn < 4) || (pn >= 8 && pn < 12);
        if (roped) {
            const float sc = (pn == 2 || pn == 3) ? KSCALE : ((pn >= 8 && pn <= 10) ? KSCALE * LOG2E : 1.0f);
            const int colb = pn * BM + 128 * (wc >> 1) + 64 * (wc & 1) + 8 * fq;
#pragma unroll
            for (int ai = 0; ai < 2; ++ai)
#pragma unroll
                for (int m = 0; m < 4; ++m) {
                    const int row = row0 + ai * HALF + m * 16; const int pos = row & (SEQ - 1), tp = (wc & 1) ? (pos & 63) : (pos >> 6);
                    u32x4 w0, w1;
#pragma unroll
                    for (int n = 0; n < 2; ++n) {
                        f32x4 c = (f32x4){1.f, 1.f, 1.f, 1.f}, s = (f32x4){0.f, 0.f, 0.f, 0.f};
                        if (lat) { c = *(const f32x4*)(thc + tp * 32 + 8 * fq + 4 * n); s = *(const f32x4*)(ths + tp * 32 + 8 * fq + 4 * n); }
                        const f32x4 v0 = acc[ai][0][m][n] * sc, v1 = acc[ai][1][m][n] * sc;
                        const f32x4 o0 = v0 * c - v1 * s, o1 = v1 * c + v0 * s;
                        w0[2 * n] = cvtpk(o0[0], o0[1]); w0[2 * n + 1] = cvtpk(o0[2], o0[3]); w1[2 * n] = cvtpk(o1[0], o1[1]); w1[2 * n + 1] = cvtpk(o1[2], o1[3]);
                    }
                    bf16_t* rp = P + (size_t)row * INW + colb;
                    *(u32x4*)rp = w0; *(u32x4*)(rp + 32) = w1;
                    asm volatile("" ::: "memory");
                }
            return;
        }
#pragma unroll
        for (int ai = 0; ai < 2; ++ai)
#pragma unroll
            for (int m = 0; m < 4; ++m) {
                const int row = row0 + ai * HALF + m * 16; bf16_t* rp = P + (size_t)row * INW + pn * BM + wc * 32 + 8 * fq; float ss = 0.f;
#pragma unroll
                for (int bj = 0; bj < 2; ++bj) { const f32x4 v0 = acc[ai][bj][m][0], v1 = acc[ai][bj][m][1];
                    u32x4 w; w[0] = cvtpk(v0[0], v0[1]); w[1] = cvtpk(v0[2], v0[3]); w[2] = cvtpk(v1[0], v1[1]); w[3] = cvtpk(v1[2], v1[3]);
                    *(u32x4*)(rp + bj * HALF) = w;
                    ss += ((v0[0] * v0[0] + v0[1] * v0[1]) + (v0[2] * v0[2] + v0[3] * v0[3])) + ((v1[0] * v1[0] + v1[1] * v1[1]) + (v1[2] * v1[2] + v1[3] * v1[3])); }
                if (pn >= 13 && pn <= 15) { ss += __shfl_xor(ss, 16); ss += __shfl_xor(ss, 32); if (fq == 0) RS[(size_t)row * 12 + (pn - 13) * 4 + wc] = ss; }
            }
    }
};
struct EpiQup {
    bf16_t* Q; const float* RS; const float* tmc; const float* tms;
    __device__ __forceinline__ void operator()(const f32x4 (&acc)[2][2][4][2], const Unit& u, int wr, int wc, int fr, int fq) const {
        asm volatile("" : "+v"(fr), "+v"(fq));
        const int pn = u.pn; const bool lat = u.pm < 128; const int row0 = u.pm * BM + wr * 64 + fr;
#pragma unroll
        for (int ai = 0; ai < 2; ++ai)
#pragma unroll
            for (int m = 0; m < 4; ++m) {
                const int row = row0 + ai * HALF + m * 16; const f32x4 r0 = *(const f32x4*)(RS + (size_t)row * 12), r1 = *(const f32x4*)(RS + (size_t)row * 12 + 4);
                const float rs = MLA_QSCALE / sqrtf(((r0[0] + r0[1]) + (r0[2] + r0[3]) + (r1[0] + r1[1]) + (r1[2] + r1[3])) * (1.0f / 512.0f) + RMS_EPS);
                const int pos = row & (SEQ - 1), tp = (wc & 1) ? (pos & 63) : (pos >> 6);
                const f32x4 c = *(const f32x4*)(tmc + tp * 16 + 4 * fq), s = *(const f32x4*)(tms + tp * 16 + 4 * fq);
#pragma unroll
                for (int bj = 0; bj < 2; ++bj) {
                    const int colb = pn * BM + bj * HALF + wc * 32; if (colb >= QUPW) continue;
                    const int c64 = 4 * pn + 2 * bj + (wc >> 1);
                    const f32x4 v0 = acc[ai][bj][m][0] * rs, v1 = acc[ai][bj][m][1] * rs; f32x4 o0 = v0, o1 = v1;
                    if (lat && (c64 % 3) == 2) { o0 = v0 * c - v1 * s; o1 = v1 * c + v0 * s; }
                    bf16_t* rp = Q + (size_t)row * QUPW + colb + 4 * fq; st_bf16x4(rp, o0); st_bf16x4(rp + 16, o1);
                }
                asm volatile("" ::: "memory");
            }
    }
};
struct EpiKvup {
    bf16_t* KV; const float* RS;
    __device__ __forceinline__ void operator()(const f32x4 (&acc)[2][2][4][2], const Unit& u, int wr, int wc, int fr, int fq) const {
        asm volatile("" : "+v"(fr), "+v"(fq));
        const int row0 = u.pm * BM + wr * 64 + fr;
#pragma unroll
        for (int ai = 0; ai < 2; ++ai)
#pragma unroll
            for (int m = 0; m < 4; ++m) {
                const int row = row0 + ai * HALF + m * 16; const f32x4 r0 = *(const f32x4*)(RS + (size_t)row * 12 + 8);
                const float rs = 1.0f / sqrtf(((r0[0] + r0[1]) + (r0[2] + r0[3])) * (1.0f / 256.0f) + RMS_EPS);
                bf16_t* rp = KV + (size_t)row * KVUPW + u.pn * BM + wc * 32 + 8 * fq;
#pragma unroll
                for (int bj = 0; bj < 2; ++bj) { const f32x4 v0 = acc[ai][bj][m][0] * rs, v1 = acc[ai][bj][m][1] * rs;
                    u32x4 w; w[0] = cvtpk(v0[0], v0[1]); w[1] = cvtpk(v0[2], v0[3]); w[2] = cvtpk(v1[0], v1[1]); w[3] = cvtpk(v1[2], v1[3]);
                    *(u32x4*)(rp + bj * HALF) = w; }
                asm volatile("" ::: "memory");
            }
    }
};
struct EpiMix {
    bf16_t* MIX; int chunk; int dry;
    __device__ __forceinline__ void operator()(const f32x4 (&acc)[2][2][4][2], const Unit& u, int wr, int wc, int fr, int fq) const {
        asm volatile("" : "+v"(fr), "+v"(fq));
        if (dry) { float s = 0.f;
#pragma unroll
            for (int ai = 0; ai < 2; ++ai)
#pragma unroll
                for (int bj = 0; bj < 2; ++bj)
#pragma unroll
                    for (int m = 0; m < 4; ++m)
#pragma unroll
                        for (int n = 0; n < 2; ++n) s += (acc[ai][bj][m][n][0] + acc[ai][bj][m][n][1]) + (acc[ai][bj][m][n][2] + acc[ai][bj][m][n][3]);
            if (s == 123456.789f) MIX[0] = (bf16_t)1; return; }
        const int pmg = chunk < 0 ? u.pm : (u.pm < 64 ? 64 * chunk + u.pm : 128 + (u.pm - 64));
        const int row0 = pmg * BM + wr * 64 + fr;
#pragma unroll
        for (int ai = 0; ai < 2; ++ai)
#pragma unroll
            for (int m = 0; m < 4; ++m) { bf16_t* rp = MIX + (size_t)(row0 + ai * HALF + m * 16) * D + u.pn * BM + wc * 32 + 8 * fq;
#pragma unroll
                for (int bj = 0; bj < 2; ++bj) { const f32x4 v0 = acc[ai][bj][m][0], v1 = acc[ai][bj][m][1];
                    u32x4 w; w[0] = cvtpk(v0[0], v0[1]); w[1] = cvtpk(v0[2], v0[3]); w[2] = cvtpk(v1[0], v1[1]); w[3] = cvtpk(v1[2], v1[3]);
                    *(u32x4*)(rp + bj * HALF) = w; } }
    }
};
struct EpiUpConv {
    bf16_t* ACTc; float* SB; const float* cw; const float* cb; int chunk;
    static __device__ __forceinline__ float lane_prev(float x) { return __builtin_bit_cast(float, __builtin_amdgcn_update_dpp(0, __builtin_bit_cast(int, x), 0x121, 0xf, 0xf, true)); }
    static __device__ __forceinline__ float lane_next(float x) { return __builtin_bit_cast(float, __builtin_amdgcn_update_dpp(0, __builtin_bit_cast(int, x), 0x12f, 0xf, 0xf, true)); }
    static __device__ __forceinline__ void taps2(const int MM, float& z0, float& z1, float gc0, float gc1, float gp0, float gp1, float gn0, float gn1, float w1a, float w1b, float ba, float bb_,
                                                 float w0ma, float w0mb, float w2ma, float w2mb, float w0ea, float w0eb, float w2ea, float w2eb) {
#define TAP_HEAD "v_fma_f32 %0, %2, %8, %10\n\tv_fma_f32 %1, %3, %9, %11\n\t" \
                 "v_fmac_f32_dpp %0, %2, %12 row_ror:1 row_mask:0xf bank_mask:0xf\n\tv_fmac_f32_dpp %1, %3, %13 row_ror:1 row_mask:0xf bank_mask:0xf\n\t" \
                 "v_fmac_f32_dpp %0, %2, %14 row_ror:15 row_mask:0xf bank_mask:0xf\n\tv_fmac_f32_dpp %1, %3, %15 row_ror:15 row_mask:0xf bank_mask:0xf"
#define TAP_PREV "\n\tv_fmac_f32_dpp %0, %4, %16 row_ror:1 row_mask:0xf bank_mask:0xf\n\tv_fmac_f32_dpp %1, %5, %17 row_ror:1 row_mask:0xf bank_mask:0xf"
#define TAP_NEXT "\n\tv_fmac_f32_dpp %0, %6, %18 row_ror:15 row_mask:0xf bank_mask:0xf\n\tv_fmac_f32_dpp %1, %7, %19 row_ror:15 row_mask:0xf bank_mask:0xf"
#define TAP_OPS : "=&v"(z0), "=&v"(z1) : "v"(gc0), "v"(gc1), "v"(gp0), "v"(gp1), "v"(gn0), "v"(gn1), "v"(w1a), "v"(w1b), "v"(ba), "v"(bb_), "v"(w0ma), "v"(w0mb), "v"(w2ma), "v"(w2mb), "v"(w0ea), "v"(w0eb), "v"(w2ea), "v"(w2eb)
        if (MM == 0) asm(TAP_HEAD TAP_NEXT TAP_OPS);
        else if (MM == 3) asm(TAP_HEAD TAP_PREV TAP_OPS);
        else asm(TAP_HEAD TAP_PREV TAP_NEXT TAP_OPS);
#undef TAP_HEAD
#undef TAP_PREV
#undef TAP_NEXT
#undef TAP_OPS
    }
    __device__ __forceinline__ void operator()(const f32x4 (&acc)[2][2][4][2], const Unit& u, int wr, int wc, int fr, int fq) const {
        asm volatile("" : "+v"(fr), "+v"(fq));
        const int lpm = u.pm < 128 ? u.pm - 64 * chunk : 64 + (u.pm - 128);
        const int f0 = u.pn * 128 + wc * 32 + 8 * fq;
        constexpr float NL2E = -1.4426950408889634f;
        f32x4 w0m[2], w0e[2], w2m[2], w2e[2], w1s[2], bbs[2];
#pragma unroll
        for (int n = 0; n < 2; ++n) {
            const f32x4 a0 = *(const f32x4*)(cw + f0 + 4 * n) * NL2E, a2 = *(const f32x4*)(cw + 2 * DFF + f0 + 4 * n) * NL2E; const f32x4 zero = {0.f, 0.f, 0.f, 0.f};
            w1s[n] = *(const f32x4*)(cw + DFF + f0 + 4 * n) * NL2E; bbs[n] = *(const f32x4*)(cb + f0 + 4 * n) * NL2E;
            w0m[n] = fr > 0 ? a0 : zero; w0e[n] = fr == 0 ? a0 : zero; w2m[n] = fr < 15 ? a2 : zero; w2e[n] = fr == 15 ? a2 : zero;
        }
#pragma unroll
        for (int ai = 0; ai < 2; ++ai) {
            const int rg = lpm * BM + ai * HALF + wr * 64;
            const int smask = rg < FCH_LAT ? (SEQ - 1) : (CTXL - 1);
            const bool seq_first = (rg & smask) == 0, seq_last = ((rg + 63) & smask) == smask;
#pragma unroll
            for (int m = 0; m < 4; ++m) {
                u32x4 ow;
#pragma unroll
                for (int n = 0; n < 2; ++n) {
                    const f32x4 gc = acc[ai][1][m][n], uu = acc[ai][0][m][n];
                    const f32x4 gpf = acc[ai][1][m > 0 ? m - 1 : 0][n], gnf = acc[ai][1][m < 3 ? m + 1 : 3][n];
                    f32x4 zs;
#pragma unroll
                    for (int e = 0; e < 4; e += 2) {
                        float z0, z1;
                        taps2(m, z0, z1, gc[e], gc[e + 1], gpf[e], gpf[e + 1], gnf[e], gnf[e + 1], w1s[n][e], w1s[n][e + 1], bbs[n][e], bbs[n][e + 1],
                                                              w0m[n][e], w0m[n][e + 1], w2m[n][e], w2m[n][e + 1], w0e[n][e], w0e[n][e + 1], w2e[n][e], w2e[n][e + 1]);
                        zs[e] = z0; zs[e + 1] = z1;
                    }
                    f32x4 o;
#pragma unroll
                    for (int e = 0; e < 4; ++e) o[e] = (zs[e] * uu[e]) * __builtin_amdgcn_rcpf(fmaf(__builtin_amdgcn_exp2f(zs[e]), NL2E, NL2E));
                    ow[2 * n] = cvtpk(o[0], o[1]); ow[2 * n + 1] = cvtpk(o[2], o[3]);
                    if (m == 0 && fr == 0) { float* sp = SB + ((size_t)(0 * NGRP + (rg >> 6)) * 3) * DFF + f0 + 4 * n; *(f32x4*)(sp + 2 * DFF) = gc; if (!seq_first) { *(f32x4*)sp = zs * (1.0f / NL2E); *(f32x4*)(sp + DFF) = uu; } }
                    if (m == 3 && fr == 15) { float* sp = SB + ((size_t)(1 * NGRP + (rg >> 6)) * 3) * DFF + f0 + 4 * n; *(f32x4*)(sp + 2 * DFF) = gc; if (!seq_last) { *(f32x4*)sp = zs * (1.0f / NL2E); *(f32x4*)(sp + DFF) = uu; } }
                }
                *(u32x4*)(ACTc + (size_t)(rg + 16 * m + fr) * DFF + f0) = ow;
            }
            asm volatile("" ::: "memory");
        }
    }
};
}

#define SBAR() __builtin_amdgcn_sched_barrier(0)
__device__ __forceinline__ int crow(int r, int hi) { return (r & 3) + 8 * (r >> 2) + 4 * hi; }
template <int DQK> __device__ __forceinline__ int kswz(int row, int cb) {
    return row * (DQK * 2 + 16) + cb;
}
__device__ __forceinline__ int v_st(int k, int c) { const int kk = (k & ~0xC) | ((k & 4) << 1) | ((k & 8) >> 1); return ((kk >> 3) * 4 + (c >> 5)) * 512 + ((kk & 7) * 32 + (c & 31)) * 2; }
__device__ __forceinline__ int v_stn(int k, int c) { return ((k >> 3) * 4 + (c >> 5)) * 512 + ((k & 7) * 32 + (c & 31)) * 2; }
__device__ __forceinline__ int v_rd_base(int lane) { return ((lane & 3) << 3) | (((lane >> 2) & 3) << 6) | (((lane >> 4) & 1) << 5) | (((lane >> 5) & 1) << 8); }
constexpr int v_rd_off(int d0, int ks, int half) { return d0 * 512 + ks * 4096 + half * 2048; }
template <int OFF> __device__ __forceinline__ s16x4 tr_read(int vb) {
    s16x4 r; asm volatile("ds_read_b64_tr_b16 %0, %1 offset:%2" : "=&v"(r) : "v"(vb), "i"(OFF) : "memory"); return r;
}
#define PKLH(L, H) (bf16x8){L[0], L[1], L[2], L[3], H[0], H[1], H[2], H[3]}
template <int D0> __device__ __forceinline__ void pv_one(f32x16& od, int vb, bf16x8 pa0, bf16x8 pa1, bf16x8 pa2, bf16x8 pa3) {
    const s16x4 l0 = tr_read<v_rd_off(D0, 0, 0)>(vb), h0 = tr_read<v_rd_off(D0, 0, 1)>(vb), l1 = tr_read<v_rd_off(D0, 1, 0)>(vb), h1 = tr_read<v_rd_off(D0, 1, 1)>(vb);
    const s16x4 l2 = tr_read<v_rd_off(D0, 2, 0)>(vb), h2 = tr_read<v_rd_off(D0, 2, 1)>(vb), l3 = tr_read<v_rd_off(D0, 3, 0)>(vb), h3 = tr_read<v_rd_off(D0, 3, 1)>(vb);
    asm volatile("s_waitcnt lgkmcnt(0)" ::: "memory"); SBAR();
    od = __builtin_amdgcn_mfma_f32_32x32x16_bf16(pa0, PKLH(l0, h0), od, 0, 0, 0);
    od = __builtin_amdgcn_mfma_f32_32x32x16_bf16(pa1, PKLH(l1, h1), od, 0, 0, 0);
    od = __builtin_amdgcn_mfma_f32_32x32x16_bf16(pa2, PKLH(l2, h2), od, 0, 0, 0);
    od = __builtin_amdgcn_mfma_f32_32x32x16_bf16(pa3, PKLH(l3, h3), od, 0, 0, 0);
}
__device__ __forceinline__ void pv_d0(f32x16* o, int vb, bf16x8 pa0, bf16x8 pa1, bf16x8 pa2, bf16x8 pa3) {
    pv_one<0>(o[0], vb, pa0, pa1, pa2, pa3); pv_one<1>(o[1], vb, pa0, pa1, pa2, pa3); pv_one<2>(o[2], vb, pa0, pa1, pa2, pa3); pv_one<3>(o[3], vb, pa0, pa1, pa2, pa3);
}
template <int DQK> __device__ __forceinline__ void qkt(f32x16& p0, f32x16& p1, const char* Ks, const bf16x8* qr, int r32, int hi, const f32x16 init = f32x16{}) {
    constexpr int NS = DQK / 16;
    p0 = init; p1 = init;
    bf16x8 b0[NS], b1[NS];
#pragma unroll
    for (int d0 = 0; d0 < NS; ++d0) { const int cb = (d0 * 16 + hi * 8) * 2;
        b0[d0] = *reinterpret_cast<const bf16x8*>(Ks + kswz<DQK>(r32, cb));
        b1[d0] = *reinterpret_cast<const bf16x8*>(Ks + kswz<DQK>(32 + r32, cb)); }
#pragma unroll
    for (int d0 = 0; d0 < NS; ++d0) {
        p0 = __builtin_amdgcn_mfma_f32_32x32x16_bf16(b0[d0], qr[d0], p0, 0, 0, 0);
        p1 = __builtin_amdgcn_mfma_f32_32x32x16_bf16(b1[d0], qr[d0], p1, 0, 0, 0); }
#ifndef QKT_AHEAD
#define QKT_AHEAD 3
#endif
    __builtin_amdgcn_sched_group_barrier(0x100, 2 * QKT_AHEAD, 0);
#pragma unroll
    for (int d0 = 0; d0 < NS - QKT_AHEAD; ++d0) { __builtin_amdgcn_sched_group_barrier(0x008, 2, 0); __builtin_amdgcn_sched_group_barrier(0x100, 2, 0); }
    __builtin_amdgcn_sched_group_barrier(0x008, 2 * QKT_AHEAD, 0);
}
#define PK4(P, BASE, OUT) do { const unsigned a0_ = cvtpk(P[BASE + 0], P[BASE + 1]), a1_ = cvtpk(P[BASE + 2], P[BASE + 3]);   \
    const unsigned b0_ = cvtpk(P[BASE + 4], P[BASE + 5]), b1_ = cvtpk(P[BASE + 6], P[BASE + 7]);                              \
    auto r0_ = __builtin_amdgcn_permlane32_swap(a0_, b0_, false, false); auto r1_ = __builtin_amdgcn_permlane32_swap(a1_, b1_, false, false); \
    u32x4 w_ = {r0_[0], r1_[0], r0_[1], r1_[1]}; OUT = *reinterpret_cast<bf16x8*>(&w_); } while (0)

#define PK4N(P, BASE, OUT) do { u32x4 w_ = {cvtpk(P[BASE + 0], P[BASE + 1]), cvtpk(P[BASE + 2], P[BASE + 3]), cvtpk(P[BASE + 4], P[BASE + 5]), cvtpk(P[BASE + 6], P[BASE + 7])}; \
    OUT = *reinterpret_cast<bf16x8*>(&w_); } while (0)

template <int SC1000> struct SmC { };
constexpr float THR = 8.f;

__device__ __forceinline__ void partialSM(f32x16& p0, f32x16& p1, float& m_reg, float& mn, float& alpha, const float C, const float thr_raw) {
    float pmax = p0[0];
#pragma unroll
    for (int r = 1; r < 16; ++r) pmax = fmaxf(pmax, p0[r]);
#pragma unroll
    for (int r = 0; r < 16; ++r) pmax = fmaxf(pmax, p1[r]);
    { auto rr = __builtin_amdgcn_permlane32_swap(__float_as_uint(pmax), __float_as_uint(pmax), false, false);
      pmax = fmaxf(__uint_as_float(rr[0]), __uint_as_float(rr[1])); }
    if (__builtin_expect(__all(pmax - m_reg <= thr_raw), 1)) { mn = m_reg; alpha = 1.f; }
    else { mn = fmaxf(m_reg, pmax); alpha = __builtin_amdgcn_exp2f((m_reg - mn) * C); m_reg = mn; }
    const float mnC = -mn * C;
#pragma unroll
    for (int r = 0; r < 16; ++r) p0[r] = fmaf(p0[r], C, mnC);
#pragma unroll
    for (int r = 0; r < 16; ++r) p1[r] = fmaf(p1[r], C, mnC);
#pragma unroll
    for (int r = 0; r < 16; ++r) p0[r] = __builtin_amdgcn_exp2f(p0[r]);
}
__device__ __forceinline__ void finishSM(f32x16& p0, f32x16& p1, float alpha, float& l_reg, bf16x8& pa0, bf16x8& pa1, bf16x8& pa2, bf16x8& pa3) {
#pragma unroll
    for (int r = 0; r < 16; ++r) p1[r] = __builtin_amdgcn_exp2f(p1[r]);
    float ps = 0;
#pragma unroll
    for (int r = 0; r < 16; ++r) ps += p0[r];
#pragma unroll
    for (int r = 0; r < 16; ++r) ps += p1[r];
    { auto rr = __builtin_amdgcn_permlane32_swap(__float_as_uint(ps), __float_as_uint(ps), false, false);
      ps = __uint_as_float(rr[0]) + __uint_as_float(rr[1]); }
    l_reg = l_reg * alpha + ps;
    PK4N(p0, 0, pa0); PK4N(p0, 8, pa1); PK4N(p1, 0, pa2); PK4N(p1, 8, pa3);
}

constexpr int KVBLK = 64;
struct AttnArgs {
    const bf16_t* Q; int ldq;
    const bf16_t* K; int ldk;
    const bf16_t* KR; int ldkr;
    const bf16_t* V; int ldv;
    bf16_t* O; int ldo;
    int nt;
    int seg0_tiles, seg0_row, seg1_row;
    int qpos0;
    int masked;
    float sink_l2; int has_sink;
    float C;
};
#define GAS __attribute__((address_space(1)))
template <int DQK>
__device__ __forceinline__ void attn_body(const AttnArgs& a, char* lds) {
    constexpr int SHM_V = KVBLK * 128 * 2, SHM_K = KVBLK * (DQK * 2 + 16);
    const int tid = otid(), wid = tid >> 6, lane = tid & 63, r32 = lane & 31, hi = lane >> 5;
    char* V_lds = lds; char* K_lds = lds + 2 * SHM_V;
    float* ws = (float*)(lds + 2 * SHM_V + 2 * SHM_K) + wid * 64; float* li_l = ws; float* al_l = ws + 32;
    float m_reg = -1e30f, l_reg = 0; f32x16 o[4] = {}; bf16x8 qr[DQK / 16];
    const float C = a.C, thr_raw = THR * LOG2E / a.C;
    const bf16_t* Qw = a.Q + (long)(wid * 32 + r32) * a.ldq + hi * 8;
#pragma unroll
    for (int d0 = 0; d0 < DQK / 16; ++d0) qr[d0] = *reinterpret_cast<const bf16x8*>(Qw + d0 * 16);
    const int sr = tid >> 4, sc = (tid & 15) * 8, vst0 = v_stn(sr, sc), vst1 = v_stn(32 + sr, sc);
    const int kst0 = kswz<DQK>(sr, sc * 2), kst1 = kswz<DQK>(32 + sr, sc * 2);
    const int sr2 = tid >> 3, sc2 = (tid & 7) * 8, kst2 = (DQK == 192) ? kswz<DQK>(sr2, 256 + sc2 * 2) : 0;
    const int vb0 = (int)(uintptr_t)V_lds + v_rd_base(lane);
    bf16x8 vs0, vs1, ks0, ks1, ks2;
    __syncthreads();
#define TILE_ROW(j) ((j) < a.seg0_tiles ? a.seg0_row + 64 * (j) : ((a.masked && (unsigned)(a.qpos0 - 128 + 64 * ((j) - a.seg0_tiles)) >= (unsigned)SEQ) ? a.seg0_row : a.seg1_row + 64 * ((j) - a.seg0_tiles)))
    unsigned oks0 = (unsigned)(sr * a.ldk + sc) * 2u, oks1 = oks0 + (unsigned)(64 * a.ldk), oks2 = (DQK == 192) ? (unsigned)(sr2 * a.ldkr + sc2) * 2u : 0u;
#define SLOAD(j) do { const long kr_ = TILE_ROW(j); \
    const GAS char* kb_ = (const GAS char*)a.K + kr_ * (long)(2 * a.ldk); const GAS char* vb_ = (const GAS char*)a.V + kr_ * (long)(2 * a.ldk); const GAS char* rb_ = (const GAS char*)a.KR + kr_ * (long)(2 * a.ldkr); \
    asm volatile("" : "+s"(kb_), "+s"(vb_), "+s"(rb_)); asm volatile("" : "+v"(oks0), "+v"(oks1), "+v"(oks2)); \
    vs0 = *reinterpret_cast<const GAS bf16x8*>(vb_ + oks0); vs1 = *reinterpret_cast<const GAS bf16x8*>(vb_ + oks1); \
    ks0 = *reinterpret_cast<const GAS bf16x8*>(kb_ + oks0); ks1 = *reinterpret_cast<const GAS bf16x8*>(kb_ + oks1); \
    if (DQK == 192) ks2 = *reinterpret_cast<const GAS bf16x8*>(rb_ + oks2); } while (0)
#define SWRITE(b) do { *(bf16x8*)(V_lds + (b) * SHM_V + vst0) = vs0; *(bf16x8*)(V_lds + (b) * SHM_V + vst1) = vs1; \
    *(bf16x8*)(K_lds + (b) * SHM_K + kst0) = ks0; *(bf16x8*)(K_lds + (b) * SHM_K + kst1) = ks1; \
    if (DQK == 192) *(bf16x8*)(K_lds + (b) * SHM_K + kst2) = ks2; } while (0)
#define SWAIT() asm volatile("s_waitcnt vmcnt(0)" ::: "memory")
#define RESC(al) do { if (__any((al) < 1.f)) { if (hi == 0) al_l[r32] = (al); asm volatile("s_waitcnt lgkmcnt(0)" ::: "memory"); \
    _Pragma("unroll") for (int d = 0; d < 4; ++d) _Pragma("unroll") for (int r = 0; r < 16; ++r) o[d][r] *= al_l[crow(r, hi)]; } } while (0)
#define MASK(P0, P1, j) do { if (a.masked && (j) >= a.seg0_tiles) { const int kp0_ = a.qpos0 - 128 + 64 * ((j) - a.seg0_tiles), qp_ = a.qpos0 + wid * 32 + r32; \
    const bool tv_ = (unsigned)kp0_ < (unsigned)SEQ; \
    _Pragma("unroll") for (int r = 0; r < 16; ++r) { const int d0_ = kp0_ + crow(r, hi) - qp_, d1_ = d0_ + 32; \
        P0[r] = (tv_ && d0_ <= 128 && d0_ >= -128) ? P0[r] : -1e30f; P1[r] = (tv_ && d1_ <= 128 && d1_ >= -128) ? P1[r] : -1e30f; } } } while (0)
    f32x16 pA0, pA1; float mnA, alA; bf16x8 pa0, pa1, pa2, pa3; const int NT = a.nt;
    const int wu = __builtin_amdgcn_readfirstlane(wid);
    volatile int* vflag = (volatile int*)(lds + 2 * SHM_V + 2 * SHM_K + 8 * 256);
#define TILE_BODY(CLASSIC) { \
        const int b = j & 1; \
        if (j + 1 < NT) SLOAD(j + 1); \
        bool skip = false;        \
        if (a.masked && j >= a.seg0_tiles) { const int kp0_ = a.qpos0 - 128 + 64 * (j - a.seg0_tiles), q0_ = a.qpos0 + wu * 32; \
            skip = ((unsigned)kp0_ >= (unsigned)SEQ) || (kp0_ + 63 < q0_ - 128) || (kp0_ > q0_ + 31 + 128); } \
        if (!skip) { \
            if (CLASSIC) { \
                SBAR(); qkt<DQK>(pA0, pA1, K_lds + b * SHM_K, qr, r32, hi); MASK(pA0, pA1, j); \
                partialSM(pA0, pA1, m_reg, mnA, alA, C, thr_raw); \
                RESC(alA); \
                finishSM(pA0, pA1, alA, l_reg, pa0, pa1, pa2, pa3); \
            } else { \
                SBAR(); qkt<DQK>(pA0, pA1, K_lds + b * SHM_K, qr, r32, hi, minit); MASK(pA0, pA1, j);        \
                float ps_ = 0.f; \
                _Pragma("unroll") for (int r = 0; r < 16; ++r) pA0[r] = __builtin_amdgcn_exp2f(pA0[r]); \
                _Pragma("unroll") for (int r = 0; r < 16; ++r) pA1[r] = __builtin_amdgcn_exp2f(pA1[r]); \
                _Pragma("unroll") for (int r = 0; r < 16; ++r) ps_ += pA0[r]; \
                _Pragma("unroll") for (int r = 0; r < 16; ++r) ps_ += pA1[r]; \
                { auto rr = __builtin_amdgcn_permlane32_swap(__float_as_uint(ps_), __float_as_uint(ps_), false, false); ps_ = __uint_as_float(rr[0]) + __uint_as_float(rr[1]); } \
                badu = __builtin_elementwise_max(badu, __float_as_uint(ps_));        \
                l_reg += ps_; \
                PK4N(pA0, 0, pa0); PK4N(pA0, 8, pa1); PK4N(pA1, 0, pa2); PK4N(pA1, 8, pa3); \
            } \
            SBAR(); \
            if (j + 1 < NT) { SWAIT(); SWRITE(b ^ 1); }        \
            SBAR(); \
            pv_d0(o, vb0 + b * SHM_V, pa0, pa1, pa2, pa3); \
        } else if (j + 1 < NT) { SWAIT(); SWRITE(b ^ 1); } \
        __syncthreads(); }
    if (tid == 0) *vflag = 0;
    if (wu >= 4) __builtin_amdgcn_s_setprio(1);
#pragma nounroll
    for (int pass = 0; pass < 2; ++pass) {
        int bad = 0; unsigned badu = 0u;
        SLOAD(0); SWAIT(); SWRITE(0); __syncthreads();
        const int jc = pass ? NT : 1;
        f32x16 minit = f32x16{};
#pragma nounroll
        for (int j = 0; j < jc; ++j) TILE_BODY(1)
#pragma unroll
        for (int r = 0; r < 16; ++r) minit[r] = -m_reg * C;
#pragma nounroll
        for (int j = jc; j < NT; ++j) TILE_BODY(0)
        if (pass) break;
        bad = !__all(badu <= __float_as_uint(256.0f));
        if (bad && lane == 0) *vflag = 1;
        __syncthreads();
        if (*vflag == 0) break;
        __syncthreads();
        m_reg = -1e30f; l_reg = 0.f;
#pragma unroll
        for (int d = 0; d < 4; ++d) o[d] = f32x16{};
    }
#undef TILE_BODY
    __builtin_amdgcn_s_setprio(0);
    if (a.has_sink) l_reg += __builtin_amdgcn_exp2f(a.sink_l2 - m_reg * C);
    if (hi == 0) li_l[r32] = l_reg; asm volatile("s_waitcnt lgkmcnt(0)" ::: "memory");
    float rli[16];
#pragma unroll
    for (int r = 0; r < 16; ++r) rli[r] = __builtin_amdgcn_rcpf(li_l[crow(r, hi)]);
    __syncthreads();
    { unsigned short* stg = (unsigned short*)(lds + wid * 8704);
#pragma unroll
      for (int r = 0; r < 16; ++r) { const int orow = crow(r, hi);
#pragma unroll
          for (int d0 = 0; d0 < 4; ++d0) stg[orow * 136 + d0 * 32 + r32] = (unsigned short)(cvtpk(o[d0][r] * rli[r], 0.f) & 0xffffu); }
      asm volatile("s_waitcnt lgkmcnt(0)" ::: "memory");
      bf16_t* Ow = a.O + (long)(wid * 32) * a.ldo;
#pragma unroll
      for (int i = 0; i < 8; ++i) { const int q = lane + 64 * i, row = q >> 4, c8 = (q & 15) * 8;
          *(u32x4*)(Ow + (long)row * a.ldo + c8) = *(const u32x4*)(stg + row * 136 + c8); } }
#undef TILE_ROW
#undef SLOAD
#undef SWRITE
#undef SWAIT
#undef RESC
#undef MASK
}

__device__ __forceinline__ int ret_row0(int bb, int n) { return n == 32 ? NLAT + bb * CTXL : bb * SEQ + n * 256; }
__device__ __forceinline__ float log2_sigmoid(float x) { return -log1pf(__expf(-x)) * LOG2E; }

__device__ __forceinline__ void ret_kv_unit(const bf16_t* PROJ, float* KVS, int bb, int h, int n, float lgf2, float lgb2, char* lds) {
    const int tid = otid(), wid = tid >> 6, lane = tid & 63, r32 = lane & 31, hi = lane >> 5;
    const int dir = wid >> 2, ablk = wid & 3;
    const int sr = tid >> 4, sc = (tid & 15) * 8, vst0 = v_st(sr, sc), vst1 = v_st(32 + sr, sc);
    const long R0 = ret_row0(bb, n);
    const bf16_t* Kg = PROJ + R0 * INW + 512 + h * 128; const bf16_t* Vg = PROJ + R0 * INW + 1024 + h * 128;
    const int vbK = (int)(uintptr_t)lds + dir * 16384 + v_rd_base(lane) + ablk * 512;
    const int vbV = (int)(uintptr_t)lds + 32768 + v_rd_base(lane);
    f32x16 acc[4] = {};
    u32x4 kq[2]; bf16x8 vq[2];
#pragma unroll
    for (int i = 0; i < 2; ++i) { const int j = sr + 32 * i; kq[i] = *reinterpret_cast<const u32x4*>(Kg + (long)j * INW + sc); vq[i] = *reinterpret_cast<const bf16x8*>(Vg + (long)j * INW + sc); }
    for (int t = 0; t < 4; ++t) {
        __syncthreads();
#pragma unroll
        for (int i = 0; i < 2; ++i) {
            const int j = 64 * t + sr + 32 * i;
            const u32x4 kv = kq[i];
            const bf16x8 vv = vq[i];
            const float kf = __builtin_amdgcn_exp2f(lgf2 * (float)(255 - j)), kb = __builtin_amdgcn_exp2f(lgb2 * (float)j);
            u32x4 wf, wb;
#pragma unroll
            for (int e = 0; e < 4; ++e) { const float lo = bflo(kv[e]), hh = bfhi(kv[e]); wf[e] = cvtpk(lo * kf, hh * kf); wb[e] = cvtpk(lo * kb, hh * kb); }
            const int vo = i ? vst1 : vst0;
            *(u32x4*)(lds + vo) = wf; *(u32x4*)(lds + 16384 + vo) = wb; *(bf16x8*)(lds + 32768 + vo) = vv;
        }
        if (t < 3) {
#pragma unroll
            for (int i = 0; i < 2; ++i) { const int j = 64 * (t + 1) + sr + 32 * i; kq[i] = *reinterpret_cast<const u32x4*>(Kg + (long)j * INW + sc); vq[i] = *reinterpret_cast<const bf16x8*>(Vg + (long)j * INW + sc); }
        }
        __syncthreads();
#define RKV_STEP(KS) do { \
        const s16x4 al_ = tr_read<v_rd_off(0, KS, 0)>(vbK), ah_ = tr_read<v_rd_off(0, KS, 1)>(vbK); \
        const s16x4 l0_ = tr_read<v_rd_off(0, KS, 0)>(vbV), h0_ = tr_read<v_rd_off(0, KS, 1)>(vbV), l1_ = tr_read<v_rd_off(1, KS, 0)>(vbV), h1_ = tr_read<v_rd_off(1, KS, 1)>(vbV); \
        const s16x4 l2_ = tr_read<v_rd_off(2, KS, 0)>(vbV), h2_ = tr_read<v_rd_off(2, KS, 1)>(vbV), l3_ = tr_read<v_rd_off(3, KS, 0)>(vbV), h3_ = tr_read<v_rd_off(3, KS, 1)>(vbV); \
        asm volatile("s_waitcnt lgkmcnt(0)" ::: "memory"); SBAR(); \
        const bf16x8 af_ = PKLH(al_, ah_); \
        acc[0] = __builtin_amdgcn_mfma_f32_32x32x16_bf16(af_, PKLH(l0_, h0_), acc[0], 0, 0, 0); \
        acc[1] = __builtin_amdgcn_mfma_f32_32x32x16_bf16(af_, PKLH(l1_, h1_), acc[1], 0, 0, 0); \
        acc[2] = __builtin_amdgcn_mfma_f32_32x32x16_bf16(af_, PKLH(l2_, h2_), acc[2], 0, 0, 0); \
        acc[3] = __builtin_amdgcn_mfma_f32_32x32x16_bf16(af_, PKLH(l3_, h3_), acc[3], 0, 0, 0); } while (0)
        RKV_STEP(0); RKV_STEP(1); RKV_STEP(2); RKV_STEP(3);
#undef RKV_STEP
    }
    float* outp = KVS + ((((size_t)bb * 4 + h) * 2 + dir) * 33 + n) * 16384;
#pragma unroll
    for (int r = 0; r < 16; ++r) { const int dk = 32 * ablk + crow(r, hi);
#pragma unroll
        for (int d = 0; d < 4; ++d) outp[dk * 128 + 32 * d + r32] = acc[d][r]; }
}

__device__ __forceinline__ void ret_scan(const float* KVS, bf16_t* SIN, const float* dec_f, const float* dec_b, int gtid, int gthreads) {
    for (int it = gtid; it < NB * 4 * 2 * 4096; it += gthreads) {
        const int e4 = it & 4095, dir = (it >> 12) & 1, h = (it >> 13) & 3, bb = it >> 15;
        const float lg2 = log2_sigmoid(dir ? dec_b[h] : dec_f[h]); const float cd = __builtin_amdgcn_exp2f(lg2 * 256.0f);
        const size_t base = ((((size_t)bb * 4 + h) * 2 + dir) * 33) * 16384 + (size_t)e4 * 4;
        f32x4 s = *(const f32x4*)(KVS + base + (size_t)32 * 16384);
        *(u32x2*)(SIN + base + (size_t)32 * 16384) = (u32x2){0u, 0u};
        for (int nb = 0; nb < 4; ++nb) {
            f32x4 kv[8];
#pragma unroll
            for (int q = 0; q < 8; ++q) { const int n = dir ? 31 - (nb * 8 + q) : nb * 8 + q; kv[q] = *(const f32x4*)(KVS + base + (size_t)n * 16384); }
#pragma unroll
            for (int q = 0; q < 8; ++q) { const int n = dir ? 31 - (nb * 8 + q) : nb * 8 + q;
                st_bf16x4(SIN + base + (size_t)n * 16384, s); s = s * cd + kv[q]; }
        }
    }
}

__device__ __forceinline__ void ret_out_unit(const bf16_t* PROJ, const bf16_t* SIN, bf16_t* Y, int bb, int h, int n, float lgf2, float lgb2, char* lds) {
    const int tid = otid(), wid = tid >> 6, lane = tid & 63, r32 = lane & 31, hi = lane >> 5;
    const int sr = tid >> 4, sc = (tid & 15) * 8, vst0 = v_st(sr, sc), vst1 = v_st(32 + sr, sc);
    const int kst0 = kswz<128>(sr, sc * 2), kst1 = kswz<128>(32 + sr, sc * 2);
    const long R0 = ret_row0(bb, n);
    const bf16_t* Qg = PROJ + R0 * INW + h * 128; const bf16_t* Kg = Qg + 512; const bf16_t* Vg = Qg + 1024; const bf16_t* Gg = Qg + 1536;
    char* K_lds = lds; char* V_lds = lds + 17408;
    const int vb0 = (int)(uintptr_t)V_lds + v_rd_base(lane);
    bf16x8 qr[8];
    const bf16_t* Qw = Qg + (long)(wid * 32 + r32) * INW + hi * 8;
#pragma unroll
    for (int d0 = 0; d0 < 8; ++d0) qr[d0] = *reinterpret_cast<const bf16x8*>(Qw + d0 * 16);
    f32x16 o[4] = {};
    const int iq = wid * 32 + r32;
    const bf16_t* S0 = SIN + ((((size_t)bb * 4 + h) * 2) * 33 + n) * 16384;
    bf16x8 kq[2], vq[2];
#pragma unroll
    for (int i = 0; i < 2; ++i) { const int j = sr + 32 * i; kq[i] = *reinterpret_cast<const bf16x8*>(Kg + (long)j * INW + sc); vq[i] = *reinterpret_cast<const bf16x8*>(Vg + (long)j * INW + sc); }
    for (int t = 0; t < 4; ++t) {
        __syncthreads();
#pragma unroll
        for (int i = 0; i < 2; ++i) { *(bf16x8*)(K_lds + (i ? kst1 : kst0)) = kq[i]; *(bf16x8*)(V_lds + (i ? vst1 : vst0)) = vq[i]; }
        if (t < 3) {
#pragma unroll
            for (int i = 0; i < 2; ++i) { const int j = 64 * (t + 1) + sr + 32 * i; kq[i] = *reinterpret_cast<const bf16x8*>(Kg + (long)j * INW + sc); vq[i] = *reinterpret_cast<const bf16x8*>(Vg + (long)j * INW + sc); }
        } else if (n != 32) {
#pragma unroll
            for (int i = 0; i < 2; ++i) vq[i] = *reinterpret_cast<const bf16x8*>(S0 + (sr + 32 * i) * 128 + sc);
        }
        __syncthreads();
        f32x16 p0, p1; qkt<128>(p0, p1, K_lds, qr, r32, hi);
#pragma unroll
        for (int r = 0; r < 16; ++r) {
            const int d0 = iq - (64 * t + crow(r, hi)), d1 = d0 - 32;
            const float m0 = d0 > 0 ? __builtin_amdgcn_exp2f(lgf2 * (float)d0) : (d0 < 0 ? __builtin_amdgcn_exp2f(lgb2 * (float)(-d0)) : 2.0f);
            const float m1 = d1 > 0 ? __builtin_amdgcn_exp2f(lgf2 * (float)d1) : (d1 < 0 ? __builtin_amdgcn_exp2f(lgb2 * (float)(-d1)) : 2.0f);
            p0[r] *= m0; p1[r] *= m1;
        }
        bf16x8 pa0, pa1, pa2, pa3; PK4(p0, 0, pa0); PK4(p0, 8, pa1); PK4(p1, 0, pa2); PK4(p1, 8, pa3);
        pv_d0(o, vb0, pa0, pa1, pa2, pa3);
    }
    if (n != 32) {
#pragma unroll
        for (int s4 = 0; s4 < 4; ++s4) {
            const int dir = s4 >> 1, ts = s4 & 1;
            const float qd = dir ? __builtin_amdgcn_exp2f(lgb2 * (float)(256 - iq)) : __builtin_amdgcn_exp2f(lgf2 * (float)(iq + 1));
            __syncthreads();
#pragma unroll
            for (int i = 0; i < 2; ++i) *(bf16x8*)(V_lds + (i ? vst1 : vst0)) = vq[i];
            if (s4 < 3) { const int d2 = (s4 + 1) >> 1, t2 = (s4 + 1) & 1; const bf16_t* Sn = S0 + (size_t)d2 * 33 * 16384;
#pragma unroll
                for (int i = 0; i < 2; ++i) vq[i] = *reinterpret_cast<const bf16x8*>(Sn + (64 * t2 + sr + 32 * i) * 128 + sc); }
            bf16x8 qs[4];
#pragma unroll
            for (int k = 0; k < 4; ++k) { const u32x4 w = *reinterpret_cast<const u32x4*>(&qr[4 * ts + k]); u32x4 x;
#pragma unroll
                for (int e = 0; e < 4; ++e) x[e] = cvtpk(bflo(w[e]) * qd, bfhi(w[e]) * qd);
                qs[k] = *reinterpret_cast<bf16x8*>(&x); }
            __syncthreads();
            pv_d0(o, vb0, qs[0], qs[1], qs[2], qs[3]);
        }
    }
    __syncthreads();
    { unsigned short* stg = (unsigned short*)(lds + wid * 8704);
#pragma unroll
      for (int r = 0; r < 16; ++r) {
          float ss = (o[0][r] * o[0][r] + o[1][r] * o[1][r]) + (o[2][r] * o[2][r] + o[3][r] * o[3][r]);
          ss += __shfl_xor(ss, 1); ss += __shfl_xor(ss, 2); ss += __shfl_xor(ss, 4); ss += __shfl_xor(ss, 8); ss += __shfl_xor(ss, 16);
          const float rn = 1.0f / sqrtf(ss * (1.0f / 128.0f) + RMS_EPS);
#pragma unroll
          for (int d = 0; d < 4; ++d) stg[crow(r, hi) * 136 + 32 * d + r32] = (unsigned short)(cvtpk(o[d][r] * rn, 0.f) & 0xffffu);
      }
      asm volatile("s_waitcnt lgkmcnt(0)" ::: "memory");
#pragma unroll
      for (int i = 0; i < 8; ++i) { const int q = lane + 64 * i, row = q >> 4, c8 = (q & 15) * 8;
          const u32x4 gw = *(const u32x4*)(Gg + (long)(wid * 32 + row) * INW + c8);
          const u32x4 xw = *(const u32x4*)(stg + row * 136 + c8);
          u32x4 ow;
#pragma unroll
          for (int e = 0; e < 4; ++e) ow[e] = cvtpk(silu_f(bflo(gw[e])) * bflo(xw[e]), silu_f(bfhi(gw[e])) * bfhi(xw[e]));
          *(u32x4*)(Y + (R0 + wid * 32 + row) * D + h * 128 + c8) = ow; } }
}

struct Params {
    const float* in[23];
    float* out; unsigned char* ws;
    int ph_lo, ph_hi, bar_region, pad;
};
enum { I_X = 0, I_C, I_CTX, I_CCTX, I_ADAW, I_ADAB, I_WIN, I_DECF, I_DECB, I_SINK, I_QNORM, I_WUQ, I_KVNORM, I_WUKV, I_WO, I_LN1G, I_LN1B, I_WUP, I_CONVW, I_CONVB, I_WDN, I_LN2G, I_LN2B };

__device__ __forceinline__ int win_src_col(int p) {
    if (p >= INW) return -1;
    if (p >= 4096) return p;
    const int pn = p >> 8;
    if (pn < 4 || (pn >= 8 && pn < 12)) {
        const int bj = (p >> 7) & 1, x = p & 127, wc = x >> 5, nn = (x >> 4) & 1, q = x & 15;
        return (p & ~255) + 128 * (wc >> 1) + 64 * (wc & 1) + 32 * bj + 8 * (q >> 2) + 4 * nn + (q & 3);
    }
    return (p & ~31) + 8 * ((p & 15) >> 2) + 4 * ((p >> 4) & 1) + (p & 3);
}
__device__ __forceinline__ int wup_src_col(int p) {
    const int pn = p >> 8, bj = (p >> 7) & 1, x = p & 127, wc = x >> 5, nn = (x >> 4) & 1, q = x & 15, fq = q >> 2, j = q & 3;
    const int f = 128 * pn + 32 * wc + 8 * fq + 4 * nn + j;
    return bj ? DFF + f : f;
}
__device__ __forceinline__ void cvt_item(const float* W, int K, int N, bf16_t* Bt, int mode, const float* kscale, int item, int nkt, float* scr, int lane) {
    const int pt = item / nkt, kt = item - pt * nkt, p0 = pt * 32, k0 = kt * 64;
    const int p = p0 + (lane & 31);
    const int src = mode == 1 ? win_src_col(p) : (mode == 2 ? wup_src_col(p) : (mode == 3 ? ((p & ~31) + 8 * ((p & 15) >> 2) + 4 * ((p >> 4) & 1) + (p & 3)) : (p < N ? p : -1)));
    const float* wp = W + (size_t)(k0 + (lane >> 5)) * N + (src >= 0 ? src : 0);
    float v[32];
#pragma unroll
    for (int i = 0; i < 32; ++i) v[i] = src >= 0 ? wp[(size_t)(2 * i) * N] : 0.f;
    if (kscale) {
#pragma unroll
        for (int i = 0; i < 32; ++i) v[i] *= kscale[k0 + 2 * i + (lane >> 5)];
    }
#pragma unroll
    for (int i = 0; i < 32; ++i) scr[(2 * i + (lane >> 5)) * 33 + (lane & 31)] = v[i];
    asm volatile("s_waitcnt lgkmcnt(0)" ::: "memory");
    const int c = lane & 7;
#pragma unroll
    for (int j = 0; j < 4; ++j) { const int n = (lane >> 3) + 8 * j; const float* s = scr + (8 * c) * 33 + n;
        u32x4 o; o[0] = cvtpk(s[0 * 33], s[1 * 33]); o[1] = cvtpk(s[2 * 33], s[3 * 33]); o[2] = cvtpk(s[4 * 33], s[5 * 33]); o[3] = cvtpk(s[6 * 33], s[7 * 33]);
        *(u32x4*)(Bt + (size_t)(p0 + n) * K + k0 + 8 * c) = o; }
    asm volatile("s_waitcnt lgkmcnt(0)" ::: "memory");
}

__device__ __forceinline__ void ln_phase(const bf16_t* X, const bf16_t* MIX, float* dstf, bf16_t* dsth, bf16_t* H, const float* g, const float* b,
                                         const float* gate, const float* sc, const float* sh, int nrows, int bid, int G, char* lds) {
    const int tid = otid(), lane = tid & 63, wid = __builtin_amdgcn_readfirstlane(tid >> 6);
    float* L = (float*)lds;
    __syncthreads();
    for (int i = tid; i < D; i += 512) { L[i] = g[i]; L[D + i] = b[i]; }
    const int ngroups = nrows >> 3, grp0 = (int)(((long)bid * ngroups) / G), nsteps = (int)(((long)(bid + 1) * ngroups) / G) - grp0; int s_cur = -1;
#define LN_ROW(k) ((grp0 + (k)) * 8 + wid)
#define LN_LOAD(XA, MA, ROW) do { const bf16_t* xr_ = X + (size_t)(ROW) * D + 4 * lane; const bf16_t* mr_ = MIX + (size_t)(ROW) * D + 4 * lane; \
    _Pragma("unroll") for (int j = 0; j < 8; ++j) { XA[j] = *(const u32x2*)(xr_ + 256 * j); MA[j] = *(const u32x2*)(mr_ + 256 * j); } } while (0)
#define LN_SVEC(k) do { const int s_ = mod_index((grp0 + (k)) * 8); \
    if (s_ != s_cur) { __syncthreads(); \
        { float gv_[4], sv_[4], hv_[4]; \
          _Pragma("unroll") for (int q_ = 0; q_ < 4; ++q_) { const int i = tid + 512 * q_; gv_[q_] = gate[(size_t)s_ * MODW + i]; sv_[q_] = H ? sc[(size_t)s_ * MODW + i] : 0.f; hv_[q_] = H ? sh[(size_t)s_ * MODW + i] : 0.f; } \
          _Pragma("unroll") for (int q_ = 0; q_ < 4; ++q_) { const int i = tid + 512 * q_; L[2 * D + i] = gv_[q_] + 1.0f; L[3 * D + i] = sv_[q_] + 1.0f; L[4 * D + i] = hv_[q_]; } } \
        s_cur = s_; __syncthreads(); } } while (0)
#define LN_COMP(XA, MA, ROW) do { \
    f32x4 v[8]; float sum = 0.f; \
    _Pragma("unroll") for (int j = 0; j < 8; ++j) { const int c = 4 * lane + 256 * j; \
        const f32x4 mv = (f32x4){bflo(MA[j][0]), bfhi(MA[j][0]), bflo(MA[j][1]), bfhi(MA[j][1])}; \
        v[j] = cvt_f16x4(XA[j]) * ALPHA + *(const f32x4*)(L + 2 * D + c) * mv; sum += (v[j][0] + v[j][1]) + (v[j][2] + v[j][3]); } \
    const float mean = wave_sum(sum) * (1.0f / D); float s2 = 0.f; \
    _Pragma("unroll") for (int j = 0; j < 8; ++j) { v[j] = v[j] - mean; s2 += (v[j][0] * v[j][0] + v[j][1] * v[j][1]) + (v[j][2] * v[j][2] + v[j][3] * v[j][3]); } \
    const float rstd = 1.0f / sqrtf(wave_sum(s2) * (1.0f / D) + LN_EPS); \
    _Pragma("unroll") for (int j = 0; j < 8; ++j) { const int c = 4 * lane + 256 * j; \
        const f32x4 y = v[j] * rstd * *(const f32x4*)(L + c) + *(const f32x4*)(L + D + c); \
        if (dstf) *(f32x4*)(dstf + (size_t)(ROW) * D + c) = y; else st_f16x4(dsth + (size_t)(ROW) * D + c, y); \
        if (H) st_bf16x4(H + (size_t)(ROW) * D + c, y * *(const f32x4*)(L + 3 * D + c) + *(const f32x4*)(L + 4 * D + c)); } } while (0)
    u32x2 xa[8], xb[8], ma[8], mb[8];
    if (LN_ROW(0) < nrows) LN_LOAD(xa, ma, LN_ROW(0));
    for (int k = 0; k < nsteps; k += 2) {
        LN_SVEC(k);
        if (k + 1 < nsteps && LN_ROW(k + 1) < nrows) LN_LOAD(xb, mb, LN_ROW(k + 1));
        SBAR();
        if (LN_ROW(k) < nrows) LN_COMP(xa, ma, LN_ROW(k));
        if (k + 1 < nsteps) {
            LN_SVEC(k + 1);
            if (k + 2 < nsteps && LN_ROW(k + 2) < nrows) LN_LOAD(xa, ma, LN_ROW(k + 2));
            SBAR();
            if (LN_ROW(k + 1) < nrows) LN_COMP(xb, mb, LN_ROW(k + 1));
        }
    }
#undef LN_ROW
#undef LN_LOAD
#undef LN_SVEC
#undef LN_COMP
}

__global__ void __launch_bounds__(512, 2) fwd_kernel(Params p) {
    extern __shared__ __attribute__((aligned(16))) unsigned char lds_raw[];
    LAS unsigned char* ldsl = (LAS unsigned char*)lds_raw;
    char* lds = (char*)lds_raw;
    if (threadIdx.x < 4) ((volatile LAS unsigned*)(ldsl + 131072))[threadIdx.x] = 0u;
    __syncthreads();
    XcdBarrier bar; bar.bar = (unsigned*)(p.ws + WS_CTL) + (size_t)p.bar_region * 4096; bar.x = 0; bar.st = (volatile LAS unsigned*)(ldsl + 131072);
    if (p.ph_hi - p.ph_lo > 1) bar = xcd_barrier_post(bar.bar, (volatile LAS unsigned*)(ldsl + 131072));

    int g = 0, lcur = 0;
#ifndef DUPMASK
#define DUPMASK 0
#endif
#define NREP(k) (1 + ((DUPMASK >> (k)) & 1))
#ifndef PHMASK
#define PHMASK 0xffff
#endif
#ifndef SUBMASK
#define SUBMASK 0xffff
#endif
#define SUB(k) ((SUBMASK >> (k)) & 1)
#define PH_BEGIN(k) if (((PHMASK >> (k)) & 1) && g >= p.ph_lo && g < p.ph_hi) { \
    int bid = blockIdx.x, G = gridDim.x; asm volatile("" : "+s"(bid), "+s"(G)); const int NGW = G * 8, gthreads = G * 512; (void)NGW; (void)gthreads; \
    const int tid = otid(), lane = tid & 63, wid = __builtin_amdgcn_readfirstlane(tid >> 6); const int gw = bid * 8 + wid, gtid = bid * 512 + tid; (void)lane; (void)gw; (void)gtid; \
    size_t wsoff_ = 0; asm volatile("" : "+s"(wsoff_)); unsigned char* ws = p.ws + wsoff_; \
    float* MOD = (float*)(ws + WS_MOD); float* ROPE = (float*)(ws + WS_ROPE); float* RS = (float*)(ws + WS_RS); float* SM = (float*)(ws + WS_SM); (void)SM; \
    float* thc = ROPE, *ths = ROPE + 4096, *tmc = ROPE + 8192, *tms = ROPE + 8192 + 2048; \
    bf16_t* WB = (bf16_t*)(ws + WS_W); float* X = (float*)(ws + WS_X); bf16_t* XH = (bf16_t*)(ws + WS_X); (void)XH; bf16_t* H = (bf16_t*)(ws + WS_H); bf16_t* Y = (bf16_t*)(ws + WS_Y); \
    bf16_t* PROJ = (bf16_t*)(ws + WS_PROJ); bf16_t* QUP = (bf16_t*)(ws + WS_QUP); bf16_t* KVUP = (bf16_t*)(ws + WS_KVUP); \
    float* KVS = (float*)(ws + WS_KVS); bf16_t* SIN = (bf16_t*)(ws + WS_SIN); bf16_t* ACT0 = (bf16_t*)(ws + WS_ACT0); bf16_t* ACT1 = (bf16_t*)(ws + WS_ACT1); float* SB = (float*)(ws + WS_SB); bf16_t* MIX = (bf16_t*)(ws + WS_MIX); (void)MIX; \
    const bf16_t* wl = WB + (size_t)lcur * W_LAYER; const float* modl = MOD + (size_t)lcur * 5 * MODW; \
    (void)RS; (void)thc; (void)ths; (void)tmc; (void)tms; (void)X; (void)H; (void)Y; (void)PROJ; (void)QUP; (void)KVUP; (void)KVS; (void)SIN; (void)ACT0; (void)ACT1; (void)SB; (void)wl; (void)modl;
#define PH_END   if (g + 1 < p.ph_hi) xcd_barrier(bar); } ++g;

    PH_BEGIN(0)
    {
        for (int i = gtid; i < SM_END; i += gthreads) {
            float v = 0.f;
            if (i < SM_DECB) v = p.in[I_DECF][i];
            else if (i < SM_SINK) v = p.in[I_DECB][i - SM_DECB];
            else if (i < SM_LN1G) v = (i - SM_SINK) < DEPTH * 6 ? p.in[I_SINK][i - SM_SINK] : 0.f;
            else if (i < SM_LN1B) v = p.in[I_LN1G][i - SM_LN1G];
            else if (i < SM_LN2G) v = p.in[I_LN1B][i - SM_LN1B];
            else if (i < SM_LN2B) v = p.in[I_LN2G][i - SM_LN2G];
            else if (i < SM_CONVW) v = p.in[I_LN2B][i - SM_LN2B];
            else if (i < SM_CONVB) v = p.in[I_CONVW][i - SM_CONVW];
            else v = p.in[I_CONVB][i - SM_CONVB];
            SM[i] = v;
        }
        for (int i = gtid; i < 4096 + 2048; i += gthreads) {
            if (i < 4096) { const int pos = i >> 5, f = i & 31; const float inv = exp2f(-(float)f * (13.287712379549449f / 32.0f)); const float ang = (float)pos * inv; thc[i] = cosf(ang); ths[i] = sinf(ang); }
            else { const int q = i - 4096, pos = q >> 4, f = q & 15; const float inv = exp2f(-(float)f * (13.287712379549449f / 16.0f)); const float ang = (float)pos * inv; tmc[q] = cosf(ang); tms[q] = sinf(ang); }
        }
        {
            float* scs = (float*)lds;
            float* red = (float*)(lds + 5 * 2048 * 4);
            for (int i = tid; i < 5 * 2048; i += 512) { const int s = i >> 11, k = i & 2047; const float cv = s < 4 ? p.in[I_C][s * D + k] : p.in[I_CCTX][k]; scs[i] = silu_f(cv); }
            __syncthreads();
            for (int u = bid; u < DEPTH * (MODW / 64); u += G) {
                const int l = u / (MODW / 64), j = (u % (MODW / 64)) * 64 + lane;
                const float* Wp = p.in[I_ADAW] + (size_t)l * D * MODW + j;
                float a0 = 0.f, a1 = 0.f, a2 = 0.f, a3 = 0.f, a4 = 0.f;
#pragma unroll 16
                for (int kk = 0; kk < 256; ++kk) { const int k = wid * 256 + kk; const float w = Wp[(size_t)k * MODW];
                    a0 += scs[k] * w; a1 += scs[2048 + k] * w; a2 += scs[4096 + k] * w; a3 += scs[6144 + k] * w; a4 += scs[8192 + k] * w; }
                red[(wid * 5 + 0) * 64 + lane] = a0; red[(wid * 5 + 1) * 64 + lane] = a1; red[(wid * 5 + 2) * 64 + lane] = a2; red[(wid * 5 + 3) * 64 + lane] = a3; red[(wid * 5 + 4) * 64 + lane] = a4;
                __syncthreads();
                if (wid < 5) { float sum = 0.f;
#pragma unroll
                    for (int w8 = 0; w8 < 8; ++w8) sum += red[(w8 * 5 + wid) * 64 + lane];
                    MOD[((size_t)l * 5 + wid) * MODW + j] = sum + p.in[I_ADAB][(size_t)l * MODW + j]; }
                __syncthreads();
            }
        }
        {
            __syncthreads();
            float* scr = (float*)(lds + wid * 8448);
            constexpr int T_IN = (INWP / 32) * (D / 64), T_UQ = (QUPWP / 32) * (512 / 64), T_UKV = (KVUPW / 32) * (256 / 64), T_O = (D / 32) * (D / 64), T_UP = (DFF2 / 32) * (D / 64), T_DN = (D / 32) * (DFF / 64);
            constexpr int T_L = T_IN + T_UQ + T_UKV + T_O + T_UP + T_DN;
            for (int u = gw; u < DEPTH * T_L; u += NGW) {
                const int l = u / T_L; int r = u % T_L; bf16_t* wlp = WB + (size_t)l * W_LAYER;
                const float* Wsrc; const float* ksc = nullptr; bf16_t* dst; int Kd, Nd, mode;
                if (r < T_IN) { Wsrc = p.in[I_WIN] + (size_t)l * D * INW; Kd = D; Nd = INW; dst = wlp + W_IN; mode = 1; }
                else if ((r -= T_IN) < T_UQ) { Wsrc = p.in[I_WUQ] + (size_t)l * 512 * QUPW; Kd = 512; Nd = QUPW; dst = wlp + W_UQ; mode = 0; ksc = p.in[I_QNORM] + l * 512; }
                else if ((r -= T_UQ) < T_UKV) { Wsrc = p.in[I_WUKV] + (size_t)l * 256 * KVUPW; Kd = 256; Nd = KVUPW; dst = wlp + W_UKV; mode = 3; ksc = p.in[I_KVNORM] + l * 256; }
                else if ((r -= T_UKV) < T_O) { Wsrc = p.in[I_WO] + (size_t)l * D * D; Kd = D; Nd = D; dst = wlp + W_O; mode = 3; }
                else if ((r -= T_O) < T_UP) { Wsrc = p.in[I_WUP] + (size_t)l * D * DFF2; Kd = D; Nd = DFF2; dst = wlp + W_UP; mode = 2; }
                else { r -= T_UP; Wsrc = p.in[I_WDN] + (size_t)l * DFF * D; Kd = DFF; Nd = D; dst = wlp + W_DN; mode = 3; }
                cvt_item(Wsrc, Kd, Nd, dst, mode, ksc, r, Kd / 64, scr, lane);
            }
        }
    }
    PH_END

    PH_BEGIN(1)
    {
        f32x4 va[8], vb[8];
#define G1_SRC(ROW) ((ROW) < NLAT ? p.in[I_X] + (size_t)(ROW) * D : p.in[I_CTX] + (size_t)((ROW) - NLAT) * D)
#define G1_LOAD(VA, ROW) do { const float* s_ = G1_SRC(ROW) + 4 * lane; _Pragma("unroll") for (int j = 0; j < 8; ++j) VA[j] = *(const f32x4*)(s_ + 256 * j); } while (0)
#define G1_STORE(VA, ROW) do { const float* mp_ = MOD + (size_t)mod_index(ROW) * MODW; \
        _Pragma("unroll") for (int j = 0; j < 8; ++j) { const int c = 4 * lane + 256 * j; \
            st_f16x4(XH + (size_t)(ROW) * D + c, VA[j]); \
            st_bf16x4(H + (size_t)(ROW) * D + c, VA[j] * (*(const f32x4*)(mp_ + D + c) + 1.0f) + *(const f32x4*)(mp_ + c)); } } while (0)
        int row = gw;
        if (row < NROWS) G1_LOAD(va, row);
        for (; row < NROWS; row += 2 * NGW) {
            if (row + NGW < NROWS) G1_LOAD(vb, row + NGW);
            SBAR();
            G1_STORE(va, row);
            if (row + NGW < NROWS) {
                if (row + 2 * NGW < NROWS) G1_LOAD(va, row + 2 * NGW);
                SBAR();
                G1_STORE(vb, row + NGW);
            }
        }
#undef G1_SRC
#undef G1_LOAD
#undef G1_STORE
    }
    PH_END

    for (int l = 0; l < DEPTH; ++l) {
        const bool last = (l == DEPTH - 1);
        const int nMfull = last ? 128 : 132;
        lcur = l;

        PH_BEGIN(2)
        for (int rep_ = 0; rep_ < NREP(0); ++rep_) { pg8::Gemm gm{H, wl + W_IN, D, D}; pg8::TileOrder S; S.init(132, INWP / 256, G, bid, -1);
          pg8::EpiProj E{PROJ, RS, thc, ths, tmc, tms};
          pg8::gemm_phase<pg8::EpiProj, pg8::TileOrder>(ldsl, gm, S, E); }
        PH_END

        PH_BEGIN(3)
        if (SUB(0)) for (int rep_ = 0; rep_ < NREP(1); ++rep_) { pg8::Gemm gm{PROJ + 3328, wl + W_UQ, INW, 512}; pg8::TileOrder S; S.init(132, QUPWP / 256, G, bid, -1);
          pg8::EpiQup E{QUP, RS, tmc, tms};
          pg8::gemm_phase<pg8::EpiQup, pg8::TileOrder>(ldsl, gm, S, E); }
        if (SUB(1)) for (int rep_ = 0; rep_ < NREP(2); ++rep_) { pg8::Gemm gm{PROJ + 3840, wl + W_UKV, INW, 256}; pg8::TileOrder S; S.init(132, KVUPW / 256, G, (G == 256) ? ((bid + 104) & 255) : bid, -1);
          pg8::EpiKvup E{KVUP, RS};
          pg8::gemm_phase<pg8::EpiKvup, pg8::TileOrder>(ldsl, gm, S, E); }
        if (SUB(2)) for (int rep_ = 0; rep_ < NREP(3); ++rep_) for (int u = (G == 256) ? ((bid + 80) & 255) : bid; u < NB * 4 * 33; u += G) {
            const int n = u % 33, h = (u / 33) & 3, bb = u / 132;
            const float lgf2 = log2_sigmoid(SM[SM_DECF + l * 4 + h]), lgb2 = log2_sigmoid(SM[SM_DECB + l * 4 + h]);
            ret_kv_unit(PROJ, KVS, bb, h, n, lgf2, lgb2, lds);
        }
        PH_END

        PH_BEGIN(4)
        if (SUB(3)) for (int rep_ = 0; rep_ < NREP(4); ++rep_) ret_scan(KVS, SIN, SM + SM_DECF + l * 4, SM + SM_DECB + l * 4, gtid, gthreads);
        if (SUB(4)) for (int rep_ = 0; rep_ < NREP(5); ++rep_) {
            const int nun = last ? 768 : 792;
            for (int u = bid; u < nun; u += G) {
                AttnArgs a;
                int bb, h, qrow;
                if (u < 768) { const int rnd = u / G, w_ = u % G; const int bh = (G == 256) ? (rnd * 8 + (w_ & 7)) : (u >> 5); const int qb = (G == 256) ? (w_ >> 3) : (u & 31); h = bh % 6; bb = bh / 6; qrow = bb * SEQ + qb * 256; a.nt = 132; a.seg0_tiles = 128; a.seg0_row = bb * SEQ; a.seg1_row = NLAT + bb * CTXL; }
                else { const int v = u - 768; h = v % 6; bb = v / 6; qrow = NLAT + bb * CTXL; a.nt = 4; a.seg0_tiles = 4; a.seg0_row = NLAT + bb * CTXL; a.seg1_row = a.seg0_row; }
                a.Q = QUP + (size_t)qrow * QUPW + h * 192; a.ldq = QUPW;
                a.K = KVUP + h * 256; a.ldk = KVUPW; a.KR = PROJ + 4096; a.ldkr = INW; a.V = KVUP + h * 256 + 128; a.ldv = KVUPW;
                a.O = Y + (size_t)qrow * D + 1280 + h * 128; a.ldo = D;
                a.qpos0 = 0; a.masked = 0; a.sink_l2 = 0.f; a.has_sink = 0; a.C = 1.0f;
                attn_body<192>(a, lds);
            }
        }
        if (SUB(5)) for (int rep_ = 0; rep_ < NREP(6); ++rep_) {
            const int nun = last ? 768 : 792;
            for (int u = bid; u < nun; u += G) {
                AttnArgs a;
                int bb, h, qrow;
                if (u < 768) { const int rnd = u / G, w_ = u % G; const int bh = (G == 256) ? (rnd * 8 + (w_ & 7)) : (u >> 5); const int qb = (G == 256) ? (w_ >> 3) : (u & 31); h = bh % 6; bb = bh / 6; qrow = bb * SEQ + qb * 256; a.nt = 12; a.seg0_tiles = 4; a.seg0_row = NLAT + bb * CTXL; a.seg1_row = bb * SEQ + qb * 256 - 128; a.qpos0 = qb * 256; a.masked = 1; }
                else { const int v = u - 768; h = v % 6; bb = v / 6; qrow = NLAT + bb * CTXL; a.nt = 4; a.seg0_tiles = 4; a.seg0_row = NLAT + bb * CTXL; a.seg1_row = a.seg0_row; a.qpos0 = 0; a.masked = 0; }
                const int kvh = h / 3;
                a.Q = PROJ + (size_t)qrow * INW + 2048 + h * 128; a.ldq = INW;
                a.K = PROJ + 2816 + kvh * 128; a.ldk = INW; a.KR = a.K; a.ldkr = INW; a.V = PROJ + 3072 + kvh * 128; a.ldv = INW;
                a.O = Y + (size_t)qrow * D + 512 + h * 128; a.ldo = D;
                a.sink_l2 = SM[SM_SINK + l * 6 + h] * LOG2E; a.has_sink = 1; a.C = 1.0f;
                attn_body<128>(a, lds);
            }
        }
        PH_END

        PH_BEGIN(5)
        for (int rep_ = 0; rep_ < NREP(7); ++rep_) for (int u = bid; u < NB * 4 * 33; u += G) {
            const int n = u % 33, h = (u / 33) & 3, bb = u / 132;
            if (last && n == 32) continue;
            const float lgf2 = log2_sigmoid(SM[SM_DECF + l * 4 + h]), lgb2 = log2_sigmoid(SM[SM_DECB + l * 4 + h]);
            ret_out_unit(PROJ, SIN, Y, bb, h, n, lgf2, lgb2, lds);
        }
        PH_END

        PH_BEGIN(6)
        for (int rep_ = 0; rep_ < NREP(10); ++rep_) { pg8::Gemm gm{Y, wl + W_O, D, D}; pg8::TileOrder S; S.init(nMfull, D / 256, G, bid, -1);
          pg8::EpiMix E{MIX, -1, rep_ + 1 < NREP(10)};
          pg8::gemm_phase<pg8::EpiMix, pg8::TileOrder>(ldsl, gm, S, E); }
        PH_END

        PH_BEGIN(7)
        ln_phase(XH, MIX, (float*)nullptr, XH, H, SM + SM_LN1G + l * D, SM + SM_LN1B + l * D, modl + 2 * D, modl + 4 * D, modl + 3 * D, last ? NLAT : NROWS, bid, G, lds);
        PH_END

#define FFN_UP(cc, nMc, skn, ski) for (int rep_ = 0; rep_ < NREP(8); ++rep_) { pg8::Gemm gm{H, wl + W_UP, D, D}; pg8::TileOrder S; S.init(nMc, DFF2 / 256, G, bid, cc, skn, ski); \
              pg8::EpiUpConv E{cc ? ACT1 : ACT0, SB, SM + SM_CONVW + (size_t)l * 3 * DFF, SM + SM_CONVB + (size_t)l * DFF, cc}; pg8::gemm_phase<pg8::EpiUpConv, pg8::TileOrder>(ldsl, gm, S, E); }
#define FFN_DOWN(cc, nMc) for (int rep_ = 0; rep_ < NREP(11); ++rep_) { pg8::Gemm gm{cc ? ACT1 : ACT0, wl + W_DN, DFF, DFF}; pg8::TileOrder S; S.init(nMc, D / 256, G, bid, -1); \
              pg8::EpiMix E{MIX, cc, rep_ + 1 < NREP(11)}; pg8::gemm_phase<pg8::EpiMix, pg8::TileOrder>(ldsl, gm, S, E); }
#define FFN_FIX(ACTc, nrows) { \
                const float* cw = SM + SM_CONVW + (size_t)l * 3 * DFF; \
                const int ngr = (nrows) / 64; \
                for (int it = gtid; it < 2 * ngr * (DFF / 4); it += gthreads) { \
                    const int f = (it % (DFF / 4)) * 4, gk = it / (DFF / 4), kind = gk / ngr, gi = gk % ngr; \
                    const int rg = gi * 64, smask = rg < FCH_LAT ? (SEQ - 1) : (CTXL - 1); \
                    const bool edge = kind ? (((rg + 63) & smask) == smask) : ((rg & smask) == 0); \
                    if (edge) continue; \
                    const float* sp = SB + ((size_t)(kind * NGRP + gi) * 3) * DFF + f; \
                    const float* np_ = SB + ((size_t)((1 - kind) * NGRP + (kind ? gi + 1 : gi - 1)) * 3 + 2) * DFF + f; \
                    const f32x4 z = *(const f32x4*)sp + *(const f32x4*)(cw + (kind ? 2 * DFF : 0) + f) * *(const f32x4*)np_; const f32x4 uu = *(const f32x4*)(sp + DFF); \
                    u32x2 ow; ow[0] = cvtpk(silu_f(z[0]) * uu[0], silu_f(z[1]) * uu[1]); ow[1] = cvtpk(silu_f(z[2]) * uu[2], silu_f(z[3]) * uu[3]); \
                    *(u32x2*)((ACTc) + (size_t)(rg + (kind ? 63 : 0)) * DFF + f) = ow; } }
        {
            const int nM0 = last ? 64 : 68, rows0 = last ? FCH_LAT : FCH_ROWS;
            const int skn = last ? 0 : 32;
            PH_BEGIN(8)
            FFN_UP(0, nM0, 0, 0)
            PH_END
            PH_BEGIN(9)
            FFN_FIX(ACT0, rows0)
            PH_END
            PH_BEGIN(10)
            FFN_DOWN(0, nM0)
            FFN_UP(1, 64, skn, 8)
            PH_END
            PH_BEGIN(11)
            FFN_FIX(ACT1, FCH_LAT)
            PH_END
            PH_BEGIN(12)
            FFN_DOWN(1, 64)
            PH_END
        }
#undef FFN_UP
#undef FFN_DOWN
#undef FFN_FIX

        PH_BEGIN(13)
        { const float* modn = MOD + (size_t)(last ? l : l + 1) * 5 * MODW;
          ln_phase(XH, MIX, last ? p.out : (float*)nullptr, XH, last ? (bf16_t*)nullptr : H, SM + SM_LN2G + l * D, SM + SM_LN2B + l * D, modl + 5 * D, modn + D, modn, last ? NLAT : NROWS, bid, G, lds); }
        PH_END
    }
#undef PH_BEGIN
#undef PH_END
}

constexpr int N_PHASES = 2 + DEPTH * 12;

extern "C" void kernel_launch(void* const* d_in, const int* in_sizes, int n_in, void* d_out, int out_size, void* d_ws, size_t ws_size, hipStream_t stream) {
    static int grid = 0;
    if (grid == 0) {
        if (n_in != 23 || in_sizes[0] != NLAT * D || out_size != NLAT * D || ws_size < WS_END) {
            fprintf(stderr, "kernel_launch: unexpected shapes: n_in %d in0 %d out %d ws %zu (need %zu)\n", n_in, n_in > 0 ? in_sizes[0] : -1, out_size, ws_size, (size_t)WS_END); grid = -1; return; }
        int dev = 0, cus = 0, per_cu = 0;
        if (hipGetDevice(&dev) != hipSuccess || hipDeviceGetAttribute(&cus, hipDeviceAttributeMultiprocessorCount, dev) != hipSuccess) { fprintf(stderr, "kernel_launch: device query failed\n"); grid = -1; return; }
        if (hipFuncSetAttribute((const void*)fwd_kernel, hipFuncAttributeMaxDynamicSharedMemorySize, LDS_BYTES) != hipSuccess) { fprintf(stderr, "kernel_launch: hipFuncSetAttribute failed\n"); grid = -1; return; }
        if (hipOccupancyMaxActiveBlocksPerMultiprocessor(&per_cu, (const void*)fwd_kernel, 512, LDS_BYTES) != hipSuccess || per_cu < 1) {
            fprintf(stderr, "kernel_launch: occupancy query reports %d workgroups per CU\n", per_cu); (void)hipGetLastError(); grid = -1; return; }
        grid = cus;
    }
    if (grid < 0) return;
    if (hipMemsetAsync((char*)d_ws + WS_CTL, 0, CTL_BYTES, stream) != hipSuccess) { fprintf(stderr, "kernel_launch: memset failed\n"); return; }
    Params p{};
    for (int i = 0; i < 23; ++i) p.in[i] = (const float*)d_in[i];
    p.out = (float*)d_out; p.ws = (unsigned char*)d_ws; p.pad = 0;
#if MK_ONE_LAUNCH
    p.ph_lo = 0; p.ph_hi = N_PHASES; p.bar_region = 0;
    hipLaunchKernelGGL(fwd_kernel, dim3(grid), dim3(512), LDS_BYTES, stream, p);
#else
    for (int g = 0; g < N_PHASES; ++g) { p.ph_lo = g; p.ph_hi = g + 1; p.bar_region = 0;
        hipLaunchKernelGGL(fwd_kernel, dim3(grid), dim3(512), LDS_BYTES, stream, p); }
#endif
    const hipError_t le = hipPeekAtLastError();
    if (le != hipSuccess) fprintf(stderr, "kernel_launch: launch failed: %s\n", hipGetErrorName(le));
}
```

```cpp
#include <hip/hip_runtime.h>
#include <cstdio>
#include <cstdint>

#define LAS __attribute__((address_space(3)))
typedef unsigned short bf16_t;
typedef short bf16x8 __attribute__((ext_vector_type(8)));
typedef short s16x4 __attribute__((ext_vector_type(4)));
typedef float f32x4 __attribute__((ext_vector_type(4)));
typedef float f32x16 __attribute__((ext_vector_type(16)));
typedef unsigned u32x4 __attribute__((ext_vector_type(4)));
typedef unsigned u32x2 __attribute__((ext_vector_type(2)));

#ifndef MK_ONE_LAUNCH
#define MK_ONE_LAUNCH 1
#endif

constexpr int D = 2048, NB = 4, SEQ = 8192, DEPTH = 4, CTXL = 256;
constexpr int NLAT = NB * SEQ, NCTX = NB * CTXL, NROWS = NLAT + NCTX;
constexpr int INW = 4160, INWP = 4352, DFF = 5632, DFF2 = 11264;
constexpr int QUPW = 1152, QUPWP = 1280, KVUPW = 1536;
constexpr int NMOD = 6, MODW = NMOD * D;
constexpr float LN_EPS = 1e-5f, RMS_EPS = 1e-6f;
constexpr float ALPHA = 1.6817928305074292f;
constexpr float KSCALE = 0.08838834764831845f;
constexpr float MLA_QSCALE = 0.07216878364870323f * 1.4426950408889634f;
constexpr float LOG2E = 1.4426950408889634f;

constexpr size_t MiB = 1u << 20;
constexpr size_t WS_CTL = 0, CTL_BYTES = 1 * MiB;
constexpr size_t WS_MOD = 1 * MiB;
constexpr size_t WS_ROPE = 2 * MiB;
constexpr size_t WS_SM = 2 * MiB + 65536;
constexpr int SM_DECF = 0, SM_DECB = 16, SM_SINK = 32, SM_LN1G = 64, SM_LN1B = SM_LN1G + DEPTH * D, SM_LN2G = SM_LN1B + DEPTH * D, SM_LN2B = SM_LN2G + DEPTH * D,
              SM_CONVW = SM_LN2B + DEPTH * D, SM_CONVB = SM_CONVW + DEPTH * 3 * DFF, SM_END = SM_CONVB + DEPTH * DFF;
static_assert(WS_SM + (size_t)SM_END * 4 <= 3 * MiB, "small vectors");
constexpr size_t WS_RS = 3 * MiB;
constexpr size_t WS_W = 5 * MiB;
constexpr size_t W_IN = 0, W_UQ = W_IN + (size_t)INWP * D, W_UKV = W_UQ + (size_t)QUPWP * 512, W_O = W_UKV + (size_t)KVUPW * 256,
                 W_UP = W_O + (size_t)D * D, W_DN = W_UP + (size_t)DFF2 * D, W_LAYER = W_DN + (size_t)D * DFF;
constexpr size_t WS_X = WS_W + W_LAYER * 2 * DEPTH;
constexpr size_t WS_H = WS_X + (size_t)NROWS * D * 4;
constexpr size_t WS_Y = WS_H + (size_t)NROWS * D * 2;
constexpr size_t WS_PROJ = WS_Y + (size_t)NROWS * D * 2;
constexpr size_t WS_QUP = WS_PROJ + (size_t)NROWS * INW * 2;
constexpr size_t WS_KVUP = WS_QUP + (size_t)NROWS * QUPW * 2;
constexpr size_t WS_KVS = WS_KVUP + (size_t)NROWS * KVUPW * 2;
constexpr size_t WS_SIN = WS_KVS + (size_t)NB * 4 * 2 * 33 * 16384 * 4;
constexpr size_t WS_END = WS_SIN + (size_t)NB * 4 * 2 * 33 * 16384 * 2;
constexpr int FCH_LAT = 64 * 256, FCH_ROWS = FCH_LAT + NCTX;
constexpr size_t WS_ACT0 = WS_Y;
constexpr size_t WS_ACT1 = WS_ACT0 + (size_t)FCH_ROWS * DFF * 2;
constexpr int NGRP = FCH_ROWS / 64;
constexpr size_t WS_SB = WS_ACT1 + (size_t)FCH_LAT * DFF * 2;
static_assert(WS_SB + (size_t)2 * NGRP * 3 * DFF * 4 <= WS_QUP, "FFN overlay");
constexpr size_t WS_MIX = WS_QUP;
static_assert(WS_MIX >= WS_QUP && WS_MIX + (size_t)NROWS * D * 2 <= WS_END, "FFN overlay");
static_assert(WS_W % 256 == 0 && W_LAYER % 128 == 0 && WS_X % 256 == 0, "align");

constexpr int LDS_BYTES = 131072 + 512;

#define XB_TMO      128
#define XB_XCNT(j)  (256  + 64 * (j))
#define XB_XSUB(j)  (1280 + 64 * (j))
#define XB_XGEN(j)  (2304 + 64 * (j))
#define XB_TOP      3328
#define XB_TOPGEN   3392
#define XCD_BAR_WORDS 3456
#define XB_SPIN_CAP (1u << 20)

__device__ __forceinline__ unsigned xb_ld(unsigned* p)              { return __hip_atomic_load(p, __ATOMIC_RELAXED, __HIP_MEMORY_SCOPE_AGENT); }
__device__ __forceinline__ unsigned xb_add(unsigned* p, unsigned v) { return __hip_atomic_fetch_add(p, v, __ATOMIC_RELAXED, __HIP_MEMORY_SCOPE_AGENT); }
__device__ __forceinline__ unsigned xb_xcc_id() { return (unsigned)__builtin_amdgcn_s_getreg((3 << 11) | 20) & 0xFu; }
#define XB_SPIN(cond, bar) do { unsigned _sp = 0; while (cond) { __builtin_amdgcn_s_sleep(1); \
    if ((++_sp & 255u) == 0u) { if (xb_ld(&(bar)[XB_TMO])) break; if (_sp > XB_SPIN_CAP) { atomicAdd(&(bar)[XB_TMO], 1u); break; } } } } while (0)

struct XcdBarrier { unsigned* bar; unsigned x; volatile LAS unsigned* st; };

__device__ __forceinline__ XcdBarrier xcd_barrier_post(unsigned* bar, volatile LAS unsigned* st) {
    XcdBarrier b; b.bar = bar; b.x = xb_xcc_id(); b.st = st;
    if (threadIdx.x == 0) (void)xb_add(&bar[XB_XCNT(b.x)], 1u);
    return b;
}
__device__ __forceinline__ void xcd_barrier_complete(unsigned* bar, unsigned x, unsigned& nloc, unsigned& nx) {
    const unsigned G = gridDim.x * gridDim.y * gridDim.z;
    unsigned sum, cnt, mine, sp = 0u;
    for (;;) {
        sum = 0u; cnt = 0u; mine = 0u;
#pragma unroll
        for (unsigned j = 0; j < 16; ++j) { const unsigned c = xb_ld(&bar[XB_XCNT(j)]); sum += c; cnt += (c > 0u) ? 1u : 0u; mine = (j == x) ? c : mine; }
        if (sum == G) break;
        __builtin_amdgcn_s_sleep(1);
        if ((++sp & 255u) == 0u) { if (xb_ld(&bar[XB_TMO])) break; if (sp > XB_SPIN_CAP) { atomicAdd(&bar[XB_TMO], 1u); break; } }
    }
    nloc = mine > 0u ? mine : 1u; nx = cnt > 0u ? cnt : 1u;
}
__device__ __forceinline__ void xcd_barrier(const XcdBarrier& b) {
    asm volatile("s_waitcnt vmcnt(0)" ::: "memory");
    __syncthreads();
    if (threadIdx.x == 0) {
        unsigned* bar = b.bar;
        __builtin_amdgcn_s_waitcnt(0);
        unsigned nloc = b.st[0], nx = b.st[1];
        if (nloc == 0u) { xcd_barrier_complete(bar, b.x, nloc, nx); b.st[0] = nloc; b.st[1] = nx; }
        const unsigned old = xb_add(&bar[XB_XSUB(b.x)], 1u);
        const unsigned gen = old / nloc;
        if (old + 1u == (gen + 1u) * nloc) {
            __builtin_amdgcn_fence(__ATOMIC_RELEASE, "agent");
            asm volatile("s_waitcnt vmcnt(0)" ::: "memory");
            const unsigned og = xb_add(&bar[XB_TOP], 1u);
            const unsigned tg = og / nx;
            if (og + 1u == (tg + 1u) * nx) xb_add(&bar[XB_TOPGEN], 1u);
            else XB_SPIN(xb_ld(&bar[XB_TOPGEN]) == tg, bar);
            __builtin_amdgcn_fence(__ATOMIC_ACQUIRE, "agent");
            xb_add(&bar[XB_XGEN(b.x)], 1u);
            asm volatile("s_waitcnt vmcnt(0)" ::: "memory");
        } else {
            XB_SPIN(xb_ld(&bar[XB_XGEN(b.x)]) == gen, bar);
            __builtin_amdgcn_fence(__ATOMIC_ACQUIRE, "agent");
            asm volatile("s_waitcnt vmcnt(0)" ::: "memory");
        }
    }
    __syncthreads();
}

__device__ __forceinline__ unsigned cvtpk(float lo, float hi) { unsigned r; asm volatile("v_cvt_pk_bf16_f32 %0, %1, %2" : "=v"(r) : "v"(lo), "v"(hi)); return r; }
__device__ __forceinline__ float bf2f(unsigned short b) { return __uint_as_float(((unsigned)b) << 16); }
__device__ __forceinline__ float bflo(unsigned w) { return __uint_as_float(w << 16); }
__device__ __forceinline__ float bfhi(unsigned w) { return __uint_as_float(w & 0xffff0000u); }
__device__ __forceinline__ void st_bf16x4(bf16_t* p, f32x4 v) { u32x2 w; w.x = cvtpk(v[0], v[1]); w.y = cvtpk(v[2], v[3]); *(u32x2*)p = w; }
typedef _Float16 f16x4 __attribute__((ext_vector_type(4)));
__device__ __forceinline__ void st_f16x4(bf16_t* p, f32x4 v) { *(f16x4*)p = __builtin_convertvector(v, f16x4); }
__device__ __forceinline__ f32x4 cvt_f16x4(u32x2 w) { return __builtin_convertvector(__builtin_bit_cast(f16x4, w), f32x4); }
__device__ __forceinline__ float silu_f(float x) { return x * __builtin_amdgcn_rcpf(1.0f + __builtin_amdgcn_exp2f(-1.4426950408889634f * x)); }
__device__ __forceinline__ float wave_sum(float v) {
#pragma unroll
    for (int o = 1; o < 64; o <<= 1) v += __shfl_xor(v, o);
    return v;
}
__device__ __forceinline__ int otid() { int t = threadIdx.x; asm volatile("" : "+v"(t)); return t; }
__device__ __forceinline__ int mod_index(int row) { return row < NLAT ? (row >> 13) : 4; }

namespace pg8 {
constexpr int BM = 256, BK = 64, HALF = 128, HTB = HALF * BK * 2, STAGE_BYTES = 8 * HTB, NXCD = 8, WGM = 8;
__host__ __device__ __forceinline__ int lds_byte(int r, int c) { const int st = (r >> 4) * 2 + (c >> 5), rr = r & 15, cc = c & 31, ob = rr * 64 + cc * 2; return st * 1024 + (ob ^ (((ob >> 9) & 1) << 5)); }
__host__ __device__ __forceinline__ void stage_rc(int b, int& R, int& C) { const int st = b / 1024, sb = b % 1024, swz = sb ^ (((sb >> 9) & 1) << 5); R = (st >> 1) * 16 + swz / 64; C = (st & 1) * 32 + (swz % 64) / 2; }

struct Unit { int pm, pn; };
struct Gemm { const bf16_t* A; const bf16_t* Bt; int lda, K; };

struct TileOrder {
    int nM, nN, nwg, G, c, chunk, skew_n, skew_i;
    __device__ __forceinline__ void init(int nM_, int nN_, int G_, int c_, int chunk_, int skew_n_ = 0, int skew_i_ = 0) { nM = nM_; nN = nN_; nwg = nM * nN; G = G_; c = c_; chunk = chunk_; skew_n = skew_n_; skew_i = skew_i_; }
    __device__ __forceinline__ bool next(int i, Unit& u) const {
        long L;
        if (skew_n == 0 || i < skew_i) L = (long)i * G + c;
        else { if (c < skew_n) return false; L = (long)skew_i * G + (long)(i - skew_i) * (G - skew_n) + (c - skew_n); }
        if (L >= nwg) return false;
        int wgid = (int)L; { const int q = nwg / NXCD, r = nwg % NXCD, xcd = wgid % NXCD, off = wgid / NXCD; wgid = (xcd < r ? xcd * (q + 1) : r * (q + 1) + (xcd - r) * q) + off; }
        const int nig = WGM * nN, gid = wgid / nig, fm = gid * WGM, gsz = (nM - fm) < WGM ? (nM - fm) : WGM;
        int pm = fm + ((wgid % nig) % gsz); u.pn = (wgid % nig) / gsz;
        if (chunk >= 0) pm = (pm < 64) ? 64 * chunk + pm : 128 + (pm - 64);
        u.pm = pm; return true;
    }
    __device__ __forceinline__ void a_ready(const Unit&) const {}
    __device__ __forceinline__ void done(const Unit&) const {}
};

template <class Epi, class Sched>
__device__ __forceinline__ void gemm_phase(LAS unsigned char* lds, const Gemm g, const Sched& S, const Epi& E) {
    const int tid = otid(), wid = __builtin_amdgcn_readfirstlane(tid >> 6), lane = tid & 63, wr = wid >> 2, wc = wid & 3, fr = lane & 15, fq = lane >> 4;
    const int K = g.K, nt = K / BK, lda = g.lda;
    unsigned voffA[2], voffB[2];
#pragma unroll
    for (int i = 0; i < 2; ++i) { int R, C; stage_rc(tid * 16 + i * 8192, R, C);
        voffA[i] = (unsigned)(R * lda + C) * 2u; voffB[i] = (unsigned)(R * K + C) * 2u; }
    const size_t kstep = (size_t)(BK * 2);
    const size_t hstepA = (size_t)HALF * lda * 2, hstepB = (size_t)HALF * K * 2;
    const size_t tstepA = 2 * hstepA, tstepB = 2 * hstepB;
    const unsigned ldsw = (unsigned)wid * 1024u;
    const int aoff = lds_byte(wr * 64 + fr, fq * 8), boff = lds_byte(wc * 32 + fr, fq * 8);
#define PG8_SA(b, h) (((b) * 2 + (h)) * HTB)
#define PG8_SB(b, h) ((4 + (b) * 2 + (h)) * HTB)
#define PG8_STAGE(bufoff, gbase, voff) do { const char* gb_ = (const char*)(gbase); asm volatile("" : "+s"(gb_));        \
        _Pragma("unroll") for (int _i = 0; _i < 2; ++_i) \
        __builtin_amdgcn_global_load_lds((const unsigned*)(gb_ + (voff)[_i]), (LAS unsigned*)(lds + (bufoff) + ldsw + _i * 8192), 16, 0, 0); } while (0)
#define PG8_LDA(dst, b, h) do { _Pragma("unroll") for (int m = 0; m < 4; ++m) _Pragma("unroll") for (int k = 0; k < 2; ++k) dst[m][k] = *(const LAS bf16x8*)(lds + PG8_SA(b, h) + aoff + m * 2048 + k * 1024); } while (0)
#define PG8_LDB(dst, b, h) do { _Pragma("unroll") for (int n = 0; n < 2; ++n) _Pragma("unroll") for (int k = 0; k < 2; ++k) dst[n][k] = *(const LAS bf16x8*)(lds + PG8_SB(b, h) + boff + n * 2048 + k * 1024); } while (0)
#define PG8_MMA(ai, bj, At, Bt) do { __builtin_amdgcn_s_setprio(1); _Pragma("unroll") for (int m = 0; m < 4; ++m) _Pragma("unroll") for (int n = 0; n < 2; ++n) _Pragma("unroll") for (int k = 0; k < 2; ++k) \
        acc[ai][bj][m][n] = __builtin_amdgcn_mfma_f32_16x16x32_bf16(Bt[n][k], At[m][k], acc[ai][bj][m][n], 0, 0, 0); __builtin_amdgcn_s_setprio(0); } while (0)
#define PG8_WAIT_V(n) asm volatile("s_waitcnt vmcnt(" #n ")" ::: "memory")
#define PG8_WAIT_L(n) asm volatile("s_waitcnt lgkmcnt(" #n ")" ::: "memory")
#define PG8_BAR __builtin_amdgcn_s_barrier()
#define PG8_SCHED __builtin_amdgcn_sched_barrier(0)
    Unit cur, nxt; int ui = 0;
    if (!S.next(0, cur)) return;
    f32x4 acc[2][2][4][2];
#pragma unroll
    for (int a = 0; a < 2; ++a)
#pragma unroll
        for (int b = 0; b < 2; ++b)
#pragma unroll
            for (int m = 0; m < 4; ++m)
#pragma unroll
                for (int n = 0; n < 2; ++n) acc[a][b][m][n] = (f32x4){0.f, 0.f, 0.f, 0.f};
    bf16x8 At[4][2], B0[2][2], B1[2][2];
    const char* cA = (const char*)g.A + (size_t)cur.pm * tstepA; const char* cB = (const char*)g.Bt + (size_t)cur.pn * tstepB;
    S.a_ready(cur);
    PG8_STAGE(PG8_SB(0, 0), cB, voffB); PG8_STAGE(PG8_SA(0, 0), cA, voffA); PG8_STAGE(PG8_SB(0, 1), cB + hstepB, voffB); PG8_STAGE(PG8_SA(0, 1), cA + hstepA, voffA);
    if (wr == 1) PG8_BAR;
    PG8_WAIT_V(4); PG8_BAR;
    PG8_STAGE(PG8_SB(1, 0), cB + kstep, voffB); PG8_STAGE(PG8_SA(1, 0), cA + kstep, voffA); PG8_STAGE(PG8_SB(1, 1), cB + hstepB + kstep, voffB);
    PG8_WAIT_V(6); PG8_BAR;
    for (;;) {
        const bool has_next = S.next(ui + 1, nxt);
        const char* nA = has_next ? (const char*)g.A + (size_t)nxt.pm * tstepA : cA; const char* nB = has_next ? (const char*)g.Bt + (size_t)nxt.pn * tstepB : cB;
#pragma nounroll
        for (int t = 0; t < nt; t += 2) {
            asm volatile("" : "+v"(voffA[0]), "+v"(voffA[1]), "+v"(voffB[0]), "+v"(voffB[1]));
            const bool last = (t == nt - 2);
            const char* a1 = cA + (size_t)(t + 1) * kstep;
            const char* a2 = last ? nA : cA + (size_t)(t + 2) * kstep; const char* b2 = last ? nB : cB + (size_t)(t + 2) * kstep;
            const char* a3 = a2 + kstep; const char* b3 = b2 + kstep;
            if (last && has_next) S.a_ready(nxt);
            PG8_LDB(B0, 0, 0); PG8_SCHED; PG8_LDA(At, 0, 0); PG8_STAGE(PG8_SA(1, 1), a1 + hstepA, voffA);
            PG8_WAIT_L(8); PG8_BAR; PG8_WAIT_L(0); PG8_MMA(0, 0, At, B0); PG8_BAR; PG8_SCHED;
            PG8_LDB(B1, 0, 1); PG8_STAGE(PG8_SB(0, 0), b2, voffB);
            PG8_BAR; PG8_WAIT_L(0); PG8_MMA(0, 1, At, B1); PG8_BAR;
            PG8_LDA(At, 0, 1); PG8_STAGE(PG8_SA(0, 0), a2, voffA);
            PG8_BAR; PG8_WAIT_L(0); PG8_MMA(1, 0, At, B0); PG8_BAR; PG8_SCHED;
            PG8_STAGE(PG8_SB(0, 1), b2 + hstepB, voffB);
            PG8_WAIT_V(6); PG8_BAR; PG8_MMA(1, 1, At, B1); PG8_BAR;
            PG8_LDB(B0, 1, 0); PG8_SCHED; PG8_LDA(At, 1, 0); PG8_STAGE(PG8_SA(0, 1), a2 + hstepA, voffA);
            PG8_WAIT_L(8); PG8_BAR; PG8_WAIT_L(0); PG8_MMA(0, 0, At, B0); PG8_BAR; PG8_SCHED;
            PG8_LDB(B1, 1, 1); PG8_STAGE(PG8_SB(1, 0), b3, voffB);
            PG8_BAR; PG8_WAIT_L(0); PG8_MMA(0, 1, At, B1); PG8_BAR;
            PG8_LDA(At, 1, 1); PG8_STAGE(PG8_SA(1, 0), a3, voffA);
            PG8_BAR; PG8_WAIT_L(0); PG8_MMA(1, 0, At, B0); PG8_BAR; PG8_SCHED;
            PG8_STAGE(PG8_SB(1, 1), b3 + hstepB, voffB);
            PG8_WAIT_V(6); PG8_BAR; PG8_MMA(1, 1, At, B1); PG8_BAR;
        }
        E(acc, cur, wr, wc, fr, fq); S.done(cur);
        if (!has_next) break;
#pragma unroll
        for (int a = 0; a < 2; ++a)
#pragma unroll
            for (int b = 0; b < 2; ++b)
#pragma unroll
                for (int m = 0; m < 4; ++m)
#pragma unroll
                    for (int n = 0; n < 2; ++n) acc[a][b][m][n] = (f32x4){0.f, 0.f, 0.f, 0.f};
        cur = nxt; cA = nA; cB = nB; ++ui;
    }
    PG8_WAIT_V(0);
    if (wr == 0) PG8_BAR;
    PG8_BAR;
#undef PG8_SA
#undef PG8_SB
#undef PG8_STAGE
#undef PG8_LDA
#undef PG8_LDB
#undef PG8_MMA
#undef PG8_WAIT_V
#undef PG8_WAIT_L
#undef PG8_BAR
#undef PG8_SCHED
}


struct EpiProj {
    bf16_t* P; float* RS; const float* thc; const float* ths; const float* tmc; const float* tms;
    __device__ __forceinline__ void operator()(const f32x4 (&acc)[2][2][4][2], const Unit& u, int wr, int wc, int fr, int fq) const {
        asm volatile("" : "+v"(fr), "+v"(fq));
        const int pn = u.pn; const bool lat = u.pm < 128;
        const int row0 = u.pm * BM + wr * 64 + fr;
        if (pn == 16) {
            if (wc < 2) {
#pragma unroll
                for (int ai = 0; ai < 2; ++ai)
#pragma unroll
                    for (int m = 0; m < 4; ++m) {
                        const int row = row0 + ai * HALF + m * 16; const f32x4 v0 = acc[ai][0][m][0], v1 = acc[ai][0][m][1]; f32x4 o0 = v0, o1 = v1;
                        if (lat) { const int pos = row & (SEQ - 1), tp = wc ? (pos & 63) : (pos >> 6);
                            const f32x4 c = *(const f32x4*)(tmc + tp * 16 + 4 * fq), s = *(const f32x4*)(tms + tp * 16 + 4 * fq);
                            o0 = v0 * c - v1 * s; o1 = v1 * c + v0 * s; }
                        bf16_t* rp = P + (size_t)row * INW + 4096 + 32 * wc + 4 * fq;
                        st_bf16x4(rp, o0); st_bf16x4(rp + 16, o1);
                        asm volatile("" ::: "memory");
                    }
            }
            return;
        }
        const bool roped = (pn < 4) || (pn >= 8 && pn < 12);
        if (roped) {
            const float sc = (pn == 2 || pn == 3) ? KSCALE : ((pn >= 8 && pn <= 10) ? KSCALE * LOG2E : 1.0f);
            const int colb = pn * BM + 128 * (wc >> 1) + 64 * (wc & 1) + 8 * fq;
#pragma unroll
            for (int ai = 0; ai < 2; ++ai)
#pragma unroll
                for (int m = 0; m < 4; ++m) {
                    const int row = row0 + ai * HALF + m * 16; const int pos = row & (SEQ - 1), tp = (wc & 1) ? (pos & 63) : (pos >> 6);
                    u32x4 w0, w1;
#pragma unroll
                    for (int n = 0; n < 2; ++n) {
                        f32x4 c = (f32x4){1.f, 1.f, 1.f, 1.f}, s = (f32x4){0.f, 0.f, 0.f, 0.f};
                        if (lat) { c = *(const f32x4*)(thc + tp * 32 + 8 * fq + 4 * n); s = *(const f32x4*)(ths + tp * 32 + 8 * fq + 4 * n); }
                        const f32x4 v0 = acc[ai][0][m][n] * sc, v1 = acc[ai][1][m][n] * sc;
                        const f32x4 o0 = v0 * c - v1 * s, o1 = v1 * c + v0 * s;
                        w0[2 * n] = cvtpk(o0[0], o0[1]); w0[2 * n + 1] = cvtpk(o0[2], o0[3]); w1[2 * n] = cvtpk(o1[0], o1[1]); w1[2 * n + 1] = cvtpk(o1[2], o1[3]);
                    }
                    bf16_t* rp = P + (size_t)row * INW + colb;
                    *(u32x4*)rp = w0; *(u32x4*)(rp + 32) = w1;
                    asm volatile("" ::: "memory");
                }
            return;
        }
#pragma unroll
        for (int ai = 0; ai < 2; ++ai)
#pragma unroll
            for (int m = 0; m < 4; ++m) {
                const int row = row0 + ai * HALF + m * 16; bf16_t* rp = P + (size_t)row * INW + pn * BM + wc * 32 + 8 * fq; float ss = 0.f;
#pragma unroll
                for (int bj = 0; bj < 2; ++bj) { const f32x4 v0 = acc[ai][bj][m][0], v1 = acc[ai][bj][m][1];
                    u32x4 w; w[0] = cvtpk(v0[0], v0[1]); w[1] = cvtpk(v0[2], v0[3]); w[2] = cvtpk(v1[0], v1[1]); w[3] = cvtpk(v1[2], v1[3]);
                    *(u32x4*)(rp + bj * HALF) = w;
                    ss += ((v0[0] * v0[0] + v0[1] * v0[1]) + (v0[2] * v0[2] + v0[3] * v0[3])) + ((v1[0] * v1[0] + v1[1] * v1[1]) + (v1[2] * v1[2] + v1[3] * v1[3])); }
                if (pn >= 13 && pn <= 15) { ss += __shfl_xor(ss, 16); ss += __shfl_xor(ss, 32); if (fq == 0) RS[(size_t)row * 12 + (pn - 13) * 4 + wc] = ss; }
            }
    }
};
struct EpiQup {
    bf16_t* Q; const float* RS; const float* tmc; const float* tms;
    __device__ __forceinline__ void operator()(const f32x4 (&acc)[2][2][4][2], const Unit& u, int wr, int wc, int fr, int fq) const {
        asm volatile("" : "+v"(fr), "+v"(fq));
        const int pn = u.pn; const bool lat = u.pm < 128; const int row0 = u.pm * BM + wr * 64 + fr;
#pragma unroll
        for (int ai = 0; ai < 2; ++ai)
#pragma unroll
            for (int m = 0; m < 4; ++m) {
                const int row = row0 + ai * HALF + m * 16; const f32x4 r0 = *(const f32x4*)(RS + (size_t)row * 12), r1 = *(const f32x4*)(RS + (size_t)row * 12 + 4);
                const float rs = MLA_QSCALE / sqrtf(((r0[0] + r0[1]) + (r0[2] + r0[3]) + (r1[0] + r1[1]) + (r1[2] + r1[3])) * (1.0f / 512.0f) + RMS_EPS);
                const int pos = row & (SEQ - 1), tp = (wc & 1) ? (pos & 63) : (pos >> 6);
                const f32x4 c = *(const f32x4*)(tmc + tp * 16 + 4 * fq), s = *(const f32x4*)(tms + tp * 16 + 4 * fq);
#pragma unroll
                for (int bj = 0; bj < 2; ++bj) {
                    const int colb = pn * BM + bj * HALF + wc * 32; if (colb >= QUPW) continue;
                    const int c64 = 4 * pn + 2 * bj + (wc >> 1);
                    const f32x4 v0 = acc[ai][bj][m][0] * rs, v1 = acc[ai][bj][m][1] * rs; f32x4 o0 = v0, o1 = v1;
                    if (lat && (c64 % 3) == 2) { o0 = v0 * c - v1 * s; o1 = v1 * c + v0 * s; }
                    bf16_t* rp = Q + (size_t)row * QUPW + colb + 4 * fq; st_bf16x4(rp, o0); st_bf16x4(rp + 16, o1);
                }
                asm volatile("" ::: "memory");
            }
    }
};
struct EpiKvup {
    bf16_t* KV; const float* RS;
    __device__ __forceinline__ void operator()(const f32x4 (&acc)[2][2][4][2], const Unit& u, int wr, int wc, int fr, int fq) const {
        asm volatile("" : "+v"(fr), "+v"(fq));
        const int row0 = u.pm * BM + wr * 64 + fr;
#pragma unroll
        for (int ai = 0; ai < 2; ++ai)
#pragma unroll
            for (int m = 0; m < 4; ++m) {
                const int row = row0 + ai * HALF + m * 16; const f32x4 r0 = *(const f32x4*)(RS + (size_t)row * 12 + 8);
                const float rs = 1.0f / sqrtf(((r0[0] + r0[1]) + (r0[2] + r0[3])) * (1.0f / 256.0f) + RMS_EPS);
                bf16_t* rp = KV + (size_t)row * KVUPW + u.pn * BM + wc * 32 + 8 * fq;
#pragma unroll
                for (int bj = 0; bj < 2; ++bj) { const f32x4 v0 = acc[ai][bj][m][0] * rs, v1 = acc[ai][bj][m][1] * rs;
                    u32x4 w; w[0] = cvtpk(v0[0], v0[1]); w[1] = cvtpk(v0[2], v0[3]); w[2] = cvtpk(v1[0], v1[1]); w[3] = cvtpk(v1[2], v1[3]);
                    *(u32x4*)(rp + bj * HALF) = w; }
                asm volatile("" ::: "memory");
            }
    }
};
struct EpiMix {
    bf16_t* MIX; int chunk; int dry;
    __device__ __forceinline__ void operator()(const f32x4 (&acc)[2][2][4][2], const Unit& u, int wr, int wc, int fr, int fq) const {
        asm volatile("" : "+v"(fr), "+v"(fq));
        if (dry) { float s = 0.f;
#pragma unroll
            for (int ai = 0; ai < 2; ++ai)
#pragma unroll
                for (int bj = 0; bj < 2; ++bj)
#pragma unroll
                    for (int m = 0; m < 4; ++m)
#pragma unroll
                        for (int n = 0; n < 2; ++n) s += (acc[ai][bj][m][n][0] + acc[ai][bj][m][n][1]) + (acc[ai][bj][m][n][2] + acc[ai][bj][m][n][3]);
            if (s == 123456.789f) MIX[0] = (bf16_t)1; return; }
        const int pmg = chunk < 0 ? u.pm : (u.pm < 64 ? 64 * chunk + u.pm : 128 + (u.pm - 64));
        const int row0 = pmg * BM + wr * 64 + fr;
#pragma unroll
        for (int ai = 0; ai < 2; ++ai)
#pragma unroll
            for (int m = 0; m < 4; ++m) { bf16_t* rp = MIX + (size_t)(row0 + ai * HALF + m * 16) * D + u.pn * BM + wc * 32 + 8 * fq;
#pragma unroll
                for (int bj = 0; bj < 2; ++bj) { const f32x4 v0 = acc[ai][bj][m][0], v1 = acc[ai][bj][m][1];
                    u32x4 w; w[0] = cvtpk(v0[0], v0[1]); w[1] = cvtpk(v0[2], v0[3]); w[2] = cvtpk(v1[0], v1[1]); w[3] = cvtpk(v1[2], v1[3]);
                    *(u32x4*)(rp + bj * HALF) = w; } }
    }
};
struct EpiUpConv {
    bf16_t* ACTc; float* SB; const float* cw; const float* cb; int chunk;
    static __device__ __forceinline__ float lane_prev(float x) { return __builtin_bit_cast(float, __builtin_amdgcn_update_dpp(0, __builtin_bit_cast(int, x), 0x121, 0xf, 0xf, true)); }
    static __device__ __forceinline__ float lane_next(float x) { return __builtin_bit_cast(float, __builtin_amdgcn_update_dpp(0, __builtin_bit_cast(int, x), 0x12f, 0xf, 0xf, true)); }
    static __device__ __forceinline__ void taps2(const int MM, float& z0, float& z1, float gc0, float gc1, float gp0, float gp1, float gn0, float gn1, float w1a, float w1b, float ba, float bb_,
                                                 float w0ma, float w0mb, float w2ma, float w2mb, float w0ea, float w0eb, float w2ea, float w2eb) {
#define TAP_HEAD "v_fma_f32 %0, %2, %8, %10\n\tv_fma_f32 %1, %3, %9, %11\n\t" \
                 "v_fmac_f32_dpp %0, %2, %12 row_ror:1 row_mask:0xf bank_mask:0xf\n\tv_fmac_f32_dpp %1, %3, %13 row_ror:1 row_mask:0xf bank_mask:0xf\n\t" \
                 "v_fmac_f32_dpp %0, %2, %14 row_ror:15 row_mask:0xf bank_mask:0xf\n\tv_fmac_f32_dpp %1, %3, %15 row_ror:15 row_mask:0xf bank_mask:0xf"
#define TAP_PREV "\n\tv_fmac_f32_dpp %0, %4, %16 row_ror:1 row_mask:0xf bank_mask:0xf\n\tv_fmac_f32_dpp %1, %5, %17 row_ror:1 row_mask:0xf bank_mask:0xf"
#define TAP_NEXT "\n\tv_fmac_f32_dpp %0, %6, %18 row_ror:15 row_mask:0xf bank_mask:0xf\n\tv_fmac_f32_dpp %1, %7, %19 row_ror:15 row_mask:0xf bank_mask:0xf"
#define TAP_OPS : "=&v"(z0), "=&v"(z1) : "v"(gc0), "v"(gc1), "v"(gp0), "v"(gp1), "v"(gn0), "v"(gn1), "v"(w1a), "v"(w1b), "v"(ba), "v"(bb_), "v"(w0ma), "v"(w0mb), "v"(w2ma), "v"(w2mb), "v"(w0ea), "v"(w0eb), "v"(w2ea), "v"(w2eb)
        if (MM == 0) asm(TAP_HEAD TAP_NEXT TAP_OPS);
        else if (MM == 3) asm(TAP_HEAD TAP_PREV TAP_OPS);
        else asm(TAP_HEAD TAP_PREV TAP_NEXT TAP_OPS);
#undef TAP_HEAD
#undef TAP_PREV
#undef TAP_NEXT
#undef TAP_OPS
    }
    __device__ __forceinline__ void operator()(const f32x4 (&acc)[2][2][4][2], const Unit& u, int wr, int wc, int fr, int fq) const {
        asm volatile("" : "+v"(fr), "+v"(fq));
        const int lpm = u.pm < 128 ? u.pm - 64 * chunk : 64 + (u.pm - 128);
        const int f0 = u.pn * 128 + wc * 32 + 8 * fq;
        constexpr float NL2E = -1.4426950408889634f;
        f32x4 w0m[2], w0e[2], w2m[2], w2e[2], w1s[2], bbs[2];
#pragma unroll
        for (int n = 0; n < 2; ++n) {
            const f32x4 a0 = *(const f32x4*)(cw + f0 + 4 * n) * NL2E, a2 = *(const f32x4*)(cw + 2 * DFF + f0 + 4 * n) * NL2E; const f32x4 zero = {0.f, 0.f, 0.f, 0.f};
            w1s[n] = *(const f32x4*)(cw + DFF + f0 + 4 * n) * NL2E; bbs[n] = *(const f32x4*)(cb + f0 + 4 * n) * NL2E;
            w0m[n] = fr > 0 ? a0 : zero; w0e[n] = fr == 0 ? a0 : zero; w2m[n] = fr < 15 ? a2 : zero; w2e[n] = fr == 15 ? a2 : zero;
        }
#pragma unroll
        for (int ai = 0; ai < 2; ++ai) {
            const int rg = lpm * BM + ai * HALF + wr * 64;
            const int smask = rg < FCH_LAT ? (SEQ - 1) : (CTXL - 1);
            const bool seq_first = (rg & smask) == 0, seq_last = ((rg + 63) & smask) == smask;
#pragma unroll
            for (int m = 0; m < 4; ++m) {
                u32x4 ow;
#pragma unroll
                for (int n = 0; n < 2; ++n) {
                    const f32x4 gc = acc[ai][1][m][n], uu = acc[ai][0][m][n];
                    const f32x4 gpf = acc[ai][1][m > 0 ? m - 1 : 0][n], gnf = acc[ai][1][m < 3 ? m + 1 : 3][n];
                    f32x4 zs;
#pragma unroll
                    for (int e = 0; e < 4; e += 2) {
                        float z0, z1;
                        taps2(m, z0, z1, gc[e], gc[e + 1], gpf[e], gpf[e + 1], gnf[e], gnf[e + 1], w1s[n][e], w1s[n][e + 1], bbs[n][e], bbs[n][e + 1],
                                                              w0m[n][e], w0m[n][e + 1], w2m[n][e], w2m[n][e + 1], w0e[n][e], w0e[n][e + 1], w2e[n][e], w2e[n][e + 1]);
                        zs[e] = z0; zs[e + 1] = z1;
                    }
                    f32x4 o;
#pragma unroll
                    for (int e = 0; e < 4; ++e) o[e] = (zs[e] * uu[e]) * __builtin_amdgcn_rcpf(fmaf(__builtin_amdgcn_exp2f(zs[e]), NL2E, NL2E));
                    ow[2 * n] = cvtpk(o[0], o[1]); ow[2 * n + 1] = cvtpk(o[2], o[3]);
                    if (m == 0 && fr == 0) { float* sp = SB + ((size_t)(0 * NGRP + (rg >> 6)) * 3) * DFF + f0 + 4 * n; *(f32x4*)(sp + 2 * DFF) = gc; if (!seq_first) { *(f32x4*)sp = zs * (1.0f / NL2E); *(f32x4*)(sp + DFF) = uu; } }
                    if (m == 3 && fr == 15) { float* sp = SB + ((size_t)(1 * NGRP + (rg >> 6)) * 3) * DFF + f0 + 4 * n; *(f32x4*)(sp + 2 * DFF) = gc; if (!seq_last) { *(f32x4*)sp = zs * (1.0f / NL2E); *(f32x4*)(sp + DFF) = uu; } }
                }
                *(u32x4*)(ACTc + (size_t)(rg + 16 * m + fr) * DFF + f0) = ow;
            }
            asm volatile("" ::: "memory");
        }
    }
};
}

#define SBAR() __builtin_amdgcn_sched_barrier(0)
__device__ __forceinline__ int crow(int r, int hi) { return (r & 3) + 8 * (r >> 2) + 4 * hi; }
template <int DQK> __device__ __forceinline__ int kswz(int row, int cb) {
    return row * (DQK * 2 + 16) + cb;
}
__device__ __forceinline__ int v_st(int k, int c) { const int kk = (k & ~0xC) | ((k & 4) << 1) | ((k & 8) >> 1); return ((kk >> 3) * 4 + (c >> 5)) * 512 + ((kk & 7) * 32 + (c & 31)) * 2; }
__device__ __forceinline__ int v_stn(int k, int c) { return ((k >> 3) * 4 + (c >> 5)) * 512 + ((k & 7) * 32 + (c & 31)) * 2; }
__device__ __forceinline__ int v_rd_base(int lane) { return ((lane & 3) << 3) | (((lane >> 2) & 3) << 6) | (((lane >> 4) & 1) << 5) | (((lane >> 5) & 1) << 8); }
constexpr int v_rd_off(int d0, int ks, int half) { return d0 * 512 + ks * 4096 + half * 2048; }
template <int OFF> __device__ __forceinline__ s16x4 tr_read(int vb) {
    s16x4 r; asm volatile("ds_read_b64_tr_b16 %0, %1 offset:%2" : "=&v"(r) : "v"(vb), "i"(OFF) : "memory"); return r;
}
#define PKLH(L, H) (bf16x8){L[0], L[1], L[2], L[3], H[0], H[1], H[2], H[3]}
template <int D0> __device__ __forceinline__ void pv_one(f32x16& od, int vb, bf16x8 pa0, bf16x8 pa1, bf16x8 pa2, bf16x8 pa3) {
    const s16x4 l0 = tr_read<v_rd_off(D0, 0, 0)>(vb), h0 = tr_read<v_rd_off(D0, 0, 1)>(vb), l1 = tr_read<v_rd_off(D0, 1, 0)>(vb), h1 = tr_read<v_rd_off(D0, 1, 1)>(vb);
    const s16x4 l2 = tr_read<v_rd_off(D0, 2, 0)>(vb), h2 = tr_read<v_rd_off(D0, 2, 1)>(vb), l3 = tr_read<v_rd_off(D0, 3, 0)>(vb), h3 = tr_read<v_rd_off(D0, 3, 1)>(vb);
    asm volatile("s_waitcnt lgkmcnt(0)" ::: "memory"); SBAR();
    od = __builtin_amdgcn_mfma_f32_32x32x16_bf16(pa0, PKLH(l0, h0), od, 0, 0, 0);
    od = __builtin_amdgcn_mfma_f32_32x32x16_bf16(pa1, PKLH(l1, h1), od, 0, 0, 0);
    od = __builtin_amdgcn_mfma_f32_32x32x16_bf16(pa2, PKLH(l2, h2), od, 0, 0, 0);
    od = __builtin_amdgcn_mfma_f32_32x32x16_bf16(pa3, PKLH(l3, h3), od, 0, 0, 0);
}
__device__ __forceinline__ void pv_d0(f32x16* o, int vb, bf16x8 pa0, bf16x8 pa1, bf16x8 pa2, bf16x8 pa3) {
    pv_one<0>(o[0], vb, pa0, pa1, pa2, pa3); pv_one<1>(o[1], vb, pa0, pa1, pa2, pa3); pv_one<2>(o[2], vb, pa0, pa1, pa2, pa3); pv_one<3>(o[3], vb, pa0, pa1, pa2, pa3);
}
template <int DQK> __device__ __forceinline__ void qkt(f32x16& p0, f32x16& p1, const char* Ks, const bf16x8* qr, int r32, int hi, const f32x16 init = f32x16{}) {
    constexpr int NS = DQK / 16;
    p0 = init; p1 = init;
    bf16x8 b0[NS], b1[NS];
#pragma unroll
    for (int d0 = 0; d0 < NS; ++d0) { const int cb = (d0 * 16 + hi * 8) * 2;
        b1[d0] = *reinterpret_cast<const bf16x8*>(Ks + kswz<DQK>(32 + r32, cb));
        b0[d0] = *reinterpret_cast<const bf16x8*>(Ks + kswz<DQK>(r32, cb)); }
#pragma unroll
    for (int d0 = 0; d0 < NS; ++d0) {
        p0 = __builtin_amdgcn_mfma_f32_32x32x16_bf16(b0[d0], qr[d0], p0, 0, 0, 0);
        p1 = __builtin_amdgcn_mfma_f32_32x32x16_bf16(b1[d0], qr[d0], p1, 0, 0, 0); }
#ifndef QKT_AHEAD
#define QKT_AHEAD 3
#endif
    __builtin_amdgcn_sched_group_barrier(0x100, 2 * QKT_AHEAD, 0);
#pragma unroll
    for (int d0 = 0; d0 < NS - QKT_AHEAD; ++d0) { __builtin_amdgcn_sched_group_barrier(0x008, 2, 0); __builtin_amdgcn_sched_group_barrier(0x100, 2, 0); }
    __builtin_amdgcn_sched_group_barrier(0x008, 2 * QKT_AHEAD, 0);
}
#define PK4(P, BASE, OUT) do { const unsigned a0_ = cvtpk(P[BASE + 0], P[BASE + 1]), a1_ = cvtpk(P[BASE + 2], P[BASE + 3]);   \
    const unsigned b0_ = cvtpk(P[BASE + 4], P[BASE + 5]), b1_ = cvtpk(P[BASE + 6], P[BASE + 7]);                              \
    auto r0_ = __builtin_amdgcn_permlane32_swap(a0_, b0_, false, false); auto r1_ = __builtin_amdgcn_permlane32_swap(a1_, b1_, false, false); \
    u32x4 w_ = {r0_[0], r1_[0], r0_[1], r1_[1]}; OUT = *reinterpret_cast<bf16x8*>(&w_); } while (0)

#define PK4N(P, BASE, OUT) do { u32x4 w_ = {cvtpk(P[BASE + 0], P[BASE + 1]), cvtpk(P[BASE + 2], P[BASE + 3]), cvtpk(P[BASE + 4], P[BASE + 5]), cvtpk(P[BASE + 6], P[BASE + 7])}; \
    OUT = *reinterpret_cast<bf16x8*>(&w_); } while (0)

template <int SC1000> struct SmC { };
constexpr float THR = 8.f;

__device__ __forceinline__ void partialSM(f32x16& p0, f32x16& p1, float& m_reg, float& mn, float& alpha, const float C, const float thr_raw) {
    float pmax = p0[0];
#pragma unroll
    for (int r = 1; r < 16; ++r) pmax = fmaxf(pmax, p0[r]);
#pragma unroll
    for (int r = 0; r < 16; ++r) pmax = fmaxf(pmax, p1[r]);
    { auto rr = __builtin_amdgcn_permlane32_swap(__float_as_uint(pmax), __float_as_uint(pmax), false, false);
      pmax = fmaxf(__uint_as_float(rr[0]), __uint_as_float(rr[1])); }
    if (__builtin_expect(__all(pmax - m_reg <= thr_raw), 1)) { mn = m_reg; alpha = 1.f; }
    else { mn = fmaxf(m_reg, pmax); alpha = __builtin_amdgcn_exp2f((m_reg - mn) * C); m_reg = mn; }
    const float mnC = -mn * C;
#pragma unroll
    for (int r = 0; r < 16; ++r) p0[r] = fmaf(p0[r], C, mnC);
#pragma unroll
    for (int r = 0; r < 16; ++r) p1[r] = fmaf(p1[r], C, mnC);
#pragma unroll
    for (int r = 0; r < 16; ++r) p0[r] = __builtin_amdgcn_exp2f(p0[r]);
}
__device__ __forceinline__ void finishSM(f32x16& p0, f32x16& p1, float alpha, float& l_reg, bf16x8& pa0, bf16x8& pa1, bf16x8& pa2, bf16x8& pa3) {
#pragma unroll
    for (int r = 0; r < 16; ++r) p1[r] = __builtin_amdgcn_exp2f(p1[r]);
    float ps = 0;
#pragma unroll
    for (int r = 0; r < 16; ++r) ps += p0[r];
#pragma unroll
    for (int r = 0; r < 16; ++r) ps += p1[r];
    { auto rr = __builtin_amdgcn_permlane32_swap(__float_as_uint(ps), __float_as_uint(ps), false, false);
      ps = __uint_as_float(rr[0]) + __uint_as_float(rr[1]); }
    l_reg = l_reg * alpha + ps;
    PK4N(p0, 0, pa0); PK4N(p0, 8, pa1); PK4N(p1, 0, pa2); PK4N(p1, 8, pa3);
}

constexpr int KVBLK = 64;
struct AttnArgs {
    const bf16_t* Q; int ldq;
    const bf16_t* K; int ldk;
    const bf16_t* KR; int ldkr;
    const bf16_t* V; int ldv;
    bf16_t* O; int ldo;
    int nt;
    int seg0_tiles, seg0_row, seg1_row;
    int qpos0;
    int masked;
    float sink_l2; int has_sink;
    float C;
};
#define GAS __attribute__((address_space(1)))
template <int DQK>
__device__ __forceinline__ void attn_body(const AttnArgs& a, char* lds) {
    constexpr int SHM_V = KVBLK * 128 * 2, SHM_K = KVBLK * (DQK * 2 + 16);
    const int tid = otid(), wid = tid >> 6, lane = tid & 63, r32 = lane & 31, hi = lane >> 5;
    char* V_lds = lds; char* K_lds = lds + 2 * SHM_V;
    float* ws = (float*)(lds + 2 * SHM_V + 2 * SHM_K) + wid * 64; float* li_l = ws; float* al_l = ws + 32;
    float m_reg = -1e30f, l_reg = 0; f32x16 o[4] = {}; bf16x8 qr[DQK / 16];
    const float C = a.C, thr_raw = THR * LOG2E / a.C;
    const bf16_t* Qw = a.Q + (long)(wid * 32 + r32) * a.ldq + hi * 8;
#pragma unroll
    for (int d0 = 0; d0 < DQK / 16; ++d0) qr[d0] = *reinterpret_cast<const bf16x8*>(Qw + d0 * 16);
    const int sr = tid >> 4, sc = (tid & 15) * 8, vst0 = v_stn(sr, sc), vst1 = v_stn(32 + sr, sc);
    const int kst0 = kswz<DQK>(sr, sc * 2), kst1 = kswz<DQK>(32 + sr, sc * 2);
    const int sr2 = tid >> 3, sc2 = (tid & 7) * 8, kst2 = (DQK == 192) ? kswz<DQK>(sr2, 256 + sc2 * 2) : 0;
    const int vb0 = (int)(uintptr_t)V_lds + v_rd_base(lane);
    bf16x8 vs0, vs1, ks0, ks1, ks2;
    __syncthreads();
#define TILE_ROW(j) ((j) < a.seg0_tiles ? a.seg0_row + 64 * (j) : ((a.masked && (unsigned)(a.qpos0 - 128 + 64 * ((j) - a.seg0_tiles)) >= (unsigned)SEQ) ? a.seg0_row : a.seg1_row + 64 * ((j) - a.seg0_tiles)))
    unsigned oks0 = (unsigned)(sr * a.ldk + sc) * 2u, oks1 = oks0 + (unsigned)(64 * a.ldk), oks2 = (DQK == 192) ? (unsigned)(sr2 * a.ldkr + sc2) * 2u : 0u;
#define SLOAD(j) do { const long kr_ = TILE_ROW(j); \
    const GAS char* kb_ = (const GAS char*)a.K + kr_ * (long)(2 * a.ldk); const GAS char* vb_ = (const GAS char*)a.V + kr_ * (long)(2 * a.ldk); const GAS char* rb_ = (const GAS char*)a.KR + kr_ * (long)(2 * a.ldkr); \
    asm volatile("" : "+s"(kb_), "+s"(vb_), "+s"(rb_)); asm volatile("" : "+v"(oks0), "+v"(oks1), "+v"(oks2)); \
    vs0 = *reinterpret_cast<const GAS bf16x8*>(vb_ + oks0); vs1 = *reinterpret_cast<const GAS bf16x8*>(vb_ + oks1); \
    ks0 = *reinterpret_cast<const GAS bf16x8*>(kb_ + oks0); ks1 = *reinterpret_cast<const GAS bf16x8*>(kb_ + oks1); \
    if (DQK == 192) ks2 = *reinterpret_cast<const GAS bf16x8*>(rb_ + oks2); } while (0)
#define SWRITE(b) do { *(bf16x8*)(V_lds + (b) * SHM_V + vst0) = vs0; *(bf16x8*)(V_lds + (b) * SHM_V + vst1) = vs1; \
    *(bf16x8*)(K_lds + (b) * SHM_K + kst0) = ks0; *(bf16x8*)(K_lds + (b) * SHM_K + kst1) = ks1; \
    if (DQK == 192) *(bf16x8*)(K_lds + (b) * SHM_K + kst2) = ks2; } while (0)
#define SWAIT() asm volatile("s_waitcnt vmcnt(0)" ::: "memory")
#define RESC(al) do { if (__any((al) < 1.f)) { if (hi == 0) al_l[r32] = (al); asm volatile("s_waitcnt lgkmcnt(0)" ::: "memory"); \
    _Pragma("unroll") for (int d = 0; d < 4; ++d) _Pragma("unroll") for (int r = 0; r < 16; ++r) o[d][r] *= al_l[crow(r, hi)]; } } while (0)
#define MASK(P0, P1, j) do { if (a.masked && (j) >= a.seg0_tiles) { const int kp0_ = a.qpos0 - 128 + 64 * ((j) - a.seg0_tiles), qp_ = a.qpos0 + wid * 32 + r32; \
    const bool tv_ = (unsigned)kp0_ < (unsigned)SEQ; \
    _Pragma("unroll") for (int r = 0; r < 16; ++r) { const int d0_ = kp0_ + crow(r, hi) - qp_, d1_ = d0_ + 32; \
        P0[r] = (tv_ && d0_ <= 128 && d0_ >= -128) ? P0[r] : -1e30f; P1[r] = (tv_ && d1_ <= 128 && d1_ >= -128) ? P1[r] : -1e30f; } } } while (0)
    f32x16 pA0, pA1; float mnA, alA; bf16x8 pa0, pa1, pa2, pa3; const int NT = a.nt;
    const int wu = __builtin_amdgcn_readfirstlane(wid);
    volatile int* vflag = (volatile int*)(lds + 2 * SHM_V + 2 * SHM_K + 8 * 256);
#define TILE_BODY(CLASSIC) { \
        const int b = j & 1; \
        if (j + 1 < NT) SLOAD(j + 1); \
        bool skip = false;        \
        if (a.masked && j >= a.seg0_tiles) { const int kp0_ = a.qpos0 - 128 + 64 * (j - a.seg0_tiles), q0_ = a.qpos0 + wu * 32; \
            skip = ((unsigned)kp0_ >= (unsigned)SEQ) || (kp0_ + 63 < q0_ - 128) || (kp0_ > q0_ + 31 + 128); } \
        if (!skip) { \
            if (CLASSIC) { \
                SBAR(); qkt<DQK>(pA0, pA1, K_lds + b * SHM_K, qr, r32, hi); MASK(pA0, pA1, j); \
                partialSM(pA0, pA1, m_reg, mnA, alA, C, thr_raw); \
                RESC(alA); \
                finishSM(pA0, pA1, alA, l_reg, pa0, pa1, pa2, pa3); \
            } else { \
                SBAR(); qkt<DQK>(pA0, pA1, K_lds + b * SHM_K, qr, r32, hi, minit); MASK(pA0, pA1, j);        \
                float ps_ = 0.f; \
                _Pragma("unroll") for (int r = 0; r < 16; ++r) pA0[r] = __builtin_amdgcn_exp2f(pA0[r]); \
                _Pragma("unroll") for (int r = 0; r < 16; ++r) pA1[r] = __builtin_amdgcn_exp2f(pA1[r]); \
                _Pragma("unroll") for (int r = 0; r < 16; ++r) ps_ += pA0[r]; \
                _Pragma("unroll") for (int r = 0; r < 16; ++r) ps_ += pA1[r]; \
                { auto rr = __builtin_amdgcn_permlane32_swap(__float_as_uint(ps_), __float_as_uint(ps_), false, false); ps_ = __uint_as_float(rr[0]) + __uint_as_float(rr[1]); } \
                badu = __builtin_elementwise_max(badu, __float_as_uint(ps_));        \
                l_reg += ps_; \
                PK4N(pA0, 0, pa0); PK4N(pA0, 8, pa1); PK4N(pA1, 0, pa2); PK4N(pA1, 8, pa3); \
            } \
            SBAR(); \
            if (j + 1 < NT) { SWAIT(); SWRITE(b ^ 1); }        \
            SBAR(); \
            pv_d0(o, vb0 + b * SHM_V, pa0, pa1, pa2, pa3); \
        } else if (j + 1 < NT) { SWAIT(); SWRITE(b ^ 1); } \
        __syncthreads(); }
    if (tid == 0) *vflag = 0;
    if (wu >= 4) __builtin_amdgcn_s_setprio(1);
#pragma nounroll
    for (int pass = 0; pass < 2; ++pass) {
        int bad = 0; unsigned badu = 0u;
        SLOAD(0); SWAIT(); SWRITE(0); __syncthreads();
        const int jc = pass ? NT : 1;
        f32x16 minit = f32x16{};
#pragma nounroll
        for (int j = 0; j < jc; ++j) TILE_BODY(1)
#pragma unroll
        for (int r = 0; r < 16; ++r) minit[r] = -m_reg * C;
#pragma nounroll
        for (int j = jc; j < NT; ++j) TILE_BODY(0)
        if (pass) break;
        bad = !__all(badu <= __float_as_uint(256.0f));
        if (bad && lane == 0) *vflag = 1;
        __syncthreads();
        if (*vflag == 0) break;
        __syncthreads();
        m_reg = -1e30f; l_reg = 0.f;
#pragma unroll
        for (int d = 0; d < 4; ++d) o[d] = f32x16{};
    }
#undef TILE_BODY
    __builtin_amdgcn_s_setprio(0);
    if (a.has_sink) l_reg += __builtin_amdgcn_exp2f(a.sink_l2 - m_reg * C);
    if (hi == 0) li_l[r32] = l_reg; asm volatile("s_waitcnt lgkmcnt(0)" ::: "memory");
    float rli[16];
#pragma unroll
    for (int r = 0; r < 16; ++r) rli[r] = __builtin_amdgcn_rcpf(li_l[crow(r, hi)]);
    __syncthreads();
    { unsigned short* stg = (unsigned short*)(lds + wid * 8704);
#pragma unroll
      for (int r = 0; r < 16; ++r) { const int orow = crow(r, hi);
#pragma unroll
          for (int d0 = 0; d0 < 4; ++d0) stg[orow * 136 + d0 * 32 + r32] = (unsigned short)(cvtpk(o[d0][r] * rli[r], 0.f) & 0xffffu); }
      asm volatile("s_waitcnt lgkmcnt(0)" ::: "memory");
      bf16_t* Ow = a.O + (long)(wid * 32) * a.ldo;
#pragma unroll
      for (int i = 0; i < 8; ++i) { const int q = lane + 64 * i, row = q >> 4, c8 = (q & 15) * 8;
          *(u32x4*)(Ow + (long)row * a.ldo + c8) = *(const u32x4*)(stg + row * 136 + c8); } }
#undef TILE_ROW
#undef SLOAD
#undef SWRITE
#undef SWAIT
#undef RESC
#undef MASK
}

__device__ __forceinline__ int ret_row0(int bb, int n) { return n == 32 ? NLAT + bb * CTXL : bb * SEQ + n * 256; }
__device__ __forceinline__ float log2_sigmoid(float x) { return -log1pf(__expf(-x)) * LOG2E; }

__device__ __forceinline__ void ret_kv_unit(const bf16_t* PROJ, float* KVS, int bb, int h, int n, float lgf2, float lgb2, char* lds) {
    const int tid = otid(), wid = tid >> 6, lane = tid & 63, r32 = lane & 31, hi = lane >> 5;
    const int dir = wid >> 2, ablk = wid & 3;
    const int sr = tid >> 4, sc = (tid & 15) * 8, vst0 = v_st(sr, sc), vst1 = v_st(32 + sr, sc);
    const long R0 = ret_row0(bb, n);
    const bf16_t* Kg = PROJ + R0 * INW + 512 + h * 128; const bf16_t* Vg = PROJ + R0 * INW + 1024 + h * 128;
    const int vbK = (int)(uintptr_t)lds + dir * 16384 + v_rd_base(lane) + ablk * 512;
    const int vbV = (int)(uintptr_t)lds + 32768 + v_rd_base(lane);
    f32x16 acc[4] = {};
    u32x4 kq[2]; bf16x8 vq[2];
#pragma unroll
    for (int i = 0; i < 2; ++i) { const int j = sr + 32 * i; kq[i] = *reinterpret_cast<const u32x4*>(Kg + (long)j * INW + sc); vq[i] = *reinterpret_cast<const bf16x8*>(Vg + (long)j * INW + sc); }
    for (int t = 0; t < 4; ++t) {
        __syncthreads();
#pragma unroll
        for (int i = 0; i < 2; ++i) {
            const int j = 64 * t + sr + 32 * i;
            const u32x4 kv = kq[i];
            const bf16x8 vv = vq[i];
            const float kf = __builtin_amdgcn_exp2f(lgf2 * (float)(255 - j)), kb = __builtin_amdgcn_exp2f(lgb2 * (float)j);
            u32x4 wf, wb;
#pragma unroll
            for (int e = 0; e < 4; ++e) { const float lo = bflo(kv[e]), hh = bfhi(kv[e]); wf[e] = cvtpk(lo * kf, hh * kf); wb[e] = cvtpk(lo * kb, hh * kb); }
            const int vo = i ? vst1 : vst0;
            *(u32x4*)(lds + vo) = wf; *(u32x4*)(lds + 16384 + vo) = wb; *(bf16x8*)(lds + 32768 + vo) = vv;
        }
        if (t < 3) {
#pragma unroll
            for (int i = 0; i < 2; ++i) { const int j = 64 * (t + 1) + sr + 32 * i; kq[i] = *reinterpret_cast<const u32x4*>(Kg + (long)j * INW + sc); vq[i] = *reinterpret_cast<const bf16x8*>(Vg + (long)j * INW + sc); }
        }
        __syncthreads();
#define RKV_STEP(KS) do { \
        const s16x4 al_ = tr_read<v_rd_off(0, KS, 0)>(vbK), ah_ = tr_read<v_rd_off(0, KS, 1)>(vbK); \
        const s16x4 l0_ = tr_read<v_rd_off(0, KS, 0)>(vbV), h0_ = tr_read<v_rd_off(0, KS, 1)>(vbV), l1_ = tr_read<v_rd_off(1, KS, 0)>(vbV), h1_ = tr_read<v_rd_off(1, KS, 1)>(vbV); \
        const s16x4 l2_ = tr_read<v_rd_off(2, KS, 0)>(vbV), h2_ = tr_read<v_rd_off(2, KS, 1)>(vbV), l3_ = tr_read<v_rd_off(3, KS, 0)>(vbV), h3_ = tr_read<v_rd_off(3, KS, 1)>(vbV); \
        asm volatile("s_waitcnt lgkmcnt(0)" ::: "memory"); SBAR(); \
        const bf16x8 af_ = PKLH(al_, ah_); \
        acc[0] = __builtin_amdgcn_mfma_f32_32x32x16_bf16(af_, PKLH(l0_, h0_), acc[0], 0, 0, 0); \
        acc[1] = __builtin_amdgcn_mfma_f32_32x32x16_bf16(af_, PKLH(l1_, h1_), acc[1], 0, 0, 0); \
        acc[2] = __builtin_amdgcn_mfma_f32_32x32x16_bf16(af_, PKLH(l2_, h2_), acc[2], 0, 0, 0); \
        acc[3] = __builtin_amdgcn_mfma_f32_32x32x16_bf16(af_, PKLH(l3_, h3_), acc[3], 0, 0, 0); } while (0)
        RKV_STEP(0); RKV_STEP(1); RKV_STEP(2); RKV_STEP(3);
#undef RKV_STEP
    }
    float* outp = KVS + ((((size_t)bb * 4 + h) * 2 + dir) * 33 + n) * 16384;
#pragma unroll
    for (int r = 0; r < 16; ++r) { const int dk = 32 * ablk + crow(r, hi);
#pragma unroll
        for (int d = 0; d < 4; ++d) outp[dk * 128 + 32 * d + r32] = acc[d][r]; }
}

__device__ __forceinline__ void ret_scan(const float* KVS, bf16_t* SIN, const float* dec_f, const float* dec_b, int gtid, int gthreads) {
    for (int it = gtid; it < NB * 4 * 2 * 4096; it += gthreads) {
        const int e4 = it & 4095, dir = (it >> 12) & 1, h = (it >> 13) & 3, bb = it >> 15;
        const float lg2 = log2_sigmoid(dir ? dec_b[h] : dec_f[h]); const float cd = __builtin_amdgcn_exp2f(lg2 * 256.0f);
        const size_t base = ((((size_t)bb * 4 + h) * 2 + dir) * 33) * 16384 + (size_t)e4 * 4;
        f32x4 s = *(const f32x4*)(KVS + base + (size_t)32 * 16384);
        *(u32x2*)(SIN + base + (size_t)32 * 16384) = (u32x2){0u, 0u};
        for (int nb = 0; nb < 4; ++nb) {
            f32x4 kv[8];
#pragma unroll
            for (int q = 0; q < 8; ++q) { const int n = dir ? 31 - (nb * 8 + q) : nb * 8 + q; kv[q] = *(const f32x4*)(KVS + base + (size_t)n * 16384); }
#pragma unroll
            for (int q = 0; q < 8; ++q) { const int n = dir ? 31 - (nb * 8 + q) : nb * 8 + q;
                st_bf16x4(SIN + base + (size_t)n * 16384, s); s = s * cd + kv[q]; }
        }
    }
}

__device__ __forceinline__ void ret_out_unit(const bf16_t* PROJ, const bf16_t* SIN, bf16_t* Y, int bb, int h, int n, float lgf2, float lgb2, char* lds) {
    const int tid = otid(), wid = tid >> 6, lane = tid & 63, r32 = lane & 31, hi = lane >> 5;
    const int sr = tid >> 4, sc = (tid & 15) * 8, vst0 = v_st(sr, sc), vst1 = v_st(32 + sr, sc);
    const int kst0 = kswz<128>(sr, sc * 2), kst1 = kswz<128>(32 + sr, sc * 2);
    const long R0 = ret_row0(bb, n);
    const bf16_t* Qg = PROJ + R0 * INW + h * 128; const bf16_t* Kg = Qg + 512; const bf16_t* Vg = Qg + 1024; const bf16_t* Gg = Qg + 1536;
    char* K_lds = lds; char* V_lds = lds + 17408;
    const int vb0 = (int)(uintptr_t)V_lds + v_rd_base(lane);
    bf16x8 qr[8];
    const bf16_t* Qw = Qg + (long)(wid * 32 + r32) * INW + hi * 8;
#pragma unroll
    for (int d0 = 0; d0 < 8; ++d0) qr[d0] = *reinterpret_cast<const bf16x8*>(Qw + d0 * 16);
    f32x16 o[4] = {};
    const int iq = wid * 32 + r32;
    const bf16_t* S0 = SIN + ((((size_t)bb * 4 + h) * 2) * 33 + n) * 16384;
    bf16x8 kq[2], vq[2];
#pragma unroll
    for (int i = 0; i < 2; ++i) { const int j = sr + 32 * i; kq[i] = *reinterpret_cast<const bf16x8*>(Kg + (long)j * INW + sc); vq[i] = *reinterpret_cast<const bf16x8*>(Vg + (long)j * INW + sc); }
    for (int t = 0; t < 4; ++t) {
        __syncthreads();
#pragma unroll
        for (int i = 0; i < 2; ++i) { *(bf16x8*)(K_lds + (i ? kst1 : kst0)) = kq[i]; *(bf16x8*)(V_lds + (i ? vst1 : vst0)) = vq[i]; }
        if (t < 3) {
#pragma unroll
            for (int i = 0; i < 2; ++i) { const int j = 64 * (t + 1) + sr + 32 * i; kq[i] = *reinterpret_cast<const bf16x8*>(Kg + (long)j * INW + sc); vq[i] = *reinterpret_cast<const bf16x8*>(Vg + (long)j * INW + sc); }
        } else if (n != 32) {
#pragma unroll
            for (int i = 0; i < 2; ++i) vq[i] = *reinterpret_cast<const bf16x8*>(S0 + (sr + 32 * i) * 128 + sc);
        }
        __syncthreads();
        f32x16 p0, p1; qkt<128>(p0, p1, K_lds, qr, r32, hi);
#pragma unroll
        for (int r = 0; r < 16; ++r) {
            const int d0 = iq - (64 * t + crow(r, hi)), d1 = d0 - 32;
            const float m0 = d0 > 0 ? __builtin_amdgcn_exp2f(lgf2 * (float)d0) : (d0 < 0 ? __builtin_amdgcn_exp2f(lgb2 * (float)(-d0)) : 2.0f);
            const float m1 = d1 > 0 ? __builtin_amdgcn_exp2f(lgf2 * (float)d1) : (d1 < 0 ? __builtin_amdgcn_exp2f(lgb2 * (float)(-d1)) : 2.0f);
            p0[r] *= m0; p1[r] *= m1;
        }
        bf16x8 pa0, pa1, pa2, pa3; PK4(p0, 0, pa0); PK4(p0, 8, pa1); PK4(p1, 0, pa2); PK4(p1, 8, pa3);
        pv_d0(o, vb0, pa0, pa1, pa2, pa3);
    }
    if (n != 32) {
#pragma unroll
        for (int s4 = 0; s4 < 4; ++s4) {
            const int dir = s4 >> 1, ts = s4 & 1;
            const float qd = dir ? __builtin_amdgcn_exp2f(lgb2 * (float)(256 - iq)) : __builtin_amdgcn_exp2f(lgf2 * (float)(iq + 1));
            __syncthreads();
#pragma unroll
            for (int i = 0; i < 2; ++i) *(bf16x8*)(V_lds + (i ? vst1 : vst0)) = vq[i];
            if (s4 < 3) { const int d2 = (s4 + 1) >> 1, t2 = (s4 + 1) & 1; const bf16_t* Sn = S0 + (size_t)d2 * 33 * 16384;
#pragma unroll
                for (int i = 0; i < 2; ++i) vq[i] = *reinterpret_cast<const bf16x8*>(Sn + (64 * t2 + sr + 32 * i) * 128 + sc); }
            bf16x8 qs[4];
#pragma unroll
            for (int k = 0; k < 4; ++k) { const u32x4 w = *reinterpret_cast<const u32x4*>(&qr[4 * ts + k]); u32x4 x;
#pragma unroll
                for (int e = 0; e < 4; ++e) x[e] = cvtpk(bflo(w[e]) * qd, bfhi(w[e]) * qd);
                qs[k] = *reinterpret_cast<bf16x8*>(&x); }
            __syncthreads();
            pv_d0(o, vb0, qs[0], qs[1], qs[2], qs[3]);
        }
    }
    __syncthreads();
    { unsigned short* stg = (unsigned short*)(lds + wid * 8704);
#pragma unroll
      for (int r = 0; r < 16; ++r) {
          float ss = (o[0][r] * o[0][r] + o[1][r] * o[1][r]) + (o[2][r] * o[2][r] + o[3][r] * o[3][r]);
          ss += __shfl_xor(ss, 1); ss += __shfl_xor(ss, 2); ss += __shfl_xor(ss, 4); ss += __shfl_xor(ss, 8); ss += __shfl_xor(ss, 16);
          const float rn = 1.0f / sqrtf(ss * (1.0f / 128.0f) + RMS_EPS);
#pragma unroll
          for (int d = 0; d < 4; ++d) stg[crow(r, hi) * 136 + 32 * d + r32] = (unsigned short)(cvtpk(o[d][r] * rn, 0.f) & 0xffffu);
      }
      asm volatile("s_waitcnt lgkmcnt(0)" ::: "memory");
#pragma unroll
      for (int i = 0; i < 8; ++i) { const int q = lane + 64 * i, row = q >> 4, c8 = (q & 15) * 8;
          const u32x4 gw = *(const u32x4*)(Gg + (long)(wid * 32 + row) * INW + c8);
          const u32x4 xw = *(const u32x4*)(stg + row * 136 + c8);
          u32x4 ow;
#pragma unroll
          for (int e = 0; e < 4; ++e) ow[e] = cvtpk(silu_f(bflo(gw[e])) * bflo(xw[e]), silu_f(bfhi(gw[e])) * bfhi(xw[e]));
          *(u32x4*)(Y + (R0 + wid * 32 + row) * D + h * 128 + c8) = ow; } }
}

struct Params {
    const float* in[23];
    float* out; unsigned char* ws;
    int ph_lo, ph_hi, bar_region, pad;
};
enum { I_X = 0, I_C, I_CTX, I_CCTX, I_ADAW, I_ADAB, I_WIN, I_DECF, I_DECB, I_SINK, I_QNORM, I_WUQ, I_KVNORM, I_WUKV, I_WO, I_LN1G, I_LN1B, I_WUP, I_CONVW, I_CONVB, I_WDN, I_LN2G, I_LN2B };

__device__ __forceinline__ int win_src_col(int p) {
    if (p >= INW) return -1;
    if (p >= 4096) return p;
    const int pn = p >> 8;
    if (pn < 4 || (pn >= 8 && pn < 12)) {
        const int bj = (p >> 7) & 1, x = p & 127, wc = x >> 5, nn = (x >> 4) & 1, q = x & 15;
        return (p & ~255) + 128 * (wc >> 1) + 64 * (wc & 1) + 32 * bj + 8 * (q >> 2) + 4 * nn + (q & 3);
    }
    return (p & ~31) + 8 * ((p & 15) >> 2) + 4 * ((p >> 4) & 1) + (p & 3);
}
__device__ __forceinline__ int wup_src_col(int p) {
    const int pn = p >> 8, bj = (p >> 7) & 1, x = p & 127, wc = x >> 5, nn = (x >> 4) & 1, q = x & 15, fq = q >> 2, j = q & 3;
    const int f = 128 * pn + 32 * wc + 8 * fq + 4 * nn + j;
    return bj ? DFF + f : f;
}
__device__ __forceinline__ void cvt_item(const float* W, int K, int N, bf16_t* Bt, int mode, const float* kscale, int item, int nkt, float* scr, int lane) {
    const int pt = item / nkt, kt = item - pt * nkt, p0 = pt * 32, k0 = kt * 64;
    const int p = p0 + (lane & 31);
    const int src = mode == 1 ? win_src_col(p) : (mode == 2 ? wup_src_col(p) : (mode == 3 ? ((p & ~31) + 8 * ((p & 15) >> 2) + 4 * ((p >> 4) & 1) + (p & 3)) : (p < N ? p : -1)));
    const float* wp = W + (size_t)(k0 + (lane >> 5)) * N + (src >= 0 ? src : 0);
    float v[32];
#pragma unroll
    for (int i = 0; i < 32; ++i) v[i] = src >= 0 ? wp[(size_t)(2 * i) * N] : 0.f;
    if (kscale) {
#pragma unroll
        for (int i = 0; i < 32; ++i) v[i] *= kscale[k0 + 2 * i + (lane >> 5)];
    }
#pragma unroll
    for (int i = 0; i < 32; ++i) scr[(2 * i + (lane >> 5)) * 33 + (lane & 31)] = v[i];
    asm volatile("s_waitcnt lgkmcnt(0)" ::: "memory");
    const int c = lane & 7;
#pragma unroll
    for (int j = 0; j < 4; ++j) { const int n = (lane >> 3) + 8 * j; const float* s = scr + (8 * c) * 33 + n;
        u32x4 o; o[0] = cvtpk(s[0 * 33], s[1 * 33]); o[1] = cvtpk(s[2 * 33], s[3 * 33]); o[2] = cvtpk(s[4 * 33], s[5 * 33]); o[3] = cvtpk(s[6 * 33], s[7 * 33]);
        *(u32x4*)(Bt + (size_t)(p0 + n) * K + k0 + 8 * c) = o; }
    asm volatile("s_waitcnt lgkmcnt(0)" ::: "memory");
}

__device__ __forceinline__ void ln_phase(const bf16_t* X, const bf16_t* MIX, float* dstf, bf16_t* dsth, bf16_t* H, const float* g, const float* b,
                                         const float* gate, const float* sc, const float* sh, int nrows, int bid, int G, char* lds) {
    const int tid = otid(), lane = tid & 63, wid = __builtin_amdgcn_readfirstlane(tid >> 6);
    float* L = (float*)lds;
    __syncthreads();
    for (int i = tid; i < D; i += 512) { L[i] = g[i]; L[D + i] = b[i]; }
    const int ngroups = nrows >> 3, grp0 = (int)(((long)bid * ngroups) / G), nsteps = (int)(((long)(bid + 1) * ngroups) / G) - grp0; int s_cur = -1;
#define LN_ROW(k) ((grp0 + (k)) * 8 + wid)
#define LN_LOAD(XA, MA, ROW) do { const bf16_t* xr_ = X + (size_t)(ROW) * D + 4 * lane; const bf16_t* mr_ = MIX + (size_t)(ROW) * D + 4 * lane; \
    _Pragma("unroll") for (int j = 0; j < 8; ++j) { XA[j] = *(const u32x2*)(xr_ + 256 * j); MA[j] = *(const u32x2*)(mr_ + 256 * j); } } while (0)
#define LN_SVEC(k) do { const int s_ = mod_index((grp0 + (k)) * 8); \
    if (s_ != s_cur) { __syncthreads(); \
        { float gv_[4], sv_[4], hv_[4]; \
          _Pragma("unroll") for (int q_ = 0; q_ < 4; ++q_) { const int i = tid + 512 * q_; gv_[q_] = gate[(size_t)s_ * MODW + i]; sv_[q_] = H ? sc[(size_t)s_ * MODW + i] : 0.f; hv_[q_] = H ? sh[(size_t)s_ * MODW + i] : 0.f; } \
          _Pragma("unroll") for (int q_ = 0; q_ < 4; ++q_) { const int i = tid + 512 * q_; L[2 * D + i] = gv_[q_] + 1.0f; L[3 * D + i] = sv_[q_] + 1.0f; L[4 * D + i] = hv_[q_]; } } \
        s_cur = s_; __syncthreads(); } } while (0)
#define LN_COMP(XA, MA, ROW) do { \
    f32x4 v[8]; float sum = 0.f; \
    _Pragma("unroll") for (int j = 0; j < 8; ++j) { const int c = 4 * lane + 256 * j; \
        const f32x4 mv = (f32x4){bflo(MA[j][0]), bfhi(MA[j][0]), bflo(MA[j][1]), bfhi(MA[j][1])}; \
        v[j] = cvt_f16x4(XA[j]) * ALPHA + *(const f32x4*)(L + 2 * D + c) * mv; sum += (v[j][0] + v[j][1]) + (v[j][2] + v[j][3]); } \
    const float mean = wave_sum(sum) * (1.0f / D); float s2 = 0.f; \
    _Pragma("unroll") for (int j = 0; j < 8; ++j) { v[j] = v[j] - mean; s2 += (v[j][0] * v[j][0] + v[j][1] * v[j][1]) + (v[j][2] * v[j][2] + v[j][3] * v[j][3]); } \
    const float rstd = 1.0f / sqrtf(wave_sum(s2) * (1.0f / D) + LN_EPS); \
    _Pragma("unroll") for (int j = 0; j < 8; ++j) { const int c = 4 * lane + 256 * j; \
        const f32x4 y = v[j] * rstd * *(const f32x4*)(L + c) + *(const f32x4*)(L + D + c); \
        if (dstf) *(f32x4*)(dstf + (size_t)(ROW) * D + c) = y; else st_f16x4(dsth + (size_t)(ROW) * D + c, y); \
        if (H) st_bf16x4(H + (size_t)(ROW) * D + c, y * *(const f32x4*)(L + 3 * D + c) + *(const f32x4*)(L + 4 * D + c)); } } while (0)
    u32x2 xa[8], xb[8], ma[8], mb[8];
    if (LN_ROW(0) < nrows) LN_LOAD(xa, ma, LN_ROW(0));
    for (int k = 0; k < nsteps; k += 2) {
        LN_SVEC(k);
        if (k + 1 < nsteps && LN_ROW(k + 1) < nrows) LN_LOAD(xb, mb, LN_ROW(k + 1));
        SBAR();
        if (LN_ROW(k) < nrows) LN_COMP(xa, ma, LN_ROW(k));
        if (k + 1 < nsteps) {
            LN_SVEC(k + 1);
            if (k + 2 < nsteps && LN_ROW(k + 2) < nrows) LN_LOAD(xa, ma, LN_ROW(k + 2));
            SBAR();
            if (LN_ROW(k + 1) < nrows) LN_COMP(xb, mb, LN_ROW(k + 1));
        }
    }
#undef LN_ROW
#undef LN_LOAD
#undef LN_SVEC
#undef LN_COMP
}

__global__ void __launch_bounds__(512, 2) fwd_kernel(Params p) {
    extern __shared__ __attribute__((aligned(16))) unsigned char lds_raw[];
    LAS unsigned char* ldsl = (LAS unsigned char*)lds_raw;
    char* lds = (char*)lds_raw;
    if (threadIdx.x < 4) ((volatile LAS unsigned*)(ldsl + 131072))[threadIdx.x] = 0u;
    __syncthreads();
    XcdBarrier bar; bar.bar = (unsigned*)(p.ws + WS_CTL) + (size_t)p.bar_region * 4096; bar.x = 0; bar.st = (volatile LAS unsigned*)(ldsl + 131072);
    if (p.ph_hi - p.ph_lo > 1) bar = xcd_barrier_post(bar.bar, (volatile LAS unsigned*)(ldsl + 131072));

    int g = 0, lcur = 0;
#ifndef DUPMASK
#define DUPMASK 0
#endif
#define NREP(k) (1 + ((DUPMASK >> (k)) & 1))
#ifndef PHMASK
#define PHMASK 0xffff
#endif
#ifndef SUBMASK
#define SUBMASK 0xffff
#endif
#define SUB(k) ((SUBMASK >> (k)) & 1)
#define PH_BEGIN(k) if (((PHMASK >> (k)) & 1) && g >= p.ph_lo && g < p.ph_hi) { \
    int bid = blockIdx.x, G = gridDim.x; asm volatile("" : "+s"(bid), "+s"(G)); const int NGW = G * 8, gthreads = G * 512; (void)NGW; (void)gthreads; \
    const int tid = otid(), lane = tid & 63, wid = __builtin_amdgcn_readfirstlane(tid >> 6); const int gw = bid * 8 + wid, gtid = bid * 512 + tid; (void)lane; (void)gw; (void)gtid; \
    size_t wsoff_ = 0; asm volatile("" : "+s"(wsoff_)); unsigned char* ws = p.ws + wsoff_; \
    float* MOD = (float*)(ws + WS_MOD); float* ROPE = (float*)(ws + WS_ROPE); float* RS = (float*)(ws + WS_RS); float* SM = (float*)(ws + WS_SM); (void)SM; \
    float* thc = ROPE, *ths = ROPE + 4096, *tmc = ROPE + 8192, *tms = ROPE + 8192 + 2048; \
    bf16_t* WB = (bf16_t*)(ws + WS_W); float* X = (float*)(ws + WS_X); bf16_t* XH = (bf16_t*)(ws + WS_X); (void)XH; bf16_t* H = (bf16_t*)(ws + WS_H); bf16_t* Y = (bf16_t*)(ws + WS_Y); \
    bf16_t* PROJ = (bf16_t*)(ws + WS_PROJ); bf16_t* QUP = (bf16_t*)(ws + WS_QUP); bf16_t* KVUP = (bf16_t*)(ws + WS_KVUP); \
    float* KVS = (float*)(ws + WS_KVS); bf16_t* SIN = (bf16_t*)(ws + WS_SIN); bf16_t* ACT0 = (bf16_t*)(ws + WS_ACT0); bf16_t* ACT1 = (bf16_t*)(ws + WS_ACT1); float* SB = (float*)(ws + WS_SB); bf16_t* MIX = (bf16_t*)(ws + WS_MIX); (void)MIX; \
    const bf16_t* wl = WB + (size_t)lcur * W_LAYER; const float* modl = MOD + (size_t)lcur * 5 * MODW; \
    (void)RS; (void)thc; (void)ths; (void)tmc; (void)tms; (void)X; (void)H; (void)Y; (void)PROJ; (void)QUP; (void)KVUP; (void)KVS; (void)SIN; (void)ACT0; (void)ACT1; (void)SB; (void)wl; (void)modl;
#define PH_END   if (g + 1 < p.ph_hi) xcd_barrier(bar); } ++g;

    PH_BEGIN(0)
    {
        for (int i = gtid; i < SM_END; i += gthreads) {
            float v = 0.f;
            if (i < SM_DECB) v = p.in[I_DECF][i];
            else if (i < SM_SINK) v = p.in[I_DECB][i - SM_DECB];
            else if (i < SM_LN1G) v = (i - SM_SINK) < DEPTH * 6 ? p.in[I_SINK][i - SM_SINK] : 0.f;
            else if (i < SM_LN1B) v = p.in[I_LN1G][i - SM_LN1G];
            else if (i < SM_LN2G) v = p.in[I_LN1B][i - SM_LN1B];
            else if (i < SM_LN2B) v = p.in[I_LN2G][i - SM_LN2G];
            else if (i < SM_CONVW) v = p.in[I_LN2B][i - SM_LN2B];
            else if (i < SM_CONVB) v = p.in[I_CONVW][i - SM_CONVW];
            else v = p.in[I_CONVB][i - SM_CONVB];
            SM[i] = v;
        }
        for (int i = gtid; i < 4096 + 2048; i += gthreads) {
            if (i < 4096) { const int pos = i >> 5, f = i & 31; const float inv = exp2f(-(float)f * (13.287712379549449f / 32.0f)); const float ang = (float)pos * inv; thc[i] = cosf(ang); ths[i] = sinf(ang); }
            else { const int q = i - 4096, pos = q >> 4, f = q & 15; const float inv = exp2f(-(float)f * (13.287712379549449f / 16.0f)); const float ang = (float)pos * inv; tmc[q] = cosf(ang); tms[q] = sinf(ang); }
        }
        {
            float* scs = (float*)lds;
            float* red = (float*)(lds + 5 * 2048 * 4);
            for (int i = tid; i < 5 * 2048; i += 512) { const int s = i >> 11, k = i & 2047; const float cv = s < 4 ? p.in[I_C][s * D + k] : p.in[I_CCTX][k]; scs[i] = silu_f(cv); }
            __syncthreads();
            for (int u = bid; u < DEPTH * (MODW / 64); u += G) {
                const int l = u / (MODW / 64), j = (u % (MODW / 64)) * 64 + lane;
                const float* Wp = p.in[I_ADAW] + (size_t)l * D * MODW + j;
                float a0 = 0.f, a1 = 0.f, a2 = 0.f, a3 = 0.f, a4 = 0.f;
#pragma unroll 16
                for (int kk = 0; kk < 256; ++kk) { const int k = wid * 256 + kk; const float w = Wp[(size_t)k * MODW];
                    a0 += scs[k] * w; a1 += scs[2048 + k] * w; a2 += scs[4096 + k] * w; a3 += scs[6144 + k] * w; a4 += scs[8192 + k] * w; }
                red[(wid * 5 + 0) * 64 + lane] = a0; red[(wid * 5 + 1) * 64 + lane] = a1; red[(wid * 5 + 2) * 64 + lane] = a2; red[(wid * 5 + 3) * 64 + lane] = a3; red[(wid * 5 + 4) * 64 + lane] = a4;
                __syncthreads();
                if (wid < 5) { float sum = 0.f;
#pragma unroll
                    for (int w8 = 0; w8 < 8; ++w8) sum += red[(w8 * 5 + wid) * 64 + lane];
                    MOD[((size_t)l * 5 + wid) * MODW + j] = sum + p.in[I_ADAB][(size_t)l * MODW + j]; }
                __syncthreads();
            }
        }
        {
            __syncthreads();
            float* scr = (float*)(lds + wid * 8448);
            constexpr int T_IN = (INWP / 32) * (D / 64), T_UQ = (QUPWP / 32) * (512 / 64), T_UKV = (KVUPW / 32) * (256 / 64), T_O = (D / 32) * (D / 64), T_UP = (DFF2 / 32) * (D / 64), T_DN = (D / 32) * (DFF / 64);
            constexpr int T_L = T_IN + T_UQ + T_UKV + T_O + T_UP + T_DN;
            for (int u = gw; u < DEPTH * T_L; u += NGW) {
                const int l = u / T_L; int r = u % T_L; bf16_t* wlp = WB + (size_t)l * W_LAYER;
                const float* Wsrc; const float* ksc = nullptr; bf16_t* dst; int Kd, Nd, mode;
                if (r < T_IN) { Wsrc = p.in[I_WIN] + (size_t)l * D * INW; Kd = D; Nd = INW; dst = wlp + W_IN; mode = 1; }
                else if ((r -= T_IN) < T_UQ) { Wsrc = p.in[I_WUQ] + (size_t)l * 512 * QUPW; Kd = 512; Nd = QUPW; dst = wlp + W_UQ; mode = 0; ksc = p.in[I_QNORM] + l * 512; }
                else if ((r -= T_UQ) < T_UKV) { Wsrc = p.in[I_WUKV] + (size_t)l * 256 * KVUPW; Kd = 256; Nd = KVUPW; dst = wlp + W_UKV; mode = 3; ksc = p.in[I_KVNORM] + l * 256; }
                else if ((r -= T_UKV) < T_O) { Wsrc = p.in[I_WO] + (size_t)l * D * D; Kd = D; Nd = D; dst = wlp + W_O; mode = 3; }
                else if ((r -= T_O) < T_UP) { Wsrc = p.in[I_WUP] + (size_t)l * D * DFF2; Kd = D; Nd = DFF2; dst = wlp + W_UP; mode = 2; }
                else { r -= T_UP; Wsrc = p.in[I_WDN] + (size_t)l * DFF * D; Kd = DFF; Nd = D; dst = wlp + W_DN; mode = 3; }
                cvt_item(Wsrc, Kd, Nd, dst, mode, ksc, r, Kd / 64, scr, lane);
            }
        }
    }
    PH_END

    PH_BEGIN(1)
    {
        f32x4 va[8], vb[8];
#define G1_SRC(ROW) ((ROW) < NLAT ? p.in[I_X] + (size_t)(ROW) * D : p.in[I_CTX] + (size_t)((ROW) - NLAT) * D)
#define G1_LOAD(VA, ROW) do { const float* s_ = G1_SRC(ROW) + 4 * lane; _Pragma("unroll") for (int j = 0; j < 8; ++j) VA[j] = *(const f32x4*)(s_ + 256 * j); } while (0)
#define G1_STORE(VA, ROW) do { const float* mp_ = MOD + (size_t)mod_index(ROW) * MODW; \
        _Pragma("unroll") for (int j = 0; j < 8; ++j) { const int c = 4 * lane + 256 * j; \
            st_f16x4(XH + (size_t)(ROW) * D + c, VA[j]); \
            st_bf16x4(H + (size_t)(ROW) * D + c, VA[j] * (*(const f32x4*)(mp_ + D + c) + 1.0f) + *(const f32x4*)(mp_ + c)); } } while (0)
        int row = gw;
        if (row < NROWS) G1_LOAD(va, row);
        for (; row < NROWS; row += 2 * NGW) {
            if (row + NGW < NROWS) G1_LOAD(vb, row + NGW);
            SBAR();
            G1_STORE(va, row);
            if (row + NGW < NROWS) {
                if (row + 2 * NGW < NROWS) G1_LOAD(va, row + 2 * NGW);
                SBAR();
                G1_STORE(vb, row + NGW);
            }
        }
#undef G1_SRC
#undef G1_LOAD
#undef G1_STORE
    }
    PH_END

    for (int l = 0; l < DEPTH; ++l) {
        const bool last = (l == DEPTH - 1);
        const int nMfull = last ? 128 : 132;
        lcur = l;

        PH_BEGIN(2)
        for (int rep_ = 0; rep_ < NREP(0); ++rep_) { pg8::Gemm gm{H, wl + W_IN, D, D}; pg8::TileOrder S; S.init(132, INWP / 256, G, bid, -1);
          pg8::EpiProj E{PROJ, RS, thc, ths, tmc, tms};
          pg8::gemm_phase<pg8::EpiProj, pg8::TileOrder>(ldsl, gm, S, E); }
        PH_END

        PH_BEGIN(3)
        if (SUB(0)) for (int rep_ = 0; rep_ < NREP(1); ++rep_) { pg8::Gemm gm{PROJ + 3328, wl + W_UQ, INW, 512}; pg8::TileOrder S; S.init(132, QUPWP / 256, G, bid, -1);
          pg8::EpiQup E{QUP, RS, tmc, tms};
          pg8::gemm_phase<pg8::EpiQup, pg8::TileOrder>(ldsl, gm, S, E); }
        if (SUB(1)) for (int rep_ = 0; rep_ < NREP(2); ++rep_) { pg8::Gemm gm{PROJ + 3840, wl + W_UKV, INW, 256}; pg8::TileOrder S; S.init(132, KVUPW / 256, G, (G == 256) ? ((bid + 104) & 255) : bid, -1);
          pg8::EpiKvup E{KVUP, RS};
          pg8::gemm_phase<pg8::EpiKvup, pg8::TileOrder>(ldsl, gm, S, E); }
        if (SUB(2)) for (int rep_ = 0; rep_ < NREP(3); ++rep_) for (int u = (G == 256) ? ((bid + 80) & 255) : bid; u < NB * 4 * 33; u += G) {
            const int n = u % 33, h = (u / 33) & 3, bb = u / 132;
            const float lgf2 = log2_sigmoid(SM[SM_DECF + l * 4 + h]), lgb2 = log2_sigmoid(SM[SM_DECB + l * 4 + h]);
            ret_kv_unit(PROJ, KVS, bb, h, n, lgf2, lgb2, lds);
        }
        PH_END

        PH_BEGIN(4)
        if (SUB(3)) for (int rep_ = 0; rep_ < NREP(4); ++rep_) ret_scan(KVS, SIN, SM + SM_DECF + l * 4, SM + SM_DECB + l * 4, gtid, gthreads);
        if (SUB(4)) for (int rep_ = 0; rep_ < NREP(5); ++rep_) {
            const int nun = last ? 768 : 792;
            for (int u = bid; u < nun; u += G) {
                AttnArgs a;
                int bb, h, qrow;
                if (u < 768) { const int rnd = u / G, w_ = u % G; const int bh = (G == 256) ? (rnd * 8 + (w_ & 7)) : (u >> 5); const int qb = (G == 256) ? (w_ >> 3) : (u & 31); h = bh % 6; bb = bh / 6; qrow = bb * SEQ + qb * 256; a.nt = 132; a.seg0_tiles = 128; a.seg0_row = bb * SEQ; a.seg1_row = NLAT + bb * CTXL; }
                else { const int v = u - 768; h = v % 6; bb = v / 6; qrow = NLAT + bb * CTXL; a.nt = 4; a.seg0_tiles = 4; a.seg0_row = NLAT + bb * CTXL; a.seg1_row = a.seg0_row; }
                a.Q = QUP + (size_t)qrow * QUPW + h * 192; a.ldq = QUPW;
                a.K = KVUP + h * 256; a.ldk = KVUPW; a.KR = PROJ + 4096; a.ldkr = INW; a.V = KVUP + h * 256 + 128; a.ldv = KVUPW;
                a.O = Y + (size_t)qrow * D + 1280 + h * 128; a.ldo = D;
                a.qpos0 = 0; a.masked = 0; a.sink_l2 = 0.f; a.has_sink = 0; a.C = 1.0f;
                attn_body<192>(a, lds);
            }
        }
        if (SUB(5)) for (int rep_ = 0; rep_ < NREP(6); ++rep_) {
            const int nun = last ? 768 : 792;
            for (int u = bid; u < nun; u += G) {
                AttnArgs a;
                int bb, h, qrow;
                if (u < 768) { const int rnd = u / G, w_ = u % G; const int bh = (G == 256) ? (rnd * 8 + (w_ & 7)) : (u >> 5); const int qb = (G == 256) ? (w_ >> 3) : (u & 31); h = bh % 6; bb = bh / 6; qrow = bb * SEQ + qb * 256; a.nt = 12; a.seg0_tiles = 4; a.seg0_row = NLAT + bb * CTXL; a.seg1_row = bb * SEQ + qb * 256 - 128; a.qpos0 = qb * 256; a.masked = 1; }
                else { const int v = u - 768; h = v % 6; bb = v / 6; qrow = NLAT + bb * CTXL; a.nt = 4; a.seg0_tiles = 4; a.seg0_row = NLAT + bb * CTXL; a.seg1_row = a.seg0_row; a.qpos0 = 0; a.masked = 0; }
                const int kvh = h / 3;
                a.Q = PROJ + (size_t)qrow * INW + 2048 + h * 128; a.ldq = INW;
                a.K = PROJ + 2816 + kvh * 128; a.ldk = INW; a.KR = a.K; a.ldkr = INW; a.V = PROJ + 3072 + kvh * 128; a.ldv = INW;
                a.O = Y + (size_t)qrow * D + 512 + h * 128; a.ldo = D;
                a.sink_l2 = SM[SM_SINK + l * 6 + h] * LOG2E; a.has_sink = 1; a.C = 1.0f;
                attn_body<128>(a, lds);
            }
        }
        PH_END

        PH_BEGIN(5)
        for (int rep_ = 0; rep_ < NREP(7); ++rep_) for (int u = bid; u < NB * 4 * 33; u += G) {
            const int n = u % 33, h = (u / 33) & 3, bb = u / 132;
            if (last && n == 32) continue;
            const float lgf2 = log2_sigmoid(SM[SM_DECF + l * 4 + h]), lgb2 = log2_sigmoid(SM[SM_DECB + l * 4 + h]);
            ret_out_unit(PROJ, SIN, Y, bb, h, n, lgf2, lgb2, lds);
        }
        PH_END

        PH_BEGIN(6)
        for (int rep_ = 0; rep_ < NREP(10); ++rep_) { pg8::Gemm gm{Y, wl + W_O, D, D}; pg8::TileOrder S; S.init(nMfull, D / 256, G, bid, -1);
          pg8::EpiMix E{MIX, -1, rep_ + 1 < NREP(10)};
          pg8::gemm_phase<pg8::EpiMix, pg8::TileOrder>(ldsl, gm, S, E); }
        PH_END

        PH_BEGIN(7)
        ln_phase(XH, MIX, (float*)nullptr, XH, H, SM + SM_LN1G + l * D, SM + SM_LN1B + l * D, modl + 2 * D, modl + 4 * D, modl + 3 * D, last ? NLAT : NROWS, bid, G, lds);
        PH_END

#define FFN_UP(cc, nMc, skn, ski) for (int rep_ = 0; rep_ < NREP(8); ++rep_) { pg8::Gemm gm{H, wl + W_UP, D, D}; pg8::TileOrder S; S.init(nMc, DFF2 / 256, G, bid, cc, skn, ski); \
              pg8::EpiUpConv E{cc ? ACT1 : ACT0, SB, SM + SM_CONVW + (size_t)l * 3 * DFF, SM + SM_CONVB + (size_t)l * DFF, cc}; pg8::gemm_phase<pg8::EpiUpConv, pg8::TileOrder>(ldsl, gm, S, E); }
#define FFN_DOWN(cc, nMc) for (int rep_ = 0; rep_ < NREP(11); ++rep_) { pg8::Gemm gm{cc ? ACT1 : ACT0, wl + W_DN, DFF, DFF}; pg8::TileOrder S; S.init(nMc, D / 256, G, bid, -1); \
              pg8::EpiMix E{MIX, cc, rep_ + 1 < NREP(11)}; pg8::gemm_phase<pg8::EpiMix, pg8::TileOrder>(ldsl, gm, S, E); }
#define FFN_FIX(ACTc, nrows) { \
                const float* cw = SM + SM_CONVW + (size_t)l * 3 * DFF; \
                const int ngr = (nrows) / 64; \
                for (int it = gtid; it < 2 * ngr * (DFF / 4); it += gthreads) { \
                    const int f = (it % (DFF / 4)) * 4, gk = it / (DFF / 4), kind = gk / ngr, gi = gk % ngr; \
                    const int rg = gi * 64, smask = rg < FCH_LAT ? (SEQ - 1) : (CTXL - 1); \
                    const bool edge = kind ? (((rg + 63) & smask) == smask) : ((rg & smask) == 0); \
                    if (edge) continue; \
                    const float* sp = SB + ((size_t)(kind * NGRP + gi) * 3) * DFF + f; \
                    const float* np_ = SB + ((size_t)((1 - kind) * NGRP + (kind ? gi + 1 : gi - 1)) * 3 + 2) * DFF + f; \
                    const f32x4 z = *(const f32x4*)sp + *(const f32x4*)(cw + (kind ? 2 * DFF : 0) + f) * *(const f32x4*)np_; const f32x4 uu = *(const f32x4*)(sp + DFF); \
                    u32x2 ow; ow[0] = cvtpk(silu_f(z[0]) * uu[0], silu_f(z[1]) * uu[1]); ow[1] = cvtpk(silu_f(z[2]) * uu[2], silu_f(z[3]) * uu[3]); \
                    *(u32x2*)((ACTc) + (size_t)(rg + (kind ? 63 : 0)) * DFF + f) = ow; } }
        {
            const int nM0 = last ? 64 : 68, rows0 = last ? FCH_LAT : FCH_ROWS;
            const int skn = last ? 0 : 32;
            PH_BEGIN(8)
            FFN_UP(0, nM0, 0, 0)
            PH_END
            PH_BEGIN(9)
            FFN_FIX(ACT0, rows0)
            PH_END
            PH_BEGIN(10)
            FFN_DOWN(0, nM0)
            FFN_UP(1, 64, skn, 8)
            PH_END
            PH_BEGIN(11)
            FFN_FIX(ACT1, FCH_LAT)
            PH_END
            PH_BEGIN(12)
            FFN_DOWN(1, 64)
            PH_END
        }
#undef FFN_UP
#undef FFN_DOWN
#undef FFN_FIX

        PH_BEGIN(13)
        { const float* modn = MOD + (size_t)(last ? l : l + 1) * 5 * MODW;
          ln_phase(XH, MIX, last ? p.out : (float*)nullptr, XH, last ? (bf16_t*)nullptr : H, SM + SM_LN2G + l * D, SM + SM_LN2B + l * D, modl + 5 * D, modn + D, modn, last ? NLAT : NROWS, bid, G, lds); }
        PH_END
    }
#undef PH_BEGIN
#undef PH_END
}

constexpr int N_PHASES = 2 + DEPTH * 12;

extern "C" void kernel_launch(void* const* d_in, const int* in_sizes, int n_in, void* d_out, int out_size, void* d_ws, size_t ws_size, hipStream_t stream) {
    static int grid = 0;
    if (grid == 0) {
        if (n_in != 23 || in_sizes[0] != NLAT * D || out_size != NLAT * D || ws_size < WS_END) {
            fprintf(stderr, "kernel_launch: unexpected shapes: n_in %d in0 %d out %d ws %zu (need %zu)\n", n_in, n_in > 0 ? in_sizes[0] : -1, out_size, ws_size, (size_t)WS_END); grid = -1; return; }
        int dev = 0, cus = 0, per_cu = 0;
        if (hipGetDevice(&dev) != hipSuccess || hipDeviceGetAttribute(&cus, hipDeviceAttributeMultiprocessorCount, dev) != hipSuccess) { fprintf(stderr, "kernel_launch: device query failed\n"); grid = -1; return; }
        if (hipFuncSetAttribute((const void*)fwd_kernel, hipFuncAttributeMaxDynamicSharedMemorySize, LDS_BYTES) != hipSuccess) { fprintf(stderr, "kernel_launch: hipFuncSetAttribute failed\n"); grid = -1; return; }
        if (hipOccupancyMaxActiveBlocksPerMultiprocessor(&per_cu, (const void*)fwd_kernel, 512, LDS_BYTES) != hipSuccess || per_cu < 1) {
            fprintf(stderr, "kernel_launch: occupancy query reports %d workgroups per CU\n", per_cu); (void)hipGetLastError(); grid = -1; return; }
        grid = cus;
    }
    if (grid < 0) return;
    if (hipMemsetAsync((char*)d_ws + WS_CTL, 0, CTL_BYTES, stream) != hipSuccess) { fprintf(stderr, "kernel_launch: memset failed\n"); return; }
    Params p{};
    for (int i = 0; i < 23; ++i) p.in[i] = (const float*)d_in[i];
    p.out = (float*)d_out; p.ws = (unsigned char*)d_ws; p.pad = 0;
#if MK_ONE_LAUNCH
    p.ph_lo = 0; p.ph_hi = N_PHASES; p.bar_region = 0;
    hipLaunchKernelGGL(fwd_kernel, dim3(grid), dim3(512), LDS_BYTES, stream, p);
#else
    for (int g = 0; g < N_PHASES; ++g) { p.ph_lo = g; p.ph_hi = g + 1; p.bar_region = 0;
        hipLaunchKernelGGL(fwd_kernel, dim3(grid), dim3(512), LDS_BYTES, stream, p); }
#endif
    const hipError_t le = hipPeekAtLastError();
    if (le != hipSuccess) fprintf(stderr, "kernel_launch: launch failed: %s\n", hipGetErrorName(le));
}
```

```cpp
#include <hip/hip_runtime.h>
#include <cstdio>
#include <cstdint>

#define LAS __attribute__((address_space(3)))
typedef unsigned short bf16_t;
typedef short bf16x8 __attribute__((ext_vector_type(8)));
typedef short s16x4 __attribute__((ext_vector_type(4)));
typedef float f32x4 __attribute__((ext_vector_type(4)));
typedef float f32x16 __attribute__((ext_vector_type(16)));
typedef unsigned u32x4 __attribute__((ext_vector_type(4)));
typedef unsigned u32x2 __attribute__((ext_vector_type(2)));

#ifndef MK_ONE_LAUNCH
#define MK_ONE_LAUNCH 1
#endif

constexpr int D = 2048, NB = 4, SEQ = 8192, DEPTH = 4, CTXL = 256;
constexpr int NLAT = NB * SEQ, NCTX = NB * CTXL, NROWS = NLAT + NCTX;
constexpr int INW = 4160, INWP = 4352, DFF = 5632, DFF2 = 11264;
constexpr int QUPW = 1152, QUPWP = 1280, KVUPW = 1536;
constexpr int NMOD = 6, MODW = NMOD * D;
constexpr float LN_EPS = 1e-5f, RMS_EPS = 1e-6f;
constexpr float ALPHA = 1.6817928305074292f;
constexpr float KSCALE = 0.08838834764831845f;
constexpr float MLA_QSCALE = 0.07216878364870323f * 1.4426950408889634f;
constexpr float LOG2E = 1.4426950408889634f;

constexpr size_t MiB = 1u << 20;
constexpr size_t WS_CTL = 0, CTL_BYTES = 1 * MiB;
constexpr size_t WS_MOD = 1 * MiB;
constexpr size_t WS_ROPE = 2 * MiB;
constexpr size_t WS_SM = 2 * MiB + 65536;
constexpr int SM_DECF = 0, SM_DECB = 16, SM_SINK = 32, SM_LN1G = 64, SM_LN1B = SM_LN1G + DEPTH * D, SM_LN2G = SM_LN1B + DEPTH * D, SM_LN2B = SM_LN2G + DEPTH * D,
              SM_CONVW = SM_LN2B + DEPTH * D, SM_CONVB = SM_CONVW + DEPTH * 3 * DFF, SM_END = SM_CONVB + DEPTH * DFF;
static_assert(WS_SM + (size_t)SM_END * 4 <= 3 * MiB, "small vectors");
constexpr size_t WS_RS = 3 * MiB;
constexpr size_t WS_W = 5 * MiB;
constexpr size_t W_IN = 0, W_UQ = W_IN + (size_t)INWP * D, W_UKV = W_UQ + (size_t)QUPWP * 512, W_O = W_UKV + (size_t)KVUPW * 256,
                 W_UP = W_O + (size_t)D * D, W_DN = W_UP + (size_t)DFF2 * D, W_LAYER = W_DN + (size_t)D * DFF;
constexpr size_t WS_X = WS_W + W_LAYER * 2 * DEPTH;
constexpr size_t WS_H = WS_X + (size_t)NROWS * D * 4;
constexpr size_t WS_Y = WS_H + (size_t)NROWS * D * 2;
constexpr size_t WS_PROJ = WS_Y + (size_t)NROWS * D * 2;
constexpr size_t WS_QUP = WS_PROJ + (size_t)NROWS * INW * 2;
constexpr size_t WS_KVUP = WS_QUP + (size_t)NROWS * QUPW * 2;
constexpr size_t WS_KVS = WS_KVUP + (size_t)NROWS * KVUPW * 2;
constexpr size_t WS_SIN = WS_KVS + (size_t)NB * 4 * 2 * 33 * 16384 * 4;
constexpr size_t WS_END = WS_SIN + (size_t)NB * 4 * 2 * 33 * 16384 * 2;
constexpr int FCH_LAT = 64 * 256, FCH_ROWS = FCH_LAT + NCTX;
constexpr size_t WS_ACT0 = WS_Y;
constexpr size_t WS_ACT1 = WS_ACT0 + (size_t)FCH_ROWS * DFF * 2;
constexpr int NGRP = FCH_ROWS / 64;
constexpr size_t WS_SB = WS_ACT1 + (size_t)FCH_LAT * DFF * 2;
static_assert(WS_SB + (size_t)2 * NGRP * 3 * DFF * 4 <= WS_QUP, "FFN overlay");
constexpr size_t WS_MIX = WS_QUP;
static_assert(WS_MIX >= WS_QUP && WS_MIX + (size_t)NROWS * D * 2 <= WS_END, "FFN overlay");
static_assert(WS_W % 256 == 0 && W_LAYER % 128 == 0 && WS_X % 256 == 0, "align");

constexpr int LDS_BYTES = 131072 + 512;

#define XB_TMO      128
#define XB_XCNT(j)  (256  + 64 * (j))
#define XB_XSUB(j)  (1280 + 64 * (j))
#define XB_XGEN(j)  (2304 + 64 * (j))
#define XB_TOP      3328
#define XB_TOPGEN   3392
#define XCD_BAR_WORDS 3456
#define XB_SPIN_CAP (1u << 20)

__device__ __forceinline__ unsigned xb_ld(unsigned* p)              { return __hip_atomic_load(p, __ATOMIC_RELAXED, __HIP_MEMORY_SCOPE_AGENT); }
__device__ __forceinline__ unsigned xb_add(unsigned* p, unsigned v) { return __hip_atomic_fetch_add(p, v, __ATOMIC_RELAXED, __HIP_MEMORY_SCOPE_AGENT); }
__device__ __forceinline__ unsigned xb_xcc_id() { return (unsigned)__builtin_amdgcn_s_getreg((3 << 11) | 20) & 0xFu; }
#define XB_SPIN(cond, bar) do { unsigned _sp = 0; while (cond) { __builtin_amdgcn_s_sleep(1); \
    if ((++_sp & 255u) == 0u) { if (xb_ld(&(bar)[XB_TMO])) break; if (_sp > XB_SPIN_CAP) { atomicAdd(&(bar)[XB_TMO], 1u); break; } } } } while (0)

struct XcdBarrier { unsigned* bar; unsigned x; volatile LAS unsigned* st; };

__device__ __forceinline__ XcdBarrier xcd_barrier_post(unsigned* bar, volatile LAS unsigned* st) {
    XcdBarrier b; b.bar = bar; b.x = xb_xcc_id(); b.st = st;
    if (threadIdx.x == 0) (void)xb_add(&bar[XB_XCNT(b.x)], 1u);
    return b;
}
__device__ __forceinline__ void xcd_barrier_complete(unsigned* bar, unsigned x, unsigned& nloc, unsigned& nx) {
    const unsigned G = gridDim.x * gridDim.y * gridDim.z;
    unsigned sum, cnt, mine, sp = 0u;
    for (;;) {
        sum = 0u; cnt = 0u; mine = 0u;
#pragma unroll
        for (unsigned j = 0; j < 16; ++j) { const unsigned c = xb_ld(&bar[XB_XCNT(j)]); sum += c; cnt += (c > 0u) ? 1u : 0u; mine = (j == x) ? c : mine; }
        if (sum == G) break;
        __builtin_amdgcn_s_sleep(1);
        if ((++sp & 255u) == 0u) { if (xb_ld(&bar[XB_TMO])) break; if (sp > XB_SPIN_CAP) { atomicAdd(&bar[XB_TMO], 1u); break; } }
    }
    nloc = mine > 0u ? mine : 1u; nx = cnt > 0u ? cnt : 1u;
}
__device__ __forceinline__ void xcd_barrier(const XcdBarrier& b) {
    asm volatile("s_waitcnt vmcnt(0)" ::: "memory");
    __syncthreads();
    if (threadIdx.x == 0) {
        unsigned* bar = b.bar;
        __builtin_amdgcn_s_waitcnt(0);
        unsigned nloc = b.st[0], nx = b.st[1];
        if (nloc == 0u) { xcd_barrier_complete(bar, b.x, nloc, nx); b.st[0] = nloc; b.st[1] = nx; }
        const unsigned old = xb_add(&bar[XB_XSUB(b.x)], 1u);
        const unsigned gen = old / nloc;
        if (old + 1u == (gen + 1u) * nloc) {
            __builtin_amdgcn_fence(__ATOMIC_RELEASE, "agent");
            asm volatile("s_waitcnt vmcnt(0)" ::: "memory");
            const unsigned og = xb_add(&bar[XB_TOP], 1u);
            const unsigned tg = og / nx;
            if (og + 1u == (tg + 1u) * nx) xb_add(&bar[XB_TOPGEN], 1u);
            else XB_SPIN(xb_ld(&bar[XB_TOPGEN]) == tg, bar);
            __builtin_amdgcn_fence(__ATOMIC_ACQUIRE, "agent");
            xb_add(&bar[XB_XGEN(b.x)], 1u);
            asm volatile("s_waitcnt vmcnt(0)" ::: "memory");
        } else {
            XB_SPIN(xb_ld(&bar[XB_XGEN(b.x)]) == gen, bar);
            __builtin_amdgcn_fence(__ATOMIC_ACQUIRE, "agent");
            asm volatile("s_waitcnt vmcnt(0)" ::: "memory");
        }
    }
    __syncthreads();
}

__device__ __forceinline__ unsigned cvtpk(float lo, float hi) { unsigned r; asm volatile("v_cvt_pk_bf16_f32 %0, %1, %2" : "=v"(r) : "v"(lo), "v"(hi)); return r; }
__device__ __forceinline__ float bf2f(unsigned short b) { return __uint_as_float(((unsigned)b) << 16); }
__device__ __forceinline__ float bflo(unsigned w) { return __uint_as_float(w << 16); }
__device__ __forceinline__ float bfhi(unsigned w) { return __uint_as_float(w & 0xffff0000u); }
__device__ __forceinline__ void st_bf16x4(bf16_t* p, f32x4 v) { u32x2 w; w.x = cvtpk(v[0], v[1]); w.y = cvtpk(v[2], v[3]); *(u32x2*)p = w; }
typedef _Float16 f16x4 __attribute__((ext_vector_type(4)));
__device__ __forceinline__ void st_f16x4(bf16_t* p, f32x4 v) { *(f16x4*)p = __builtin_convertvector(v, f16x4); }
__device__ __forceinline__ f32x4 cvt_f16x4(u32x2 w) { return __builtin_convertvector(__builtin_bit_cast(f16x4, w), f32x4); }
__device__ __forceinline__ float silu_f(float x) { return x * __builtin_amdgcn_rcpf(1.0f + __builtin_amdgcn_exp2f(-1.4426950408889634f * x)); }
__device__ __forceinline__ float wave_sum(float v) {
#pragma unroll
    for (int o = 1; o < 64; o <<= 1) v += __shfl_xor(v, o);
    return v;
}
__device__ __forceinline__ int otid() { int t = threadIdx.x; asm volatile("" : "+v"(t)); return t; }
__device__ __forceinline__ int mod_index(int row) { return row < NLAT ? (row >> 13) : 4; }

namespace pg8 {
constexpr int BM = 256, BK = 64, HALF = 128, HTB = HALF * BK * 2, STAGE_BYTES = 8 * HTB, NXCD = 8, WGM = 8;
__host__ __device__ __forceinline__ int lds_byte(int r, int c) { const int st = (r >> 4) * 2 + (c >> 5), rr = r & 15, cc = c & 31, ob = rr * 64 + cc * 2; return st * 1024 + (ob ^ (((ob >> 9) & 1) << 5)); }
__host__ __device__ __forceinline__ void stage_rc(int b, int& R, int& C) { const int st = b / 1024, sb = b % 1024, swz = sb ^ (((sb >> 9) & 1) << 5); R = (st >> 1) * 16 + swz / 64; C = (st & 1) * 32 + (swz % 64) / 2; }

struct Unit { int pm, pn; };
struct Gemm { const bf16_t* A; const bf16_t* Bt; int lda, K; };

struct TileOrder {
    int nM, nN, nwg, G, c, chunk, skew_n, skew_i;
    __device__ __forceinline__ void init(int nM_, int nN_, int G_, int c_, int chunk_, int skew_n_ = 0, int skew_i_ = 0) { nM = nM_; nN = nN_; nwg = nM * nN; G = G_; c = c_; chunk = chunk_; skew_n = skew_n_; skew_i = skew_i_; }
    __device__ __forceinline__ bool next(int i, Unit& u) const {
        long L;
        if (skew_n == 0 || i < skew_i) L = (long)i * G + c;
        else { if (c < skew_n) return false; L = (long)skew_i * G + (long)(i - skew_i) * (G - skew_n) + (c - skew_n); }
        if (L >= nwg) return false;
        int wgid = (int)L; { const int q = nwg / NXCD, r = nwg % NXCD, xcd = wgid % NXCD, off = wgid / NXCD; wgid = (xcd < r ? xcd * (q + 1) : r * (q + 1) + (xcd - r) * q) + off; }
        const int nig = WGM * nN, gid = wgid / nig, fm = gid * WGM, gsz = (nM - fm) < WGM ? (nM - fm) : WGM;
        int pm = fm + ((wgid % nig) % gsz); u.pn = (wgid % nig) / gsz;
        if (chunk >= 0) pm = (pm < 64) ? 64 * chunk + pm : 128 + (pm - 64);
        u.pm = pm; return true;
    }
    __device__ __forceinline__ void a_ready(const Unit&) const {}
    __device__ __forceinline__ void done(const Unit&) const {}
};

template <class Epi, class Sched>
__device__ __forceinline__ void gemm_phase(LAS unsigned char* lds, const Gemm g, const Sched& S, const Epi& E) {
    const int tid = otid(), wid = __builtin_amdgcn_readfirstlane(tid >> 6), lane = tid & 63, wr = wid >> 2, wc = wid & 3, fr = lane & 15, fq = lane >> 4;
    const int K = g.K, nt = K / BK, lda = g.lda;
    unsigned voffA[2], voffB[2];
#pragma unroll
    for (int i = 0; i < 2; ++i) { int R, C; stage_rc(tid * 16 + i * 8192, R, C);
        voffA[i] = (unsigned)(R * lda + C) * 2u; voffB[i] = (unsigned)(R * K + C) * 2u; }
    const size_t kstep = (size_t)(BK * 2);
    const size_t hstepA = (size_t)HALF * lda * 2, hstepB = (size_t)HALF * K * 2;
    const size_t tstepA = 2 * hstepA, tstepB = 2 * hstepB;
    const unsigned ldsw = (unsigned)wid * 1024u;
    const int aoff = lds_byte(wr * 64 + fr, fq * 8), boff = lds_byte(wc * 32 + fr, fq * 8);
#define PG8_SA(b, h) (((b) * 2 + (h)) * HTB)
#define PG8_SB(b, h) ((4 + (b) * 2 + (h)) * HTB)
#define PG8_STAGE(bufoff, gbase, voff) do { const char* gb_ = (const char*)(gbase); asm volatile("" : "+s"(gb_));        \
        _Pragma("unroll") for (int _i = 0; _i < 2; ++_i) \
        __builtin_amdgcn_global_load_lds((const unsigned*)(gb_ + (voff)[_i]), (LAS unsigned*)(lds + (bufoff) + ldsw + _i * 8192), 16, 0, 0); } while (0)
#define PG8_LDA(dst, b, h) do { _Pragma("unroll") for (int m = 0; m < 4; ++m) _Pragma("unroll") for (int k = 0; k < 2; ++k) dst[m][k] = *(const LAS bf16x8*)(lds + PG8_SA(b, h) + aoff + m * 2048 + k * 1024); } while (0)
#define PG8_LDB(dst, b, h) do { _Pragma("unroll") for (int n = 0; n < 2; ++n) _Pragma("unroll") for (int k = 0; k < 2; ++k) dst[n][k] = *(const LAS bf16x8*)(lds + PG8_SB(b, h) + boff + n * 2048 + k * 1024); } while (0)
#define PG8_MMA(ai, bj, At, Bt) do { __builtin_amdgcn_s_setprio(1); _Pragma("unroll") for (int m = 0; m < 4; ++m) _Pragma("unroll") for (int n = 0; n < 2; ++n) _Pragma("unroll") for (int k = 0; k < 2; ++k) \
        acc[ai][bj][m][n] = __builtin_amdgcn_mfma_f32_16x16x32_bf16(Bt[n][k], At[m][k], acc[ai][bj][m][n], 0, 0, 0); __builtin_amdgcn_s_setprio(0); } while (0)
#define PG8_WAIT_V(n) asm volatile("s_waitcnt vmcnt(" #n ")" ::: "memory")
#define PG8_WAIT_L(n) asm volatile("s_waitcnt lgkmcnt(" #n ")" ::: "memory")
#define PG8_BAR __builtin_amdgcn_s_barrier()
#define PG8_SCHED __builtin_amdgcn_sched_barrier(0)
    Unit cur, nxt; int ui = 0;
    if (!S.next(0, cur)) return;
    f32x4 acc[2][2][4][2];
#pragma unroll
    for (int a = 0; a < 2; ++a)
#pragma unroll
        for (int b = 0; b < 2; ++b)
#pragma unroll
            for (int m = 0; m < 4; ++m)
#pragma unroll
                for (int n = 0; n < 2; ++n) acc[a][b][m][n] = (f32x4){0.f, 0.f, 0.f, 0.f};
    bf16x8 At[4][2], B0[2][2], B1[2][2];
    const char* cA = (const char*)g.A + (size_t)cur.pm * tstepA; const char* cB = (const char*)g.Bt + (size_t)cur.pn * tstepB;
    S.a_ready(cur);
    PG8_STAGE(PG8_SB(0, 0), cB, voffB); PG8_STAGE(PG8_SA(0, 0), cA, voffA); PG8_STAGE(PG8_SB(0, 1), cB + hstepB, voffB); PG8_STAGE(PG8_SA(0, 1), cA + hstepA, voffA);
    if (wr == 1) PG8_BAR;
    PG8_WAIT_V(4); PG8_BAR;
    PG8_STAGE(PG8_SB(1, 0), cB + kstep, voffB); PG8_STAGE(PG8_SA(1, 0), cA + kstep, voffA); PG8_STAGE(PG8_SB(1, 1), cB + hstepB + kstep, voffB);
    PG8_WAIT_V(6); PG8_BAR;
    for (;;) {
        const bool has_next = S.next(ui + 1, nxt);
        const char* nA = has_next ? (const char*)g.A + (size_t)nxt.pm * tstepA : cA; const char* nB = has_next ? (const char*)g.Bt + (size_t)nxt.pn * tstepB : cB;
#pragma nounroll
        for (int t = 0; t < nt; t += 2) {
            asm volatile("" : "+v"(voffA[0]), "+v"(voffA[1]), "+v"(voffB[0]), "+v"(voffB[1]));
            const bool last = (t == nt - 2);
            const char* a1 = cA + (size_t)(t + 1) * kstep;
            const char* a2 = last ? nA : cA + (size_t)(t + 2) * kstep; const char* b2 = last ? nB : cB + (size_t)(t + 2) * kstep;
            const char* a3 = a2 + kstep; const char* b3 = b2 + kstep;
            if (last && has_next) S.a_ready(nxt);
            PG8_LDB(B0, 0, 0); PG8_SCHED; PG8_LDA(At, 0, 0); PG8_STAGE(PG8_SA(1, 1), a1 + hstepA, voffA);
            PG8_WAIT_L(8); PG8_BAR; PG8_WAIT_L(0); PG8_MMA(0, 0, At, B0); PG8_BAR; PG8_SCHED;
            PG8_LDB(B1, 0, 1); PG8_STAGE(PG8_SB(0, 0), b2, voffB);
            PG8_BAR; PG8_WAIT_L(0); PG8_MMA(0, 1, At, B1); PG8_BAR;
            PG8_LDA(At, 0, 1); PG8_STAGE(PG8_SA(0, 0), a2, voffA);
            PG8_BAR; PG8_WAIT_L(0); PG8_MMA(1, 0, At, B0); PG8_BAR; PG8_SCHED;
            PG8_STAGE(PG8_SB(0, 1), b2 + hstepB, voffB);
            PG8_WAIT_V(6); PG8_BAR; PG8_MMA(1, 1, At, B1); PG8_BAR;
            PG8_LDB(B0, 1, 0); PG8_SCHED; PG8_LDA(At, 1, 0); PG8_STAGE(PG8_SA(0, 1), a2 + hstepA, voffA);
            PG8_WAIT_L(8); PG8_BAR; PG8_WAIT_L(0); PG8_MMA(0, 0, At, B0); PG8_BAR; PG8_SCHED;
            PG8_LDB(B1, 1, 1); PG8_STAGE(PG8_SB(1, 0), b3, voffB);
            PG8_BAR; PG8_WAIT_L(0); PG8_MMA(0, 1, At, B1); PG8_BAR;
            PG8_LDA(At, 1, 1); PG8_STAGE(PG8_SA(1, 0), a3, voffA);
            PG8_BAR; PG8_WAIT_L(0); PG8_MMA(1, 0, At, B0); PG8_BAR; PG8_SCHED;
            PG8_STAGE(PG8_SB(1, 1), b3 + hstepB, voffB);
            PG8_WAIT_V(6); PG8_BAR; PG8_MMA(1, 1, At, B1); PG8_BAR;
        }
        E(acc, cur, wr, wc, fr, fq); S.done(cur);
        if (!has_next) break;
#pragma unroll
        for (int a = 0; a < 2; ++a)
#pragma unroll
            for (int b = 0; b < 2; ++b)
#pragma unroll
                for (int m = 0; m < 4; ++m)
#pragma unroll
                    for (int n = 0; n < 2; ++n) acc[a][b][m][n] = (f32x4){0.f, 0.f, 0.f, 0.f};
        cur = nxt; cA = nA; cB = nB; ++ui;
    }
    PG8_WAIT_V(0);
    if (wr == 0) PG8_BAR;
    PG8_BAR;
#undef PG8_SA
#undef PG8_SB
#undef PG8_STAGE
#undef PG8_LDA
#undef PG8_LDB
#undef PG8_MMA
#undef PG8_WAIT_V
#undef PG8_WAIT_L
#undef PG8_BAR
#undef PG8_SCHED
}


struct EpiProj {
    bf16_t* P; float* RS; const float* thc; const float* ths; const float* tmc; const float* tms;
    __device__ __forceinline__ void operator()(const f32x4 (&acc)[2][2][4][2], const Unit& u, int wr, int wc, int fr, int fq) const {
        asm volatile("" : "+v"(fr), "+v"(fq));
        const int pn = u.pn; const bool lat = u.pm < 128;
        const int row0 = u.pm * BM + wr * 64 + fr;
        if (pn == 16) {
            if (wc < 2) {
#pragma unroll
                for (int ai = 0; ai < 2; ++ai)
#pragma unroll
                    for (int m = 0; m < 4; ++m) {
                        const int row = row0 + ai * HALF + m * 16; const f32x4 v0 = acc[ai][0][m][0], v1 = acc[ai][0][m][1]; f32x4 o0 = v0, o1 = v1;
                        if (lat) { const int pos = row & (SEQ - 1), tp = wc ? (pos & 63) : (pos >> 6);
                            const f32x4 c = *(const f32x4*)(tmc + tp * 16 + 4 * fq), s = *(const f32x4*)(tms + tp * 16 + 4 * fq);
                            o0 = v0 * c - v1 * s; o1 = v1 * c + v0 * s; }
                        bf16_t* rp = P + (size_t)row * INW + 4096 + 32 * wc + 4 * fq;
                        st_bf16x4(rp, o0); st_bf16x4(rp + 16, o1);
                        asm volatile("" ::: "memory");
                    }
            }
            return;
        }
        const bool roped = (pn < 4) || (pn >= 8 && pn < 12);
        if (roped) {
            const float sc = (pn == 2 || pn == 3) ? KSCALE : ((pn >= 8 && pn <= 10) ? KSCALE * LOG2E : 1.0f);
            const int colb = pn * BM + 128 * (wc >> 1) + 64 * (wc & 1) + 8 * fq;
#pragma unroll
            for (int ai = 0; ai < 2; ++ai)
#pragma unroll
                for (int m = 0; m < 4; ++m) {
                    const int row = row0 + ai * HALF + m * 16; const int pos = row & (SEQ - 1), tp = (wc & 1) ? (pos & 63) : (pos >> 6);
                    u32x4 w0, w1;
#pragma unroll
                    for (int n = 0; n < 2; ++n) {
                        f32x4 c = (f32x4){1.f, 1.f, 1.f, 1.f}, s = (f32x4){0.f, 0.f, 0.f, 0.f};
                        if (lat) { c = *(const f32x4*)(thc + tp * 32 + 8 * fq + 4 * n); s = *(const f32x4*)(ths + tp * 32 + 8 * fq + 4 * n); }
                        const f32x4 v0 = acc[ai][0][m][n] * sc, v1 = acc[ai][1][m][n] * sc;
                        const f32x4 o0 = v0 * c - v1 * s, o1 = v1 * c + v0 * s;
                        w0[2 * n] = cvtpk(o0[0], o0[1]); w0[2 * n + 1] = cvtpk(o0[2], o0[3]); w1[2 * n] = cvtpk(o1[0], o1[1]); w1[2 * n + 1] = cvtpk(o1[2], o1[3]);
                    }
                    bf16_t* rp = P + (size_t)row * INW + colb;
                    *(u32x4*)rp = w0; *(u32x4*)(rp + 32) = w1;
                    asm volatile("" ::: "memory");
                }
            return;
        }
#pragma unroll
        for (int ai = 0; ai < 2; ++ai)
#pragma unroll
            for (int m = 0; m < 4; ++m) {
                const int row = row0 + ai * HALF + m * 16; bf16_t* rp = P + (size_t)row * INW + pn * BM + wc * 32 + 8 * fq; float ss = 0.f;
#pragma unroll
                for (int bj = 0; bj < 2; ++bj) { const f32x4 v0 = acc[ai][bj][m][0], v1 = acc[ai][bj][m][1];
                    u32x4 w; w[0] = cvtpk(v0[0], v0[1]); w[1] = cvtpk(v0[2], v0[3]); w[2] = cvtpk(v1[0], v1[1]); w[3] = cvtpk(v1[2], v1[3]);
                    *(u32x4*)(rp + bj * HALF) = w;
                    ss += ((v0[0] * v0[0] + v0[1] * v0[1]) + (v0[2] * v0[2] + v0[3] * v0[3])) + ((v1[0] * v1[0] + v1[1] * v1[1]) + (v1[2] * v1[2] + v1[3] * v1[3])); }
                if (pn >= 13 && pn <= 15) { ss += __shfl_xor(ss, 16); ss += __shfl_xor(ss, 32); if (fq == 0) RS[(size_t)row * 12 + (pn - 13) * 4 + wc] = ss; }
            }
    }
};
struct EpiQup {
    bf16_t* Q; const float* RS; const float* tmc; const float* tms;
    __device__ __forceinline__ void operator()(const f32x4 (&acc)[2][2][4][2], const Unit& u, int wr, int wc, int fr, int fq) const {
        asm volatile("" : "+v"(fr), "+v"(fq));
        const int pn = u.pn; const bool lat = u.pm < 128; const int row0 = u.pm * BM + wr * 64 + fr;
#pragma unroll
        for (int ai = 0; ai < 2; ++ai)
#pragma unroll
            for (int m = 0; m < 4; ++m) {
                const int row = row0 + ai * HALF + m * 16; const f32x4 r0 = *(const f32x4*)(RS + (size_t)row * 12), r1 = *(const f32x4*)(RS + (size_t)row * 12 + 4);
                const float rs = MLA_QSCALE / sqrtf(((r0[0] + r0[1]) + (r0[2] + r0[3]) + (r1[0] + r1[1]) + (r1[2] + r1[3])) * (1.0f / 512.0f) + RMS_EPS);
                const int pos = row & (SEQ - 1), tp = (wc & 1) ? (pos & 63) : (pos >> 6);
                const f32x4 c = *(const f32x4*)(tmc + tp * 16 + 4 * fq), s = *(const f32x4*)(tms + tp * 16 + 4 * fq);
#pragma unroll
                for (int bj = 0; bj < 2; ++bj) {
                    const int colb = pn * BM + bj * HALF + wc * 32; if (colb >= QUPW) continue;
                    const int c64 = 4 * pn + 2 * bj + (wc >> 1);
                    const f32x4 v0 = acc[ai][bj][m][0] * rs, v1 = acc[ai][bj][m][1] * rs; f32x4 o0 = v0, o1 = v1;
                    if (lat && (c64 % 3) == 2) { o0 = v0 * c - v1 * s; o1 = v1 * c + v0 * s; }
                    bf16_t* rp = Q + (size_t)row * QUPW + colb + 4 * fq; st_bf16x4(rp, o0); st_bf16x4(rp + 16, o1);
                }
                asm volatile("" ::: "memory");
            }
    }
};
struct EpiKvup {
    bf16_t* KV; const float* RS;
    __device__ __forceinline__ void operator()(const f32x4 (&acc)[2][2][4][2], const Unit& u, int wr, int wc, int fr, int fq) const {
        asm volatile("" : "+v"(fr), "+v"(fq));
        const int row0 = u.pm * BM + wr * 64 + fr;
#pragma unroll
        for (int ai = 0; ai < 2; ++ai)
#pragma unroll
            for (int m = 0; m < 4; ++m) {
                const int row = row0 + ai * HALF + m * 16; const f32x4 r0 = *(const f32x4*)(RS + (size_t)row * 12 + 8);
                const float rs = 1.0f / sqrtf(((r0[0] + r0[1]) + (r0[2] + r0[3])) * (1.0f / 256.0f) + RMS_EPS);
                bf16_t* rp = KV + (size_t)row * KVUPW + u.pn * BM + wc * 32 + 8 * fq;
#pragma unroll
                for (int bj = 0; bj < 2; ++bj) { const f32x4 v0 = acc[ai][bj][m][0] * rs, v1 = acc[ai][bj][m][1] * rs;
                    u32x4 w; w[0] = cvtpk(v0[0], v0[1]); w[1] = cvtpk(v0[2], v0[3]); w[2] = cvtpk(v1[0], v1[1]); w[3] = cvtpk(v1[2], v1[3]);
                    *(u32x4*)(rp + bj * HALF) = w; }
                asm volatile("" ::: "memory");
            }
    }
};
struct EpiMix {
    bf16_t* MIX; int chunk; int dry;
    __device__ __forceinline__ void operator()(const f32x4 (&acc)[2][2][4][2], const Unit& u, int wr, int wc, int fr, int fq) const {
        asm volatile("" : "+v"(fr), "+v"(fq));
        if (dry) { float s = 0.f;
#pragma unroll
            for (int ai = 0; ai < 2; ++ai)
#pragma unroll
                for (int bj = 0; bj < 2; ++bj)
#pragma unroll
                    for (int m = 0; m < 4; ++m)
#pragma unroll
                        for (int n = 0; n < 2; ++n) s += (acc[ai][bj][m][n][0] + acc[ai][bj][m][n][1]) + (acc[ai][bj][m][n][2] + acc[ai][bj][m][n][3]);
            if (s == 123456.789f) MIX[0] = (bf16_t)1; return; }
        const int pmg = chunk < 0 ? u.pm : (u.pm < 64 ? 64 * chunk + u.pm : 128 + (u.pm - 64));
        const int row0 = pmg * BM + wr * 64 + fr;
#pragma unroll
        for (int ai = 0; ai < 2; ++ai)
#pragma unroll
            for (int m = 0; m < 4; ++m) { bf16_t* rp = MIX + (size_t)(row0 + ai * HALF + m * 16) * D + u.pn * BM + wc * 32 + 8 * fq;
#pragma unroll
                for (int bj = 0; bj < 2; ++bj) { const f32x4 v0 = acc[ai][bj][m][0], v1 = acc[ai][bj][m][1];
                    u32x4 w; w[0] = cvtpk(v0[0], v0[1]); w[1] = cvtpk(v0[2], v0[3]); w[2] = cvtpk(v1[0], v1[1]); w[3] = cvtpk(v1[2], v1[3]);
                    *(u32x4*)(rp + bj * HALF) = w; } }
    }
};
struct EpiUpConv {
    bf16_t* ACTc; float* SB; const float* cw; const float* cb; int chunk;
    static __device__ __forceinline__ float lane_prev(float x) { return __builtin_bit_cast(float, __builtin_amdgcn_update_dpp(0, __builtin_bit_cast(int, x), 0x121, 0xf, 0xf, true)); }
    static __device__ __forceinline__ float lane_next(float x) { return __builtin_bit_cast(float, __builtin_amdgcn_update_dpp(0, __builtin_bit_cast(int, x), 0x12f, 0xf, 0xf, true)); }
    static __device__ __forceinline__ void taps2(const int MM, float& z0, float& z1, float gc0, float gc1, float gp0, float gp1, float gn0, float gn1, float w1a, float w1b, float ba, float bb_,
                                                 float w0ma, float w0mb, float w2ma, float w2mb, float w0ea, float w0eb, float w2ea, float w2eb) {
#define TAP_HEAD "v_fma_f32 %0, %2, %8, %10\n\tv_fma_f32 %1, %3, %9, %11\n\t" \
                 "v_fmac_f32_dpp %0, %2, %12 row_ror:1 row_mask:0xf bank_mask:0xf\n\tv_fmac_f32_dpp %1, %3, %13 row_ror:1 row_mask:0xf bank_mask:0xf\n\t" \
                 "v_fmac_f32_dpp %0, %2, %14 row_ror:15 row_mask:0xf bank_mask:0xf\n\tv_fmac_f32_dpp %1, %3, %15 row_ror:15 row_mask:0xf bank_mask:0xf"
#define TAP_PREV "\n\tv_fmac_f32_dpp %0, %4, %16 row_ror:1 row_mask:0xf bank_mask:0xf\n\tv_fmac_f32_dpp %1, %5, %17 row_ror:1 row_mask:0xf bank_mask:0xf"
#define TAP_NEXT "\n\tv_fmac_f32_dpp %0, %6, %18 row_ror:15 row_mask:0xf bank_mask:0xf\n\tv_fmac_f32_dpp %1, %7, %19 row_ror:15 row_mask:0xf bank_mask:0xf"
#define TAP_OPS : "=&v"(z0), "=&v"(z1) : "v"(gc0), "v"(gc1), "v"(gp0), "v"(gp1), "v"(gn0), "v"(gn1), "v"(w1a), "v"(w1b), "v"(ba), "v"(bb_), "v"(w0ma), "v"(w0mb), "v"(w2ma), "v"(w2mb), "v"(w0ea), "v"(w0eb), "v"(w2ea), "v"(w2eb)
        if (MM == 0) asm(TAP_HEAD TAP_NEXT TAP_OPS);
        else if (MM == 3) asm(TAP_HEAD TAP_PREV TAP_OPS);
        else asm(TAP_HEAD TAP_PREV TAP_NEXT TAP_OPS);
#undef TAP_HEAD
#undef TAP_PREV
#undef TAP_NEXT
#undef TAP_OPS
    }
    __device__ __forceinline__ void operator()(const f32x4 (&acc)[2][2][4][2], const Unit& u, int wr, int wc, int fr, int fq) const {
        asm volatile("" : "+v"(fr), "+v"(fq));
        const int lpm = u.pm < 128 ? u.pm - 64 * chunk : 64 + (u.pm - 128);
        const int f0 = u.pn * 128 + wc * 32 + 8 * fq;
        constexpr float NL2E = -1.4426950408889634f;
        f32x4 w0m[2], w0e[2], w2m[2], w2e[2], w1s[2], bbs[2];
#pragma unroll
        for (int n = 0; n < 2; ++n) {
            const f32x4 a0 = *(const f32x4*)(cw + f0 + 4 * n) * NL2E, a2 = *(const f32x4*)(cw + 2 * DFF + f0 + 4 * n) * NL2E; const f32x4 zero = {0.f, 0.f, 0.f, 0.f};
            w1s[n] = *(const f32x4*)(cw + DFF + f0 + 4 * n) * NL2E; bbs[n] = *(const f32x4*)(cb + f0 + 4 * n) * NL2E;
            w0m[n] = fr > 0 ? a0 : zero; w0e[n] = fr == 0 ? a0 : zero; w2m[n] = fr < 15 ? a2 : zero; w2e[n] = fr == 15 ? a2 : zero;
        }
#pragma unroll
        for (int ai = 0; ai < 2; ++ai) {
            const int rg = lpm * BM + ai * HALF + wr * 64;
            const int smask = rg < FCH_LAT ? (SEQ - 1) : (CTXL - 1);
            const bool seq_first = (rg & smask) == 0, seq_last = ((rg + 63) & smask) == smask;
#pragma unroll
            for (int m = 0; m < 4; ++m) {
                u32x4 ow;
#pragma unroll
                for (int n = 0; n < 2; ++n) {
                    const f32x4 gc = acc[ai][1][m][n], uu = acc[ai][0][m][n];
                    const f32x4 gpf = acc[ai][1][m > 0 ? m - 1 : 0][n], gnf = acc[ai][1][m < 3 ? m + 1 : 3][n];
                    f32x4 zs;
#pragma unroll
                    for (int e = 0; e < 4; e += 2) {
                        float z0, z1;
                        taps2(m, z0, z1, gc[e], gc[e + 1], gpf[e], gpf[e + 1], gnf[e], gnf[e + 1], w1s[n][e], w1s[n][e + 1], bbs[n][e], bbs[n][e + 1],
                                                              w0m[n][e], w0m[n][e + 1], w2m[n][e], w2m[n][e + 1], w0e[n][e], w0e[n][e + 1], w2e[n][e], w2e[n][e + 1]);
                        zs[e] = z0; zs[e + 1] = z1;
                    }
                    f32x4 o;
#pragma unroll
                    for (int e = 0; e < 4; ++e) o[e] = (zs[e] * uu[e]) * __builtin_amdgcn_rcpf(fmaf(__builtin_amdgcn_exp2f(zs[e]), NL2E, NL2E));
                    ow[2 * n] = cvtpk(o[0], o[1]); ow[2 * n + 1] = cvtpk(o[2], o[3]);
                    if (m == 0 && fr == 0) { float* sp = SB + ((size_t)(0 * NGRP + (rg >> 6)) * 3) * DFF + f0 + 4 * n; *(f32x4*)(sp + 2 * DFF) = gc; if (!seq_first) { *(f32x4*)sp = zs * (1.0f / NL2E); *(f32x4*)(sp + DFF) = uu; } }
                    if (m == 3 && fr == 15) { float* sp = SB + ((size_t)(1 * NGRP + (rg >> 6)) * 3) * DFF + f0 + 4 * n; *(f32x4*)(sp + 2 * DFF) = gc; if (!seq_last) { *(f32x4*)sp = zs * (1.0f / NL2E); *(f32x4*)(sp + DFF) = uu; } }
                }
                *(u32x4*)(ACTc + (size_t)(rg + 16 * m + fr) * DFF + f0) = ow;
            }
            asm volatile("" ::: "memory");
        }
    }
};
}

#define SBAR() __builtin_amdgcn_sched_barrier(0)
__device__ __forceinline__ int crow(int r, int hi) { return (r & 3) + 8 * (r >> 2) + 4 * hi; }
template <int DQK> __device__ __forceinline__ int kswz(int row, int cb) {
    return row * (DQK * 2 + 16) + cb;
}
__device__ __forceinline__ int v_st(int k, int c) { const int kk = (k & ~0xC) | ((k & 4) << 1) | ((k & 8) >> 1); return ((kk >> 3) * 4 + (c >> 5)) * 512 + ((kk & 7) * 32 + (c & 31)) * 2; }
__device__ __forceinline__ int v_stn(int k, int c) { return ((k >> 3) * 4 + (c >> 5)) * 512 + ((k & 7) * 32 + (c & 31)) * 2; }
__device__ __forceinline__ int v_rd_base(int lane) { return ((lane & 3) << 3) | (((lane >> 2) & 3) << 6) | (((lane >> 4) & 1) << 5) | (((lane >> 5) & 1) << 8); }
constexpr int v_rd_off(int d0, int ks, int half) { return d0 * 512 + ks * 4096 + half * 2048; }
template <int OFF> __device__ __forceinline__ s16x4 tr_read(int vb) {
    s16x4 r; asm volatile("ds_read_b64_tr_b16 %0, %1 offset:%2" : "=&v"(r) : "v"(vb), "i"(OFF) : "memory"); return r;
}
#define PKLH(L, H) (bf16x8){L[0], L[1], L[2], L[3], H[0], H[1], H[2], H[3]}
template <int D0> __device__ __forceinline__ void pv_one(f32x16& od, int vb, bf16x8 pa0, bf16x8 pa1, bf16x8 pa2, bf16x8 pa3) {
    const s16x4 l0 = tr_read<v_rd_off(D0, 0, 0)>(vb), h0 = tr_read<v_rd_off(D0, 0, 1)>(vb), l1 = tr_read<v_rd_off(D0, 1, 0)>(vb), h1 = tr_read<v_rd_off(D0, 1, 1)>(vb);
    const s16x4 l2 = tr_read<v_rd_off(D0, 2, 0)>(vb), h2 = tr_read<v_rd_off(D0, 2, 1)>(vb), l3 = tr_read<v_rd_off(D0, 3, 0)>(vb), h3 = tr_read<v_rd_off(D0, 3, 1)>(vb);
    asm volatile("s_waitcnt lgkmcnt(0)" ::: "memory"); SBAR();
    od = __builtin_amdgcn_mfma_f32_32x32x16_bf16(pa0, PKLH(l0, h0), od, 0, 0, 0);
    od = __builtin_amdgcn_mfma_f32_32x32x16_bf16(pa1, PKLH(l1, h1), od, 0, 0, 0);
    od = __builtin_amdgcn_mfma_f32_32x32x16_bf16(pa2, PKLH(l2, h2), od, 0, 0, 0);
    od = __builtin_amdgcn_mfma_f32_32x32x16_bf16(pa3, PKLH(l3, h3), od, 0, 0, 0);
}
__device__ __forceinline__ void pv_d0(f32x16* o, int vb, bf16x8 pa0, bf16x8 pa1, bf16x8 pa2, bf16x8 pa3) {
    pv_one<0>(o[0], vb, pa0, pa1, pa2, pa3); pv_one<1>(o[1], vb, pa0, pa1, pa2, pa3); pv_one<2>(o[2], vb, pa0, pa1, pa2, pa3); pv_one<3>(o[3], vb, pa0, pa1, pa2, pa3);
}
template <int DQK> __device__ __forceinline__ void qkt(f32x16& p0, f32x16& p1, const char* Ks, const bf16x8* qr, int r32, int hi, const f32x16 init = f32x16{}) {
    constexpr int NS = DQK / 16;
    p0 = init; p1 = init;
    bf16x8 b0[NS], b1[NS];
#pragma unroll
    for (int d0 = 0; d0 < NS; ++d0) { const int cb = (d0 * 16 + hi * 8) * 2;
        b1[d0] = *reinterpret_cast<const bf16x8*>(Ks + kswz<DQK>(32 + r32, cb));
        b0[d0] = *reinterpret_cast<const bf16x8*>(Ks + kswz<DQK>(r32, cb)); }
#pragma unroll
    for (int d0 = 0; d0 < NS; ++d0) {
        p0 = __builtin_amdgcn_mfma_f32_32x32x16_bf16(b0[d0], qr[d0], p0, 0, 0, 0);
        p1 = __builtin_amdgcn_mfma_f32_32x32x16_bf16(b1[d0], qr[d0], p1, 0, 0, 0); }
#ifndef QKT_AHEAD
#define QKT_AHEAD 3
#endif
    __builtin_amdgcn_sched_group_barrier(0x100, 2 * QKT_AHEAD, 0);
#pragma unroll
    for (int d0 = 0; d0 < NS - QKT_AHEAD; ++d0) { __builtin_amdgcn_sched_group_barrier(0x008, 2, 0); __builtin_amdgcn_sched_group_barrier(0x100, 2, 0); }
    __builtin_amdgcn_sched_group_barrier(0x008, 2 * QKT_AHEAD, 0);
}
#define PK4(P, BASE, OUT) do { const unsigned a0_ = cvtpk(P[BASE + 0], P[BASE + 1]), a1_ = cvtpk(P[BASE + 2], P[BASE + 3]);   \
    const unsigned b0_ = cvtpk(P[BASE + 4], P[BASE + 5]), b1_ = cvtpk(P[BASE + 6], P[BASE + 7]);                              \
    auto r0_ = __builtin_amdgcn_permlane32_swap(a0_, b0_, false, false); auto r1_ = __builtin_amdgcn_permlane32_swap(a1_, b1_, false, false); \
    u32x4 w_ = {r0_[0], r1_[0], r0_[1], r1_[1]}; OUT = *reinterpret_cast<bf16x8*>(&w_); } while (0)

#define PK4N(P, BASE, OUT) do { u32x4 w_ = {cvtpk(P[BASE + 0], P[BASE + 1]), cvtpk(P[BASE + 2], P[BASE + 3]), cvtpk(P[BASE + 4], P[BASE + 5]), cvtpk(P[BASE + 6], P[BASE + 7])}; \
    OUT = *reinterpret_cast<bf16x8*>(&w_); } while (0)

template <int SC1000> struct SmC { };
constexpr float THR = 8.f;

__device__ __forceinline__ void partialSM(f32x16& p0, f32x16& p1, float& m_reg, float& mn, float& alpha, const float C, const float thr_raw) {
    float pmax = p0[0];
#pragma unroll
    for (int r = 1; r < 16; ++r) pmax = fmaxf(pmax, p0[r]);
#pragma unroll
    for (int r = 0; r < 16; ++r) pmax = fmaxf(pmax, p1[r]);
    { auto rr = __builtin_amdgcn_permlane32_swap(__float_as_uint(pmax), __float_as_uint(pmax), false, false);
      pmax = fmaxf(__uint_as_float(rr[0]), __uint_as_float(rr[1])); }
    if (__builtin_expect(__all(pmax - m_reg <= thr_raw), 1)) { mn = m_reg; alpha = 1.f; }
    else { mn = fmaxf(m_reg, pmax); alpha = __builtin_amdgcn_exp2f((m_reg - mn) * C); m_reg = mn; }
    const float mnC = -mn * C;
#pragma unroll
    for (int r = 0; r < 16; ++r) p0[r] = fmaf(p0[r], C, mnC);
#pragma unroll
    for (int r = 0; r < 16; ++r) p1[r] = fmaf(p1[r], C, mnC);
#pragma unroll
    for (int r = 0; r < 16; ++r) p0[r] = __builtin_amdgcn_exp2f(p0[r]);
}
__device__ __forceinline__ void finishSM(f32x16& p0, f32x16& p1, float alpha, float& l_reg, bf16x8& pa0, bf16x8& pa1, bf16x8& pa2, bf16x8& pa3) {
#pragma unroll
    for (int r = 0; r < 16; ++r) p1[r] = __builtin_amdgcn_exp2f(p1[r]);
    float ps = 0;
#pragma unroll
    for (int r = 0; r < 16; ++r) ps += p0[r];
#pragma unroll
    for (int r = 0; r < 16; ++r) ps += p1[r];
    { auto rr = __builtin_amdgcn_permlane32_swap(__float_as_uint(ps), __float_as_uint(ps), false, false);
      ps = __uint_as_float(rr[0]) + __uint_as_float(rr[1]); }
    l_reg = l_reg * alpha + ps;
    PK4N(p0, 0, pa0); PK4N(p0, 8, pa1); PK4N(p1, 0, pa2); PK4N(p1, 8, pa3);
}

constexpr int KVBLK = 64;
struct AttnArgs {
    const bf16_t* Q; int ldq;
    const bf16_t* K; int ldk;
    const bf16_t* KR; int ldkr;
    const bf16_t* V; int ldv;
    bf16_t* O; int ldo;
    int nt;
    int seg0_tiles, seg0_row, seg1_row;
    int qpos0;
    int masked;
    float sink_l2; int has_sink;
    float C;
};
#define GAS __attribute__((address_space(1)))
template <int DQK>
__device__ __forceinline__ void attn_body(const AttnArgs& a, char* lds) {
    constexpr int SHM_V = KVBLK * 128 * 2, SHM_K = KVBLK * (DQK * 2 + 16);
    const int tid = otid(), wid = tid >> 6, lane = tid & 63, r32 = lane & 31, hi = lane >> 5;
    char* V_lds = lds; char* K_lds = lds + 2 * SHM_V;
    float* ws = (float*)(lds + 2 * SHM_V + 2 * SHM_K) + wid * 64; float* li_l = ws; float* al_l = ws + 32;
    float m_reg = -1e30f, l_reg = 0; f32x16 o[4] = {}; bf16x8 qr[DQK / 16];
    const float C = a.C, thr_raw = THR * LOG2E / a.C;
    const bf16_t* Qw = a.Q + (long)(wid * 32 + r32) * a.ldq + hi * 8;
#pragma unroll
    for (int d0 = 0; d0 < DQK / 16; ++d0) qr[d0] = *reinterpret_cast<const bf16x8*>(Qw + d0 * 16);
    const int sr = tid >> 4, sc = (tid & 15) * 8, vst0 = v_stn(sr, sc), vst1 = v_stn(32 + sr, sc);
    const int kst0 = kswz<DQK>(sr, sc * 2), kst1 = kswz<DQK>(32 + sr, sc * 2);
    const int sr2 = tid >> 3, sc2 = (tid & 7) * 8, kst2 = (DQK == 192) ? kswz<DQK>(sr2, 256 + sc2 * 2) : 0;
    const int vb0 = (int)(uintptr_t)V_lds + v_rd_base(lane);
    bf16x8 vs0, vs1, ks0, ks1, ks2;
    __syncthreads();
#define TILE_ROW(j) ((j) < a.seg0_tiles ? a.seg0_row + 64 * (j) : ((a.masked && (unsigned)(a.qpos0 - 128 + 64 * ((j) - a.seg0_tiles)) >= (unsigned)SEQ) ? a.seg0_row : a.seg1_row + 64 * ((j) - a.seg0_tiles)))
    unsigned oks0 = (unsigned)(sr * a.ldk + sc) * 2u, oks1 = oks0 + (unsigned)(64 * a.ldk), oks2 = (DQK == 192) ? (unsigned)(sr2 * a.ldkr + sc2) * 2u : 0u;
#define SLOAD(j) do { const long kr_ = TILE_ROW(j); \
    const GAS char* kb_ = (const GAS char*)a.K + kr_ * (long)(2 * a.ldk); const GAS char* vb_ = (const GAS char*)a.V + kr_ * (long)(2 * a.ldk); const GAS char* rb_ = (const GAS char*)a.KR + kr_ * (long)(2 * a.ldkr); \
    asm volatile("" : "+s"(kb_), "+s"(vb_), "+s"(rb_)); asm volatile("" : "+v"(oks0), "+v"(oks1), "+v"(oks2)); \
    vs0 = *reinterpret_cast<const GAS bf16x8*>(vb_ + oks0); vs1 = *reinterpret_cast<const GAS bf16x8*>(vb_ + oks1); \
    ks0 = *reinterpret_cast<const GAS bf16x8*>(kb_ + oks0); ks1 = *reinterpret_cast<const GAS bf16x8*>(kb_ + oks1); \
    if (DQK == 192) ks2 = *reinterpret_cast<const GAS bf16x8*>(rb_ + oks2); } while (0)
#define SWRITE(b) do { if (DQK == 192) *(bf16x8*)(K_lds + (b) * SHM_K + kst2) = ks2; \
    *(bf16x8*)(K_lds + (b) * SHM_K + kst1) = ks1; *(bf16x8*)(K_lds + (b) * SHM_K + kst0) = ks0; \
    *(bf16x8*)(V_lds + (b) * SHM_V + vst1) = vs1; *(bf16x8*)(V_lds + (b) * SHM_V + vst0) = vs0; } while (0)
#define SWAIT() do { } while (0)
#define RESC(al) do { if (__any((al) < 1.f)) { if (hi == 0) al_l[r32] = (al); asm volatile("s_waitcnt lgkmcnt(0)" ::: "memory"); \
    _Pragma("unroll") for (int d = 0; d < 4; ++d) _Pragma("unroll") for (int r = 0; r < 16; ++r) o[d][r] *= al_l[crow(r, hi)]; } } while (0)
#define MASK(P0, P1, j) do { if (a.masked && (j) >= a.seg0_tiles) { const int kp0_ = a.qpos0 - 128 + 64 * ((j) - a.seg0_tiles), qp_ = a.qpos0 + wid * 32 + r32; \
    const bool tv_ = (unsigned)kp0_ < (unsigned)SEQ; \
    _Pragma("unroll") for (int r = 0; r < 16; ++r) { const int d0_ = kp0_ + crow(r, hi) - qp_, d1_ = d0_ + 32; \
        P0[r] = (tv_ && d0_ <= 128 && d0_ >= -128) ? P0[r] : -1e30f; P1[r] = (tv_ && d1_ <= 128 && d1_ >= -128) ? P1[r] : -1e30f; } } } while (0)
    f32x16 pA0, pA1; float mnA, alA; bf16x8 pa0, pa1, pa2, pa3; const int NT = a.nt;
    const int wu = __builtin_amdgcn_readfirstlane(wid);
    volatile int* vflag = (volatile int*)(lds + 2 * SHM_V + 2 * SHM_K + 8 * 256);
#define TILE_BODY(CLASSIC) { \
        const int b = j & 1; \
        if (j + 1 < NT) SLOAD(j + 1); \
        bool skip = false;        \
        if (a.masked && j >= a.seg0_tiles) { const int kp0_ = a.qpos0 - 128 + 64 * (j - a.seg0_tiles), q0_ = a.qpos0 + wu * 32; \
            skip = ((unsigned)kp0_ >= (unsigned)SEQ) || (kp0_ + 63 < q0_ - 128) || (kp0_ > q0_ + 31 + 128); } \
        if (!skip) { \
            if (CLASSIC) { \
                SBAR(); qkt<DQK>(pA0, pA1, K_lds + b * SHM_K, qr, r32, hi); MASK(pA0, pA1, j); \
                partialSM(pA0, pA1, m_reg, mnA, alA, C, thr_raw); \
                RESC(alA); \
                finishSM(pA0, pA1, alA, l_reg, pa0, pa1, pa2, pa3); \
            } else { \
                SBAR(); qkt<DQK>(pA0, pA1, K_lds + b * SHM_K, qr, r32, hi, minit); MASK(pA0, pA1, j);        \
                float ps_ = 0.f; \
                _Pragma("unroll") for (int r = 0; r < 16; ++r) pA0[r] = __builtin_amdgcn_exp2f(pA0[r]); \
                _Pragma("unroll") for (int r = 0; r < 16; ++r) pA1[r] = __builtin_amdgcn_exp2f(pA1[r]); \
                _Pragma("unroll") for (int r = 0; r < 16; ++r) ps_ += pA0[r]; \
                _Pragma("unroll") for (int r = 0; r < 16; ++r) ps_ += pA1[r]; \
                { auto rr = __builtin_amdgcn_permlane32_swap(__float_as_uint(ps_), __float_as_uint(ps_), false, false); ps_ = __uint_as_float(rr[0]) + __uint_as_float(rr[1]); } \
                badu = __builtin_elementwise_max(badu, __float_as_uint(ps_));        \
                l_reg += ps_; \
                PK4N(pA0, 0, pa0); PK4N(pA0, 8, pa1); PK4N(pA1, 0, pa2); PK4N(pA1, 8, pa3); \
            } \
            SBAR(); \
            if (j + 1 < NT) { SWAIT(); SWRITE(b ^ 1); }        \
            SBAR(); \
            pv_d0(o, vb0 + b * SHM_V, pa0, pa1, pa2, pa3); \
        } else if (j + 1 < NT) { SWAIT(); SWRITE(b ^ 1); } \
        __syncthreads(); }
    if (tid == 0) *vflag = 0;
    if (wu >= 4) __builtin_amdgcn_s_setprio(1);
#pragma nounroll
    for (int pass = 0; pass < 2; ++pass) {
        int bad = 0; unsigned badu = 0u;
        SLOAD(0); SWAIT(); SWRITE(0); __syncthreads();
        const int jc = pass ? NT : 1;
        f32x16 minit = f32x16{};
#pragma nounroll
        for (int j = 0; j < jc; ++j) TILE_BODY(1)
#pragma unroll
        for (int r = 0; r < 16; ++r) minit[r] = -m_reg * C;
#pragma nounroll
        for (int j = jc; j < NT; ++j) TILE_BODY(0)
        if (pass) break;
        bad = !__all(badu <= __float_as_uint(256.0f));
        if (bad && lane == 0) *vflag = 1;
        __syncthreads();
        if (*vflag == 0) break;
        __syncthreads();
        m_reg = -1e30f; l_reg = 0.f;
#pragma unroll
        for (int d = 0; d < 4; ++d) o[d] = f32x16{};
    }
#undef TILE_BODY
    __builtin_amdgcn_s_setprio(0);
    if (a.has_sink) l_reg += __builtin_amdgcn_exp2f(a.sink_l2 - m_reg * C);
    if (hi == 0) li_l[r32] = l_reg; asm volatile("s_waitcnt lgkmcnt(0)" ::: "memory");
    float rli[16];
#pragma unroll
    for (int r = 0; r < 16; ++r) rli[r] = __builtin_amdgcn_rcpf(li_l[crow(r, hi)]);
    __syncthreads();
    { unsigned short* stg = (unsigned short*)(lds + wid * 8704);
#pragma unroll
      for (int r = 0; r < 16; ++r) { const int orow = crow(r, hi);
#pragma unroll
          for (int d0 = 0; d0 < 4; ++d0) stg[orow * 136 + d0 * 32 + r32] = (unsigned short)(cvtpk(o[d0][r] * rli[r], 0.f) & 0xffffu); }
      asm volatile("s_waitcnt lgkmcnt(0)" ::: "memory");
      bf16_t* Ow = a.O + (long)(wid * 32) * a.ldo;
#pragma unroll
      for (int i = 0; i < 8; ++i) { const int q = lane + 64 * i, row = q >> 4, c8 = (q & 15) * 8;
          *(u32x4*)(Ow + (long)row * a.ldo + c8) = *(const u32x4*)(stg + row * 136 + c8); } }
#undef TILE_ROW
#undef SLOAD
#undef SWRITE
#undef SWAIT
#undef RESC
#undef MASK
}

__device__ __forceinline__ int ret_row0(int bb, int n) { return n == 32 ? NLAT + bb * CTXL : bb * SEQ + n * 256; }
__device__ __forceinline__ float log2_sigmoid(float x) { return -log1pf(__expf(-x)) * LOG2E; }

__device__ __forceinline__ void ret_kv_unit(const bf16_t* PROJ, float* KVS, int bb, int h, int n, float lgf2, float lgb2, char* lds) {
    const int tid = otid(), wid = tid >> 6, lane = tid & 63, r32 = lane & 31, hi = lane >> 5;
    const int dir = wid >> 2, ablk = wid & 3;
    const int sr = tid >> 4, sc = (tid & 15) * 8, vst0 = v_st(sr, sc), vst1 = v_st(32 + sr, sc);
    const long R0 = ret_row0(bb, n);
    const bf16_t* Kg = PROJ + R0 * INW + 512 + h * 128; const bf16_t* Vg = PROJ + R0 * INW + 1024 + h * 128;
    const int vbK = (int)(uintptr_t)lds + dir * 16384 + v_rd_base(lane) + ablk * 512;
    const int vbV = (int)(uintptr_t)lds + 32768 + v_rd_base(lane);
    f32x16 acc[4] = {};
    u32x4 kq[2]; bf16x8 vq[2];
#pragma unroll
    for (int i = 0; i < 2; ++i) { const int j = sr + 32 * i; kq[i] = *reinterpret_cast<const u32x4*>(Kg + (long)j * INW + sc); vq[i] = *reinterpret_cast<const bf16x8*>(Vg + (long)j * INW + sc); }
    for (int t = 0; t < 4; ++t) {
        __syncthreads();
#pragma unroll
        for (int i = 0; i < 2; ++i) {
            const int j = 64 * t + sr + 32 * i;
            const u32x4 kv = kq[i];
            const bf16x8 vv = vq[i];
            const float kf = __builtin_amdgcn_exp2f(lgf2 * (float)(255 - j)), kb = __builtin_amdgcn_exp2f(lgb2 * (float)j);
            u32x4 wf, wb;
#pragma unroll
            for (int e = 0; e < 4; ++e) { const float lo = bflo(kv[e]), hh = bfhi(kv[e]); wf[e] = cvtpk(lo * kf, hh * kf); wb[e] = cvtpk(lo * kb, hh * kb); }
            const int vo = i ? vst1 : vst0;
            *(u32x4*)(lds + vo) = wf; *(u32x4*)(lds + 16384 + vo) = wb; *(bf16x8*)(lds + 32768 + vo) = vv;
        }
        if (t < 3) {
#pragma unroll
            for (int i = 0; i < 2; ++i) { const int j = 64 * (t + 1) + sr + 32 * i; kq[i] = *reinterpret_cast<const u32x4*>(Kg + (long)j * INW + sc); vq[i] = *reinterpret_cast<const bf16x8*>(Vg + (long)j * INW + sc); }
        }
        __syncthreads();
#define RKV_STEP(KS) do { \
        const s16x4 al_ = tr_read<v_rd_off(0, KS, 0)>(vbK), ah_ = tr_read<v_rd_off(0, KS, 1)>(vbK); \
        const s16x4 l0_ = tr_read<v_rd_off(0, KS, 0)>(vbV), h0_ = tr_read<v_rd_off(0, KS, 1)>(vbV), l1_ = tr_read<v_rd_off(1, KS, 0)>(vbV), h1_ = tr_read<v_rd_off(1, KS, 1)>(vbV); \
        const s16x4 l2_ = tr_read<v_rd_off(2, KS, 0)>(vbV), h2_ = tr_read<v_rd_off(2, KS, 1)>(vbV), l3_ = tr_read<v_rd_off(3, KS, 0)>(vbV), h3_ = tr_read<v_rd_off(3, KS, 1)>(vbV); \
        asm volatile("s_waitcnt lgkmcnt(0)" ::: "memory"); SBAR(); \
        const bf16x8 af_ = PKLH(al_, ah_); \
        acc[0] = __builtin_amdgcn_mfma_f32_32x32x16_bf16(af_, PKLH(l0_, h0_), acc[0], 0, 0, 0); \
        acc[1] = __builtin_amdgcn_mfma_f32_32x32x16_bf16(af_, PKLH(l1_, h1_), acc[1], 0, 0, 0); \
        acc[2] = __builtin_amdgcn_mfma_f32_32x32x16_bf16(af_, PKLH(l2_, h2_), acc[2], 0, 0, 0); \
        acc[3] = __builtin_amdgcn_mfma_f32_32x32x16_bf16(af_, PKLH(l3_, h3_), acc[3], 0, 0, 0); } while (0)
        RKV_STEP(0); RKV_STEP(1); RKV_STEP(2); RKV_STEP(3);
#undef RKV_STEP
    }
    float* outp = KVS + ((((size_t)bb * 4 + h) * 2 + dir) * 33 + n) * 16384;
#pragma unroll
    for (int r = 0; r < 16; ++r) { const int dk = 32 * ablk + crow(r, hi);
#pragma unroll
        for (int d = 0; d < 4; ++d) outp[dk * 128 + 32 * d + r32] = acc[d][r]; }
}

__device__ __forceinline__ void ret_scan(const float* KVS, bf16_t* SIN, const float* dec_f, const float* dec_b, int gtid, int gthreads) {
    for (int it = gtid; it < NB * 4 * 2 * 4096; it += gthreads) {
        const int e4 = it & 4095, dir = (it >> 12) & 1, h = (it >> 13) & 3, bb = it >> 15;
        const float lg2 = log2_sigmoid(dir ? dec_b[h] : dec_f[h]); const float cd = __builtin_amdgcn_exp2f(lg2 * 256.0f);
        const size_t base = ((((size_t)bb * 4 + h) * 2 + dir) * 33) * 16384 + (size_t)e4 * 4;
        f32x4 s = *(const f32x4*)(KVS + base + (size_t)32 * 16384);
        *(u32x2*)(SIN + base + (size_t)32 * 16384) = (u32x2){0u, 0u};
        for (int nb = 0; nb < 4; ++nb) {
            f32x4 kv[8];
#pragma unroll
            for (int q = 0; q < 8; ++q) { const int n = dir ? 31 - (nb * 8 + q) : nb * 8 + q; kv[q] = *(const f32x4*)(KVS + base + (size_t)n * 16384); }
#pragma unroll
            for (int q = 0; q < 8; ++q) { const int n = dir ? 31 - (nb * 8 + q) : nb * 8 + q;
                st_bf16x4(SIN + base + (size_t)n * 16384, s); s = s * cd + kv[q]; }
        }
    }
}

__device__ __forceinline__ void ret_out_unit(const bf16_t* PROJ, const bf16_t* SIN, bf16_t* Y, int bb, int h, int n, float lgf2, float lgb2, char* lds) {
    const int tid = otid(), wid = tid >> 6, lane = tid & 63, r32 = lane & 31, hi = lane >> 5;
    const int sr = tid >> 4, sc = (tid & 15) * 8, vst0 = v_st(sr, sc), vst1 = v_st(32 + sr, sc);
    const int kst0 = kswz<128>(sr, sc * 2), kst1 = kswz<128>(32 + sr, sc * 2);
    const long R0 = ret_row0(bb, n);
    const bf16_t* Qg = PROJ + R0 * INW + h * 128; const bf16_t* Kg = Qg + 512; const bf16_t* Vg = Qg + 1024; const bf16_t* Gg = Qg + 1536;
    char* K_lds = lds; char* V_lds = lds + 17408;
    const int vb0 = (int)(uintptr_t)V_lds + v_rd_base(lane);
    bf16x8 qr[8];
    const bf16_t* Qw = Qg + (long)(wid * 32 + r32) * INW + hi * 8;
#pragma unroll
    for (int d0 = 0; d0 < 8; ++d0) qr[d0] = *reinterpret_cast<const bf16x8*>(Qw + d0 * 16);
    f32x16 o[4] = {};
    const int iq = wid * 32 + r32;
    const bf16_t* S0 = SIN + ((((size_t)bb * 4 + h) * 2) * 33 + n) * 16384;
    bf16x8 kq[2], vq[2];
#pragma unroll
    for (int i = 0; i < 2; ++i) { const int j = sr + 32 * i; kq[i] = *reinterpret_cast<const bf16x8*>(Kg + (long)j * INW + sc); vq[i] = *reinterpret_cast<const bf16x8*>(Vg + (long)j * INW + sc); }
    for (int t = 0; t < 4; ++t) {
        __syncthreads();
#pragma unroll
        for (int i = 0; i < 2; ++i) { *(bf16x8*)(K_lds + (i ? kst1 : kst0)) = kq[i]; *(bf16x8*)(V_lds + (i ? vst1 : vst0)) = vq[i]; }
        if (t < 3) {
#pragma unroll
            for (int i = 0; i < 2; ++i) { const int j = 64 * (t + 1) + sr + 32 * i; kq[i] = *reinterpret_cast<const bf16x8*>(Kg + (long)j * INW + sc); vq[i] = *reinterpret_cast<const bf16x8*>(Vg + (long)j * INW + sc); }
        } else if (n != 32) {
#pragma unroll
            for (int i = 0; i < 2; ++i) vq[i] = *reinterpret_cast<const bf16x8*>(S0 + (sr + 32 * i) * 128 + sc);
        }
        __syncthreads();
        f32x16 p0, p1; qkt<128>(p0, p1, K_lds, qr, r32, hi);
#pragma unroll
        for (int r = 0; r < 16; ++r) {
            const int d0 = iq - (64 * t + crow(r, hi)), d1 = d0 - 32;
            const float m0 = d0 > 0 ? __builtin_amdgcn_exp2f(lgf2 * (float)d0) : (d0 < 0 ? __builtin_amdgcn_exp2f(lgb2 * (float)(-d0)) : 2.0f);
            const float m1 = d1 > 0 ? __builtin_amdgcn_exp2f(lgf2 * (float)d1) : (d1 < 0 ? __builtin_amdgcn_exp2f(lgb2 * (float)(-d1)) : 2.0f);
            p0[r] *= m0; p1[r] *= m1;
        }
        bf16x8 pa0, pa1, pa2, pa3; PK4(p0, 0, pa0); PK4(p0, 8, pa1); PK4(p1, 0, pa2); PK4(p1, 8, pa3);
        pv_d0(o, vb0, pa0, pa1, pa2, pa3);
    }
    if (n != 32) {
#pragma unroll
        for (int s4 = 0; s4 < 4; ++s4) {
            const int dir = s4 >> 1, ts = s4 & 1;
            const float qd = dir ? __builtin_amdgcn_exp2f(lgb2 * (float)(256 - iq)) : __builtin_amdgcn_exp2f(lgf2 * (float)(iq + 1));
            __syncthreads();
#pragma unroll
            for (int i = 0; i < 2; ++i) *(bf16x8*)(V_lds + (i ? vst1 : vst0)) = vq[i];
            if (s4 < 3) { const int d2 = (s4 + 1) >> 1, t2 = (s4 + 1) & 1; const bf16_t* Sn = S0 + (size_t)d2 * 33 * 16384;
#pragma unroll
                for (int i = 0; i < 2; ++i) vq[i] = *reinterpret_cast<const bf16x8*>(Sn + (64 * t2 + sr + 32 * i) * 128 + sc); }
            bf16x8 qs[4];
#pragma unroll
            for (int k = 0; k < 4; ++k) { const u32x4 w = *reinterpret_cast<const u32x4*>(&qr[4 * ts + k]); u32x4 x;
#pragma unroll
                for (int e = 0; e < 4; ++e) x[e] = cvtpk(bflo(w[e]) * qd, bfhi(w[e]) * qd);
                qs[k] = *reinterpret_cast<bf16x8*>(&x); }
            __syncthreads();
            pv_d0(o, vb0, qs[0], qs[1], qs[2], qs[3]);
        }
    }
    __syncthreads();
    { unsigned short* stg = (unsigned short*)(lds + wid * 8704);
#pragma unroll
      for (int r = 0; r < 16; ++r) {
          float ss = (o[0][r] * o[0][r] + o[1][r] * o[1][r]) + (o[2][r] * o[2][r] + o[3][r] * o[3][r]);
          ss += __shfl_xor(ss, 1); ss += __shfl_xor(ss, 2); ss += __shfl_xor(ss, 4); ss += __shfl_xor(ss, 8); ss += __shfl_xor(ss, 16);
          const float rn = 1.0f / sqrtf(ss * (1.0f / 128.0f) + RMS_EPS);
#pragma unroll
          for (int d = 0; d < 4; ++d) stg[crow(r, hi) * 136 + 32 * d + r32] = (unsigned short)(cvtpk(o[d][r] * rn, 0.f) & 0xffffu);
      }
      asm volatile("s_waitcnt lgkmcnt(0)" ::: "memory");
#pragma unroll
      for (int i = 0; i < 8; ++i) { const int q = lane + 64 * i, row = q >> 4, c8 = (q & 15) * 8;
          const u32x4 gw = *(const u32x4*)(Gg + (long)(wid * 32 + row) * INW + c8);
          const u32x4 xw = *(const u32x4*)(stg + row * 136 + c8);
          u32x4 ow;
#pragma unroll
          for (int e = 0; e < 4; ++e) ow[e] = cvtpk(silu_f(bflo(gw[e])) * bflo(xw[e]), silu_f(bfhi(gw[e])) * bfhi(xw[e]));
          *(u32x4*)(Y + (R0 + wid * 32 + row) * D + h * 128 + c8) = ow; } }
}

struct Params {
    const float* in[23];
    float* out; unsigned char* ws;
    int ph_lo, ph_hi, bar_region, pad;
};
enum { I_X = 0, I_C, I_CTX, I_CCTX, I_ADAW, I_ADAB, I_WIN, I_DECF, I_DECB, I_SINK, I_QNORM, I_WUQ, I_KVNORM, I_WUKV, I_WO, I_LN1G, I_LN1B, I_WUP, I_CONVW, I_CONVB, I_WDN, I_LN2G, I_LN2B };

__device__ __forceinline__ int win_src_col(int p) {
    if (p >= INW) return -1;
    if (p >= 4096) return p;
    const int pn = p >> 8;
    if (pn < 4 || (pn >= 8 && pn < 12)) {
        const int bj = (p >> 7) & 1, x = p & 127, wc = x >> 5, nn = (x >> 4) & 1, q = x & 15;
        return (p & ~255) + 128 * (wc >> 1) + 64 * (wc & 1) + 32 * bj + 8 * (q >> 2) + 4 * nn + (q & 3);
    }
    return (p & ~31) + 8 * ((p & 15) >> 2) + 4 * ((p >> 4) & 1) + (p & 3);
}
__device__ __forceinline__ int wup_src_col(int p) {
    const int pn = p >> 8, bj = (p >> 7) & 1, x = p & 127, wc = x >> 5, nn = (x >> 4) & 1, q = x & 15, fq = q >> 2, j = q & 3;
    const int f = 128 * pn + 32 * wc + 8 * fq + 4 * nn + j;
    return bj ? DFF + f : f;
}
__device__ __forceinline__ void cvt_item(const float* W, int K, int N, bf16_t* Bt, int mode, const float* kscale, int item, int nkt, float* scr, int lane) {
    const int pt = item / nkt, kt = item - pt * nkt, p0 = pt * 32, k0 = kt * 64;
    const int p = p0 + (lane & 31);
    const int src = mode == 1 ? win_src_col(p) : (mode == 2 ? wup_src_col(p) : (mode == 3 ? ((p & ~31) + 8 * ((p & 15) >> 2) + 4 * ((p >> 4) & 1) + (p & 3)) : (p < N ? p : -1)));
    const float* wp = W + (size_t)(k0 + (lane >> 5)) * N + (src >= 0 ? src : 0);
    float v[32];
#pragma unroll
    for (int i = 0; i < 32; ++i) v[i] = src >= 0 ? wp[(size_t)(2 * i) * N] : 0.f;
    if (kscale) {
#pragma unroll
        for (int i = 0; i < 32; ++i) v[i] *= kscale[k0 + 2 * i + (lane >> 5)];
    }
#pragma unroll
    for (int i = 0; i < 32; ++i) scr[(2 * i + (lane >> 5)) * 33 + (lane & 31)] = v[i];
    asm volatile("s_waitcnt lgkmcnt(0)" ::: "memory");
    const int c = lane & 7;
#pragma unroll
    for (int j = 0; j < 4; ++j) { const int n = (lane >> 3) + 8 * j; const float* s = scr + (8 * c) * 33 + n;
        u32x4 o; o[0] = cvtpk(s[0 * 33], s[1 * 33]); o[1] = cvtpk(s[2 * 33], s[3 * 33]); o[2] = cvtpk(s[4 * 33], s[5 * 33]); o[3] = cvtpk(s[6 * 33], s[7 * 33]);
        *(u32x4*)(Bt + (size_t)(p0 + n) * K + k0 + 8 * c) = o; }
    asm volatile("s_waitcnt lgkmcnt(0)" ::: "memory");
}

__device__ __forceinline__ void ln_phase(const bf16_t* X, const bf16_t* MIX, float* dstf, bf16_t* dsth, bf16_t* H, const float* g, const float* b,
                                         const float* gate, const float* sc, const float* sh, int nrows, int bid, int G, char* lds) {
    const int tid = otid(), lane = tid & 63, wid = __builtin_amdgcn_readfirstlane(tid >> 6);
    float* L = (float*)lds;
    __syncthreads();
    for (int i = tid; i < D; i += 512) { L[i] = g[i]; L[D + i] = b[i]; }
    const int ngroups = nrows >> 3, grp0 = (int)(((long)bid * ngroups) / G), nsteps = (int)(((long)(bid + 1) * ngroups) / G) - grp0; int s_cur = -1;
#define LN_ROW(k) ((grp0 + (k)) * 8 + wid)
#define LN_LOAD(XA, MA, ROW) do { const bf16_t* xr_ = X + (size_t)(ROW) * D + 4 * lane; const bf16_t* mr_ = MIX + (size_t)(ROW) * D + 4 * lane; \
    _Pragma("unroll") for (int j = 0; j < 8; ++j) { XA[j] = *(const u32x2*)(xr_ + 256 * j); MA[j] = *(const u32x2*)(mr_ + 256 * j); } } while (0)
#define LN_SVEC(k) do { const int s_ = mod_index((grp0 + (k)) * 8); \
    if (s_ != s_cur) { __syncthreads(); \
        { float gv_[4], sv_[4], hv_[4]; \
          _Pragma("unroll") for (int q_ = 0; q_ < 4; ++q_) { const int i = tid + 512 * q_; gv_[q_] = gate[(size_t)s_ * MODW + i]; sv_[q_] = H ? sc[(size_t)s_ * MODW + i] : 0.f; hv_[q_] = H ? sh[(size_t)s_ * MODW + i] : 0.f; } \
          _Pragma("unroll") for (int q_ = 0; q_ < 4; ++q_) { const int i = tid + 512 * q_; L[2 * D + i] = gv_[q_] + 1.0f; L[3 * D + i] = sv_[q_] + 1.0f; L[4 * D + i] = hv_[q_]; } } \
        s_cur = s_; __syncthreads(); } } while (0)
#define LN_COMP(XA, MA, ROW) do { \
    f32x4 v[8]; float sum = 0.f; \
    _Pragma("unroll") for (int j = 0; j < 8; ++j) { const int c = 4 * lane + 256 * j; \
        const f32x4 mv = (f32x4){bflo(MA[j][0]), bfhi(MA[j][0]), bflo(MA[j][1]), bfhi(MA[j][1])}; \
        v[j] = cvt_f16x4(XA[j]) * ALPHA + *(const f32x4*)(L + 2 * D + c) * mv; sum += (v[j][0] + v[j][1]) + (v[j][2] + v[j][3]); } \
    const float mean = wave_sum(sum) * (1.0f / D); float s2 = 0.f; \
    _Pragma("unroll") for (int j = 0; j < 8; ++j) { v[j] = v[j] - mean; s2 += (v[j][0] * v[j][0] + v[j][1] * v[j][1]) + (v[j][2] * v[j][2] + v[j][3] * v[j][3]); } \
    const float rstd = 1.0f / sqrtf(wave_sum(s2) * (1.0f / D) + LN_EPS); \
    _Pragma("unroll") for (int j = 0; j < 8; ++j) { const int c = 4 * lane + 256 * j; \
        const f32x4 y = v[j] * rstd * *(const f32x4*)(L + c) + *(const f32x4*)(L + D + c); \
        if (dstf) *(f32x4*)(dstf + (size_t)(ROW) * D + c) = y; else st_f16x4(dsth + (size_t)(ROW) * D + c, y); \
        if (H) st_bf16x4(H + (size_t)(ROW) * D + c, y * *(const f32x4*)(L + 3 * D + c) + *(const f32x4*)(L + 4 * D + c)); } } while (0)
    u32x2 xa[8], xb[8], ma[8], mb[8];
    if (LN_ROW(0) < nrows) LN_LOAD(xa, ma, LN_ROW(0));
    for (int k = 0; k < nsteps; k += 2) {
        LN_SVEC(k);
        if (k + 1 < nsteps && LN_ROW(k + 1) < nrows) LN_LOAD(xb, mb, LN_ROW(k + 1));
        SBAR();
        if (LN_ROW(k) < nrows) LN_COMP(xa, ma, LN_ROW(k));
        if (k + 1 < nsteps) {
            LN_SVEC(k + 1);
            if (k + 2 < nsteps && LN_ROW(k + 2) < nrows) LN_LOAD(xa, ma, LN_ROW(k + 2));
            SBAR();
            if (LN_ROW(k + 1) < nrows) LN_COMP(xb, mb, LN_ROW(k + 1));
        }
    }
#undef LN_ROW
#undef LN_LOAD
#undef LN_SVEC
#undef LN_COMP
}

__global__ void __launch_bounds__(512, 2) fwd_kernel(Params p) {
    extern __shared__ __attribute__((aligned(16))) unsigned char lds_raw[];
    LAS unsigned char* ldsl = (LAS unsigned char*)lds_raw;
    char* lds = (char*)lds_raw;
    if (threadIdx.x < 4) ((volatile LAS unsigned*)(ldsl + 131072))[threadIdx.x] = 0u;
    __syncthreads();
    XcdBarrier bar; bar.bar = (unsigned*)(p.ws + WS_CTL) + (size_t)p.bar_region * 4096; bar.x = 0; bar.st = (volatile LAS unsigned*)(ldsl + 131072);
    if (p.ph_hi - p.ph_lo > 1) bar = xcd_barrier_post(bar.bar, (volatile LAS unsigned*)(ldsl + 131072));

    int g = 0, lcur = 0;
#ifndef DUPMASK
#define DUPMASK 0
#endif
#define NREP(k) (1 + ((DUPMASK >> (k)) & 1))
#ifndef PHMASK
#define PHMASK 0xffff
#endif
#ifndef SUBMASK
#define SUBMASK 0xffff
#endif
#define SUB(k) ((SUBMASK >> (k)) & 1)
#define PH_BEGIN(k) if (((PHMASK >> (k)) & 1) && g >= p.ph_lo && g < p.ph_hi) { \
    int bid = blockIdx.x, G = gridDim.x; asm volatile("" : "+s"(bid), "+s"(G)); const int NGW = G * 8, gthreads = G * 512; (void)NGW; (void)gthreads; \
    const int tid = otid(), lane = tid & 63, wid = __builtin_amdgcn_readfirstlane(tid >> 6); const int gw = bid * 8 + wid, gtid = bid * 512 + tid; (void)lane; (void)gw; (void)gtid; \
    size_t wsoff_ = 0; asm volatile("" : "+s"(wsoff_)); unsigned char* ws = p.ws + wsoff_; \
    float* MOD = (float*)(ws + WS_MOD); float* ROPE = (float*)(ws + WS_ROPE); float* RS = (float*)(ws + WS_RS); float* SM = (float*)(ws + WS_SM); (void)SM; \
    float* thc = ROPE, *ths = ROPE + 4096, *tmc = ROPE + 8192, *tms = ROPE + 8192 + 2048; \
    bf16_t* WB = (bf16_t*)(ws + WS_W); float* X = (float*)(ws + WS_X); bf16_t* XH = (bf16_t*)(ws + WS_X); (void)XH; bf16_t* H = (bf16_t*)(ws + WS_H); bf16_t* Y = (bf16_t*)(ws + WS_Y); \
    bf16_t* PROJ = (bf16_t*)(ws + WS_PROJ); bf16_t* QUP = (bf16_t*)(ws + WS_QUP); bf16_t* KVUP = (bf16_t*)(ws + WS_KVUP); \
    float* KVS = (float*)(ws + WS_KVS); bf16_t* SIN = (bf16_t*)(ws + WS_SIN); bf16_t* ACT0 = (bf16_t*)(ws + WS_ACT0); bf16_t* ACT1 = (bf16_t*)(ws + WS_ACT1); float* SB = (float*)(ws + WS_SB); bf16_t* MIX = (bf16_t*)(ws + WS_MIX); (void)MIX; \
    const bf16_t* wl = WB + (size_t)lcur * W_LAYER; const float* modl = MOD + (size_t)lcur * 5 * MODW; \
    (void)RS; (void)thc; (void)ths; (void)tmc; (void)tms; (void)X; (void)H; (void)Y; (void)PROJ; (void)QUP; (void)KVUP; (void)KVS; (void)SIN; (void)ACT0; (void)ACT1; (void)SB; (void)wl; (void)modl;
#define PH_END   if (g + 1 < p.ph_hi) xcd_barrier(bar); } ++g;

    PH_BEGIN(0)
    {
        for (int i = gtid; i < SM_END; i += gthreads) {
            float v = 0.f;
            if (i < SM_DECB) v = p.in[I_DECF][i];
            else if (i < SM_SINK) v = p.in[I_DECB][i - SM_DECB];
            else if (i < SM_LN1G) v = (i - SM_SINK) < DEPTH * 6 ? p.in[I_SINK][i - SM_SINK] : 0.f;
            else if (i < SM_LN1B) v = p.in[I_LN1G][i - SM_LN1G];
            else if (i < SM_LN2G) v = p.in[I_LN1B][i - SM_LN1B];
            else if (i < SM_LN2B) v = p.in[I_LN2G][i - SM_LN2G];
            else if (i < SM_CONVW) v = p.in[I_LN2B][i - SM_LN2B];
            else if (i < SM_CONVB) v = p.in[I_CONVW][i - SM_CONVW];
            else v = p.in[I_CONVB][i - SM_CONVB];
            SM[i] = v;
        }
        for (int i = gtid; i < 4096 + 2048; i += gthreads) {
            if (i < 4096) { const int pos = i >> 5, f = i & 31; const float inv = exp2f(-(float)f * (13.287712379549449f / 32.0f)); const float ang = (float)pos * inv; thc[i] = cosf(ang); ths[i] = sinf(ang); }
            else { const int q = i - 4096, pos = q >> 4, f = q & 15; const float inv = exp2f(-(float)f * (13.287712379549449f / 16.0f)); const float ang = (float)pos * inv; tmc[q] = cosf(ang); tms[q] = sinf(ang); }
        }
        {
            float* scs = (float*)lds;
            float* red = (float*)(lds + 5 * 2048 * 4);
            for (int i = tid; i < 5 * 2048; i += 512) { const int s = i >> 11, k = i & 2047; const float cv = s < 4 ? p.in[I_C][s * D + k] : p.in[I_CCTX][k]; scs[i] = silu_f(cv); }
            __syncthreads();
            for (int u = bid; u < DEPTH * (MODW / 64); u += G) {
                const int l = u / (MODW / 64), j = (u % (MODW / 64)) * 64 + lane;
                const float* Wp = p.in[I_ADAW] + (size_t)l * D * MODW + j;
                float a0 = 0.f, a1 = 0.f, a2 = 0.f, a3 = 0.f, a4 = 0.f;
#pragma unroll 16
                for (int kk = 0; kk < 256; ++kk) { const int k = wid * 256 + kk; const float w = Wp[(size_t)k * MODW];
                    a0 += scs[k] * w; a1 += scs[2048 + k] * w; a2 += scs[4096 + k] * w; a3 += scs[6144 + k] * w; a4 += scs[8192 + k] * w; }
                red[(wid * 5 + 0) * 64 + lane] = a0; red[(wid * 5 + 1) * 64 + lane] = a1; red[(wid * 5 + 2) * 64 + lane] = a2; red[(wid * 5 + 3) * 64 + lane] = a3; red[(wid * 5 + 4) * 64 + lane] = a4;
                __syncthreads();
                if (wid < 5) { float sum = 0.f;
#pragma unroll
                    for (int w8 = 0; w8 < 8; ++w8) sum += red[(w8 * 5 + wid) * 64 + lane];
                    MOD[((size_t)l * 5 + wid) * MODW + j] = sum + p.in[I_ADAB][(size_t)l * MODW + j]; }
                __syncthreads();
            }
        }
        {
            __syncthreads();
            float* scr = (float*)(lds + wid * 8448);
            constexpr int T_IN = (INWP / 32) * (D / 64), T_UQ = (QUPWP / 32) * (512 / 64), T_UKV = (KVUPW / 32) * (256 / 64), T_O = (D / 32) * (D / 64), T_UP = (DFF2 / 32) * (D / 64), T_DN = (D / 32) * (DFF / 64);
            constexpr int T_L = T_IN + T_UQ + T_UKV + T_O + T_UP + T_DN;
            for (int u = gw; u < DEPTH * T_L; u += NGW) {
                const int l = u / T_L; int r = u % T_L; bf16_t* wlp = WB + (size_t)l * W_LAYER;
                const float* Wsrc; const float* ksc = nullptr; bf16_t* dst; int Kd, Nd, mode;
                if (r < T_IN) { Wsrc = p.in[I_WIN] + (size_t)l * D * INW; Kd = D; Nd = INW; dst = wlp + W_IN; mode = 1; }
                else if ((r -= T_IN) < T_UQ) { Wsrc = p.in[I_WUQ] + (size_t)l * 512 * QUPW; Kd = 512; Nd = QUPW; dst = wlp + W_UQ; mode = 0; ksc = p.in[I_QNORM] + l * 512; }
                else if ((r -= T_UQ) < T_UKV) { Wsrc = p.in[I_WUKV] + (size_t)l * 256 * KVUPW; Kd = 256; Nd = KVUPW; dst = wlp + W_UKV; mode = 3; ksc = p.in[I_KVNORM] + l * 256; }
                else if ((r -= T_UKV) < T_O) { Wsrc = p.in[I_WO] + (size_t)l * D * D; Kd = D; Nd = D; dst = wlp + W_O; mode = 3; }
                else if ((r -= T_O) < T_UP) { Wsrc = p.in[I_WUP] + (size_t)l * D * DFF2; Kd = D; Nd = DFF2; dst = wlp + W_UP; mode = 2; }
                else { r -= T_UP; Wsrc = p.in[I_WDN] + (size_t)l * DFF * D; Kd = DFF; Nd = D; dst = wlp + W_DN; mode = 3; }
                cvt_item(Wsrc, Kd, Nd, dst, mode, ksc, r, Kd / 64, scr, lane);
            }
        }
    }
    PH_END

    PH_BEGIN(1)
    {
        f32x4 va[8], vb[8];
#define G1_SRC(ROW) ((ROW) < NLAT ? p.in[I_X] + (size_t)(ROW) * D : p.in[I_CTX] + (size_t)((ROW) - NLAT) * D)
#define G1_LOAD(VA, ROW) do { const float* s_ = G1_SRC(ROW) + 4 * lane; _Pragma("unroll") for (int j = 0; j < 8; ++j) VA[j] = *(const f32x4*)(s_ + 256 * j); } while (0)
#define G1_STORE(VA, ROW) do { const float* mp_ = MOD + (size_t)mod_index(ROW) * MODW; \
        _Pragma("unroll") for (int j = 0; j < 8; ++j) { const int c = 4 * lane + 256 * j; \
            st_f16x4(XH + (size_t)(ROW) * D + c, VA[j]); \
            st_bf16x4(H + (size_t)(ROW) * D + c, VA[j] * (*(const f32x4*)(mp_ + D + c) + 1.0f) + *(const f32x4*)(mp_ + c)); } } while (0)
        int row = gw;
        if (row < NROWS) G1_LOAD(va, row);
        for (; row < NROWS; row += 2 * NGW) {
            if (row + NGW < NROWS) G1_LOAD(vb, row + NGW);
            SBAR();
            G1_STORE(va, row);
            if (row + NGW < NROWS) {
                if (row + 2 * NGW < NROWS) G1_LOAD(va, row + 2 * NGW);
                SBAR();
                G1_STORE(vb, row + NGW);
            }
        }
#undef G1_SRC
#undef G1_LOAD
#undef G1_STORE
    }
    PH_END

    for (int l = 0; l < DEPTH; ++l) {
        const bool last = (l == DEPTH - 1);
        const int nMfull = last ? 128 : 132;
        lcur = l;

        PH_BEGIN(2)
        for (int rep_ = 0; rep_ < NREP(0); ++rep_) { pg8::Gemm gm{H, wl + W_IN, D, D}; pg8::TileOrder S; S.init(132, INWP / 256, G, bid, -1);
          pg8::EpiProj E{PROJ, RS, thc, ths, tmc, tms};
          pg8::gemm_phase<pg8::EpiProj, pg8::TileOrder>(ldsl, gm, S, E); }
        PH_END

        PH_BEGIN(3)
        if (SUB(0)) for (int rep_ = 0; rep_ < NREP(1); ++rep_) { pg8::Gemm gm{PROJ + 3328, wl + W_UQ, INW, 512}; pg8::TileOrder S; S.init(132, QUPWP / 256, G, bid, -1);
          pg8::EpiQup E{QUP, RS, tmc, tms};
          pg8::gemm_phase<pg8::EpiQup, pg8::TileOrder>(ldsl, gm, S, E); }
        if (SUB(1)) for (int rep_ = 0; rep_ < NREP(2); ++rep_) { pg8::Gemm gm{PROJ + 3840, wl + W_UKV, INW, 256}; pg8::TileOrder S; S.init(132, KVUPW / 256, G, (G == 256) ? ((bid + 104) & 255) : bid, -1);
          pg8::EpiKvup E{KVUP, RS};
          pg8::gemm_phase<pg8::EpiKvup, pg8::TileOrder>(ldsl, gm, S, E); }
        if (SUB(2)) for (int rep_ = 0; rep_ < NREP(3); ++rep_) for (int u = (G == 256) ? ((bid + 80) & 255) : bid; u < NB * 4 * 33; u += G) {
            const int n = u % 33, h = (u / 33) & 3, bb = u / 132;
            const float lgf2 = log2_sigmoid(SM[SM_DECF + l * 4 + h]), lgb2 = log2_sigmoid(SM[SM_DECB + l * 4 + h]);
            ret_kv_unit(PROJ, KVS, bb, h, n, lgf2, lgb2, lds);
        }
        PH_END

        PH_BEGIN(4)
        if (SUB(3)) for (int rep_ = 0; rep_ < NREP(4); ++rep_) ret_scan(KVS, SIN, SM + SM_DECF + l * 4, SM + SM_DECB + l * 4, gtid, gthreads);
        if (SUB(4)) for (int rep_ = 0; rep_ < NREP(5); ++rep_) {
            const int nun = last ? 768 : 792;
            for (int u = bid; u < nun; u += G) {
                AttnArgs a;
                int bb, h, qrow;
                if (u < 768) { const int rnd = u / G, w_ = u % G; const int bh = (G == 256) ? (rnd * 8 + (w_ & 7)) : (u >> 5); const int qb = (G == 256) ? (w_ >> 3) : (u & 31); h = bh % 6; bb = bh / 6; qrow = bb * SEQ + qb * 256; a.nt = 132; a.seg0_tiles = 128; a.seg0_row = bb * SEQ; a.seg1_row = NLAT + bb * CTXL; }
                else { const int v = u - 768; h = v % 6; bb = v / 6; qrow = NLAT + bb * CTXL; a.nt = 4; a.seg0_tiles = 4; a.seg0_row = NLAT + bb * CTXL; a.seg1_row = a.seg0_row; }
                a.Q = QUP + (size_t)qrow * QUPW + h * 192; a.ldq = QUPW;
                a.K = KVUP + h * 256; a.ldk = KVUPW; a.KR = PROJ + 4096; a.ldkr = INW; a.V = KVUP + h * 256 + 128; a.ldv = KVUPW;
                a.O = Y + (size_t)qrow * D + 1280 + h * 128; a.ldo = D;
                a.qpos0 = 0; a.masked = 0; a.sink_l2 = 0.f; a.has_sink = 0; a.C = 1.0f;
                attn_body<192>(a, lds);
            }
        }
        if (SUB(5)) for (int rep_ = 0; rep_ < NREP(6); ++rep_) {
            const int nun = last ? 768 : 792;
            for (int u = bid; u < nun; u += G) {
                AttnArgs a;
                int bb, h, qrow;
                if (u < 768) { const int rnd = u / G, w_ = u % G; const int bh = (G == 256) ? (rnd * 8 + (w_ & 7)) : (u >> 5); const int qb = (G == 256) ? (w_ >> 3) : (u & 31); h = bh % 6; bb = bh / 6; qrow = bb * SEQ + qb * 256; a.nt = 12; a.seg0_tiles = 4; a.seg0_row = NLAT + bb * CTXL; a.seg1_row = bb * SEQ + qb * 256 - 128; a.qpos0 = qb * 256; a.masked = 1; }
                else { const int v = u - 768; h = v % 6; bb = v / 6; qrow = NLAT + bb * CTXL; a.nt = 4; a.seg0_tiles = 4; a.seg0_row = NLAT + bb * CTXL; a.seg1_row = a.seg0_row; a.qpos0 = 0; a.masked = 0; }
                const int kvh = h / 3;
                a.Q = PROJ + (size_t)qrow * INW + 2048 + h * 128; a.ldq = INW;
                a.K = PROJ + 2816 + kvh * 128; a.ldk = INW; a.KR = a.K; a.ldkr = INW; a.V = PROJ + 3072 + kvh * 128; a.ldv = INW;
                a.O = Y + (size_t)qrow * D + 512 + h * 128; a.ldo = D;
                a.sink_l2 = SM[SM_SINK + l * 6 + h] * LOG2E; a.has_sink = 1; a.C = 1.0f;
                attn_body<128>(a, lds);
            }
        }
        PH_END

        PH_BEGIN(5)
        for (int rep_ = 0; rep_ < NREP(7); ++rep_) for (int u = bid; u < NB * 4 * 33; u += G) {
            const int n = u % 33, h = (u / 33) & 3, bb = u / 132;
            if (last && n == 32) continue;
            const float lgf2 = log2_sigmoid(SM[SM_DECF + l * 4 + h]), lgb2 = log2_sigmoid(SM[SM_DECB + l * 4 + h]);
            ret_out_unit(PROJ, SIN, Y, bb, h, n, lgf2, lgb2, lds);
        }
        PH_END

        PH_BEGIN(6)
        for (int rep_ = 0; rep_ < NREP(10); ++rep_) { pg8::Gemm gm{Y, wl + W_O, D, D}; pg8::TileOrder S; S.init(nMfull, D / 256, G, bid, -1);
          pg8::EpiMix E{MIX, -1, rep_ + 1 < NREP(10)};
          pg8::gemm_phase<pg8::EpiMix, pg8::TileOrder>(ldsl, gm, S, E); }
        PH_END

        PH_BEGIN(7)
        ln_phase(XH, MIX, (float*)nullptr, XH, H, SM + SM_LN1G + l * D, SM + SM_LN1B + l * D, modl + 2 * D, modl + 4 * D, modl + 3 * D, last ? NLAT : NROWS, bid, G, lds);
        PH_END

#define FFN_UP(cc, nMc, skn, ski) for (int rep_ = 0; rep_ < NREP(8); ++rep_) { pg8::Gemm gm{H, wl + W_UP, D, D}; pg8::TileOrder S; S.init(nMc, DFF2 / 256, G, bid, cc, skn, ski); \
              pg8::EpiUpConv E{cc ? ACT1 : ACT0, SB, SM + SM_CONVW + (size_t)l * 3 * DFF, SM + SM_CONVB + (size_t)l * DFF, cc}; pg8::gemm_phase<pg8::EpiUpConv, pg8::TileOrder>(ldsl, gm, S, E); }
#define FFN_DOWN(cc, nMc) for (int rep_ = 0; rep_ < NREP(11); ++rep_) { pg8::Gemm gm{cc ? ACT1 : ACT0, wl + W_DN, DFF, DFF}; pg8::TileOrder S; S.init(nMc, D / 256, G, bid, -1); \
              pg8::EpiMix E{MIX, cc, rep_ + 1 < NREP(11)}; pg8::gemm_phase<pg8::EpiMix, pg8::TileOrder>(ldsl, gm, S, E); }
#define FFN_FIX(ACTc, nrows) { \
                const float* cw = SM + SM_CONVW + (size_t)l * 3 * DFF; \
                const int ngr = (nrows) / 64; \
                for (int it = gtid; it < 2 * ngr * (DFF / 4); it += gthreads) { \
                    const int f = (it % (DFF / 4)) * 4, gk = it / (DFF / 4), kind = gk / ngr, gi = gk % ngr; \
                    const int rg = gi * 64, smask = rg < FCH_LAT ? (SEQ - 1) : (CTXL - 1); \
                    const bool edge = kind ? (((rg + 63) & smask) == smask) : ((rg & smask) == 0); \
                    if (edge) continue; \
                    const float* sp = SB + ((size_t)(kind * NGRP + gi) * 3) * DFF + f; \
                    const float* np_ = SB + ((size_t)((1 - kind) * NGRP + (kind ? gi + 1 : gi - 1)) * 3 + 2) * DFF + f; \
                    const f32x4 z = *(const f32x4*)sp + *(const f32x4*)(cw + (kind ? 2 * DFF : 0) + f) * *(const f32x4*)np_; const f32x4 uu = *(const f32x4*)(sp + DFF); \
                    u32x2 ow; ow[0] = cvtpk(silu_f(z[0]) * uu[0], silu_f(z[1]) * uu[1]); ow[1] = cvtpk(silu_f(z[2]) * uu[2], silu_f(z[3]) * uu[3]); \
                    *(u32x2*)((ACTc) + (size_t)(rg + (kind ? 63 : 0)) * DFF + f) = ow; } }
        {
            const int nM0 = last ? 64 : 68, rows0 = last ? FCH_LAT : FCH_ROWS;
            const int skn = last ? 0 : 32;
            PH_BEGIN(8)
            FFN_UP(0, nM0, 0, 0)
            PH_END
            PH_BEGIN(9)
            FFN_FIX(ACT0, rows0)
            PH_END
            PH_BEGIN(10)
            FFN_DOWN(0, nM0)
            FFN_UP(1, 64, skn, 8)
            PH_END
            PH_BEGIN(11)
            FFN_FIX(ACT1, FCH_LAT)
            PH_END
            PH_BEGIN(12)
            FFN_DOWN(1, 64)
            PH_END
        }
#undef FFN_UP
#undef FFN_DOWN
#undef FFN_FIX

        PH_BEGIN(13)
        { const float* modn = MOD + (size_t)(last ? l : l + 1) * 5 * MODW;
          ln_phase(XH, MIX, last ? p.out : (float*)nullptr, XH, last ? (bf16_t*)nullptr : H, SM + SM_LN2G + l * D, SM + SM_LN2B + l * D, modl + 5 * D, modn + D, modn, last ? NLAT : NROWS, bid, G, lds); }
        PH_END
    }
#undef PH_BEGIN
#undef PH_END
}

constexpr int N_PHASES = 2 + DEPTH * 12;

extern "C" void kernel_launch(void* const* d_in, const int* in_sizes, int n_in, void* d_out, int out_size, void* d_ws, size_t ws_size, hipStream_t stream) {
    static int grid = 0;
    if (grid == 0) {
        if (n_in != 23 || in_sizes[0] != NLAT * D || out_size != NLAT * D || ws_size < WS_END) {
            fprintf(stderr, "kernel_launch: unexpected shapes: n_in %d in0 %d out %d ws %zu (need %zu)\n", n_in, n_in > 0 ? in_sizes[0] : -1, out_size, ws_size, (size_t)WS_END); grid = -1; return; }
        int dev = 0, cus = 0, per_cu = 0;
        if (hipGetDevice(&dev) != hipSuccess || hipDeviceGetAttribute(&cus, hipDeviceAttributeMultiprocessorCount, dev) != hipSuccess) { fprintf(stderr, "kernel_launch: device query failed\n"); grid = -1; return; }
        if (hipFuncSetAttribute((const void*)fwd_kernel, hipFuncAttributeMaxDynamicSharedMemorySize, LDS_BYTES) != hipSuccess) { fprintf(stderr, "kernel_launch: hipFuncSetAttribute failed\n"); grid = -1; return; }
        if (hipOccupancyMaxActiveBlocksPerMultiprocessor(&per_cu, (const void*)fwd_kernel, 512, LDS_BYTES) != hipSuccess || per_cu < 1) {
            fprintf(stderr, "kernel_launch: occupancy query reports %d workgroups per CU\n", per_cu); (void)hipGetLastError(); grid = -1; return; }
        grid = cus;
    }
    if (grid < 0) return;
    if (hipMemsetAsync((char*)d_ws + WS_CTL, 0, CTL_BYTES, stream) != hipSuccess) { fprintf(stderr, "kernel_launch: memset failed\n"); return; }
    Params p{};
    for (int i = 0; i < 23; ++i) p.in[i] = (const float*)d_in[i];
    p.out = (float*)d_out; p.ws = (unsigned char*)d_ws; p.pad = 0;
#if MK_ONE_LAUNCH
    p.ph_lo = 0; p.ph_hi = N_PHASES; p.bar_region = 0;
    hipLaunchKernelGGL(fwd_kernel, dim3(grid), dim3(512), LDS_BYTES, stream, p);
#else
    for (int g = 0; g < N_PHASES; ++g) { p.ph_lo = g; p.ph_hi = g + 1; p.bar_region = 0;
        hipLaunchKernelGGL(fwd_kernel, dim3(grid), dim3(512), LDS_BYTES, stream, p); }
#endif
    const hipError_t le = hipPeekAtLastError();
    if (le != hipSuccess) fprintf(stderr, "kernel_launch: launch failed: %s\n", hipGetErrorName(le));
}
```
